# Optimizing an MI355X kernel written in HIP

```python
import numpy as np
import jax, jax.numpy as jnp
from jax import lax

D_MODEL = 1024
BATCH = 16
SEQ = 2048
DEPTH = 2

HEAD_DIM = 64
NSA_HEADS = 8
NSA_KV_GROUPS = 2
NSA_GROUP_SIZE = NSA_HEADS // NSA_KV_GROUPS
CMP_BLOCK = 32
CMP_STRIDE = 16
CMP_HIDDEN = 128
SEL_BLOCK = 64
SEL_TOPK = 8
WINDOW = 512
NSA_Q_BLOCK = 64
FORCED_SCORE = 1e9
DIFF_HEADS = 4
DIFF_Q_BLOCK = 128
MOE_GROUPS = 4
EXPERTS_PER_GROUP = 4
N_EXPERTS = MOE_GROUPS * EXPERTS_PER_GROUP
MOE_TOPK = 2
EXPERT_FF = D_MODEL // 8

RMS_EPS = 1e-6
SUBLN_EPS = 1e-5
NEG_INF = -1e30
N_ALIBI_HEADS = NSA_HEADS + DIFF_HEADS

NSA_Q_COLS = NSA_HEADS * HEAD_DIM
NSA_KV_COLS = NSA_KV_GROUPS * HEAD_DIM
NSA_GATE_COLS = 3 * NSA_HEADS
DIFF_QK_COLS = DIFF_HEADS * 2 * HEAD_DIM
DIFF_V_COLS = DIFF_HEADS * 2 * HEAD_DIM
IN_COLS = NSA_Q_COLS + 6 * NSA_KV_COLS + NSA_GATE_COLS + 2 * DIFF_QK_COLS + DIFF_V_COLS + 2 * D_MODEL

kernel_name = 'hybrid_nsa_diffattn_hier_moe'


def rms_norm(x, g, eps=RMS_EPS):
    xf = x.astype(jnp.float32)
    y = xf * lax.rsqrt(jnp.mean(xf * xf, axis=-1, keepdims=True) + eps)
    return (y * g.astype(jnp.float32)).astype(x.dtype)


def alibi_slopes():
    s = 2.0 ** (-8.0 * np.arange(1, N_ALIBI_HEADS + 1) / N_ALIBI_HEADS)
    return jnp.asarray(s, dtype=jnp.float32)


def masked_softmax(s, mask):
    return jax.nn.softmax(jnp.where(mask, s, NEG_INF), axis=-1)


def split_points():
    sizes = [NSA_Q_COLS] + [NSA_KV_COLS] * 6 + [NSA_GATE_COLS, DIFF_QK_COLS, DIFF_QK_COLS, DIFF_V_COLS, D_MODEL, D_MODEL]
    return [int(v) for v in np.cumsum(sizes)[:-1]]


def compress_tokens(kv, pe, w1, b1, w2, b2):
    B, T, G, HD = kv.shape
    nc = (T - CMP_BLOCK) // CMP_STRIDE + 1
    idx = np.arange(nc)[:, None] * CMP_STRIDE + np.arange(CMP_BLOCK)[None, :]
    blk = kv[:, idx] + pe[:, None, :]
    blk = jnp.swapaxes(blk, 2, 3).reshape(B, nc, G, CMP_BLOCK * HD)
    h = jax.nn.gelu(blk @ w1 + b1)
    return h @ w2 + b2


def cmp_to_sel_matrix(nc, nb):
    c0 = np.arange(nc)[:, None] * CMP_STRIDE
    s0 = np.arange(nb)[None, :] * SEL_BLOCK
    ov = np.maximum(0, np.minimum(c0 + CMP_BLOCK, s0 + SEL_BLOCK) - np.maximum(c0, s0))
    return jnp.asarray(ov / CMP_BLOCK, dtype=jnp.float32)


def nsa_attention(q, kc, vc, ks, vs, kw, vw, gate_logits, slopes):
    B, T = q.shape[0], q.shape[1]
    dt = q.dtype
    G, Hg, HD, QB = NSA_KV_GROUPS, NSA_GROUP_SIZE, HEAD_DIM, NSA_Q_BLOCK
    nc = kc.shape[1]
    nb = T // SEL_BLOCK
    k_sel = min(SEL_TOPK, nb)
    n_chunks = T // QB
    scale = HD ** -0.5
    sl = slopes.reshape(G, Hg)[None, :, :, None, None]
    cmp_end = jnp.arange(nc) * CMP_STRIDE + CMP_BLOCK - 1
    a_sel = cmp_to_sel_matrix(nc, nb)
    blk_start = jnp.arange(nb) * SEL_BLOCK
    blk_ids = jnp.arange(nb)
    ks_b = ks.reshape(B, nb, SEL_BLOCK, G, HD).transpose(0, 3, 1, 2, 4)
    vs_b = vs.reshape(B, nb, SEL_BLOCK, G, HD).transpose(0, 3, 1, 2, 4)
    kw_p = jnp.pad(kw, ((0, 0), (WINDOW, 0), (0, 0), (0, 0)))
    vw_p = jnp.pad(vw, ((0, 0), (WINDOW, 0), (0, 0), (0, 0)))
    bi = jnp.arange(B)[:, None, None, None]
    gi = jnp.arange(G)[None, :, None, None]
    qs = q.reshape(B, n_chunks, QB, G, Hg, HD).swapaxes(0, 1)
    gs = jax.nn.sigmoid(gate_logits.astype(jnp.float32)).astype(dt)
    gs = gs.reshape(B, n_chunks, QB, G, Hg, 3).swapaxes(0, 1)
    starts = jnp.arange(n_chunks, dtype=jnp.int32) * QB

    def chunk(args):
        qc, gc, start = args
        t = start + jnp.arange(QB)
        s = jnp.einsum('bqghd,bngd->bghqn', qc, kc).astype(jnp.float32) * scale
        dist = (t[:, None] - cmp_end[None, :]).astype(jnp.float32)
        valid = cmp_end[None, :] <= t[:, None]
        p_cmp = masked_softmax(s - sl * dist, valid) * jnp.any(valid, axis=-1)[:, None].astype(jnp.float32)
        o_cmp = jnp.einsum('bghqn,bngd->bqghd', p_cmp.astype(dt), vc)
        imp = jnp.einsum('bghqn,nm->bgqm', p_cmp, a_sel)
        cur = t // SEL_BLOCK
        forced = (blk_ids[None, :] == 0) | (blk_ids[None, :] == cur[:, None]) | (blk_ids[None, :] == cur[:, None] - 1)
        imp = jnp.where(forced, FORCED_SCORE, imp)
        imp = jnp.where(blk_start[None, :] <= t[:, None], imp, -1.0)
        _, idx = lax.top_k(imp, k_sel)
        kg = ks_b[bi, gi, idx].reshape(B, G, QB, k_sel * SEL_BLOCK, HD)
        vg = vs_b[bi, gi, idx].reshape(B, G, QB, k_sel * SEL_BLOCK, HD)
        tok = (idx[..., None] * SEL_BLOCK + jnp.arange(SEL_BLOCK)).reshape(B, G, QB, k_sel * SEL_BLOCK)
        s = jnp.einsum('bqghd,bgqld->bghql', qc, kg).astype(jnp.float32) * scale
        dist = (t[:, None] - tok).astype(jnp.float32)[:, :, None]
        p_sel = masked_softmax(s - sl * dist, (tok <= t[:, None])[:, :, None])
        o_sel = jnp.einsum('bghql,bgqld->bqghd', p_sel.astype(dt), vg)
        kwc = lax.dynamic_slice_in_dim(kw_p, start, QB + WINDOW, axis=1)
        vwc = lax.dynamic_slice_in_dim(vw_p, start, QB + WINDOW, axis=1)
        kpos = start - WINDOW + jnp.arange(QB + WINDOW)
        s = jnp.einsum('bqghd,bkgd->bghqk', qc, kwc).astype(jnp.float32) * scale
        d_i = t[:, None] - kpos[None, :]
        valid = (d_i >= 0) & (d_i < WINDOW) & (kpos[None, :] >= 0)
        p_win = masked_softmax(s - sl * d_i.astype(jnp.float32), valid)
        o_win = jnp.einsum('bghqk,bkgd->bqghd', p_win.astype(dt), vwc)
        return gc[..., 0:1] * o_cmp + gc[..., 1:2] * o_sel + gc[..., 2:3] * o_win

    out = lax.map(chunk, (qs, gs, starts))
    return out.swapaxes(0, 1).reshape(B, T, NSA_HEADS * HEAD_DIM)


def diff_attention(q, k, v, lam, lam_init, subln_g, slopes):
    B, T = q.shape[0], q.shape[1]
    dt = q.dtype
    QB = DIFF_Q_BLOCK
    n_chunks = T // QB
    scale = HEAD_DIM ** -0.5
    sl = slopes[None, :, None, None, None]
    kpos = jnp.arange(T)
    qs = q.reshape(B, n_chunks, QB, DIFF_HEADS, 2, HEAD_DIM).swapaxes(0, 1)
    starts = jnp.arange(n_chunks, dtype=jnp.int32) * QB

    def chunk(args):
        qc, start = args
        t = start + jnp.arange(QB)
        s = jnp.einsum('bqhcd,bkhcd->bhcqk', qc, k).astype(jnp.float32) * scale
        d_i = t[:, None] - kpos[None, :]
        p = masked_softmax(s - sl * d_i.astype(jnp.float32), d_i >= 0)
        a = p[:, :, 0] - lam * p[:, :, 1]
        return jnp.einsum('bhqk,bkhe->bqhe', a.astype(dt), v)

    o = lax.map(chunk, (qs, starts)).swapaxes(0, 1).reshape(B, T, DIFF_HEADS, 2 * HEAD_DIM)
    o = rms_norm(o, subln_g, SUBLN_EPS) * (1.0 - lam_init)
    return o.reshape(B, T, DIFF_HEADS * 2 * HEAD_DIM)


def hier_moe(x, wg, bg, we, be, w_gate, w_up, w_down):
    B, T, D = x.shape
    dt = x.dtype
    xf = x.reshape(B * T, D)
    g_logits = (xf @ wg).astype(jnp.float32) + bg.astype(jnp.float32)
    g_prob = jax.nn.softmax(g_logits, axis=-1)
    g_idx = jnp.argmax(g_logits, axis=-1)
    g_w = jnp.take_along_axis(g_prob, g_idx[:, None], axis=1)
    e_logits = jnp.einsum('nd,dge->nge', xf, we).astype(jnp.float32) + be.astype(jnp.float32)
    e_logits = jnp.take_along_axis(e_logits, g_idx[:, None, None], axis=1)[:, 0]
    top_v, top_i = lax.top_k(e_logits, MOE_TOPK)
    top_w = jax.nn.softmax(top_v, axis=-1) * g_w
    combine = jnp.einsum('ng,nke->nge', jax.nn.one_hot(g_idx, MOE_GROUPS),
                         jax.nn.one_hot(top_i, EXPERTS_PER_GROUP) * top_w[..., None])
    combine = combine.reshape(B * T, N_EXPERTS).astype(dt)
    h = jax.nn.silu(jnp.einsum('nd,edf->nef', xf, w_gate)) * jnp.einsum('nd,edf->nef', xf, w_up)
    y = jnp.einsum('nef,efd->nd', h * combine[:, :, None], w_down)
    return y.reshape(B, T, D)


def setup_inputs(seed: int = 0) -> dict:
    key = jax.random.key(seed)
    ks = jax.random.split(key, 24)
    D, L, HD = D_MODEL, DEPTH, HEAD_DIM

    def nrm(k, shape, scale):
        return jax.random.normal(k, shape, jnp.float32) * scale

    def gain(k, shape):
        return 1.0 + 0.02 * jax.random.normal(k, shape, jnp.float32)

    return {
        'x': nrm(ks[0], (BATCH, SEQ, D), 1.0),
        'norm1_g': gain(ks[1], (L, D)),
        'w_in': nrm(ks[2], (L, D, IN_COLS), D ** -0.5),
        'cmp_pe': nrm(ks[3], (L, 2, CMP_BLOCK, HD), 0.02),
        'cmp_w1': nrm(ks[4], (L, 2, CMP_BLOCK * HD, CMP_HIDDEN), (CMP_BLOCK * HD) ** -0.5),
        'cmp_b1': nrm(ks[5], (L, 2, CMP_HIDDEN), 0.02),
        'cmp_w2': nrm(ks[6], (L, 2, CMP_HIDDEN, HD), CMP_HIDDEN ** -0.5),
        'cmp_b2': nrm(ks[7], (L, 2, HD), 0.02),
        'diff_lambda': nrm(ks[8], (L, 4, HD), 0.1),
        'diff_subln_g': gain(ks[9], (L, 2 * HD)),
        'w_branch_a': nrm(ks[10], (L, NSA_HEADS * HD, D), (NSA_HEADS * HD) ** -0.5),
        'w_branch_b': nrm(ks[11], (L, DIFF_HEADS * 2 * HD, D), (DIFF_HEADS * 2 * HD) ** -0.5),
        'w_out': nrm(ks[12], (L, D, D), D ** -0.5),
        'norm2_g': gain(ks[13], (L, D)),
        'router_grp_w': nrm(ks[14], (L, D, MOE_GROUPS), D ** -0.5),
        'router_grp_b': nrm(ks[15], (L, MOE_GROUPS), 0.01),
        'router_exp_w': nrm(ks[16], (L, D, MOE_GROUPS, EXPERTS_PER_GROUP), D ** -0.5),
        'router_exp_b': nrm(ks[17], (L, MOE_GROUPS, EXPERTS_PER_GROUP), 0.01),
        'exp_w_gate': nrm(ks[18], (L, N_EXPERTS, D, EXPERT_FF), D ** -0.5),
        'exp_w_up': nrm(ks[19], (L, N_EXPERTS, D, EXPERT_FF), D ** -0.5),
        'exp_w_down': nrm(ks[20], (L, N_EXPERTS, EXPERT_FF, D), EXPERT_FF ** -0.5),
        'final_norm_g': gain(ks[21], (D,)),
    }


def reference(x, norm1_g, w_in, cmp_pe, cmp_w1, cmp_b1, cmp_w2, cmp_b2, diff_lambda, diff_subln_g,
              w_branch_a, w_branch_b, w_out, norm2_g, router_grp_w, router_grp_b, router_exp_w,
              router_exp_b, exp_w_gate, exp_w_up, exp_w_down, final_norm_g):
    B, T, _ = x.shape
    slopes = alibi_slopes()
    sl_nsa, sl_diff = slopes[:NSA_HEADS], slopes[NSA_HEADS:]
    cuts = split_points()
    G, HD = NSA_KV_GROUPS, HEAD_DIM
    h = x
    for l in range(DEPTH):
        xn = rms_norm(h, norm1_g[l])
        proj = xn @ w_in[l]
        (nq, kc_r, vc_r, ks_r, vs_r, kw_r, vw_r, ngate, dq, dk, dv, gate_a, gate_b) = jnp.split(proj, cuts, axis=-1)
        kc = compress_tokens(kc_r.reshape(B, T, G, HD), cmp_pe[l, 0], cmp_w1[l, 0], cmp_b1[l, 0], cmp_w2[l, 0], cmp_b2[l, 0])
        vc = compress_tokens(vc_r.reshape(B, T, G, HD), cmp_pe[l, 1], cmp_w1[l, 1], cmp_b1[l, 1], cmp_w2[l, 1], cmp_b2[l, 1])
        y_a = nsa_attention(nq.reshape(B, T, NSA_HEADS, HD), kc, vc,
                            ks_r.reshape(B, T, G, HD), vs_r.reshape(B, T, G, HD),
                            kw_r.reshape(B, T, G, HD), vw_r.reshape(B, T, G, HD),
                            ngate.reshape(B, T, NSA_HEADS, 3), sl_nsa)
        lam_init = 0.8 - 0.6 * float(np.exp(-0.3 * l))
        lp = diff_lambda[l].astype(jnp.float32)
        lam = jnp.exp(jnp.sum(lp[0] * lp[1])) - jnp.exp(jnp.sum(lp[2] * lp[3])) + lam_init
        y_b = diff_attention(dq.reshape(B, T, DIFF_HEADS, 2, HD), dk.reshape(B, T, DIFF_HEADS, 2, HD),
                             dv.reshape(B, T, DIFF_HEADS, 2 * HD), lam, lam_init, diff_subln_g[l], sl_diff)
        merged = jax.nn.sigmoid(gate_a) * (y_a @ w_branch_a[l]) + jax.nn.sigmoid(gate_b) * (y_b @ w_branch_b[l])
        h = h + merged @ w_out[l]
        h = h + hier_moe(rms_norm(h, norm2_g[l]), router_grp_w[l], router_grp_b[l], router_exp_w[l],
                         router_exp_b[l], exp_w_gate[l], exp_w_up[l], exp_w_down[l])
    return rms_norm(h, final_norm_g)
```

```cpp
#include <hip/hip_runtime.h>
#include <hip/hip_cooperative_groups.h>
#include <cstdio>
#include <cstdint>
namespace cg = cooperative_groups;

#ifndef MK_MULTI
#define MK_MULTI 0
#endif

#define LAS __attribute__((address_space(3)))
typedef unsigned short bf16_t;
typedef short bf16x8 __attribute__((ext_vector_type(8)));
typedef short s16x4 __attribute__((ext_vector_type(4)));
typedef float f32x2 __attribute__((ext_vector_type(2)));
typedef float f32x4 __attribute__((ext_vector_type(4)));
typedef float f32x16 __attribute__((ext_vector_type(16)));
typedef unsigned u32x2 __attribute__((ext_vector_type(2)));
typedef unsigned u32x4 __attribute__((ext_vector_type(4)));
typedef __bf16 bf16x2_t __attribute__((ext_vector_type(2)));

constexpr int NTOK = 32768, DM = 1024, TSEQ = 2048, NBATCH = 16, DEPTH = 2;
constexpr int INCOLS = 4888, NPAD = 5120;
constexpr float LOG2E = 1.4426950408889634f;
constexpr float QSCALE = 0.125f * LOG2E;
constexpr int NPHASE = 1 + 9 * DEPTH;

constexpr size_t MiB = 1u << 20;
constexpr size_t WS_CTL = 0, CTL_BYTES = 65536;
constexpr size_t WS_WIN = 1 * MiB;
constexpr size_t WS_WA = 21 * MiB;
constexpr size_t WS_WB = 23 * MiB;
constexpr size_t WS_WO = 25 * MiB;
constexpr size_t WS_WC1 = 29 * MiB;
constexpr size_t WS_WGU = 31 * MiB;
constexpr size_t WS_WD = 47 * MiB;
constexpr size_t WS_MISC = 55 * MiB;
constexpr size_t WS_LIST = 58 * MiB;
constexpr size_t WS_WL = 60 * MiB;
constexpr size_t WS_XN = 64 * MiB;
constexpr size_t WS_NQ = 128 * MiB;
constexpr size_t WS_KV6 = 160 * MiB;
constexpr size_t WS_NG = 208 * MiB;
constexpr size_t WS_DQ = 210 * MiB;
constexpr size_t WS_DK = 242 * MiB;
constexpr size_t WS_DV = 274 * MiB;
constexpr size_t WS_GA = 306 * MiB;
constexpr size_t WS_GB = 370 * MiB;
constexpr size_t WS_END = 434 * MiB;
constexpr size_t WS_H = WS_DK;
constexpr int CW_QCTR = 64;
constexpr int CW_ECNT = 1024;

constexpr int LDS_BYTES = 147456;
constexpr int LDS_MISC = 131072;

struct Params {
    const float* x; const float* norm1_g; const float* w_in; const float* cmp_pe; const float* cmp_w1; const float* cmp_b1; const float* cmp_w2; const float* cmp_b2;
    const float* diff_lambda; const float* diff_subln_g; const float* w_branch_a; const float* w_branch_b; const float* w_out; const float* norm2_g;
    const float* router_grp_w; const float* router_grp_b; const float* router_exp_w; const float* router_exp_b; const float* exp_w_gate; const float* exp_w_up; const float* exp_w_down; const float* final_norm_g;
    float* out; unsigned char* ws; int ph_lo, ph_hi;
};

__device__ __forceinline__ unsigned cvtpk(float lo, float hi) { f32x2 v = {lo, hi}; bf16x2_t b = __builtin_convertvector(v, bf16x2_t); return __builtin_bit_cast(unsigned, b); }
__device__ __forceinline__ float bflo(unsigned u) { return __uint_as_float(u << 16); }
__device__ __forceinline__ float bfhi(unsigned u) { return __uint_as_float(u & 0xffff0000u); }
__device__ __forceinline__ float bf1(bf16_t b) { return __uint_as_float(((unsigned)b) << 16); }
__device__ __forceinline__ bf16_t f2bf(float f) { return (bf16_t)(cvtpk(f, 0.f) & 0xffffu); }
__device__ __forceinline__ int crow(int r, int hi) { return (r & 3) + 8 * (r >> 2) + 4 * hi; }
__device__ __forceinline__ float wave_sum(float v) {
#pragma unroll
    for (int o = 1; o < 64; o <<= 1) v += __shfl_xor(v, o);
    return v;
}
__device__ __forceinline__ float sigm(float x) { return 1.f / (1.f + __expf(-x)); }
__device__ __forceinline__ float ex2(float x) { return __builtin_amdgcn_exp2f(x); }
__device__ __forceinline__ float alibi_slope(int i  ) { return exp2f(-8.0f * (float)i / 12.0f); }
__device__ __forceinline__ s16x4 vtr(LAS const unsigned char* p) { return __builtin_bit_cast(s16x4, __builtin_amdgcn_ds_read_tr16_b64_v4i16((LAS s16x4*)p)); }
#define MFMA32(a, b, c) __builtin_amdgcn_mfma_f32_32x32x16_bf16(a, b, c, 0, 0, 0)
#define MFMA16(a, b, c) __builtin_amdgcn_mfma_f32_16x16x32_bf16(a, b, c, 0, 0, 0)

struct ARowLin { const char* base; size_t stride; __device__ __forceinline__ const char* operator()(int r) const { return base + (size_t)r * stride; } };
struct ARowGather { const unsigned* list; int n; const char* xn; __device__ __forceinline__ const char* operator()(int r) const { const int i = r < n ? r : n - 1; return xn + (size_t)(list[i] >> 1) * 2048; } };

template <class ARow>
__device__ __forceinline__ void sg_kloop(f32x4 (&acc)[2][4], const ARow& arow, int kstepA, const bf16_t* Bt, int ldb, int nt, LAS unsigned char* lds) {
    int tid_ = threadIdx.x; asm volatile("" : "+v"(tid_));
    const int tid = tid_, lane = tid & 63, wid = tid >> 6, wr = wid >> 1, wc = wid & 1, fr = lane & 15, fq = lane >> 4;
    const int lrow = tid >> 3, lch = tid & 7;
    const char* pa0 = arow(lrow) + lch * 16; const char* pa1 = arow(lrow + 64) + lch * 16;
    const char* pb0 = (const char*)(Bt + (size_t)lrow * ldb) + lch * 16; const char* pb1 = (const char*)(Bt + (size_t)(lrow + 64) * ldb) + lch * 16;
    const int wofs0 = lrow * 128 + ((lch ^ ((lrow >> 1) & 7)) << 4), wofs1 = wofs0 + 64 * 128;
    u32x4 ra0 = *(const u32x4*)pa0, ra1 = *(const u32x4*)pa1, rb0 = *(const u32x4*)pb0, rb1 = *(const u32x4*)pb1;
    for (int t = 0; t < nt; ++t) {
        __syncthreads();
        *(LAS u32x4*)(lds + wofs0) = ra0; *(LAS u32x4*)(lds + wofs1) = ra1; *(LAS u32x4*)(lds + 16384 + wofs0) = rb0; *(LAS u32x4*)(lds + 16384 + wofs1) = rb1;
        __syncthreads();
        if (t + 1 < nt) { pa0 += kstepA; pa1 += kstepA; pb0 += 128; pb1 += 128; ra0 = *(const u32x4*)pa0; ra1 = *(const u32x4*)pa1; rb0 = *(const u32x4*)pb0; rb1 = *(const u32x4*)pb1; }
#pragma unroll
        for (int ks = 0; ks < 2; ++ks) {
            bf16x8 af[2], bfr[4];
            const int ch = ks * 4 + fq;
#pragma unroll
            for (int m = 0; m < 2; ++m) { const int row = wr * 32 + m * 16 + fr; af[m] = *(LAS const bf16x8*)(lds + row * 128 + ((ch ^ ((row >> 1) & 7)) << 4)); }
#pragma unroll
            for (int n = 0; n < 4; ++n) { const int row = wc * 64 + n * 16 + fr; bfr[n] = *(LAS const bf16x8*)(lds + 16384 + row * 128 + ((ch ^ ((row >> 1) & 7)) << 4)); }
#pragma unroll
            for (int m = 0; m < 2; ++m)
#pragma unroll
                for (int n = 0; n < 4; ++n) acc[m][n] = MFMA16(bfr[n], af[m], acc[m][n]);
        }
    }
}
#define SG_ZERO(acc) do { _Pragma("unroll") for (int m_ = 0; m_ < 2; ++m_) _Pragma("unroll") for (int n_ = 0; n_ < 4; ++n_) acc[m_][n_] = (f32x4){0.f, 0.f, 0.f, 0.f}; } while (0)
#define SG_IDS int tid_ = threadIdx.x; asm volatile("" : "+v"(tid_)); const int tid = tid_, lane = tid & 63, wid = tid >> 6, wr = wid >> 1, wc = wid & 1, fr = lane & 15, fq = lane >> 4; (void)tid; (void)lane; (void)wid;
#define SG_ROW(m) (wr * 32 + (m) * 16 + fr)
#define SG_COL(n) (wc * 64 + (n) * 16 + 4 * fq)
__device__ __forceinline__ void st4bf(bf16_t* dst, f32x4 v) { u32x2 w; w.x = cvtpk(v[0], v[1]); w.y = cvtpk(v[2], v[3]); *(u32x2*)dst = w; }

__device__ __forceinline__ void transpose_item(const float* W, int ldw, int src_col, int valid, bf16_t* WT, int K, int dst_row, int k0, LAS float* scr, int lane) {
#pragma unroll 8
    for (int i = 0; i < 32; ++i) { const int kk = 2 * i + (lane >> 5), c = lane & 31; scr[kk * 33 + c] = (c < valid) ? W[(size_t)(k0 + kk) * ldw + src_col + c] : 0.f; }
    asm volatile("s_waitcnt lgkmcnt(0)" ::: "memory");
    const int c = lane & 7;
#pragma unroll
    for (int j = 0; j < 4; ++j) { const int n = (lane >> 3) + 8 * j; LAS const float* s = scr + (8 * c) * 33 + n;
        u32x4 o; o.x = cvtpk(s[0 * 33], s[1 * 33]); o.y = cvtpk(s[2 * 33], s[3 * 33]); o.z = cvtpk(s[4 * 33], s[5 * 33]); o.w = cvtpk(s[6 * 33], s[7 * 33]);
        *(u32x4*)(WT + (size_t)(dst_row + n) * K + k0 + 8 * c) = o; }
    asm volatile("s_waitcnt lgkmcnt(0)" ::: "memory");
}
__device__ __forceinline__ void norm_row_bf16(const float* xrow, const float* g, bf16_t* orow, int lane) {
    f32x4 v[4]; float s = 0.f;
#pragma unroll
    for (int j = 0; j < 4; ++j) { v[j] = *(const f32x4*)(xrow + (64 * j + lane) * 4); s += (v[j][0] * v[j][0] + v[j][1] * v[j][1]) + (v[j][2] * v[j][2] + v[j][3] * v[j][3]); }
    const float rstd = rsqrtf(wave_sum(s) * (1.f / 1024.f) + 1e-6f);
#pragma unroll
    for (int j = 0; j < 4; ++j) { const f32x4 gg = *(const f32x4*)(g + (64 * j + lane) * 4); f32x4 o = v[j] * rstd * gg; st4bf(orow + (64 * j + lane) * 4, o); }
}

__device__ __forceinline__ void phase_prologue(const Params& p, LAS unsigned char* lds) {
    int tid_ = threadIdx.x; asm volatile("" : "+v"(tid_));
    const int tid = tid_, lane = tid & 63, wid = tid >> 6;
    const int gw = blockIdx.x * 8 + wid, NGW = gridDim.x * 8;
    LAS float* scr = (LAS float*)(lds + wid * 8448);
    unsigned char* ws = p.ws;
    constexpr int I_IN = 16 * 160, I_A = 8 * 32, I_O = 16 * 32, I_C1 = 2 * 32 * 4, I_G = 16 * 16 * 4, I_D = 16 * 2 * 32;
    constexpr int I_LAYER = I_IN + 2 * I_A + I_O + I_C1 + 2 * I_G + I_D;
    for (int it = gw; it < DEPTH * I_LAYER; it += NGW) {
        const int l = it / I_LAYER; int r = it % I_LAYER;
        if (r < I_IN) { const int kb = r / 160, nb = r % 160, n0 = nb * 32; int src, valid = 32;
            if (n0 < 1280) src = n0; else if (n0 < 4864) src = n0 + 24; else { src = 1280 + (n0 - 4864); valid = (n0 == 4864) ? 24 : 0; if (valid == 0) src = 0; }
            transpose_item(p.w_in + (size_t)l * DM * INCOLS, INCOLS, src, valid, (bf16_t*)(ws + WS_WIN) + (size_t)l * NPAD * DM, DM, n0, kb * 64, scr, lane); continue; }
        r -= I_IN;
        if (r < I_A) { const int kb = r / 32, nb = r % 32; transpose_item(p.w_branch_a + (size_t)l * 512 * DM, DM, nb * 32, 32, (bf16_t*)(ws + WS_WA) + (size_t)l * DM * 512, 512, nb * 32, kb * 64, scr, lane); continue; }
        r -= I_A;
        if (r < I_A) { const int kb = r / 32, nb = r % 32; transpose_item(p.w_branch_b + (size_t)l * 512 * DM, DM, nb * 32, 32, (bf16_t*)(ws + WS_WB) + (size_t)l * DM * 512, 512, nb * 32, kb * 64, scr, lane); continue; }
        r -= I_A;
        if (r < I_O) { const int kb = r / 32, nb = r % 32; transpose_item(p.w_out + (size_t)l * DM * DM, DM, nb * 32, 32, (bf16_t*)(ws + WS_WO) + (size_t)l * DM * DM, DM, nb * 32, kb * 64, scr, lane); continue; }
        r -= I_O;
        if (r < I_C1) { const int kv = r / 128, r2 = r % 128, kb = r2 / 4, nb = r2 % 4;
            transpose_item(p.cmp_w1 + (size_t)(l * 2 + kv) * 2048 * 128, 128, nb * 32, 32, (bf16_t*)(ws + WS_WC1) + (size_t)(l * 2 + kv) * 128 * 2048, 2048, nb * 32, kb * 64, scr, lane); continue; }
        r -= I_C1;
        if (r < 2 * I_G) { const int which = r / I_G, r2 = r % I_G, e = r2 / 64, r3 = r2 % 64, kb = r3 / 4, nb = r3 % 4;
            const float* W = (which ? p.exp_w_up : p.exp_w_gate) + (size_t)(l * 16 + e) * DM * 128;
            transpose_item(W, 128, nb * 32, 32, (bf16_t*)(ws + WS_WGU) + (size_t)(l * 16 + e) * 256 * DM, DM, which * 128 + nb * 32, kb * 64, scr, lane); continue; }
        r -= 2 * I_G;
        { const int e = r / 64, r3 = r % 64, kb = r3 / 32, nb = r3 % 32;
            transpose_item(p.exp_w_down + (size_t)(l * 16 + e) * 128 * DM, DM, nb * 32, 32, (bf16_t*)(ws + WS_WD) + (size_t)(l * 16 + e) * DM * 128, 128, nb * 32, kb * 64, scr, lane); }
    }
    for (int m = gw; m < NTOK; m += NGW) norm_row_bf16(p.x + (size_t)m * DM, p.norm1_g, (bf16_t*)(ws + WS_XN) + (size_t)m * DM, lane);
    __syncthreads();
    if (blockIdx.x < 8) {
        const int l = blockIdx.x >> 2, kv = (blockIdx.x >> 1) & 1, jh = blockIdx.x & 1, j = jh * 64 + lane;
        const float* pe = p.cmp_pe + (size_t)(l * 2 + kv) * 2048; const float* w1 = p.cmp_w1 + (size_t)(l * 2 + kv) * 2048 * 128;
        float s = 0.f;
        for (int f = wid * 256; f < wid * 256 + 256; ++f) s += pe[f] * w1[(size_t)f * 128 + j];
        LAS float* part = (LAS float*)(lds + 70000);
        part[wid * 64 + lane] = s;
        __syncthreads();
        if (wid == 0) { float t = p.cmp_b1[(l * 2 + kv) * 128 + j];
#pragma unroll
            for (int w = 0; w < 8; ++w) t += part[w * 64 + lane];
            ((float*)(ws + WS_MISC))[(l * 2 + kv) * 128 + j] = t; }
    }
    if (blockIdx.x == 8 && wid < DEPTH) {
        const int l = wid; const float* lp = p.diff_lambda + l * 256;
        const float a = wave_sum(lp[lane] * lp[64 + lane]), b = wave_sum(lp[128 + lane] * lp[192 + lane]);
        const float lam_init = 0.8f - 0.6f * expf(-0.3f * (float)l);
        if (lane == 0) ((float*)(ws + WS_MISC + 4096))[l] = expf(a) - expf(b) + lam_init;
    }
}

__device__ __forceinline__ void phase_inproj(const Params& p, int l, LAS unsigned char* lds) {
    SG_IDS
    unsigned char* ws = p.ws;
    const bf16_t* XN = (const bf16_t*)(ws + WS_XN); const bf16_t* W = (const bf16_t*)(ws + WS_WIN) + (size_t)l * NPAD * DM;
    constexpr int NT = 39, GRP = 16;
    for (int u = blockIdx.x; u < 256 * NT; u += gridDim.x) {
        const int grp = u / (GRP * NT), rem = u % (GRP * NT), pn = rem / GRP, pm = grp * GRP + rem % GRP;
        const int m0 = pm * 128, n0 = pn * 128;
        f32x4 acc[2][4]; SG_ZERO(acc);
        sg_kloop(acc, ARowLin{(const char*)(XN + (size_t)m0 * DM), 2048}, 128, W + (size_t)n0 * DM, DM, 16, lds);
        bf16_t* dst; int pitch, c0, mode = 0;
        if (n0 < 512) { dst = (bf16_t*)(ws + WS_NQ); pitch = 512; c0 = n0; mode = 1; }
        else if (n0 < 1280) { dst = (bf16_t*)(ws + WS_KV6); pitch = 768; c0 = n0 - 512; }
        else if (n0 < 1792) { dst = (bf16_t*)(ws + WS_DQ); pitch = 512; c0 = n0 - 1280; mode = 1; }
        else if (n0 < 2304) { dst = (bf16_t*)(ws + WS_DK); pitch = 512; c0 = n0 - 1792; }
        else if (n0 < 2816) { dst = (bf16_t*)(ws + WS_DV); pitch = 512; c0 = n0 - 2304; }
        else if (n0 < 3840) { dst = (bf16_t*)(ws + WS_GA); pitch = 1024; c0 = n0 - 2816; mode = 2; }
        else if (n0 < 4864) { dst = (bf16_t*)(ws + WS_GB); pitch = 1024; c0 = n0 - 3840; mode = 2; }
        else { dst = (bf16_t*)(ws + WS_NG); pitch = 32; c0 = 0; mode = 3; }
#pragma unroll
        for (int m = 0; m < 2; ++m)
#pragma unroll
            for (int n = 0; n < 4; ++n) {
                const int row = m0 + SG_ROW(m), col = SG_COL(n); f32x4 v = acc[m][n];
                if (mode == 1) v = v * QSCALE;
                else if (mode >= 2) { v[0] = sigm(v[0]); v[1] = sigm(v[1]); v[2] = sigm(v[2]); v[3] = sigm(v[3]); }
                if (mode != 3 || col < 32) st4bf(dst + (size_t)row * pitch + c0 + col, v);
            }
    }
}

__device__ __forceinline__ void stage_k(LAS unsigned char* kdst, const bf16_t* src  , int pitch, int tid) {
    const int row = tid & 63, ch = tid >> 6;
    *(LAS u32x4*)(kdst + ch * 1024 + row * 16) = *(const u32x4*)(src + (size_t)row * pitch + ch * 8);
}
template <int NDB> __device__ __forceinline__ void stage_v(LAS unsigned char* vdst, const bf16_t* src, int pitch, int tid) {
#pragma unroll
    for (int i = 0; i < NDB / 2; ++i) { const int pc = tid + 512 * i, pw = pc >> 6, ln = pc & 63, db = pw >> 2, rg = pw & 3;
        *(LAS u32x4*)(vdst + pw * 1024 + ln * 16) = *(const u32x4*)(src + (size_t)(16 * rg + (ln >> 2)) * pitch + db * 32 + (ln & 3) * 8); }
}
__device__ __forceinline__ void qkt(f32x16& p0, f32x16& p1, LAS const unsigned char* K, const bf16x8 (&qr)[4], int r32, int hi) {
    LAS const unsigned char* kb = K + hi * 1024 + r32 * 16;
    p0 = (f32x16){0.f}; p1 = (f32x16){0.f};
#pragma unroll
    for (int d0 = 0; d0 < 4; ++d0) {
        const bf16x8 b0 = *(LAS const bf16x8*)(kb + d0 * 2048), b1 = *(LAS const bf16x8*)(kb + d0 * 2048 + 512);
        p0 = MFMA32(b0, qr[d0], p0); p1 = MFMA32(b1, qr[d0], p1);
    }
    __builtin_amdgcn_sched_barrier(0);
}
template <int NDB> __device__ __forceinline__ void pv(f32x16 (&o)[NDB], const f32x16& p0, const f32x16& p1, LAS const unsigned char* V, int lane, int hi) {
    u32x4 pw[4];
    pw[0] = (u32x4){cvtpk(p0[0], p0[1]), cvtpk(p0[2], p0[3]), cvtpk(p0[4], p0[5]), cvtpk(p0[6], p0[7])};
    pw[1] = (u32x4){cvtpk(p0[8], p0[9]), cvtpk(p0[10], p0[11]), cvtpk(p0[12], p0[13]), cvtpk(p0[14], p0[15])};
    pw[2] = (u32x4){cvtpk(p1[0], p1[1]), cvtpk(p1[2], p1[3]), cvtpk(p1[4], p1[5]), cvtpk(p1[6], p1[7])};
    pw[3] = (u32x4){cvtpk(p1[8], p1[9]), cvtpk(p1[10], p1[11]), cvtpk(p1[12], p1[13]), cvtpk(p1[14], p1[15])};
    LAS const unsigned char* vb = V + ((lane >> 4) & 1) * 32 + (lane & 3) * 8 + (4 * hi + ((lane & 15) >> 2)) * 64;
#pragma unroll
    for (int d0 = 0; d0 < NDB; ++d0)
#pragma unroll
        for (int ks = 0; ks < 4; ++ks) {
            const s16x4 lo = vtr(vb + d0 * 4096 + ks * 1024), hh = vtr(vb + d0 * 4096 + ks * 1024 + 512);
            const bf16x8 vf = (bf16x8){lo[0], lo[1], lo[2], lo[3], hh[0], hh[1], hh[2], hh[3]};
            o[d0] = MFMA32(__builtin_bit_cast(bf16x8, pw[ks]), vf, o[d0]);
            if (ks == 3) __builtin_amdgcn_sched_barrier(0);
        }
}
constexpr float SM_THR = 6.0f;
constexpr float NEG = -1e30f;
template <int NDB> __device__ __forceinline__ void softmax_pv(f32x16& s0, f32x16& s1, float& m, float& l, f32x16 (&o)[NDB], LAS float* wsf, LAS const unsigned char* V, int lane, int r32, int hi) {
    float rm = fmaxf(s0[0], s1[0]);
#pragma unroll
    for (int r = 1; r < 16; ++r) rm = fmaxf(rm, fmaxf(s0[r], s1[r]));
    rm = fmaxf(rm, __shfl_xor(rm, 32));
    if (__any(rm > m + SM_THR)) {
        const float mn = fmaxf(m, rm), f = ex2(m - mn); l *= f; m = mn;
        if (hi == 0) wsf[r32] = f;
#pragma unroll
        for (int r = 0; r < 16; ++r) { const float fr_ = wsf[crow(r, hi)];
#pragma unroll
            for (int d = 0; d < NDB; ++d) o[d][r] *= fr_; }
    }
    float sum = 0.f;
#pragma unroll
    for (int r = 0; r < 16; ++r) { s0[r] = ex2(s0[r] - m); s1[r] = ex2(s1[r] - m); sum += s0[r] + s1[r]; }
    l += sum;
    pv<NDB>(o, s0, s1, V, lane, hi);
}

__device__ __forceinline__ float gelu_tanh(float x) { const float u = 0.7978845608f * (x + 0.044715f * x * x * x); const float e = __expf(2.f * u); return 0.5f * x * (2.f - 2.f / (1.f + e)); }

__device__ __forceinline__ void compress_unit(const Params& p, int l, int u, LAS unsigned char* lds) {
    SG_IDS
    unsigned char* ws = p.ws;
    const int kv = u >> 5, m0 = (u & 31) * 128;
    const bf16_t* KV6 = (const bf16_t*)(ws + WS_KV6);
    struct ARowC { const bf16_t* KV6; int m0, kv; __device__ __forceinline__ const char* operator()(int r) const { const int mm = m0 + r, g = mm >> 11, tok = (mm & 2047) * 16; return (const char*)(KV6 + (size_t)tok * 768 + kv * 128 + g * 64); } };
    f32x4 acc[2][4]; SG_ZERO(acc);
    sg_kloop(acc, ARowC{KV6, m0, kv}, 768 * 2, (const bf16_t*)(ws + WS_WC1) + (size_t)(l * 2 + kv) * 128 * 2048, 2048, 32, lds);
    LAS bf16_t* Ht = (LAS bf16_t*)(lds + 32768);
    LAS float* W2 = (LAS float*)(lds + 32768 + 34816);
    const float* cb1 = (const float*)(ws + WS_MISC) + (l * 2 + kv) * 128;
#pragma unroll
    for (int m = 0; m < 2; ++m)
#pragma unroll
        for (int n = 0; n < 4; ++n) { const int row = SG_ROW(m), col = SG_COL(n); const f32x4 b = *(const f32x4*)(cb1 + col); f32x4 v = acc[m][n] + b;
            u32x2 w; w.x = cvtpk(gelu_tanh(v[0]), gelu_tanh(v[1])); w.y = cvtpk(gelu_tanh(v[2]), gelu_tanh(v[3])); *(LAS u32x2*)(Ht + row * 136 + col) = w; }
    const float* w2g = p.cmp_w2 + (size_t)(l * 2 + kv) * 128 * 64;
    for (int i = tid; i < 128 * 64 / 4; i += 512) *(LAS f32x4*)(W2 + i * 4) = *(const f32x4*)(w2g + i * 4);
    __syncthreads();
    const int d = tid & 63; const float b2 = p.cmp_b2[(l * 2 + kv) * 64 + d];
    bf16_t* dstb = (bf16_t*)(ws + WS_MISC + 65536 + (size_t)kv * 524288);
    for (int i = 0; i < 16; ++i) { const int row = (tid >> 6) + 8 * i; float s = b2;
#pragma unroll 8
        for (int f = 0; f < 128; ++f) s += bf1(Ht[row * 136 + f]) * W2[f * 64 + d];
        const int mm = m0 + row, g = mm >> 11, bi = mm & 2047;
        dstb[((size_t)bi * 2 + g) * 64 + d] = f2bf(s); }
    __syncthreads();
}

__device__ __forceinline__ void diff_unit(const Params& p, int l, int u, LAS unsigned char* lds) {
    int tid_ = threadIdx.x; asm volatile("" : "+v"(tid_));
    const int tid = tid_, lane = tid & 63, r32 = lane & 31, hi = lane >> 5, wid = __builtin_amdgcn_readfirstlane(tid >> 6);
    unsigned char* ws = p.ws;
    const int c = 15 - (u >> 6), b = (u & 63) >> 2, hd = u & 3;
    const int cm = wid >> 2, qq = wid & 3, t0 = 128 * c + 32 * qq, tq = t0 + r32;
    const size_t tokb = (size_t)b * TSEQ;
    bf16_t* DQ = (bf16_t*)(ws + WS_DQ); const bf16_t* DK = (const bf16_t*)(ws + WS_DK); const bf16_t* DV = (const bf16_t*)(ws + WS_DV);
    bf16x8 qr[4];
    { const bf16_t* qp = DQ + (tokb + tq) * 512 + hd * 128 + cm * 64 + hi * 8;
#pragma unroll
      for (int d0 = 0; d0 < 4; ++d0) qr[d0] = *(const bf16x8*)(qp + d0 * 16); }
    const float sl2 = alibi_slope(9 + hd) * LOG2E;
    const float cbh = sl2 * (float)(4 * hi);
#define CB(r) fmaf(sl2, (float)(((r) & 3) + 8 * ((r) >> 2)), cbh)
    f32x16 o[4];
#pragma unroll
    for (int d = 0; d < 4; ++d) o[d] = (f32x16){0.f};
    float m = NEG, lsum = 0.f;
    LAS float* wsf = (LAS float*)(lds + LDS_MISC + 1024 + wid * 128);
    LAS unsigned char* Kt = lds; LAS unsigned char* Vt = lds + 16384;
    const int jmax_w = (t0 + 31) >> 6;
    for (int j = 2 * c + 1; j >= 0; --j) {
        __syncthreads();
        { const bf16_t* ksrc = DK + (tokb + 64 * j) * 512 + hd * 128; stage_k(Kt, ksrc, 512, tid); stage_k(Kt + 8192, ksrc + 64, 512, tid);
          stage_v<4>(Vt, DV + (tokb + 64 * j) * 512 + hd * 128, 512, tid); }
        __syncthreads();
        if (j <= jmax_w) {
            f32x16 s0, s1; qkt(s0, s1, Kt + cm * 8192, qr, r32, hi);
            const float tc = sl2 * (float)(64 * j - 128 * c);
            const bool diag = (64 * j + 63 > t0); const int lim = tq - 64 * j;
#pragma unroll
            for (int r = 0; r < 16; ++r) { s0[r] += CB(r) + tc; s1[r] += CB(r) + (tc + 32.f * sl2);
                if (diag) { if (crow(r, hi) > lim) s0[r] = NEG; if (crow(r, hi) + 32 > lim) s1[r] = NEG; } }
            softmax_pv<4>(s0, s1, m, lsum, o, wsf, Vt, lane, r32, hi);
        }
    }
    __syncthreads();
    const float lam = ((const float*)(ws + WS_MISC + 4096))[l];
    const float lam_init = 0.8f - 0.6f * expf(-0.3f * (float)l);
    const float ltot = lsum + __shfl_xor(lsum, 32);
    if (hi == 0) wsf[r32] = (cm == 0 ? 1.f : lam) / ltot;
    LAS float* X = (LAS float*)(lds + cm * 65536);
#pragma unroll
    for (int r = 0; r < 16; ++r) { const float f = wsf[crow(r, hi)]; const int q = 32 * qq + crow(r, hi);
#pragma unroll
        for (int d = 0; d < 4; ++d) X[q * 128 + d * 32 + r32] = o[d][r] * f; }
    __syncthreads();
    { const int q = tid >> 2, qt = tid & 3; LAS const float* x0 = (LAS const float*)lds + q * 128 + qt * 32; LAS const float* x1 = x0 + 16384;
      float v[32]; float ss = 0.f;
#pragma unroll
      for (int i = 0; i < 32; ++i) { v[i] = x0[i] - x1[i]; ss += v[i] * v[i]; }
      ss += __shfl_xor(ss, 1); ss += __shfl_xor(ss, 2);
      const float rstd = rsqrtf(ss * (1.f / 128.f) + 1e-5f) * (1.f - lam_init);
      const float* sg = p.diff_subln_g + l * 128 + qt * 32;
      bf16_t* dst = DQ + (tokb + 128 * c + q) * 512 + hd * 128 + qt * 32;
#pragma unroll
      for (int i = 0; i < 32; i += 8) { u32x4 w; w.x = cvtpk(v[i] * rstd * sg[i], v[i + 1] * rstd * sg[i + 1]); w.y = cvtpk(v[i + 2] * rstd * sg[i + 2], v[i + 3] * rstd * sg[i + 3]);
          w.z = cvtpk(v[i + 4] * rstd * sg[i + 4], v[i + 5] * rstd * sg[i + 5]); w.w = cvtpk(v[i + 6] * rstd * sg[i + 6], v[i + 7] * rstd * sg[i + 7]); *(u32x4*)(dst + i) = w; } }
    __syncthreads();
}

__device__ __forceinline__ void nsa_unit(const Params& p, int l, int u, LAS unsigned char* lds) {
    int tid_ = threadIdx.x; asm volatile("" : "+v"(tid_));
    const int tid = tid_, lane = tid & 63, r32 = lane & 31, hi = lane >> 5, wid = __builtin_amdgcn_readfirstlane(tid >> 6);
    unsigned char* ws = p.ws;
    const int c = 31 - (u >> 5), b = (u & 31) >> 1, g = u & 1;
    const int hl = wid >> 1, qh = wid & 1, h = g * 4 + hl, t0 = 64 * c + 32 * qh, tq = t0 + r32, ql = 32 * qh + r32;
    const size_t tokb = (size_t)b * TSEQ;
    bf16_t* NQ = (bf16_t*)(ws + WS_NQ); const bf16_t* KV6 = (const bf16_t*)(ws + WS_KV6); const bf16_t* NG = (const bf16_t*)(ws + WS_NG);
    const bf16_t* KC = (const bf16_t*)(ws + WS_MISC + 65536); const bf16_t* VC = (const bf16_t*)(ws + WS_MISC + 65536 + 524288);
    bf16x8 qr[4];
    { const bf16_t* qp = NQ + (tokb + tq) * 512 + h * 64 + hi * 8;
#pragma unroll
      for (int d0 = 0; d0 < 4; ++d0) qr[d0] = *(const bf16x8*)(qp + d0 * 16); }
    const float sl2 = alibi_slope(h + 1) * LOG2E;
    const float cbh = sl2 * (float)(4 * hi);
    LAS float* wsf = (LAS float*)(lds + LDS_MISC + 1024 + wid * 128);
    LAS unsigned char* Kt = lds; LAS unsigned char* Vt = lds + 16384;
    LAS float* IMPH = (LAS float*)(lds + 32768);
    LAS float* VAL = (LAS float*)(lds + 65536);
    LAS unsigned* MASK = (LAS unsigned*)(lds + 73728);
    const float g0 = bf1(NG[(tokb + tq) * 32 + h * 3 + 0]), g1 = bf1(NG[(tokb + tq) * 32 + h * 3 + 1]), g2 = bf1(NG[(tokb + tq) * 32 + h * 3 + 2]);
    f32x16 oacc[2];
    __syncthreads();
    { const bf16_t* ksrc = KC + ((size_t)b * 128 * 2 + g) * 64; const bf16_t* vsrc = VC + ((size_t)b * 128 * 2 + g) * 64;
      stage_k(Kt, ksrc, 128, tid); stage_k(Kt + 8192, ksrc + 64 * 128, 128, tid);
      stage_v<2>(Vt, vsrc, 128, tid); stage_v<2>(Vt + 8192, vsrc + 64 * 128, 128, tid);
      if (tid < 64) MASK[tid] = 0u; }
    __syncthreads();
    {
        f32x16 s[4];
        qkt(s[0], s[1], Kt, qr, r32, hi); qkt(s[2], s[3], Kt + 8192, qr, r32, hi);
        int nmax = (tq - 31) >> 4; if (nmax > 126) nmax = 126;
        float rm = NEG;
#pragma unroll
        for (int k = 0; k < 4; ++k)
#pragma unroll
            for (int r = 0; r < 16; ++r) { const int n = 32 * k + crow(r, hi); float v = s[k][r] + 16.f * CB(r) + sl2 * (float)(512 * k);
                v = (n <= nmax) ? v : NEG; s[k][r] = v; rm = fmaxf(rm, v); }
        rm = fmaxf(rm, __shfl_xor(rm, 32));
        float sum = 0.f;
#pragma unroll
        for (int k = 0; k < 4; ++k)
#pragma unroll
            for (int r = 0; r < 16; ++r) { const float e = ex2(s[k][r] - rm); s[k][r] = e; sum += e; }
        sum += __shfl_xor(sum, 32);
        const float inv = (nmax >= 0) ? 1.f / sum : 0.f;
#pragma unroll
        for (int k = 0; k < 4; ++k)
#pragma unroll
            for (int r = 0; r < 16; ++r) s[k][r] *= inv;
        float prev = 0.f;
#pragma unroll
        for (int k = 0; k < 4; ++k)
#pragma unroll
            for (int a = 0; a < 4; ++a) { const int i = 4 * k + a; const float Bi = 0.5f * s[k][4 * a + 3]; const float Ai = (s[k][4 * a] + s[k][4 * a + 1]) + (s[k][4 * a + 2] + Bi);
                const float rc = __shfl_xor(Bi, 32); const float add = hi ? rc : prev; prev = rc;
                IMPH[(hl * 64 + ql) * 32 + 2 * i + hi] = Ai + add; }
        f32x16 o[2]; o[0] = (f32x16){0.f}; o[1] = (f32x16){0.f};
        pv<2>(o, s[0], s[1], Vt, lane, hi); pv<2>(o, s[2], s[3], Vt + 8192, lane, hi);
        if (hi == 0) wsf[r32] = g0;
#pragma unroll
        for (int r = 0; r < 16; ++r) { const float f = wsf[crow(r, hi)]; oacc[0][r] = o[0][r] * f; oacc[1][r] = o[1][r] * f; }
        asm volatile("" : "+v"(oacc[0]), "+v"(oacc[1]));
    }
    __syncthreads();
    { const int q = tid >> 3, mg = tid & 7;
#pragma unroll
      for (int i = 0; i < 4; ++i) { const int mb = 4 * mg + i; float v = ((IMPH[(0 * 64 + q) * 32 + mb] + IMPH[(1 * 64 + q) * 32 + mb]) + IMPH[(2 * 64 + q) * 32 + mb]) + IMPH[(3 * 64 + q) * 32 + mb];
          if (mb == 0 || mb == c || mb == c - 1) v = 1e9f; if (mb > c) v = -1.f; VAL[q * 32 + mb] = v; } }
    __syncthreads();
    { const int q = tid >> 3, mg = tid & 7; unsigned bits = 0u;
      float mine[4];
#pragma unroll
      for (int i = 0; i < 4; ++i) mine[i] = VAL[q * 32 + 4 * mg + i];
      int cnt0 = 0, cnt1 = 0, cnt2 = 0, cnt3 = 0;
#pragma unroll 4
      for (int m2 = 0; m2 < 32; ++m2) { const float v2 = VAL[q * 32 + m2]; const int rel = m2 - 4 * mg;
          cnt0 += (int)(v2 > mine[0]) | ((int)(v2 == mine[0]) & (int)(rel < 0));
          cnt1 += (int)(v2 > mine[1]) | ((int)(v2 == mine[1]) & (int)(rel < 1));
          cnt2 += (int)(v2 > mine[2]) | ((int)(v2 == mine[2]) & (int)(rel < 2));
          cnt3 += (int)(v2 > mine[3]) | ((int)(v2 == mine[3]) & (int)(rel < 3)); }
      bits = ((cnt0 < 8) ? 1u : 0u) | ((cnt1 < 8) ? 2u : 0u) | ((cnt2 < 8) ? 4u : 0u) | ((cnt3 < 8) ? 8u : 0u);
      bits <<= 4 * mg;
      if (bits) __hip_atomic_fetch_or(&MASK[q], bits, __ATOMIC_RELAXED, __HIP_MEMORY_SCOPE_WORKGROUP); }
    __syncthreads();
    const unsigned vmask = (c >= 31) ? 0xffffffffu : ((2u << c) - 1u);
    if (wid == 0) { unsigned mk = MASK[lane] & vmask;
#pragma unroll
        for (int o_ = 1; o_ < 64; o_ <<= 1) mk |= __shfl_xor(mk, o_);
        if (lane == 0) MASK[64] = mk; }
    __syncthreads();
    const unsigned mymask = MASK[ql] & vmask;
    unsigned uni = __builtin_amdgcn_readfirstlane(MASK[64]);
    {
        f32x16 o[2]; o[0] = (f32x16){0.f}; o[1] = (f32x16){0.f}; float m = NEG, lsum = 0.f;
        while (uni) {
            const int j = 31 - __builtin_clz(uni); uni &= ~(1u << j);
            __syncthreads();
            stage_k(Kt, KV6 + (tokb + 64 * j) * 768 + 256 + g * 64, 768, tid); stage_v<2>(Vt, KV6 + (tokb + 64 * j) * 768 + 384 + g * 64, 768, tid);
            __syncthreads();
            const bool sel = (mymask >> j) & 1u;
            if (__any(sel)) {
                f32x16 s0, s1; qkt(s0, s1, Kt, qr, r32, hi);
                const float tc = sl2 * (float)(64 * (j - c)); const int lim = (j == c) ? ql : 64;
#pragma unroll
                for (int r = 0; r < 16; ++r) { s0[r] += CB(r) + tc; s1[r] += CB(r) + (tc + 32.f * sl2);
                    if (!sel || crow(r, hi) > lim) s0[r] = NEG; if (!sel || crow(r, hi) + 32 > lim) s1[r] = NEG; }
                softmax_pv<2>(s0, s1, m, lsum, o, wsf, Vt, lane, r32, hi);
            }
        }
        const float ltot = lsum + __shfl_xor(lsum, 32);
        if (hi == 0) wsf[r32] = g1 / ltot;
#pragma unroll
        for (int r = 0; r < 16; ++r) { const float f = wsf[crow(r, hi)]; oacc[0][r] += o[0][r] * f; oacc[1][r] += o[1][r] * f; }
        asm volatile("" : "+v"(oacc[0]), "+v"(oacc[1]));
    }
    {
        f32x16 o[2]; o[0] = (f32x16){0.f}; o[1] = (f32x16){0.f}; float m = NEG, lsum = 0.f;
        const int jlo = c - 8 < 0 ? 0 : c - 8;
        for (int j = c; j >= jlo; --j) {
            __syncthreads();
            stage_k(Kt, KV6 + (tokb + 64 * j) * 768 + 512 + g * 64, 768, tid); stage_v<2>(Vt, KV6 + (tokb + 64 * j) * 768 + 640 + g * 64, 768, tid);
            __syncthreads();
            f32x16 s0, s1; qkt(s0, s1, Kt, qr, r32, hi);
            const float tc = sl2 * (float)(64 * (j - c));
            const int lim = (j == c) ? ql : 64;
            const int low = (j == c - 8) ? ql : -1;
#pragma unroll
            for (int r = 0; r < 16; ++r) { s0[r] += CB(r) + tc; s1[r] += CB(r) + (tc + 32.f * sl2);
                const int k0 = crow(r, hi), k1 = k0 + 32;
                if (k0 > lim || k0 <= low) s0[r] = NEG; if (k1 > lim || k1 <= low) s1[r] = NEG; }
            softmax_pv<2>(s0, s1, m, lsum, o, wsf, Vt, lane, r32, hi);
        }
        const float ltot = lsum + __shfl_xor(lsum, 32);
        if (hi == 0) wsf[r32] = g2 / ltot;
#pragma unroll
        for (int r = 0; r < 16; ++r) { const float f = wsf[crow(r, hi)]; oacc[0][r] += o[0][r] * f; oacc[1][r] += o[1][r] * f; }
        asm volatile("" : "+v"(oacc[0]), "+v"(oacc[1]));
    }
#pragma unroll
    for (int r = 0; r < 16; ++r) { bf16_t* dst = NQ + (tokb + t0 + crow(r, hi)) * 512 + h * 64 + r32; dst[0] = f2bf(oacc[0][r]); dst[32] = f2bf(oacc[1][r]); }
    __syncthreads();
}

__device__ __forceinline__ int next_unit(unsigned* ctr, LAS unsigned char* lds) {
    LAS int* bc = (LAS int*)(lds + LDS_MISC);
    __syncthreads();
    if (threadIdx.x == 0) bc[0] = (int)__hip_atomic_fetch_add(ctr, 1u, __ATOMIC_RELAXED, __HIP_MEMORY_SCOPE_AGENT);
    __syncthreads();
    return __builtin_amdgcn_readfirstlane(bc[0]);
}

__device__ __forceinline__ void phase_merge(const Params& p, int l, LAS unsigned char* lds) {
    SG_IDS
    unsigned char* ws = p.ws;
    const bf16_t* YA = (const bf16_t*)(ws + WS_NQ); const bf16_t* YB = (const bf16_t*)(ws + WS_DQ);
    const bf16_t* WA = (const bf16_t*)(ws + WS_WA) + (size_t)l * DM * 512; const bf16_t* WB = (const bf16_t*)(ws + WS_WB) + (size_t)l * DM * 512;
    const bf16_t* GA = (const bf16_t*)(ws + WS_GA); const bf16_t* GB = (const bf16_t*)(ws + WS_GB); bf16_t* MG = (bf16_t*)(ws + WS_XN);
    for (int u = blockIdx.x; u < 256 * 8; u += gridDim.x) {
        const int pm = (u >> 7) * 16 + (u & 15), pn = (u >> 4) & 7, m0 = pm * 128, n0 = pn * 128;
        f32x4 acc[2][4], t[2][4]; SG_ZERO(acc);
        sg_kloop(acc, ARowLin{(const char*)(YA + (size_t)m0 * 512), 1024}, 128, WA + (size_t)n0 * 512, 512, 8, lds);
#pragma unroll
        for (int m = 0; m < 2; ++m)
#pragma unroll
            for (int n = 0; n < 4; ++n) { const u32x2 gw = *(const u32x2*)(GA + (size_t)(m0 + SG_ROW(m)) * DM + n0 + SG_COL(n));
                t[m][n] = acc[m][n] * (f32x4){bflo(gw.x), bfhi(gw.x), bflo(gw.y), bfhi(gw.y)}; }
        SG_ZERO(acc);
        sg_kloop(acc, ARowLin{(const char*)(YB + (size_t)m0 * 512), 1024}, 128, WB + (size_t)n0 * 512, 512, 8, lds);
#pragma unroll
        for (int m = 0; m < 2; ++m)
#pragma unroll
            for (int n = 0; n < 4; ++n) { const size_t off = (size_t)(m0 + SG_ROW(m)) * DM + n0 + SG_COL(n); const u32x2 gw = *(const u32x2*)(GB + off);
                st4bf(MG + off, t[m][n] + acc[m][n] * (f32x4){bflo(gw.x), bfhi(gw.x), bflo(gw.y), bfhi(gw.y)}); }
    }
}
__device__ __forceinline__ void phase_outproj(const Params& p, int l, LAS unsigned char* lds) {
    SG_IDS
    unsigned char* ws = p.ws;
    const bf16_t* MG = (const bf16_t*)(ws + WS_XN); const bf16_t* WO = (const bf16_t*)(ws + WS_WO) + (size_t)l * DM * DM;
    const float* hin = (l == 0) ? p.x : p.out; float* hout = p.out;
    for (int u = blockIdx.x; u < 256 * 8; u += gridDim.x) {
        const int pm = (u >> 7) * 16 + (u & 15), pn = (u >> 4) & 7, m0 = pm * 128, n0 = pn * 128;
        f32x4 acc[2][4]; SG_ZERO(acc);
        sg_kloop(acc, ARowLin{(const char*)(MG + (size_t)m0 * DM), 2048}, 128, WO + (size_t)n0 * DM, DM, 16, lds);
#pragma unroll
        for (int m = 0; m < 2; ++m)
#pragma unroll
            for (int n = 0; n < 4; ++n) { const size_t off = (size_t)(m0 + SG_ROW(m)) * DM + n0 + SG_COL(n); *(f32x4*)(hout + off) = *(const f32x4*)(hin + off) + acc[m][n]; }
    }
}

__device__ __forceinline__ void phase_router(const Params& p, int l, LAS unsigned char* lds) {
    int tid_ = threadIdx.x; asm volatile("" : "+v"(tid_));
    const int tid = tid_, lane = tid & 63, wid = tid >> 6;
    unsigned char* ws = p.ws;
    LAS float* RW = (LAS float*)lds;
    LAS unsigned* cntl = (LAS unsigned*)(lds + 81920);
    LAS unsigned* lbase = (LAS unsigned*)(lds + 81920 + 64);
    LAS unsigned* loc = (LAS unsigned*)(lds + 82048);
    LAS float* wloc = (LAS float*)(lds + 82048 + 16384);
    const float* gwp = p.router_grp_w + (size_t)l * DM * 4; const float* ewp = p.router_exp_w + (size_t)l * DM * 16;
    __syncthreads();
    for (int k = tid; k < DM; k += 512) {
        const f32x4 a = *(const f32x4*)(gwp + k * 4);
#pragma unroll
        for (int i = 0; i < 4; ++i) RW[i * 1024 + k] = a[i];
#pragma unroll
        for (int q4 = 0; q4 < 4; ++q4) { const f32x4 e = *(const f32x4*)(ewp + k * 16 + q4 * 4);
#pragma unroll
            for (int i = 0; i < 4; ++i) RW[(4 + q4 * 4 + i) * 1024 + k] = e[i]; }
    }
    const float* gb = p.router_grp_b + l * 4; const float* eb = p.router_exp_b + l * 16;
    const float* g2 = p.norm2_g + (size_t)l * DM;
    unsigned* ecnt = (unsigned*)(ws + WS_CTL) + CW_ECNT + 64 * l;
    unsigned* LIST = (unsigned*)(ws + WS_LIST); float* WL = (float*)(ws + WS_WL);
    bf16_t* XN = (bf16_t*)(ws + WS_XN);
    for (int ch = blockIdx.x; ch < NTOK / 128; ch += gridDim.x) {
        __syncthreads();
        if (tid < 16) cntl[tid] = 0u;
        __syncthreads();
        for (int i = 0; i < 16; ++i) {
            const int tok = ch * 128 + wid * 16 + i;
            const float* xrow = p.out + (size_t)tok * DM;
            f32x4 v[4]; float s = 0.f;
#pragma unroll
            for (int j = 0; j < 4; ++j) { v[j] = *(const f32x4*)(xrow + (64 * j + lane) * 4); s += (v[j][0] * v[j][0] + v[j][1] * v[j][1]) + (v[j][2] * v[j][2] + v[j][3] * v[j][3]); }
            const float rstd = rsqrtf(wave_sum(s) * (1.f / 1024.f) + 1e-6f);
#pragma unroll
            for (int j = 0; j < 4; ++j) { const f32x4 gg = *(const f32x4*)(g2 + (64 * j + lane) * 4); v[j] = v[j] * rstd * gg; st4bf(XN + (size_t)tok * DM + (64 * j + lane) * 4, v[j]); }
            float lg[20];
#pragma unroll
            for (int cc = 0; cc < 20; ++cc) { float a = 0.f;
#pragma unroll
                for (int j = 0; j < 4; ++j) { const f32x4 w = *(LAS const f32x4*)(RW + cc * 1024 + (64 * j + lane) * 4); a += (v[j][0] * w[0] + v[j][1] * w[1]) + (v[j][2] * w[2] + v[j][3] * w[3]); }
                lg[cc] = wave_sum(a); }
            if (lane == 0) {
                float gl[4];
#pragma unroll
                for (int q4 = 0; q4 < 4; ++q4) gl[q4] = lg[q4] + gb[q4];
                int gi = 0; float gm = gl[0];
#pragma unroll
                for (int q4 = 1; q4 < 4; ++q4) if (gl[q4] > gm) { gm = gl[q4]; gi = q4; }
                float gs = 0.f;
#pragma unroll
                for (int q4 = 0; q4 < 4; ++q4) gs += __expf(gl[q4] - gm);
                const float gwt = 1.f / gs;
                float el[4];
#pragma unroll
                for (int e = 0; e < 4; ++e) el[e] = (gi == 0 ? lg[4 + e] : gi == 1 ? lg[8 + e] : gi == 2 ? lg[12 + e] : lg[16 + e]) + eb[gi * 4 + e];
                int i1 = 0; float v1 = el[0];
#pragma unroll
                for (int e = 1; e < 4; ++e) if (el[e] > v1) { v1 = el[e]; i1 = e; }
                int i2 = -1; float v2 = -3.0e38f;
#pragma unroll
                for (int e = 0; e < 4; ++e) if (e != i1 && el[e] > v2) { v2 = el[e]; i2 = e; }
                const float ex = __expf(v2 - v1), w1 = gwt / (1.f + ex), w2 = gwt * ex / (1.f + ex);
                const int e1 = gi * 4 + i1, e2 = gi * 4 + i2;
                const unsigned s1 = __hip_atomic_fetch_add(&cntl[e1], 1u, __ATOMIC_RELAXED, __HIP_MEMORY_SCOPE_WORKGROUP); loc[e1 * 256 + s1] = (unsigned)tok * 2u; wloc[e1 * 256 + s1] = w1;
                const unsigned s2 = __hip_atomic_fetch_add(&cntl[e2], 1u, __ATOMIC_RELAXED, __HIP_MEMORY_SCOPE_WORKGROUP); loc[e2 * 256 + s2] = (unsigned)tok * 2u + 1u; wloc[e2 * 256 + s2] = w2;
            }
        }
        __syncthreads();
        if (tid < 16) lbase[tid] = __hip_atomic_fetch_add(&ecnt[tid], cntl[tid], __ATOMIC_RELAXED, __HIP_MEMORY_SCOPE_AGENT);
        __syncthreads();
        for (int e = 0; e < 16; ++e) { const unsigned n = cntl[e], bs = lbase[e];
            for (unsigned i = tid; i < n; i += 512) { LIST[(size_t)e * NTOK + bs + i] = loc[e * 256 + i]; WL[(size_t)e * NTOK + bs + i] = wloc[e * 256 + i]; } }
    }
}

struct MoeUnit { int e, tile, n, hoff; };
__device__ __forceinline__ bool moe_find(LAS const int* cnts, int ut, MoeUnit& mu) {
    int pre = 0;
    for (int e = 0; e < 16; ++e) { const int cn = cnts[e], nt = (cn + 127) >> 7; if (ut < pre + nt) { mu.e = e; mu.tile = ut - pre; mu.n = cn - mu.tile * 128; if (mu.n > 128) mu.n = 128; mu.hoff = (pre + mu.tile) * 128; return true; } pre += nt; }
    return false;
}
__device__ __forceinline__ void phase_moe1(const Params& p, int l, LAS unsigned char* lds) {
    SG_IDS
    unsigned char* ws = p.ws;
    LAS int* cnts = (LAS int*)(lds + LDS_MISC + 64);
    const unsigned* ecnt = (const unsigned*)(ws + WS_CTL) + CW_ECNT + 64 * l;
    __syncthreads();
    if (tid < 16) cnts[tid] = (int)__hip_atomic_load(&ecnt[tid], __ATOMIC_RELAXED, __HIP_MEMORY_SCOPE_AGENT);
    __syncthreads();
    const unsigned* LIST = (const unsigned*)(ws + WS_LIST); const float* WL = (const float*)(ws + WS_WL);
    const char* XN = (const char*)(ws + WS_XN); bf16_t* H = (bf16_t*)(ws + WS_H);
    for (int ut = blockIdx.x;; ut += gridDim.x) {
        MoeUnit mu; if (!moe_find(cnts, ut, mu)) break;
        const unsigned* lst = LIST + (size_t)mu.e * NTOK + mu.tile * 128;
        const bf16_t* W = (const bf16_t*)(ws + WS_WGU) + (size_t)(l * 16 + mu.e) * 256 * DM;
        f32x4 ag[2][4], au[2][4]; SG_ZERO(ag); SG_ZERO(au);
        sg_kloop(ag, ARowGather{lst, mu.n, XN}, 128, W, DM, 16, lds);
        sg_kloop(au, ARowGather{lst, mu.n, XN}, 128, W + (size_t)128 * DM, DM, 16, lds);
        const float* wl = WL + (size_t)mu.e * NTOK + mu.tile * 128;
#pragma unroll
        for (int m = 0; m < 2; ++m) { const int rl = SG_ROW(m); const float wgt = (rl < mu.n) ? wl[rl] : 0.f;
#pragma unroll
            for (int n = 0; n < 4; ++n) { f32x4 gv = ag[m][n], uv = au[m][n], hv;
#pragma unroll
                for (int i = 0; i < 4; ++i) hv[i] = gv[i] * sigm(gv[i]) * uv[i] * wgt;
                st4bf(H + (size_t)(mu.hoff + rl) * 128 + SG_COL(n), hv); } }
    }
}
__device__ __forceinline__ void phase_moe2(const Params& p, int l, LAS unsigned char* lds) {
    SG_IDS
    unsigned char* ws = p.ws;
    LAS int* cnts = (LAS int*)(lds + LDS_MISC + 64);
    const unsigned* ecnt = (const unsigned*)(ws + WS_CTL) + CW_ECNT + 64 * l;
    __syncthreads();
    if (tid < 16) cnts[tid] = (int)__hip_atomic_load(&ecnt[tid], __ATOMIC_RELAXED, __HIP_MEMORY_SCOPE_AGENT);
    __syncthreads();
    const unsigned* LIST = (const unsigned*)(ws + WS_LIST); const bf16_t* H = (const bf16_t*)(ws + WS_H);
    bf16_t* Y0 = (bf16_t*)(ws + WS_GA); bf16_t* Y1 = (bf16_t*)(ws + WS_GB);
    for (int u = blockIdx.x;; u += gridDim.x) {
        MoeUnit mu; if (!moe_find(cnts, u >> 3, mu)) break;
        const int pn = u & 7;
        const unsigned* lst = LIST + (size_t)mu.e * NTOK + mu.tile * 128;
        const bf16_t* W = (const bf16_t*)(ws + WS_WD) + (size_t)(l * 16 + mu.e) * DM * 128 + (size_t)pn * 128 * 128;
        f32x4 acc[2][4]; SG_ZERO(acc);
        sg_kloop(acc, ARowLin{(const char*)(H + (size_t)mu.hoff * 128), 256}, 128, W, 128, 2, lds);
#pragma unroll
        for (int m = 0; m < 2; ++m) { const int rl = SG_ROW(m);
            if (rl < mu.n) { const unsigned ent = lst[rl]; bf16_t* dst = ((ent & 1u) ? Y1 : Y0) + (size_t)(ent >> 1) * DM + pn * 128;
#pragma unroll
                for (int n = 0; n < 4; ++n) st4bf(dst + SG_COL(n), acc[m][n]); } }
    }
}

__device__ __forceinline__ void phase_combine(const Params& p, int l) {
    int tid_ = threadIdx.x; asm volatile("" : "+v"(tid_));
    const int tid = tid_, lane = tid & 63, wid = tid >> 6;
    unsigned char* ws = p.ws;
    const int gw = blockIdx.x * 8 + wid, NGW = gridDim.x * 8;
    const bf16_t* Y0 = (const bf16_t*)(ws + WS_GA); const bf16_t* Y1 = (const bf16_t*)(ws + WS_GB); bf16_t* XN = (bf16_t*)(ws + WS_XN);
    const bool last = (l == DEPTH - 1);
    const float* g = last ? p.final_norm_g : p.norm1_g + (size_t)(l + 1) * DM;
    for (int mrow = gw; mrow < NTOK; mrow += NGW) {
        float* hrow = p.out + (size_t)mrow * DM;
        f32x4 v[4]; float s = 0.f;
#pragma unroll
        for (int j = 0; j < 4; ++j) { const int cidx = (64 * j + lane) * 4; v[j] = *(const f32x4*)(hrow + cidx);
            const u32x2 a = *(const u32x2*)(Y0 + (size_t)mrow * DM + cidx), b2 = *(const u32x2*)(Y1 + (size_t)mrow * DM + cidx);
            v[j] = v[j] + (f32x4){bflo(a.x), bfhi(a.x), bflo(a.y), bfhi(a.y)} + (f32x4){bflo(b2.x), bfhi(b2.x), bflo(b2.y), bfhi(b2.y)};
            s += (v[j][0] * v[j][0] + v[j][1] * v[j][1]) + (v[j][2] * v[j][2] + v[j][3] * v[j][3]); }
        const float rstd = rsqrtf(wave_sum(s) * (1.f / 1024.f) + 1e-6f);
#pragma unroll
        for (int j = 0; j < 4; ++j) { const int cidx = (64 * j + lane) * 4; const f32x4 gg = *(const f32x4*)(g + cidx);
            if (last) *(f32x4*)(hrow + cidx) = v[j] * rstd * gg;
            else { *(f32x4*)(hrow + cidx) = v[j]; st4bf(XN + (size_t)mrow * DM + cidx, v[j] * rstd * gg); } }
    }
}

template <int K> __device__ __forceinline__ void run_phase(const Params& p, int l, LAS unsigned char* lds) {
    unsigned* ctl = (unsigned*)(p.ws + WS_CTL);
    if (K == 0) phase_prologue(p, lds);
    if (K == 1) phase_inproj(p, l, lds);
    if (K == 2) { unsigned* ctr = ctl + CW_QCTR + 64 * (l * 2 + 0);
        for (;;) { const int u = next_unit(ctr, lds); if (u >= 64 + 1024) break; if (u < 64) compress_unit(p, l, u, lds); else diff_unit(p, l, u - 64, lds); } }
    if (K == 3) { unsigned* ctr = ctl + CW_QCTR + 64 * (l * 2 + 1);
        for (;;) { const int u = next_unit(ctr, lds); if (u >= 1024) break; nsa_unit(p, l, u, lds); } }
    if (K == 4) phase_merge(p, l, lds);
    if (K == 5) phase_outproj(p, l, lds);
    if (K == 6) phase_router(p, l, lds);
    if (K == 7) phase_moe1(p, l, lds);
    if (K == 8) phase_moe2(p, l, lds);
    if (K == 9) phase_combine(p, l);
}
#if MK_MULTI
template <int K> __global__ void __launch_bounds__(512, 2) mk_one(Params p) {
    extern __shared__ __attribute__((aligned(16))) unsigned char lds_raw[];
    run_phase<K>(p, p.ph_lo, (LAS unsigned char*)lds_raw);
}
template <int K> static void launch_one(int grid, hipStream_t stream, Params p, int l) {
    static bool attr = false;
    if (!attr) { (void)hipFuncSetAttribute((const void*)mk_one<K>, hipFuncAttributeMaxDynamicSharedMemorySize, LDS_BYTES); attr = true; }
    p.ph_lo = l; p.ph_hi = l + 1;
    hipLaunchKernelGGL(mk_one<K>, dim3(grid), dim3(512), LDS_BYTES, stream, p);
}
#else
__global__ void __launch_bounds__(512, 2) mk_fwd(Params p) {
    extern __shared__ __attribute__((aligned(16))) unsigned char lds_raw[];
    LAS unsigned char* lds = (LAS unsigned char*)lds_raw;
    cg::grid_group grid = cg::this_grid();
    run_phase<0>(p, 0, lds); grid.sync();
    for (int l = 0; l < DEPTH; ++l) {
        run_phase<1>(p, l, lds); grid.sync();
        run_phase<2>(p, l, lds); grid.sync();
        run_phase<3>(p, l, lds); grid.sync();
        run_phase<4>(p, l, lds); grid.sync();
        run_phase<5>(p, l, lds); grid.sync();
        run_phase<6>(p, l, lds); grid.sync();
        run_phase<7>(p, l, lds); grid.sync();
        run_phase<8>(p, l, lds); grid.sync();
        run_phase<9>(p, l, lds); if (l + 1 < DEPTH) grid.sync();
    }
}
#endif

extern "C" void kernel_launch(void* const* d_in, const int* in_sizes, int n_in, void* d_out, int out_size, void* d_ws, size_t ws_size, hipStream_t stream) {
    static int grid = 0;
    if (grid == 0) {
        if (n_in != 22 || in_sizes[0] != NTOK * DM || out_size != NTOK * DM || ws_size < WS_END) { fprintf(stderr, "kernel_launch: unexpected shapes (n_in %d, in0 %d, out %d, ws %zu)\n", n_in, n_in > 0 ? in_sizes[0] : -1, out_size, ws_size); grid = -1; return; }
        int dev = 0, cus = 0, per_cu = 1;
        (void)hipGetDevice(&dev); (void)hipDeviceGetAttribute(&cus, hipDeviceAttributeMultiprocessorCount, dev);
#if !MK_MULTI
        (void)hipFuncSetAttribute((const void*)mk_fwd, hipFuncAttributeMaxDynamicSharedMemorySize, LDS_BYTES);
        (void)hipOccupancyMaxActiveBlocksPerMultiprocessor(&per_cu, (const void*)mk_fwd, 512, LDS_BYTES);
        if (per_cu < 1) { fprintf(stderr, "kernel_launch: occupancy query says %d blocks per CU\n", per_cu); per_cu = 1; }
#endif
        (void)hipGetLastError();
        grid = cus * per_cu;
    }
    if (grid < 0) return;
    (void)hipMemsetAsync((char*)d_ws + WS_CTL, 0, CTL_BYTES, stream);
    Params p{};
    const float** pp = (const float**)&p;
    for (int i = 0; i < 22; ++i) pp[i] = (const float*)d_in[i];
    p.out = (float*)d_out; p.ws = (unsigned char*)d_ws;
#if MK_MULTI
    launch_one<0>(grid, stream, p, 0);
    for (int l = 0; l < DEPTH; ++l) {
        launch_one<1>(grid, stream, p, l); launch_one<2>(grid, stream, p, l); launch_one<3>(grid, stream, p, l); launch_one<4>(grid, stream, p, l); launch_one<5>(grid, stream, p, l);
        launch_one<6>(grid, stream, p, l); launch_one<7>(grid, stream, p, l); launch_one<8>(grid, stream, p, l); launch_one<9>(grid, stream, p, l);
    }
#else
    p.ph_lo = 0; p.ph_hi = NPHASE;
    void* args[] = {&p};
    hipError_t e = hipLaunchCooperativeKernel((const void*)mk_fwd, dim3(grid), dim3(512), args, LDS_BYTES, stream);
    if (e != hipSuccess) fprintf(stderr, "cooperative launch failed: %s (grid %d)\n", hipGetErrorString(e), grid);
#endif
}
```

```cpp
#include <hip/hip_runtime.h>
#include <hip/hip_cooperative_groups.h>
#include <cstdio>
#include <cstdint>
namespace cg = cooperative_groups;

#ifndef MK_MULTI
#define MK_MULTI 0
#endif

#define LAS __attribute__((address_space(3)))
typedef unsigned short bf16_t;
typedef short bf16x8 __attribute__((ext_vector_type(8)));
typedef short s16x4 __attribute__((ext_vector_type(4)));
typedef float f32x2 __attribute__((ext_vector_type(2)));
typedef float f32x4 __attribute__((ext_vector_type(4)));
typedef float f32x16 __attribute__((ext_vector_type(16)));
typedef unsigned u32x2 __attribute__((ext_vector_type(2)));
typedef unsigned u32x4 __attribute__((ext_vector_type(4)));
typedef __bf16 bf16x2_t __attribute__((ext_vector_type(2)));

constexpr int NTOK = 32768, DM = 1024, TSEQ = 2048, NBATCH = 16, DEPTH = 2;
constexpr int INCOLS = 4888, NPAD = 5120;
constexpr float LOG2E = 1.4426950408889634f;
constexpr float QSCALE = 0.125f * LOG2E;
constexpr int NPHASE = 1 + 9 * DEPTH;

constexpr size_t MiB = 1u << 20;
constexpr size_t WS_CTL = 0, CTL_BYTES = 65536;
constexpr size_t WS_WIN = 1 * MiB;
constexpr size_t WS_WA = 21 * MiB;
constexpr size_t WS_WB = 23 * MiB;
constexpr size_t WS_WO = 25 * MiB;
constexpr size_t WS_WC1 = 29 * MiB;
constexpr size_t WS_WGU = 31 * MiB;
constexpr size_t WS_WD = 47 * MiB;
constexpr size_t WS_MISC = 55 * MiB;
constexpr size_t WS_LIST = 58 * MiB;
constexpr size_t WS_WL = 60 * MiB;
constexpr size_t WS_XN = 64 * MiB;
constexpr size_t WS_NQ = 128 * MiB;
constexpr size_t WS_KV6 = 160 * MiB;
constexpr size_t WS_NG = 208 * MiB;
constexpr size_t WS_DQ = 210 * MiB;
constexpr size_t WS_DK = 242 * MiB;
constexpr size_t WS_DV = 274 * MiB;
constexpr size_t WS_GA = 306 * MiB;
constexpr size_t WS_GB = 370 * MiB;
constexpr size_t WS_END = 434 * MiB;
constexpr size_t WS_H = WS_DK;
constexpr int CW_QCTR = 64;
constexpr int CW_ECNT = 1024;
constexpr int CW_BAR = 4096;

constexpr int LDS_BYTES = 147456;
constexpr int LDS_MISC = 131072;

struct Params {
    const float* x; const float* norm1_g; const float* w_in; const float* cmp_pe; const float* cmp_w1; const float* cmp_b1; const float* cmp_w2; const float* cmp_b2;
    const float* diff_lambda; const float* diff_subln_g; const float* w_branch_a; const float* w_branch_b; const float* w_out; const float* norm2_g;
    const float* router_grp_w; const float* router_grp_b; const float* router_exp_w; const float* router_exp_b; const float* exp_w_gate; const float* exp_w_up; const float* exp_w_down; const float* final_norm_g;
    float* out; unsigned char* ws; int ph_lo, ph_hi;
};

__device__ __forceinline__ unsigned cvtpk(float lo, float hi) { f32x2 v = {lo, hi}; bf16x2_t b = __builtin_convertvector(v, bf16x2_t); return __builtin_bit_cast(unsigned, b); }
__device__ __forceinline__ float bflo(unsigned u) { return __uint_as_float(u << 16); }
__device__ __forceinline__ float bfhi(unsigned u) { return __uint_as_float(u & 0xffff0000u); }
__device__ __forceinline__ float bf1(bf16_t b) { return __uint_as_float(((unsigned)b) << 16); }
__device__ __forceinline__ bf16_t f2bf(float f) { return (bf16_t)(cvtpk(f, 0.f) & 0xffffu); }
__device__ __forceinline__ int crow(int r, int hi) { return (r & 3) + 8 * (r >> 2) + 4 * hi; }
__device__ __forceinline__ float wave_sum(float v) {
#pragma unroll
    for (int o = 1; o < 64; o <<= 1) v += __shfl_xor(v, o);
    return v;
}
__device__ __forceinline__ float sigm(float x) { return 1.f / (1.f + __expf(-x)); }
__device__ __forceinline__ float ex2(float x) { return __builtin_amdgcn_exp2f(x); }
__device__ __forceinline__ float alibi_slope(int i  ) { return exp2f(-8.0f * (float)i / 12.0f); }
__device__ __forceinline__ s16x4 vtr(LAS const unsigned char* p) { return __builtin_bit_cast(s16x4, __builtin_amdgcn_ds_read_tr16_b64_v4i16((LAS s16x4*)p)); }
#define MFMA32(a, b, c) __builtin_amdgcn_mfma_f32_32x32x16_bf16(a, b, c, 0, 0, 0)
#define MFMA16(a, b, c) __builtin_amdgcn_mfma_f32_16x16x32_bf16(a, b, c, 0, 0, 0)

struct ARowLin { const char* base; size_t stride; __device__ __forceinline__ const char* operator()(int r) const { return base + (size_t)r * stride; } };
struct ARowGather { const unsigned* list; int n; const char* xn; __device__ __forceinline__ const char* operator()(int r) const { const int i = r < n ? r : n - 1; return xn + (size_t)(list[i] >> 1) * 2048; } };

template <class ARow>
__device__ __forceinline__ void sg_kloop(f32x4 (&acc)[2][4], const ARow& arow, int kstepA, const bf16_t* Bt, int ldb, int nt, LAS unsigned char* lds) {
    int tid_ = threadIdx.x; asm volatile("" : "+v"(tid_));
    const int tid = tid_, lane = tid & 63, wid = tid >> 6, wr = wid >> 1, wc = wid & 1, fr = lane & 15, fq = lane >> 4;
    const int lrow = tid >> 3, lch = tid & 7;
    const char* pa0 = arow(lrow) + lch * 16; const char* pa1 = arow(lrow + 64) + lch * 16;
    const char* pb0 = (const char*)(Bt + (size_t)lrow * ldb) + lch * 16; const char* pb1 = (const char*)(Bt + (size_t)(lrow + 64) * ldb) + lch * 16;
    const int wofs0 = lrow * 128 + ((lch ^ ((lrow >> 1) & 7)) << 4), wofs1 = wofs0 + 64 * 128;
    u32x4 ra0 = *(const u32x4*)pa0, ra1 = *(const u32x4*)pa1, rb0 = *(const u32x4*)pb0, rb1 = *(const u32x4*)pb1;
    for (int t = 0; t < nt; ++t) {
        __syncthreads();
        *(LAS u32x4*)(lds + wofs0) = ra0; *(LAS u32x4*)(lds + wofs1) = ra1; *(LAS u32x4*)(lds + 16384 + wofs0) = rb0; *(LAS u32x4*)(lds + 16384 + wofs1) = rb1;
        __syncthreads();
        if (t + 1 < nt) { pa0 += kstepA; pa1 += kstepA; pb0 += 128; pb1 += 128; ra0 = *(const u32x4*)pa0; ra1 = *(const u32x4*)pa1; rb0 = *(const u32x4*)pb0; rb1 = *(const u32x4*)pb1; }
#pragma unroll
        for (int ks = 0; ks < 2; ++ks) {
            bf16x8 af[2], bfr[4];
            const int ch = ks * 4 + fq;
#pragma unroll
            for (int m = 0; m < 2; ++m) { const int row = wr * 32 + m * 16 + fr; af[m] = *(LAS const bf16x8*)(lds + row * 128 + ((ch ^ ((row >> 1) & 7)) << 4)); }
#pragma unroll
            for (int n = 0; n < 4; ++n) { const int row = wc * 64 + n * 16 + fr; bfr[n] = *(LAS const bf16x8*)(lds + 16384 + row * 128 + ((ch ^ ((row >> 1) & 7)) << 4)); }
#pragma unroll
            for (int m = 0; m < 2; ++m)
#pragma unroll
                for (int n = 0; n < 4; ++n) acc[m][n] = MFMA16(bfr[n], af[m], acc[m][n]);
        }
    }
}
#define SG_ZERO(acc) do { _Pragma("unroll") for (int m_ = 0; m_ < 2; ++m_) _Pragma("unroll") for (int n_ = 0; n_ < 4; ++n_) acc[m_][n_] = (f32x4){0.f, 0.f, 0.f, 0.f}; } while (0)
#define SG_IDS int tid_ = threadIdx.x; asm volatile("" : "+v"(tid_)); const int tid = tid_, lane = tid & 63, wid = tid >> 6, wr = wid >> 1, wc = wid & 1, fr = lane & 15, fq = lane >> 4; (void)tid; (void)lane; (void)wid;
#define SG_ROW(m) (wr * 32 + (m) * 16 + fr)
#define SG_COL(n) (wc * 64 + (n) * 16 + 4 * fq)
__device__ __forceinline__ void st4bf(bf16_t* dst, f32x4 v) { u32x2 w; w.x = cvtpk(v[0], v[1]); w.y = cvtpk(v[2], v[3]); *(u32x2*)dst = w; }

__device__ __forceinline__ void transpose_item(const float* W, int ldw, int src_col, int valid, bf16_t* WT, int K, int dst_row, int k0, LAS float* scr, int lane) {
#pragma unroll 8
    for (int i = 0; i < 32; ++i) { const int kk = 2 * i + (lane >> 5), c = lane & 31; scr[kk * 33 + c] = (c < valid) ? W[(size_t)(k0 + kk) * ldw + src_col + c] : 0.f; }
    asm volatile("s_waitcnt lgkmcnt(0)" ::: "memory");
    const int c = lane & 7;
#pragma unroll
    for (int j = 0; j < 4; ++j) { const int n = (lane >> 3) + 8 * j; LAS const float* s = scr + (8 * c) * 33 + n;
        u32x4 o; o.x = cvtpk(s[0 * 33], s[1 * 33]); o.y = cvtpk(s[2 * 33], s[3 * 33]); o.z = cvtpk(s[4 * 33], s[5 * 33]); o.w = cvtpk(s[6 * 33], s[7 * 33]);
        *(u32x4*)(WT + (size_t)(dst_row + n) * K + k0 + 8 * c) = o; }
    asm volatile("s_waitcnt lgkmcnt(0)" ::: "memory");
}
__device__ __forceinline__ void norm_row_bf16(const float* xrow, const float* g, bf16_t* orow, int lane) {
    f32x4 v[4]; float s = 0.f;
#pragma unroll
    for (int j = 0; j < 4; ++j) { v[j] = *(const f32x4*)(xrow + (64 * j + lane) * 4); s += (v[j][0] * v[j][0] + v[j][1] * v[j][1]) + (v[j][2] * v[j][2] + v[j][3] * v[j][3]); }
    const float rstd = rsqrtf(wave_sum(s) * (1.f / 1024.f) + 1e-6f);
#pragma unroll
    for (int j = 0; j < 4; ++j) { const f32x4 gg = *(const f32x4*)(g + (64 * j + lane) * 4); f32x4 o = v[j] * rstd * gg; st4bf(orow + (64 * j + lane) * 4, o); }
}

__device__ __forceinline__ void phase_prologue(const Params& p, LAS unsigned char* lds) {
    int tid_ = threadIdx.x; asm volatile("" : "+v"(tid_));
    const int tid = tid_, lane = tid & 63, wid = tid >> 6;
    const int gw = blockIdx.x * 8 + wid, NGW = gridDim.x * 8;
    LAS float* scr = (LAS float*)(lds + wid * 8448);
    unsigned char* ws = p.ws;
    constexpr int I_IN = 16 * 160, I_A = 8 * 32, I_O = 16 * 32, I_C1 = 2 * 32 * 4, I_G = 16 * 16 * 4, I_D = 16 * 2 * 32;
    constexpr int I_LAYER = I_IN + 2 * I_A + I_O + I_C1 + 2 * I_G + I_D;
    for (int it = gw; it < DEPTH * I_LAYER; it += NGW) {
        const int l = it / I_LAYER; int r = it % I_LAYER;
        if (r < I_IN) { const int kb = r / 160, nb = r % 160, n0 = nb * 32; int src, valid = 32;
            if (n0 < 1280) src = n0; else if (n0 < 4864) src = n0 + 24; else { src = 1280 + (n0 - 4864); valid = (n0 == 4864) ? 24 : 0; if (valid == 0) src = 0; }
            transpose_item(p.w_in + (size_t)l * DM * INCOLS, INCOLS, src, valid, (bf16_t*)(ws + WS_WIN) + (size_t)l * NPAD * DM, DM, n0, kb * 64, scr, lane); continue; }
        r -= I_IN;
        if (r < I_A) { const int kb = r / 32, nb = r % 32; transpose_item(p.w_branch_a + (size_t)l * 512 * DM, DM, nb * 32, 32, (bf16_t*)(ws + WS_WA) + (size_t)l * DM * 512, 512, nb * 32, kb * 64, scr, lane); continue; }
        r -= I_A;
        if (r < I_A) { const int kb = r / 32, nb = r % 32; transpose_item(p.w_branch_b + (size_t)l * 512 * DM, DM, nb * 32, 32, (bf16_t*)(ws + WS_WB) + (size_t)l * DM * 512, 512, nb * 32, kb * 64, scr, lane); continue; }
        r -= I_A;
        if (r < I_O) { const int kb = r / 32, nb = r % 32; transpose_item(p.w_out + (size_t)l * DM * DM, DM, nb * 32, 32, (bf16_t*)(ws + WS_WO) + (size_t)l * DM * DM, DM, nb * 32, kb * 64, scr, lane); continue; }
        r -= I_O;
        if (r < I_C1) { const int kv = r / 128, r2 = r % 128, kb = r2 / 4, nb = r2 % 4;
            transpose_item(p.cmp_w1 + (size_t)(l * 2 + kv) * 2048 * 128, 128, nb * 32, 32, (bf16_t*)(ws + WS_WC1) + (size_t)(l * 2 + kv) * 128 * 2048, 2048, nb * 32, kb * 64, scr, lane); continue; }
        r -= I_C1;
        if (r < 2 * I_G) { const int which = r / I_G, r2 = r % I_G, e = r2 / 64, r3 = r2 % 64, kb = r3 / 4, nb = r3 % 4;
            const float* W = (which ? p.exp_w_up : p.exp_w_gate) + (size_t)(l * 16 + e) * DM * 128;
            transpose_item(W, 128, nb * 32, 32, (bf16_t*)(ws + WS_WGU) + (size_t)(l * 16 + e) * 256 * DM, DM, which * 128 + nb * 32, kb * 64, scr, lane); continue; }
        r -= 2 * I_G;
        { const int e = r / 64, r3 = r % 64, kb = r3 / 32, nb = r3 % 32;
            transpose_item(p.exp_w_down + (size_t)(l * 16 + e) * 128 * DM, DM, nb * 32, 32, (bf16_t*)(ws + WS_WD) + (size_t)(l * 16 + e) * DM * 128, 128, nb * 32, kb * 64, scr, lane); }
    }
    for (int m = gw; m < NTOK; m += NGW) norm_row_bf16(p.x + (size_t)m * DM, p.norm1_g, (bf16_t*)(ws + WS_XN) + (size_t)m * DM, lane);
    __syncthreads();
    if (blockIdx.x < 8) {
        const int l = blockIdx.x >> 2, kv = (blockIdx.x >> 1) & 1, jh = blockIdx.x & 1, j = jh * 64 + lane;
        const float* pe = p.cmp_pe + (size_t)(l * 2 + kv) * 2048; const float* w1 = p.cmp_w1 + (size_t)(l * 2 + kv) * 2048 * 128;
        float s = 0.f;
        for (int f = wid * 256; f < wid * 256 + 256; ++f) s += pe[f] * w1[(size_t)f * 128 + j];
        LAS float* part = (LAS float*)(lds + 70000);
        part[wid * 64 + lane] = s;
        __syncthreads();
        if (wid == 0) { float t = p.cmp_b1[(l * 2 + kv) * 128 + j];
#pragma unroll
            for (int w = 0; w < 8; ++w) t += part[w * 64 + lane];
            ((float*)(ws + WS_MISC))[(l * 2 + kv) * 128 + j] = t; }
    }
    if (blockIdx.x == 8 && wid < DEPTH) {
        const int l = wid; const float* lp = p.diff_lambda + l * 256;
        const float a = wave_sum(lp[lane] * lp[64 + lane]), b = wave_sum(lp[128 + lane] * lp[192 + lane]);
        const float lam_init = 0.8f - 0.6f * expf(-0.3f * (float)l);
        if (lane == 0) ((float*)(ws + WS_MISC + 4096))[l] = expf(a) - expf(b) + lam_init;
    }
}

__device__ __forceinline__ void phase_inproj(const Params& p, int l, LAS unsigned char* lds) {
    SG_IDS
    unsigned char* ws = p.ws;
    const bf16_t* XN = (const bf16_t*)(ws + WS_XN); const bf16_t* W = (const bf16_t*)(ws + WS_WIN) + (size_t)l * NPAD * DM;
    constexpr int NT = 39, GRP = 16;
    for (int u = blockIdx.x; u < 256 * NT; u += gridDim.x) {
        const int grp = u / (GRP * NT), rem = u % (GRP * NT), pn = rem / GRP, pm = grp * GRP + rem % GRP;
        const int m0 = pm * 128, n0 = pn * 128;
        f32x4 acc[2][4]; SG_ZERO(acc);
        sg_kloop(acc, ARowLin{(const char*)(XN + (size_t)m0 * DM), 2048}, 128, W + (size_t)n0 * DM, DM, 16, lds);
        bf16_t* dst; int pitch, c0, mode = 0;
        if (n0 < 512) { dst = (bf16_t*)(ws + WS_NQ); pitch = 512; c0 = n0; mode = 1; }
        else if (n0 < 1280) { dst = (bf16_t*)(ws + WS_KV6); pitch = 768; c0 = n0 - 512; }
        else if (n0 < 1792) { dst = (bf16_t*)(ws + WS_DQ); pitch = 512; c0 = n0 - 1280; mode = 1; }
        else if (n0 < 2304) { dst = (bf16_t*)(ws + WS_DK); pitch = 512; c0 = n0 - 1792; }
        else if (n0 < 2816) { dst = (bf16_t*)(ws + WS_DV); pitch = 512; c0 = n0 - 2304; }
        else if (n0 < 3840) { dst = (bf16_t*)(ws + WS_GA); pitch = 1024; c0 = n0 - 2816; mode = 2; }
        else if (n0 < 4864) { dst = (bf16_t*)(ws + WS_GB); pitch = 1024; c0 = n0 - 3840; mode = 2; }
        else { dst = (bf16_t*)(ws + WS_NG); pitch = 32; c0 = 0; mode = 3; }
#pragma unroll
        for (int m = 0; m < 2; ++m)
#pragma unroll
            for (int n = 0; n < 4; ++n) {
                const int row = m0 + SG_ROW(m), col = SG_COL(n); f32x4 v = acc[m][n];
                if (mode == 1) v = v * QSCALE;
                else if (mode >= 2) { v[0] = sigm(v[0]); v[1] = sigm(v[1]); v[2] = sigm(v[2]); v[3] = sigm(v[3]); }
                if (mode != 3 || col < 32) st4bf(dst + (size_t)row * pitch + c0 + col, v);
            }
    }
}

__device__ __forceinline__ void stage_k(LAS unsigned char* kdst, const bf16_t* src  , int pitch, int tid) {
    const int row = tid & 63, ch = tid >> 6;
    *(LAS u32x4*)(kdst + ch * 1024 + row * 16) = *(const u32x4*)(src + (size_t)row * pitch + ch * 8);
}
template <int NDB> __device__ __forceinline__ void stage_v(LAS unsigned char* vdst, const bf16_t* src, int pitch, int tid) {
#pragma unroll
    for (int i = 0; i < NDB / 2; ++i) { const int pc = tid + 512 * i, pw = pc >> 6, ln = pc & 63, db = pw >> 2, rg = pw & 3;
        *(LAS u32x4*)(vdst + pw * 1024 + ln * 16) = *(const u32x4*)(src + (size_t)(16 * rg + (ln >> 2)) * pitch + db * 32 + (ln & 3) * 8); }
}
__device__ __forceinline__ void qkt(f32x16& p0, f32x16& p1, LAS const unsigned char* K, const bf16x8 (&qr)[4], int r32, int hi) {
    LAS const unsigned char* kb = K + hi * 1024 + r32 * 16;
    p0 = (f32x16){0.f}; p1 = (f32x16){0.f};
#pragma unroll
    for (int d0 = 0; d0 < 4; ++d0) {
        const bf16x8 b0 = *(LAS const bf16x8*)(kb + d0 * 2048), b1 = *(LAS const bf16x8*)(kb + d0 * 2048 + 512);
        p0 = MFMA32(b0, qr[d0], p0); p1 = MFMA32(b1, qr[d0], p1);
    }
    __builtin_amdgcn_sched_barrier(0);
}
template <int NDB> __device__ __forceinline__ void pv(f32x16 (&o)[NDB], const f32x16& p0, const f32x16& p1, LAS const unsigned char* V, int lane, int hi) {
    u32x4 pw[4];
    pw[0] = (u32x4){cvtpk(p0[0], p0[1]), cvtpk(p0[2], p0[3]), cvtpk(p0[4], p0[5]), cvtpk(p0[6], p0[7])};
    pw[1] = (u32x4){cvtpk(p0[8], p0[9]), cvtpk(p0[10], p0[11]), cvtpk(p0[12], p0[13]), cvtpk(p0[14], p0[15])};
    pw[2] = (u32x4){cvtpk(p1[0], p1[1]), cvtpk(p1[2], p1[3]), cvtpk(p1[4], p1[5]), cvtpk(p1[6], p1[7])};
    pw[3] = (u32x4){cvtpk(p1[8], p1[9]), cvtpk(p1[10], p1[11]), cvtpk(p1[12], p1[13]), cvtpk(p1[14], p1[15])};
    LAS const unsigned char* vb = V + ((lane >> 4) & 1) * 32 + (lane & 3) * 8 + (4 * hi + ((lane & 15) >> 2)) * 64;
#pragma unroll
    for (int d0 = 0; d0 < NDB; ++d0)
#pragma unroll
        for (int ks = 0; ks < 4; ++ks) {
            const s16x4 lo = vtr(vb + d0 * 4096 + ks * 1024), hh = vtr(vb + d0 * 4096 + ks * 1024 + 512);
            const bf16x8 vf = (bf16x8){lo[0], lo[1], lo[2], lo[3], hh[0], hh[1], hh[2], hh[3]};
            o[d0] = MFMA32(__builtin_bit_cast(bf16x8, pw[ks]), vf, o[d0]);
            if (ks == 3) __builtin_amdgcn_sched_barrier(0);
        }
}
constexpr float SM_THR = 6.0f;
constexpr float NEG = -1e30f;
template <int NDB> __device__ __forceinline__ void softmax_pv(f32x16& s0, f32x16& s1, float& m, float& l, f32x16 (&o)[NDB], LAS float* wsf, LAS const unsigned char* V, int lane, int r32, int hi) {
    float rm = fmaxf(s0[0], s1[0]);
#pragma unroll
    for (int r = 1; r < 16; ++r) rm = fmaxf(rm, fmaxf(s0[r], s1[r]));
    rm = fmaxf(rm, __shfl_xor(rm, 32));
    if (__any(rm > m + SM_THR)) {
        const float mn = fmaxf(m, rm), f = ex2(m - mn); l *= f; m = mn;
        if (hi == 0) wsf[r32] = f;
#pragma unroll
        for (int r = 0; r < 16; ++r) { const float fr_ = wsf[crow(r, hi)];
#pragma unroll
            for (int d = 0; d < NDB; ++d) o[d][r] *= fr_; }
    }
    float sum = 0.f;
#pragma unroll
    for (int r = 0; r < 16; ++r) { s0[r] = ex2(s0[r] - m); s1[r] = ex2(s1[r] - m); sum += s0[r] + s1[r]; }
    l += sum;
    pv<NDB>(o, s0, s1, V, lane, hi);
}

__device__ __forceinline__ float gelu_tanh(float x) { const float u = 0.7978845608f * (x + 0.044715f * x * x * x); const float e = __expf(2.f * u); return 0.5f * x * (2.f - 2.f / (1.f + e)); }

__device__ __forceinline__ void compress_unit(const Params& p, int l, int u, LAS unsigned char* lds) {
    SG_IDS
    unsigned char* ws = p.ws;
    const int kv = u >> 5, m0 = (u & 31) * 128;
    const bf16_t* KV6 = (const bf16_t*)(ws + WS_KV6);
    struct ARowC { const bf16_t* KV6; int m0, kv; __device__ __forceinline__ const char* operator()(int r) const { const int mm = m0 + r, g = mm >> 11, tok = (mm & 2047) * 16; return (const char*)(KV6 + (size_t)tok * 768 + kv * 128 + g * 64); } };
    f32x4 acc[2][4]; SG_ZERO(acc);
    sg_kloop(acc, ARowC{KV6, m0, kv}, 768 * 2, (const bf16_t*)(ws + WS_WC1) + (size_t)(l * 2 + kv) * 128 * 2048, 2048, 32, lds);
    LAS bf16_t* Ht = (LAS bf16_t*)(lds + 32768);
    LAS float* W2 = (LAS float*)(lds + 32768 + 34816);
    const float* cb1 = (const float*)(ws + WS_MISC) + (l * 2 + kv) * 128;
#pragma unroll
    for (int m = 0; m < 2; ++m)
#pragma unroll
        for (int n = 0; n < 4; ++n) { const int row = SG_ROW(m), col = SG_COL(n); const f32x4 b = *(const f32x4*)(cb1 + col); f32x4 v = acc[m][n] + b;
            u32x2 w; w.x = cvtpk(gelu_tanh(v[0]), gelu_tanh(v[1])); w.y = cvtpk(gelu_tanh(v[2]), gelu_tanh(v[3])); *(LAS u32x2*)(Ht + row * 136 + col) = w; }
    const float* w2g = p.cmp_w2 + (size_t)(l * 2 + kv) * 128 * 64;
    for (int i = tid; i < 128 * 64 / 4; i += 512) *(LAS f32x4*)(W2 + i * 4) = *(const f32x4*)(w2g + i * 4);
    __syncthreads();
    const int d = tid & 63; const float b2 = p.cmp_b2[(l * 2 + kv) * 64 + d];
    bf16_t* dstb = (bf16_t*)(ws + WS_MISC + 65536 + (size_t)kv * 524288);
    for (int i = 0; i < 16; ++i) { const int row = (tid >> 6) + 8 * i; float s = b2;
#pragma unroll 8
        for (int f = 0; f < 128; ++f) s += bf1(Ht[row * 136 + f]) * W2[f * 64 + d];
        const int mm = m0 + row, g = mm >> 11, bi = mm & 2047;
        dstb[((size_t)bi * 2 + g) * 64 + d] = f2bf(s); }
    __syncthreads();
}

__device__ __forceinline__ void diff_unit(const Params& p, int l, int u, LAS unsigned char* lds) {
    int tid_ = threadIdx.x; asm volatile("" : "+v"(tid_));
    const int tid = tid_, lane = tid & 63, r32 = lane & 31, hi = lane >> 5, wid = __builtin_amdgcn_readfirstlane(tid >> 6);
    unsigned char* ws = p.ws;
    const int c = 15 - (u >> 6), b = (u & 63) >> 2, hd = u & 3;
    const int cm = wid >> 2, qq = wid & 3, t0 = 128 * c + 32 * qq, tq = t0 + r32;
    const size_t tokb = (size_t)b * TSEQ;
    bf16_t* DQ = (bf16_t*)(ws + WS_DQ); const bf16_t* DK = (const bf16_t*)(ws + WS_DK); const bf16_t* DV = (const bf16_t*)(ws + WS_DV);
    bf16x8 qr[4];
    { const bf16_t* qp = DQ + (tokb + tq) * 512 + hd * 128 + cm * 64 + hi * 8;
#pragma unroll
      for (int d0 = 0; d0 < 4; ++d0) qr[d0] = *(const bf16x8*)(qp + d0 * 16); }
    const float sl2 = alibi_slope(9 + hd) * LOG2E;
    const float cbh = sl2 * (float)(4 * hi);
#define CB(r) fmaf(sl2, (float)(((r) & 3) + 8 * ((r) >> 2)), cbh)
    f32x16 o[4];
#pragma unroll
    for (int d = 0; d < 4; ++d) o[d] = (f32x16){0.f};
    float m = NEG, lsum = 0.f;
    LAS float* wsf = (LAS float*)(lds + LDS_MISC + 1024 + wid * 128);
    LAS unsigned char* Kt = lds; LAS unsigned char* Vt = lds + 16384;
    const int jmax_w = (t0 + 31) >> 6;
    for (int j = 2 * c + 1; j >= 0; --j) {
        __syncthreads();
        { const bf16_t* ksrc = DK + (tokb + 64 * j) * 512 + hd * 128; stage_k(Kt, ksrc, 512, tid); stage_k(Kt + 8192, ksrc + 64, 512, tid);
          stage_v<4>(Vt, DV + (tokb + 64 * j) * 512 + hd * 128, 512, tid); }
        __syncthreads();
        if (j <= jmax_w) {
            f32x16 s0, s1; qkt(s0, s1, Kt + cm * 8192, qr, r32, hi);
            const float tc = sl2 * (float)(64 * j - 128 * c);
            const bool diag = (64 * j + 63 > t0); const int lim = tq - 64 * j;
#pragma unroll
            for (int r = 0; r < 16; ++r) { s0[r] += CB(r) + tc; s1[r] += CB(r) + (tc + 32.f * sl2);
                if (diag) { if (crow(r, hi) > lim) s0[r] = NEG; if (crow(r, hi) + 32 > lim) s1[r] = NEG; } }
            softmax_pv<4>(s0, s1, m, lsum, o, wsf, Vt, lane, r32, hi);
        }
    }
    __syncthreads();
    const float lam = ((const float*)(ws + WS_MISC + 4096))[l];
    const float lam_init = 0.8f - 0.6f * expf(-0.3f * (float)l);
    const float ltot = lsum + __shfl_xor(lsum, 32);
    if (hi == 0) wsf[r32] = (cm == 0 ? 1.f : lam) / ltot;
    LAS float* X = (LAS float*)(lds + cm * 65536);
#pragma unroll
    for (int r = 0; r < 16; ++r) { const float f = wsf[crow(r, hi)]; const int q = 32 * qq + crow(r, hi);
#pragma unroll
        for (int d = 0; d < 4; ++d) X[q * 128 + d * 32 + r32] = o[d][r] * f; }
    __syncthreads();
    { const int q = tid >> 2, qt = tid & 3; LAS const float* x0 = (LAS const float*)lds + q * 128 + qt * 32; LAS const float* x1 = x0 + 16384;
      float v[32]; float ss = 0.f;
#pragma unroll
      for (int i = 0; i < 32; ++i) { v[i] = x0[i] - x1[i]; ss += v[i] * v[i]; }
      ss += __shfl_xor(ss, 1); ss += __shfl_xor(ss, 2);
      const float rstd = rsqrtf(ss * (1.f / 128.f) + 1e-5f) * (1.f - lam_init);
      const float* sg = p.diff_subln_g + l * 128 + qt * 32;
      bf16_t* dst = DQ + (tokb + 128 * c + q) * 512 + hd * 128 + qt * 32;
#pragma unroll
      for (int i = 0; i < 32; i += 8) { u32x4 w; w.x = cvtpk(v[i] * rstd * sg[i], v[i + 1] * rstd * sg[i + 1]); w.y = cvtpk(v[i + 2] * rstd * sg[i + 2], v[i + 3] * rstd * sg[i + 3]);
          w.z = cvtpk(v[i + 4] * rstd * sg[i + 4], v[i + 5] * rstd * sg[i + 5]); w.w = cvtpk(v[i + 6] * rstd * sg[i + 6], v[i + 7] * rstd * sg[i + 7]); *(u32x4*)(dst + i) = w; } }
    __syncthreads();
}

__device__ __forceinline__ void nsa_unit(const Params& p, int l, int u, LAS unsigned char* lds) {
    int tid_ = threadIdx.x; asm volatile("" : "+v"(tid_));
    const int tid = tid_, lane = tid & 63, r32 = lane & 31, hi = lane >> 5, wid = __builtin_amdgcn_readfirstlane(tid >> 6);
    unsigned char* ws = p.ws;
    const int c = 31 - (u >> 5), b = (u & 31) >> 1, g = u & 1;
    const int hl = wid >> 1, qh = wid & 1, h = g * 4 + hl, t0 = 64 * c + 32 * qh, tq = t0 + r32, ql = 32 * qh + r32;
    const size_t tokb = (size_t)b * TSEQ;
    bf16_t* NQ = (bf16_t*)(ws + WS_NQ); const bf16_t* KV6 = (const bf16_t*)(ws + WS_KV6); const bf16_t* NG = (const bf16_t*)(ws + WS_NG);
    const bf16_t* KC = (const bf16_t*)(ws + WS_MISC + 65536); const bf16_t* VC = (const bf16_t*)(ws + WS_MISC + 65536 + 524288);
    bf16x8 qr[4];
    { const bf16_t* qp = NQ + (tokb + tq) * 512 + h * 64 + hi * 8;
#pragma unroll
      for (int d0 = 0; d0 < 4; ++d0) qr[d0] = *(const bf16x8*)(qp + d0 * 16); }
    const float sl2 = alibi_slope(h + 1) * LOG2E;
    const float cbh = sl2 * (float)(4 * hi);
    LAS float* wsf = (LAS float*)(lds + LDS_MISC + 1024 + wid * 128);
    LAS unsigned char* Kt = lds; LAS unsigned char* Vt = lds + 16384;
    LAS float* IMPH = (LAS float*)(lds + 32768);
    LAS float* VAL = (LAS float*)(lds + 65536);
    LAS unsigned* MASK = (LAS unsigned*)(lds + 73728);
    const float g0 = bf1(NG[(tokb + tq) * 32 + h * 3 + 0]), g1 = bf1(NG[(tokb + tq) * 32 + h * 3 + 1]), g2 = bf1(NG[(tokb + tq) * 32 + h * 3 + 2]);
    f32x16 oacc[2];
    __syncthreads();
    { const bf16_t* ksrc = KC + ((size_t)b * 128 * 2 + g) * 64; const bf16_t* vsrc = VC + ((size_t)b * 128 * 2 + g) * 64;
      stage_k(Kt, ksrc, 128, tid); stage_k(Kt + 8192, ksrc + 64 * 128, 128, tid);
      stage_v<2>(Vt, vsrc, 128, tid); stage_v<2>(Vt + 8192, vsrc + 64 * 128, 128, tid);
      if (tid < 64) MASK[tid] = 0u; }
    __syncthreads();
    {
        f32x16 s[4];
        qkt(s[0], s[1], Kt, qr, r32, hi); qkt(s[2], s[3], Kt + 8192, qr, r32, hi);
        int nmax = (tq - 31) >> 4; if (nmax > 126) nmax = 126;
        float rm = NEG;
#pragma unroll
        for (int k = 0; k < 4; ++k)
#pragma unroll
            for (int r = 0; r < 16; ++r) { const int n = 32 * k + crow(r, hi); float v = s[k][r] + 16.f * CB(r) + sl2 * (float)(512 * k);
                v = (n <= nmax) ? v : NEG; s[k][r] = v; rm = fmaxf(rm, v); }
        rm = fmaxf(rm, __shfl_xor(rm, 32));
        float sum = 0.f;
#pragma unroll
        for (int k = 0; k < 4; ++k)
#pragma unroll
            for (int r = 0; r < 16; ++r) { const float e = ex2(s[k][r] - rm); s[k][r] = e; sum += e; }
        sum += __shfl_xor(sum, 32);
        const float inv = (nmax >= 0) ? 1.f / sum : 0.f;
#pragma unroll
        for (int k = 0; k < 4; ++k)
#pragma unroll
            for (int r = 0; r < 16; ++r) s[k][r] *= inv;
        float prev = 0.f;
#pragma unroll
        for (int k = 0; k < 4; ++k)
#pragma unroll
            for (int a = 0; a < 4; ++a) { const int i = 4 * k + a; const float Bi = 0.5f * s[k][4 * a + 3]; const float Ai = (s[k][4 * a] + s[k][4 * a + 1]) + (s[k][4 * a + 2] + Bi);
                const float rc = __shfl_xor(Bi, 32); const float add = hi ? rc : prev; prev = rc;
                IMPH[(hl * 64 + ql) * 32 + 2 * i + hi] = Ai + add; }
        f32x16 o[2]; o[0] = (f32x16){0.f}; o[1] = (f32x16){0.f};
        pv<2>(o, s[0], s[1], Vt, lane, hi); pv<2>(o, s[2], s[3], Vt + 8192, lane, hi);
        if (hi == 0) wsf[r32] = g0;
#pragma unroll
        for (int r = 0; r < 16; ++r) { const float f = wsf[crow(r, hi)]; oacc[0][r] = o[0][r] * f; oacc[1][r] = o[1][r] * f; }
        asm volatile("" : "+v"(oacc[0]), "+v"(oacc[1]));
    }
    __syncthreads();
    { const int q = tid >> 3, mg = tid & 7;
#pragma unroll
      for (int i = 0; i < 4; ++i) { const int mb = 4 * mg + i; float v = ((IMPH[(0 * 64 + q) * 32 + mb] + IMPH[(1 * 64 + q) * 32 + mb]) + IMPH[(2 * 64 + q) * 32 + mb]) + IMPH[(3 * 64 + q) * 32 + mb];
          if (mb == 0 || mb == c || mb == c - 1) v = 1e9f; if (mb > c) v = -1.f; VAL[q * 32 + mb] = v; } }
    __syncthreads();
    { const int q = tid >> 3, mg = tid & 7; unsigned bits = 0u;
      float mine[4];
#pragma unroll
      for (int i = 0; i < 4; ++i) mine[i] = VAL[q * 32 + 4 * mg + i];
      int cnt0 = 0, cnt1 = 0, cnt2 = 0, cnt3 = 0;
#pragma unroll 4
      for (int m2 = 0; m2 < 32; ++m2) { const float v2 = VAL[q * 32 + m2]; const int rel = m2 - 4 * mg;
          cnt0 += (int)(v2 > mine[0]) | ((int)(v2 == mine[0]) & (int)(rel < 0));
          cnt1 += (int)(v2 > mine[1]) | ((int)(v2 == mine[1]) & (int)(rel < 1));
          cnt2 += (int)(v2 > mine[2]) | ((int)(v2 == mine[2]) & (int)(rel < 2));
          cnt3 += (int)(v2 > mine[3]) | ((int)(v2 == mine[3]) & (int)(rel < 3)); }
      bits = ((cnt0 < 8) ? 1u : 0u) | ((cnt1 < 8) ? 2u : 0u) | ((cnt2 < 8) ? 4u : 0u) | ((cnt3 < 8) ? 8u : 0u);
      bits <<= 4 * mg;
      if (bits) __hip_atomic_fetch_or(&MASK[q], bits, __ATOMIC_RELAXED, __HIP_MEMORY_SCOPE_WORKGROUP); }
    __syncthreads();
    const unsigned vmask = (c >= 31) ? 0xffffffffu : ((2u << c) - 1u);
    if (wid == 0) { unsigned mk = MASK[lane] & vmask;
#pragma unroll
        for (int o_ = 1; o_ < 64; o_ <<= 1) mk |= __shfl_xor(mk, o_);
        if (lane == 0) MASK[64] = mk; }
    __syncthreads();
    const unsigned mymask = MASK[ql] & vmask;
    unsigned uni = __builtin_amdgcn_readfirstlane(MASK[64]);
    {
        f32x16 o[2]; o[0] = (f32x16){0.f}; o[1] = (f32x16){0.f}; float m = NEG, lsum = 0.f;
        while (uni) {
            const int j = 31 - __builtin_clz(uni); uni &= ~(1u << j);
            __syncthreads();
            stage_k(Kt, KV6 + (tokb + 64 * j) * 768 + 256 + g * 64, 768, tid); stage_v<2>(Vt, KV6 + (tokb + 64 * j) * 768 + 384 + g * 64, 768, tid);
            __syncthreads();
            const bool sel = (mymask >> j) & 1u;
            if (__any(sel)) {
                f32x16 s0, s1; qkt(s0, s1, Kt, qr, r32, hi);
                const float tc = sl2 * (float)(64 * (j - c)); const int lim = (j == c) ? ql : 64;
#pragma unroll
                for (int r = 0; r < 16; ++r) { s0[r] += CB(r) + tc; s1[r] += CB(r) + (tc + 32.f * sl2);
                    if (!sel || crow(r, hi) > lim) s0[r] = NEG; if (!sel || crow(r, hi) + 32 > lim) s1[r] = NEG; }
                softmax_pv<2>(s0, s1, m, lsum, o, wsf, Vt, lane, r32, hi);
            }
        }
        const float ltot = lsum + __shfl_xor(lsum, 32);
        if (hi == 0) wsf[r32] = g1 / ltot;
#pragma unroll
        for (int r = 0; r < 16; ++r) { const float f = wsf[crow(r, hi)]; oacc[0][r] += o[0][r] * f; oacc[1][r] += o[1][r] * f; }
        asm volatile("" : "+v"(oacc[0]), "+v"(oacc[1]));
    }
    {
        f32x16 o[2]; o[0] = (f32x16){0.f}; o[1] = (f32x16){0.f}; float m = NEG, lsum = 0.f;
        const int jlo = c - 8 < 0 ? 0 : c - 8;
        for (int j = c; j >= jlo; --j) {
            __syncthreads();
            stage_k(Kt, KV6 + (tokb + 64 * j) * 768 + 512 + g * 64, 768, tid); stage_v<2>(Vt, KV6 + (tokb + 64 * j) * 768 + 640 + g * 64, 768, tid);
            __syncthreads();
            f32x16 s0, s1; qkt(s0, s1, Kt, qr, r32, hi);
            const float tc = sl2 * (float)(64 * (j - c));
            const int lim = (j == c) ? ql : 64;
            const int low = (j == c - 8) ? ql : -1;
#pragma unroll
            for (int r = 0; r < 16; ++r) { s0[r] += CB(r) + tc; s1[r] += CB(r) + (tc + 32.f * sl2);
                const int k0 = crow(r, hi), k1 = k0 + 32;
                if (k0 > lim || k0 <= low) s0[r] = NEG; if (k1 > lim || k1 <= low) s1[r] = NEG; }
            softmax_pv<2>(s0, s1, m, lsum, o, wsf, Vt, lane, r32, hi);
        }
        const float ltot = lsum + __shfl_xor(lsum, 32);
        if (hi == 0) wsf[r32] = g2 / ltot;
#pragma unroll
        for (int r = 0; r < 16; ++r) { const float f = wsf[crow(r, hi)]; oacc[0][r] += o[0][r] * f; oacc[1][r] += o[1][r] * f; }
        asm volatile("" : "+v"(oacc[0]), "+v"(oacc[1]));
    }
#pragma unroll
    for (int r = 0; r < 16; ++r) { bf16_t* dst = NQ + (tokb + t0 + crow(r, hi)) * 512 + h * 64 + r32; dst[0] = f2bf(oacc[0][r]); dst[32] = f2bf(oacc[1][r]); }
    __syncthreads();
}

__device__ __forceinline__ int next_unit(unsigned* ctr, LAS unsigned char* lds) {
    LAS int* bc = (LAS int*)(lds + LDS_MISC);
    __syncthreads();
    if (threadIdx.x == 0) bc[0] = (int)__hip_atomic_fetch_add(ctr, 1u, __ATOMIC_RELAXED, __HIP_MEMORY_SCOPE_AGENT);
    __syncthreads();
    return __builtin_amdgcn_readfirstlane(bc[0]);
}

__device__ __forceinline__ void phase_merge(const Params& p, int l, LAS unsigned char* lds) {
    SG_IDS
    unsigned char* ws = p.ws;
    const bf16_t* YA = (const bf16_t*)(ws + WS_NQ); const bf16_t* YB = (const bf16_t*)(ws + WS_DQ);
    const bf16_t* WA = (const bf16_t*)(ws + WS_WA) + (size_t)l * DM * 512; const bf16_t* WB = (const bf16_t*)(ws + WS_WB) + (size_t)l * DM * 512;
    const bf16_t* GA = (const bf16_t*)(ws + WS_GA); const bf16_t* GB = (const bf16_t*)(ws + WS_GB); bf16_t* MG = (bf16_t*)(ws + WS_XN);
    for (int u = blockIdx.x; u < 256 * 8; u += gridDim.x) {
        const int pm = (u >> 7) * 16 + (u & 15), pn = (u >> 4) & 7, m0 = pm * 128, n0 = pn * 128;
        f32x4 acc[2][4], t[2][4]; SG_ZERO(acc);
        sg_kloop(acc, ARowLin{(const char*)(YA + (size_t)m0 * 512), 1024}, 128, WA + (size_t)n0 * 512, 512, 8, lds);
#pragma unroll
        for (int m = 0; m < 2; ++m)
#pragma unroll
            for (int n = 0; n < 4; ++n) { const u32x2 gw = *(const u32x2*)(GA + (size_t)(m0 + SG_ROW(m)) * DM + n0 + SG_COL(n));
                t[m][n] = acc[m][n] * (f32x4){bflo(gw.x), bfhi(gw.x), bflo(gw.y), bfhi(gw.y)}; }
        SG_ZERO(acc);
        sg_kloop(acc, ARowLin{(const char*)(YB + (size_t)m0 * 512), 1024}, 128, WB + (size_t)n0 * 512, 512, 8, lds);
#pragma unroll
        for (int m = 0; m < 2; ++m)
#pragma unroll
            for (int n = 0; n < 4; ++n) { const size_t off = (size_t)(m0 + SG_ROW(m)) * DM + n0 + SG_COL(n); const u32x2 gw = *(const u32x2*)(GB + off);
                st4bf(MG + off, t[m][n] + acc[m][n] * (f32x4){bflo(gw.x), bfhi(gw.x), bflo(gw.y), bfhi(gw.y)}); }
    }
}
__device__ __forceinline__ void phase_outproj(const Params& p, int l, LAS unsigned char* lds) {
    SG_IDS
    unsigned char* ws = p.ws;
    const bf16_t* MG = (const bf16_t*)(ws + WS_XN); const bf16_t* WO = (const bf16_t*)(ws + WS_WO) + (size_t)l * DM * DM;
    const float* hin = (l == 0) ? p.x : p.out; float* hout = p.out;
    for (int u = blockIdx.x; u < 256 * 8; u += gridDim.x) {
        const int pm = (u >> 7) * 16 + (u & 15), pn = (u >> 4) & 7, m0 = pm * 128, n0 = pn * 128;
        f32x4 acc[2][4]; SG_ZERO(acc);
        sg_kloop(acc, ARowLin{(const char*)(MG + (size_t)m0 * DM), 2048}, 128, WO + (size_t)n0 * DM, DM, 16, lds);
#pragma unroll
        for (int m = 0; m < 2; ++m)
#pragma unroll
            for (int n = 0; n < 4; ++n) { const size_t off = (size_t)(m0 + SG_ROW(m)) * DM + n0 + SG_COL(n); *(f32x4*)(hout + off) = *(const f32x4*)(hin + off) + acc[m][n]; }
    }
}

__device__ __forceinline__ void phase_router(const Params& p, int l, LAS unsigned char* lds) {
    int tid_ = threadIdx.x; asm volatile("" : "+v"(tid_));
    const int tid = tid_, lane = tid & 63, wid = tid >> 6;
    unsigned char* ws = p.ws;
    LAS float* RW = (LAS float*)lds;
    LAS unsigned* cntl = (LAS unsigned*)(lds + 81920);
    LAS unsigned* lbase = (LAS unsigned*)(lds + 81920 + 64);
    LAS unsigned* loc = (LAS unsigned*)(lds + 82048);
    LAS float* wloc = (LAS float*)(lds + 82048 + 16384);
    const float* gwp = p.router_grp_w + (size_t)l * DM * 4; const float* ewp = p.router_exp_w + (size_t)l * DM * 16;
    __syncthreads();
    for (int k = tid; k < DM; k += 512) {
        const f32x4 a = *(const f32x4*)(gwp + k * 4);
#pragma unroll
        for (int i = 0; i < 4; ++i) RW[i * 1024 + k] = a[i];
#pragma unroll
        for (int q4 = 0; q4 < 4; ++q4) { const f32x4 e = *(const f32x4*)(ewp + k * 16 + q4 * 4);
#pragma unroll
            for (int i = 0; i < 4; ++i) RW[(4 + q4 * 4 + i) * 1024 + k] = e[i]; }
    }
    const float* gb = p.router_grp_b + l * 4; const float* eb = p.router_exp_b + l * 16;
    const float* g2 = p.norm2_g + (size_t)l * DM;
    unsigned* ecnt = (unsigned*)(ws + WS_CTL) + CW_ECNT + 64 * l;
    unsigned* LIST = (unsigned*)(ws + WS_LIST); float* WL = (float*)(ws + WS_WL);
    bf16_t* XN = (bf16_t*)(ws + WS_XN);
    for (int ch = blockIdx.x; ch < NTOK / 128; ch += gridDim.x) {
        __syncthreads();
        if (tid < 16) cntl[tid] = 0u;
        __syncthreads();
        for (int i = 0; i < 16; ++i) {
            const int tok = ch * 128 + wid * 16 + i;
            const float* xrow = p.out + (size_t)tok * DM;
            f32x4 v[4]; float s = 0.f;
#pragma unroll
            for (int j = 0; j < 4; ++j) { v[j] = *(const f32x4*)(xrow + (64 * j + lane) * 4); s += (v[j][0] * v[j][0] + v[j][1] * v[j][1]) + (v[j][2] * v[j][2] + v[j][3] * v[j][3]); }
            const float rstd = rsqrtf(wave_sum(s) * (1.f / 1024.f) + 1e-6f);
#pragma unroll
            for (int j = 0; j < 4; ++j) { const f32x4 gg = *(const f32x4*)(g2 + (64 * j + lane) * 4); v[j] = v[j] * rstd * gg; st4bf(XN + (size_t)tok * DM + (64 * j + lane) * 4, v[j]); }
            float lg[20];
#pragma unroll
            for (int cc = 0; cc < 20; ++cc) { float a = 0.f;
#pragma unroll
                for (int j = 0; j < 4; ++j) { const f32x4 w = *(LAS const f32x4*)(RW + cc * 1024 + (64 * j + lane) * 4); a += (v[j][0] * w[0] + v[j][1] * w[1]) + (v[j][2] * w[2] + v[j][3] * w[3]); }
                lg[cc] = wave_sum(a); }
            if (lane == 0) {
                float gl[4];
#pragma unroll
                for (int q4 = 0; q4 < 4; ++q4) gl[q4] = lg[q4] + gb[q4];
                int gi = 0; float gm = gl[0];
#pragma unroll
                for (int q4 = 1; q4 < 4; ++q4) if (gl[q4] > gm) { gm = gl[q4]; gi = q4; }
                float gs = 0.f;
#pragma unroll
                for (int q4 = 0; q4 < 4; ++q4) gs += __expf(gl[q4] - gm);
                const float gwt = 1.f / gs;
                float el[4];
#pragma unroll
                for (int e = 0; e < 4; ++e) el[e] = (gi == 0 ? lg[4 + e] : gi == 1 ? lg[8 + e] : gi == 2 ? lg[12 + e] : lg[16 + e]) + eb[gi * 4 + e];
                int i1 = 0; float v1 = el[0];
#pragma unroll
                for (int e = 1; e < 4; ++e) if (el[e] > v1) { v1 = el[e]; i1 = e; }
                int i2 = -1; float v2 = -3.0e38f;
#pragma unroll
                for (int e = 0; e < 4; ++e) if (e != i1 && el[e] > v2) { v2 = el[e]; i2 = e; }
                const float ex = __expf(v2 - v1), w1 = gwt / (1.f + ex), w2 = gwt * ex / (1.f + ex);
                const int e1 = gi * 4 + i1, e2 = gi * 4 + i2;
                const unsigned s1 = __hip_atomic_fetch_add(&cntl[e1], 1u, __ATOMIC_RELAXED, __HIP_MEMORY_SCOPE_WORKGROUP); loc[e1 * 256 + s1] = (unsigned)tok * 2u; wloc[e1 * 256 + s1] = w1;
                const unsigned s2 = __hip_atomic_fetch_add(&cntl[e2], 1u, __ATOMIC_RELAXED, __HIP_MEMORY_SCOPE_WORKGROUP); loc[e2 * 256 + s2] = (unsigned)tok * 2u + 1u; wloc[e2 * 256 + s2] = w2;
            }
        }
        __syncthreads();
        if (tid < 16) lbase[tid] = __hip_atomic_fetch_add(&ecnt[tid], cntl[tid], __ATOMIC_RELAXED, __HIP_MEMORY_SCOPE_AGENT);
        __syncthreads();
        for (int e = 0; e < 16; ++e) { const unsigned n = cntl[e], bs = lbase[e];
            for (unsigned i = tid; i < n; i += 512) { LIST[(size_t)e * NTOK + bs + i] = loc[e * 256 + i]; WL[(size_t)e * NTOK + bs + i] = wloc[e * 256 + i]; } }
    }
}

struct MoeUnit { int e, tile, n, hoff; };
__device__ __forceinline__ bool moe_find(LAS const int* cnts, int ut, MoeUnit& mu) {
    int pre = 0;
    for (int e = 0; e < 16; ++e) { const int cn = cnts[e], nt = (cn + 127) >> 7; if (ut < pre + nt) { mu.e = e; mu.tile = ut - pre; mu.n = cn - mu.tile * 128; if (mu.n > 128) mu.n = 128; mu.hoff = (pre + mu.tile) * 128; return true; } pre += nt; }
    return false;
}
__device__ __forceinline__ void phase_moe1(const Params& p, int l, LAS unsigned char* lds) {
    SG_IDS
    unsigned char* ws = p.ws;
    LAS int* cnts = (LAS int*)(lds + LDS_MISC + 64);
    const unsigned* ecnt = (const unsigned*)(ws + WS_CTL) + CW_ECNT + 64 * l;
    __syncthreads();
    if (tid < 16) cnts[tid] = (int)__hip_atomic_load(&ecnt[tid], __ATOMIC_RELAXED, __HIP_MEMORY_SCOPE_AGENT);
    __syncthreads();
    const unsigned* LIST = (const unsigned*)(ws + WS_LIST); const float* WL = (const float*)(ws + WS_WL);
    const char* XN = (const char*)(ws + WS_XN); bf16_t* H = (bf16_t*)(ws + WS_H);
    for (int ut = blockIdx.x;; ut += gridDim.x) {
        MoeUnit mu; if (!moe_find(cnts, ut, mu)) break;
        const unsigned* lst = LIST + (size_t)mu.e * NTOK + mu.tile * 128;
        const bf16_t* W = (const bf16_t*)(ws + WS_WGU) + (size_t)(l * 16 + mu.e) * 256 * DM;
        f32x4 ag[2][4], au[2][4]; SG_ZERO(ag); SG_ZERO(au);
        sg_kloop(ag, ARowGather{lst, mu.n, XN}, 128, W, DM, 16, lds);
        sg_kloop(au, ARowGather{lst, mu.n, XN}, 128, W + (size_t)128 * DM, DM, 16, lds);
        const float* wl = WL + (size_t)mu.e * NTOK + mu.tile * 128;
#pragma unroll
        for (int m = 0; m < 2; ++m) { const int rl = SG_ROW(m); const float wgt = (rl < mu.n) ? wl[rl] : 0.f;
#pragma unroll
            for (int n = 0; n < 4; ++n) { f32x4 gv = ag[m][n], uv = au[m][n], hv;
#pragma unroll
                for (int i = 0; i < 4; ++i) hv[i] = gv[i] * sigm(gv[i]) * uv[i] * wgt;
                st4bf(H + (size_t)(mu.hoff + rl) * 128 + SG_COL(n), hv); } }
    }
}
__device__ __forceinline__ void phase_moe2(const Params& p, int l, LAS unsigned char* lds) {
    SG_IDS
    unsigned char* ws = p.ws;
    LAS int* cnts = (LAS int*)(lds + LDS_MISC + 64);
    const unsigned* ecnt = (const unsigned*)(ws + WS_CTL) + CW_ECNT + 64 * l;
    __syncthreads();
    if (tid < 16) cnts[tid] = (int)__hip_atomic_load(&ecnt[tid], __ATOMIC_RELAXED, __HIP_MEMORY_SCOPE_AGENT);
    __syncthreads();
    const unsigned* LIST = (const unsigned*)(ws + WS_LIST); const bf16_t* H = (const bf16_t*)(ws + WS_H);
    bf16_t* Y0 = (bf16_t*)(ws + WS_GA); bf16_t* Y1 = (bf16_t*)(ws + WS_GB);
    for (int u = blockIdx.x;; u += gridDim.x) {
        MoeUnit mu; if (!moe_find(cnts, u >> 3, mu)) break;
        const int pn = u & 7;
        const unsigned* lst = LIST + (size_t)mu.e * NTOK + mu.tile * 128;
        const bf16_t* W = (const bf16_t*)(ws + WS_WD) + (size_t)(l * 16 + mu.e) * DM * 128 + (size_t)pn * 128 * 128;
        f32x4 acc[2][4]; SG_ZERO(acc);
        sg_kloop(acc, ARowLin{(const char*)(H + (size_t)mu.hoff * 128), 256}, 128, W, 128, 2, lds);
#pragma unroll
        for (int m = 0; m < 2; ++m) { const int rl = SG_ROW(m);
            if (rl < mu.n) { const unsigned ent = lst[rl]; bf16_t* dst = ((ent & 1u) ? Y1 : Y0) + (size_t)(ent >> 1) * DM + pn * 128;
#pragma unroll
                for (int n = 0; n < 4; ++n) st4bf(dst + SG_COL(n), acc[m][n]); } }
    }
}

__device__ __forceinline__ void phase_combine(const Params& p, int l) {
    int tid_ = threadIdx.x; asm volatile("" : "+v"(tid_));
    const int tid = tid_, lane = tid & 63, wid = tid >> 6;
    unsigned char* ws = p.ws;
    const int gw = blockIdx.x * 8 + wid, NGW = gridDim.x * 8;
    const bf16_t* Y0 = (const bf16_t*)(ws + WS_GA); const bf16_t* Y1 = (const bf16_t*)(ws + WS_GB); bf16_t* XN = (bf16_t*)(ws + WS_XN);
    const bool last = (l == DEPTH - 1);
    const float* g = last ? p.final_norm_g : p.norm1_g + (size_t)(l + 1) * DM;
    for (int mrow = gw; mrow < NTOK; mrow += NGW) {
        float* hrow = p.out + (size_t)mrow * DM;
        f32x4 v[4]; float s = 0.f;
#pragma unroll
        for (int j = 0; j < 4; ++j) { const int cidx = (64 * j + lane) * 4; v[j] = *(const f32x4*)(hrow + cidx);
            const u32x2 a = *(const u32x2*)(Y0 + (size_t)mrow * DM + cidx), b2 = *(const u32x2*)(Y1 + (size_t)mrow * DM + cidx);
            v[j] = v[j] + (f32x4){bflo(a.x), bfhi(a.x), bflo(a.y), bfhi(a.y)} + (f32x4){bflo(b2.x), bfhi(b2.x), bflo(b2.y), bfhi(b2.y)};
            s += (v[j][0] * v[j][0] + v[j][1] * v[j][1]) + (v[j][2] * v[j][2] + v[j][3] * v[j][3]); }
        const float rstd = rsqrtf(wave_sum(s) * (1.f / 1024.f) + 1e-6f);
#pragma unroll
        for (int j = 0; j < 4; ++j) { const int cidx = (64 * j + lane) * 4; const f32x4 gg = *(const f32x4*)(g + cidx);
            if (last) *(f32x4*)(hrow + cidx) = v[j] * rstd * gg;
            else { *(f32x4*)(hrow + cidx) = v[j]; st4bf(XN + (size_t)mrow * DM + cidx, v[j] * rstd * gg); } }
    }
}


#define XB_TMO      128
#define XB_XCNT(j)  (256  + 64 * (j))
#define XB_XSUB(j)  (1280 + 64 * (j))
#define XB_XGEN(j)  (2304 + 64 * (j))
#define XB_TOP      3328
#define XB_TOPGEN   3392
#define XCD_BAR_WORDS 3456
#define XB_SPIN_CAP (1u << 18)
__device__ __forceinline__ unsigned xb_ld(unsigned* p)              { return __hip_atomic_load(p, __ATOMIC_RELAXED, __HIP_MEMORY_SCOPE_AGENT); }
__device__ __forceinline__ unsigned xb_add(unsigned* p, unsigned v) { return __hip_atomic_fetch_add(p, v, __ATOMIC_RELAXED, __HIP_MEMORY_SCOPE_AGENT); }
__device__ __forceinline__ unsigned xb_xcc_id() { return (unsigned)__builtin_amdgcn_s_getreg((3 << 11) | 20) & 0xFu; }
#define XB_SPIN(cond, bar) do { unsigned _sp = 0; while (cond) { __builtin_amdgcn_s_sleep(1); \
    if ((++_sp & 255u) == 0u) { if (xb_ld(&(bar)[XB_TMO])) break; if (_sp > XB_SPIN_CAP) { atomicAdd(&(bar)[XB_TMO], 1u); break; } } } } while (0)
struct XcdBarrier { unsigned* bar; unsigned x; volatile LAS unsigned* st; };
__device__ __forceinline__ XcdBarrier xcd_barrier_post(unsigned* bar, volatile LAS unsigned* st) {
    XcdBarrier b; b.bar = bar; b.x = xb_xcc_id(); b.st = st;
    if (threadIdx.x == 0) (void)xb_add(&bar[XB_XCNT(b.x)], 1u);
    return b;
}
__device__ __forceinline__ void xcd_barrier_complete(unsigned* bar, unsigned x, unsigned& nloc, unsigned& nx) {
    const unsigned G = gridDim.x * gridDim.y * gridDim.z;
    unsigned sum, cnt, mine, sp = 0u;
    for (;;) {
        sum = 0u; cnt = 0u; mine = 0u;
#pragma unroll
        for (unsigned j = 0; j < 16; ++j) { const unsigned c = xb_ld(&bar[XB_XCNT(j)]); sum += c; cnt += (c > 0u) ? 1u : 0u; mine = (j == x) ? c : mine; }
        if (sum == G) break;
        __builtin_amdgcn_s_sleep(1);
        if ((++sp & 255u) == 0u) { if (xb_ld(&bar[XB_TMO])) break; if (sp > XB_SPIN_CAP) { atomicAdd(&bar[XB_TMO], 1u); break; } }
    }
    nloc = mine > 0u ? mine : 1u; nx = cnt > 0u ? cnt : 1u;
}
__device__ __forceinline__ void xcd_barrier(const XcdBarrier& b) {
    asm volatile("s_waitcnt vmcnt(0)" ::: "memory");
    __syncthreads();
    if (threadIdx.x == 0) {
        unsigned* bar = b.bar;
        __builtin_amdgcn_s_waitcnt(0);
        unsigned nloc = b.st[0], nx = b.st[1];
        if (nloc == 0u) { xcd_barrier_complete(bar, b.x, nloc, nx); b.st[0] = nloc; b.st[1] = nx; }
        const unsigned old = xb_add(&bar[XB_XSUB(b.x)], 1u);
        const unsigned gen = old / nloc;
        if (old + 1u == (gen + 1u) * nloc) {
            __builtin_amdgcn_fence(__ATOMIC_RELEASE, "agent");
            asm volatile("s_waitcnt vmcnt(0)" ::: "memory");
            const unsigned og = xb_add(&bar[XB_TOP], 1u);
            const unsigned tg = og / nx;
            if (og + 1u == (tg + 1u) * nx) xb_add(&bar[XB_TOPGEN], 1u);
            else XB_SPIN(xb_ld(&bar[XB_TOPGEN]) == tg, bar);
            __builtin_amdgcn_fence(__ATOMIC_ACQUIRE, "agent");
            xb_add(&bar[XB_XGEN(b.x)], 1u);
            asm volatile("s_waitcnt vmcnt(0)" ::: "memory");
        } else {
            XB_SPIN(xb_ld(&bar[XB_XGEN(b.x)]) == gen, bar);
            __builtin_amdgcn_fence(__ATOMIC_ACQUIRE, "agent");
            asm volatile("s_waitcnt vmcnt(0)" ::: "memory");
        }
    }
    __syncthreads();
}

template <int K> __device__ __forceinline__ void run_phase(const Params& p, int l, LAS unsigned char* lds) {
    unsigned* ctl = (unsigned*)(p.ws + WS_CTL);
    if (K == 0) phase_prologue(p, lds);
    if (K == 1) phase_inproj(p, l, lds);
    if (K == 2) { unsigned* ctr = ctl + CW_QCTR + 64 * (l * 2 + 0);
        for (;;) { const int u = next_unit(ctr, lds); if (u >= 64 + 1024) break; if (u < 64) compress_unit(p, l, u, lds); else diff_unit(p, l, u - 64, lds); } }
    if (K == 3) { unsigned* ctr = ctl + CW_QCTR + 64 * (l * 2 + 1);
        for (;;) { const int u = next_unit(ctr, lds); if (u >= 1024) break; nsa_unit(p, l, u, lds); } }
    if (K == 4) phase_merge(p, l, lds);
    if (K == 5) phase_outproj(p, l, lds);
    if (K == 6) phase_router(p, l, lds);
    if (K == 7) phase_moe1(p, l, lds);
    if (K == 8) phase_moe2(p, l, lds);
    if (K == 9) phase_combine(p, l);
}
#if MK_MULTI
template <int K> __global__ void __launch_bounds__(512, 2) mk_one(Params p) {
    extern __shared__ __attribute__((aligned(16))) unsigned char lds_raw[];
    run_phase<K>(p, p.ph_lo, (LAS unsigned char*)lds_raw);
}
template <int K> static void launch_one(int grid, hipStream_t stream, Params p, int l) {
    static bool attr = false;
    if (!attr) { (void)hipFuncSetAttribute((const void*)mk_one<K>, hipFuncAttributeMaxDynamicSharedMemorySize, LDS_BYTES); attr = true; }
    p.ph_lo = l; p.ph_hi = l + 1;
    hipLaunchKernelGGL(mk_one<K>, dim3(grid), dim3(512), LDS_BYTES, stream, p);
}
#else
__global__ void __launch_bounds__(512, 2) mk_fwd(Params p) {
    extern __shared__ __attribute__((aligned(16))) unsigned char lds_raw[];
    LAS unsigned char* lds = (LAS unsigned char*)lds_raw;
    cg::grid_group grid = cg::this_grid();
    volatile LAS unsigned* bst = (volatile LAS unsigned*)(lds + LDS_MISC + 256);
    if (threadIdx.x < 2) bst[threadIdx.x] = 0u;
    __syncthreads();
    const XcdBarrier bar = xcd_barrier_post((unsigned*)(p.ws + WS_CTL) + CW_BAR, bst);
#define SEAM() xcd_barrier(bar)
    run_phase<0>(p, 0, lds); grid.sync();
    for (int l = 0; l < DEPTH; ++l) {
        run_phase<1>(p, l, lds); SEAM();
        run_phase<2>(p, l, lds); SEAM();
        run_phase<3>(p, l, lds); SEAM();
        run_phase<4>(p, l, lds); SEAM();
        run_phase<5>(p, l, lds); SEAM();
        run_phase<6>(p, l, lds); SEAM();
        run_phase<7>(p, l, lds); SEAM();
        run_phase<8>(p, l, lds); SEAM();
        run_phase<9>(p, l, lds); if (l + 1 < DEPTH) SEAM();
    }
}
#endif

extern "C" void kernel_launch(void* const* d_in, const int* in_sizes, int n_in, void* d_out, int out_size, void* d_ws, size_t ws_size, hipStream_t stream) {
    static int grid = 0;
    if (grid == 0) {
        if (n_in != 22 || in_sizes[0] != NTOK * DM || out_size != NTOK * DM || ws_size < WS_END) { fprintf(stderr, "kernel_launch: unexpected shapes (n_in %d, in0 %d, out %d, ws %zu)\n", n_in, n_in > 0 ? in_sizes[0] : -1, out_size, ws_size); grid = -1; return; }
        int dev = 0, cus = 0, per_cu = 1;
        (void)hipGetDevice(&dev); (void)hipDeviceGetAttribute(&cus, hipDeviceAttributeMultiprocessorCount, dev);
#if !MK_MULTI
        (void)hipFuncSetAttribute((const void*)mk_fwd, hipFuncAttributeMaxDynamicSharedMemorySize, LDS_BYTES);
        (void)hipOccupancyMaxActiveBlocksPerMultiprocessor(&per_cu, (const void*)mk_fwd, 512, LDS_BYTES);
        if (per_cu < 1) { fprintf(stderr, "kernel_launch: occupancy query says %d blocks per CU\n", per_cu); per_cu = 1; }
#endif
        (void)hipGetLastError();
        grid = cus * per_cu;
    }
    if (grid < 0) return;
    (void)hipMemsetAsync((char*)d_ws + WS_CTL, 0, CTL_BYTES, stream);
    Params p{};
    const float** pp = (const float**)&p;
    for (int i = 0; i < 22; ++i) pp[i] = (const float*)d_in[i];
    p.out = (float*)d_out; p.ws = (unsigned char*)d_ws;
#if MK_MULTI
    launch_one<0>(grid, stream, p, 0);
    for (int l = 0; l < DEPTH; ++l) {
        launch_one<1>(grid, stream, p, l); launch_one<2>(grid, stream, p, l); launch_one<3>(grid, stream, p, l); launch_one<4>(grid, stream, p, l); launch_one<5>(grid, stream, p, l);
        launch_one<6>(grid, stream, p, l); launch_one<7>(grid, stream, p, l); launch_one<8>(grid, stream, p, l); launch_one<9>(grid, stream, p, l);
    }
#else
    p.ph_lo = 0; p.ph_hi = NPHASE;
    void* args[] = {&p};
    hipError_t e = hipLaunchCooperativeKernel((const void*)mk_fwd, dim3(grid), dim3(512), args, LDS_BYTES, stream);
    if (e != hipSuccess) fprintf(stderr, "cooperative launch failed: %s (grid %d)\n", hipGetErrorString(e), grid);
#endif
}
```

```cpp
#include <hip/hip_runtime.h>
#include <hip/hip_cooperative_groups.h>
#include <cstdio>
#include <cstdint>
namespace cg = cooperative_groups;

#ifndef MK_MULTI
#define MK_MULTI 0
#endif

#define LAS __attribute__((address_space(3)))
typedef unsigned short bf16_t;
typedef short bf16x8 __attribute__((ext_vector_type(8)));
typedef short s16x4 __attribute__((ext_vector_type(4)));
typedef float f32x2 __attribute__((ext_vector_type(2)));
typedef float f32x4 __attribute__((ext_vector_type(4)));
typedef float f32x16 __attribute__((ext_vector_type(16)));
typedef unsigned u32x2 __attribute__((ext_vector_type(2)));
typedef unsigned u32x4 __attribute__((ext_vector_type(4)));
typedef __bf16 bf16x2_t __attribute__((ext_vector_type(2)));

constexpr int NTOK = 32768, DM = 1024, TSEQ = 2048, NBATCH = 16, DEPTH = 2;
constexpr int INCOLS = 4888, NPAD = 5120;
constexpr float LOG2E = 1.4426950408889634f;
constexpr float QSCALE = 0.125f * LOG2E;
constexpr int NPHASE = 1 + 9 * DEPTH;

constexpr size_t MiB = 1u << 20;
constexpr size_t WS_CTL = 0, CTL_BYTES = 65536;
constexpr size_t WS_WIN = 1 * MiB;
constexpr size_t WS_WA = 21 * MiB;
constexpr size_t WS_WB = 23 * MiB;
constexpr size_t WS_WO = 25 * MiB;
constexpr size_t WS_WC1 = 29 * MiB;
constexpr size_t WS_WGU = 31 * MiB;
constexpr size_t WS_WD = 47 * MiB;
constexpr size_t WS_MISC = 55 * MiB;
constexpr size_t WS_LIST = 58 * MiB;
constexpr size_t WS_WL = 60 * MiB;
constexpr size_t WS_XN = 64 * MiB;
constexpr size_t WS_NQ = 128 * MiB;
constexpr size_t WS_KV6 = 160 * MiB;
constexpr size_t WS_NG = 208 * MiB;
constexpr size_t WS_DQ = 210 * MiB;
constexpr size_t WS_DK = 242 * MiB;
constexpr size_t WS_DV = 274 * MiB;
constexpr size_t WS_GA = 306 * MiB;
constexpr size_t WS_GB = 370 * MiB;
constexpr size_t WS_END = 434 * MiB;
constexpr size_t WS_H = WS_DK;
constexpr int CW_QCTR = 64;
constexpr int CW_ECNT = 1024;
constexpr int CW_BAR = 4096;

constexpr int LDS_BYTES = 147456;
constexpr int LDS_MISC = 131072;

struct Params {
    const float* x; const float* norm1_g; const float* w_in; const float* cmp_pe; const float* cmp_w1; const float* cmp_b1; const float* cmp_w2; const float* cmp_b2;
    const float* diff_lambda; const float* diff_subln_g; const float* w_branch_a; const float* w_branch_b; const float* w_out; const float* norm2_g;
    const float* router_grp_w; const float* router_grp_b; const float* router_exp_w; const float* router_exp_b; const float* exp_w_gate; const float* exp_w_up; const float* exp_w_down; const float* final_norm_g;
    float* out; unsigned char* ws; int ph_lo, ph_hi;
};

typedef const __attribute__((address_space(4))) Params& PRef;

__device__ __forceinline__ unsigned cvtpk(float lo, float hi) { f32x2 v = {lo, hi}; bf16x2_t b = __builtin_convertvector(v, bf16x2_t); return __builtin_bit_cast(unsigned, b); }
__device__ __forceinline__ float bflo(unsigned u) { return __uint_as_float(u << 16); }
__device__ __forceinline__ float bfhi(unsigned u) { return __uint_as_float(u & 0xffff0000u); }
__device__ __forceinline__ float bf1(bf16_t b) { return __uint_as_float(((unsigned)b) << 16); }
__device__ __forceinline__ bf16_t f2bf(float f) { return (bf16_t)(cvtpk(f, 0.f) & 0xffffu); }
__device__ __forceinline__ int crow(int r, int hi) { return (r & 3) + 8 * (r >> 2) + 4 * hi; }
__device__ __forceinline__ float wave_sum(float v) {
#pragma unroll
    for (int o = 1; o < 64; o <<= 1) v += __shfl_xor(v, o);
    return v;
}
__device__ __forceinline__ float sigm(float x) { return 1.f / (1.f + __expf(-x)); }
__device__ __forceinline__ float ex2(float x) { return __builtin_amdgcn_exp2f(x); }
__device__ __forceinline__ float alibi_slope(int i  ) { return exp2f(-8.0f * (float)i / 12.0f); }
__device__ __forceinline__ s16x4 vtr(LAS const unsigned char* p) { return __builtin_bit_cast(s16x4, __builtin_amdgcn_ds_read_tr16_b64_v4i16((LAS s16x4*)p)); }
#define MFMA32(a, b, c) __builtin_amdgcn_mfma_f32_32x32x16_bf16(a, b, c, 0, 0, 0)
#define MFMA16(a, b, c) __builtin_amdgcn_mfma_f32_16x16x32_bf16(a, b, c, 0, 0, 0)

struct ARowLin { const char* base; size_t stride; __device__ __forceinline__ const char* operator()(int r) const { return base + (size_t)r * stride; } };
struct ARowGather { const unsigned* list; int n; const char* xn; __device__ __forceinline__ const char* operator()(int r) const { const int i = r < n ? r : n - 1; return xn + (size_t)(list[i] >> 1) * 2048; } };

template <class ARow>
__device__ __forceinline__ void sg_kloop(f32x4 (&acc)[2][4], const ARow& arow, int kstepA, const bf16_t* Bt, int ldb, int nt, LAS unsigned char* lds) {
    int tid_ = threadIdx.x; asm volatile("" : "+v"(tid_));
    const int tid = tid_, lane = tid & 63, wid = tid >> 6, wr = wid >> 1, wc = wid & 1, fr = lane & 15, fq = lane >> 4;
    const int lrow = tid >> 3, lch = tid & 7;
    const char* pa0 = arow(lrow) + lch * 16; const char* pa1 = arow(lrow + 64) + lch * 16;
    const char* pb0 = (const char*)(Bt + (size_t)lrow * ldb) + lch * 16; const char* pb1 = (const char*)(Bt + (size_t)(lrow + 64) * ldb) + lch * 16;
    const int wofs0 = lrow * 128 + ((lch ^ ((lrow >> 1) & 7)) << 4), wofs1 = wofs0 + 64 * 128;
    u32x4 ra0 = *(const u32x4*)pa0, ra1 = *(const u32x4*)pa1, rb0 = *(const u32x4*)pb0, rb1 = *(const u32x4*)pb1;
    for (int t = 0; t < nt; ++t) {
        __syncthreads();
        *(LAS u32x4*)(lds + wofs0) = ra0; *(LAS u32x4*)(lds + wofs1) = ra1; *(LAS u32x4*)(lds + 16384 + wofs0) = rb0; *(LAS u32x4*)(lds + 16384 + wofs1) = rb1;
        __syncthreads();
        if (t + 1 < nt) { pa0 += kstepA; pa1 += kstepA; pb0 += 128; pb1 += 128; ra0 = *(const u32x4*)pa0; ra1 = *(const u32x4*)pa1; rb0 = *(const u32x4*)pb0; rb1 = *(const u32x4*)pb1; }
#pragma unroll
        for (int ks = 0; ks < 2; ++ks) {
            bf16x8 af[2], bfr[4];
            const int ch = ks * 4 + fq;
#pragma unroll
            for (int m = 0; m < 2; ++m) { const int row = wr * 32 + m * 16 + fr; af[m] = *(LAS const bf16x8*)(lds + row * 128 + ((ch ^ ((row >> 1) & 7)) << 4)); }
#pragma unroll
            for (int n = 0; n < 4; ++n) { const int row = wc * 64 + n * 16 + fr; bfr[n] = *(LAS const bf16x8*)(lds + 16384 + row * 128 + ((ch ^ ((row >> 1) & 7)) << 4)); }
#pragma unroll
            for (int m = 0; m < 2; ++m)
#pragma unroll
                for (int n = 0; n < 4; ++n) acc[m][n] = MFMA16(bfr[n], af[m], acc[m][n]);
        }
    }
}
#define SG_ZERO(acc) do { _Pragma("unroll") for (int m_ = 0; m_ < 2; ++m_) _Pragma("unroll") for (int n_ = 0; n_ < 4; ++n_) acc[m_][n_] = (f32x4){0.f, 0.f, 0.f, 0.f}; } while (0)
#define SG_IDS int tid_ = threadIdx.x; asm volatile("" : "+v"(tid_)); const int tid = tid_, lane = tid & 63, wid = tid >> 6, wr = wid >> 1, wc = wid & 1, fr = lane & 15, fq = lane >> 4; (void)tid; (void)lane; (void)wid;
#define SG_ROW(m) (wr * 32 + (m) * 16 + fr)
#define SG_COL(n) (wc * 64 + (n) * 16 + 4 * fq)
__device__ __forceinline__ void st4bf(bf16_t* dst, f32x4 v) { u32x2 w; w.x = cvtpk(v[0], v[1]); w.y = cvtpk(v[2], v[3]); *(u32x2*)dst = w; }

__device__ __forceinline__ void transpose_item(const float* W, int ldw, int src_col, int valid, bf16_t* WT, int K, int dst_row, int k0, LAS float* scr, int lane) {
#pragma unroll 8
    for (int i = 0; i < 32; ++i) { const int kk = 2 * i + (lane >> 5), c = lane & 31; scr[kk * 33 + c] = (c < valid) ? W[(size_t)(k0 + kk) * ldw + src_col + c] : 0.f; }
    asm volatile("s_waitcnt lgkmcnt(0)" ::: "memory");
    const int c = lane & 7;
#pragma unroll
    for (int j = 0; j < 4; ++j) { const int n = (lane >> 3) + 8 * j; LAS const float* s = scr + (8 * c) * 33 + n;
        u32x4 o; o.x = cvtpk(s[0 * 33], s[1 * 33]); o.y = cvtpk(s[2 * 33], s[3 * 33]); o.z = cvtpk(s[4 * 33], s[5 * 33]); o.w = cvtpk(s[6 * 33], s[7 * 33]);
        *(u32x4*)(WT + (size_t)(dst_row + n) * K + k0 + 8 * c) = o; }
    asm volatile("s_waitcnt lgkmcnt(0)" ::: "memory");
}
__device__ __forceinline__ void norm_row_bf16(const float* xrow, const float* g, bf16_t* orow, int lane) {
    f32x4 v[4]; float s = 0.f;
#pragma unroll
    for (int j = 0; j < 4; ++j) { v[j] = *(const f32x4*)(xrow + (64 * j + lane) * 4); s += (v[j][0] * v[j][0] + v[j][1] * v[j][1]) + (v[j][2] * v[j][2] + v[j][3] * v[j][3]); }
    const float rstd = rsqrtf(wave_sum(s) * (1.f / 1024.f) + 1e-6f);
#pragma unroll
    for (int j = 0; j < 4; ++j) { const f32x4 gg = *(const f32x4*)(g + (64 * j + lane) * 4); f32x4 o = v[j] * rstd * gg; st4bf(orow + (64 * j + lane) * 4, o); }
}

__device__ __forceinline__ void phase_prologue(PRef p, LAS unsigned char* lds) {
    int tid_ = threadIdx.x; asm volatile("" : "+v"(tid_));
    const int tid = tid_, lane = tid & 63, wid = tid >> 6;
    const int gw = blockIdx.x * 8 + wid, NGW = gridDim.x * 8;
    LAS float* scr = (LAS float*)(lds + wid * 8448);
    unsigned char* ws = p.ws;
    constexpr int I_IN = 16 * 160, I_A = 8 * 32, I_O = 16 * 32, I_C1 = 2 * 32 * 4, I_G = 16 * 16 * 4, I_D = 16 * 2 * 32;
    constexpr int I_LAYER = I_IN + 2 * I_A + I_O + I_C1 + 2 * I_G + I_D;
    for (int it = gw; it < DEPTH * I_LAYER; it += NGW) {
        const int l = it / I_LAYER; int r = it % I_LAYER;
        if (r < I_IN) { const int kb = r / 160, nb = r % 160, n0 = nb * 32; int src, valid = 32;
            if (n0 < 1280) src = n0; else if (n0 < 4864) src = n0 + 24; else { src = 1280 + (n0 - 4864); valid = (n0 == 4864) ? 24 : 0; if (valid == 0) src = 0; }
            transpose_item(p.w_in + (size_t)l * DM * INCOLS, INCOLS, src, valid, (bf16_t*)(ws + WS_WIN) + (size_t)l * NPAD * DM, DM, n0, kb * 64, scr, lane); continue; }
        r -= I_IN;
        if (r < I_A) { const int kb = r / 32, nb = r % 32; transpose_item(p.w_branch_a + (size_t)l * 512 * DM, DM, nb * 32, 32, (bf16_t*)(ws + WS_WA) + (size_t)l * DM * 512, 512, nb * 32, kb * 64, scr, lane); continue; }
        r -= I_A;
        if (r < I_A) { const int kb = r / 32, nb = r % 32; transpose_item(p.w_branch_b + (size_t)l * 512 * DM, DM, nb * 32, 32, (bf16_t*)(ws + WS_WB) + (size_t)l * DM * 512, 512, nb * 32, kb * 64, scr, lane); continue; }
        r -= I_A;
        if (r < I_O) { const int kb = r / 32, nb = r % 32; transpose_item(p.w_out + (size_t)l * DM * DM, DM, nb * 32, 32, (bf16_t*)(ws + WS_WO) + (size_t)l * DM * DM, DM, nb * 32, kb * 64, scr, lane); continue; }
        r -= I_O;
        if (r < I_C1) { const int kv = r / 128, r2 = r % 128, kb = r2 / 4, nb = r2 % 4;
            transpose_item(p.cmp_w1 + (size_t)(l * 2 + kv) * 2048 * 128, 128, nb * 32, 32, (bf16_t*)(ws + WS_WC1) + (size_t)(l * 2 + kv) * 128 * 2048, 2048, nb * 32, kb * 64, scr, lane); continue; }
        r -= I_C1;
        if (r < 2 * I_G) { const int which = r / I_G, r2 = r % I_G, e = r2 / 64, r3 = r2 % 64, kb = r3 / 4, nb = r3 % 4;
            const float* W = (which ? p.exp_w_up : p.exp_w_gate) + (size_t)(l * 16 + e) * DM * 128;
            transpose_item(W, 128, nb * 32, 32, (bf16_t*)(ws + WS_WGU) + (size_t)(l * 16 + e) * 256 * DM, DM, which * 128 + nb * 32, kb * 64, scr, lane); continue; }
        r -= 2 * I_G;
        { const int e = r / 64, r3 = r % 64, kb = r3 / 32, nb = r3 % 32;
            transpose_item(p.exp_w_down + (size_t)(l * 16 + e) * 128 * DM, DM, nb * 32, 32, (bf16_t*)(ws + WS_WD) + (size_t)(l * 16 + e) * DM * 128, 128, nb * 32, kb * 64, scr, lane); }
    }
    for (int m = gw; m < NTOK; m += NGW) norm_row_bf16(p.x + (size_t)m * DM, p.norm1_g, (bf16_t*)(ws + WS_XN) + (size_t)m * DM, lane);
    __syncthreads();
    if (blockIdx.x < 8) {
        const int l = blockIdx.x >> 2, kv = (blockIdx.x >> 1) & 1, jh = blockIdx.x & 1, j = jh * 64 + lane;
        const float* pe = p.cmp_pe + (size_t)(l * 2 + kv) * 2048; const float* w1 = p.cmp_w1 + (size_t)(l * 2 + kv) * 2048 * 128;
        float s = 0.f;
        for (int f = wid * 256; f < wid * 256 + 256; ++f) s += pe[f] * w1[(size_t)f * 128 + j];
        LAS float* part = (LAS float*)(lds + 70000);
        part[wid * 64 + lane] = s;
        __syncthreads();
        if (wid == 0) { float t = p.cmp_b1[(l * 2 + kv) * 128 + j];
#pragma unroll
            for (int w = 0; w < 8; ++w) t += part[w * 64 + lane];
            ((float*)(ws + WS_MISC))[(l * 2 + kv) * 128 + j] = t; }
    }
    if (blockIdx.x == 8 && wid < DEPTH) {
        const int l = wid; const float* lp = p.diff_lambda + l * 256;
        const float a = wave_sum(lp[lane] * lp[64 + lane]), b = wave_sum(lp[128 + lane] * lp[192 + lane]);
        const float lam_init = 0.8f - 0.6f * expf(-0.3f * (float)l);
        if (lane == 0) ((float*)(ws + WS_MISC + 4096))[l] = expf(a) - expf(b) + lam_init;
    }
}

namespace pg8 {
#define PG8_LAS __attribute__((address_space(3)))
constexpr int BM = 256, BK = 64, HALF = 128, HTB = HALF * BK * 2  , STAGE_BYTES = 8 * HTB, NXCD = 8, WGM = 8;

__host__ __device__ __forceinline__ int lds_byte(int r, int c) { const int st = (r >> 4) * 2 + (c >> 5), rr = r & 15, cc = c & 31, ob = rr * 64 + cc * 2; return st * 1024 + (ob ^ (((ob >> 9) & 1) << 5)); }
__host__ __device__ __forceinline__ void stage_rc(int b, int& R, int& C) { const int st = b / 1024, sb = b % 1024, swz = sb ^ (((sb >> 9) & 1) << 5); R = (st >> 1) * 16 + swz / 64; C = (st & 1) * 32 + (swz % 64) / 2; }
__host__ __device__ __forceinline__ int perm32(int rho) { const int n = rho >> 4, i = rho & 15; return 8 * (i >> 2) + 4 * n + (i & 3); }

struct Unit { int pm, pn, z; };
struct Gemm { const bf16_t* A; const bf16_t* Bt; const bf16_t* A2; const bf16_t* Bt2; int M, N, K; };

struct StaticOrder {
    int nM, nN, nwg, G, c;
    __host__ __device__ void init(int M, int N, int G_, int c_) { nM = M / BM; nN = N / BM; nwg = nM * nN; G = G_; c = c_; }
    __host__ __device__ bool next(int i, Unit& u) const {
        const long L = (long)i * G + c; if (L >= nwg) return false;
        int wgid = (int)L; { const int q = nwg / NXCD, r = nwg % NXCD, xcd = wgid % NXCD, off = wgid / NXCD; wgid = (xcd < r ? xcd * (q + 1) : r * (q + 1) + (xcd - r) * q) + off; }
        const int nig = WGM * nN, gid = wgid / nig, fm = gid * WGM, gsz = (nM - fm) < WGM ? (nM - fm) : WGM;
        u.pm = fm + ((wgid % nig) % gsz); u.pn = (wgid % nig) / gsz; u.z = 0; return true;
    }
    __device__ __forceinline__ void a_ready(const Unit&) const {}
    __device__ __forceinline__ void done(const Unit&) const {}
};

template <class Epi, class Sched, bool ALIGN_EPI = false, bool SP2 = false>
__device__ __forceinline__ void gemm_phase(PG8_LAS unsigned char* lds, const Gemm g, const Sched& S, const Epi& E) {
    int tid_ = threadIdx.x; asm volatile("" : "+v"(tid_));
    const int tid = tid_, wid = __builtin_amdgcn_readfirstlane(tid >> 6), lane = tid & 63, wr = wid >> 2, wc = wid & 3, fr = lane & 15, fq = lane >> 4;
    const int K = g.K, nt = K / BK;
    unsigned voffA[2], voffB[2];
#pragma unroll
    for (int i = 0; i < 2; ++i) { int R, C; stage_rc(tid * 16 + i * 8192, R, C); const int Rb = Epi::PERM ? ((R & ~31) + perm32(R & 31)) : R;
        voffA[i] = (unsigned)(R * K + C) * 2u; voffB[i] = (unsigned)(Rb * K + C) * 2u; }
    const size_t kstep = (size_t)(BK * 2);
    const size_t hstep = (size_t)HALF * K * 2;
    const size_t tstep = 2 * hstep;
    const unsigned ldsw = (unsigned)wid * 1024u;
    const int aoff = lds_byte(wr * 64 + fr, fq * 8), boff = lds_byte(wc * 32 + fr, fq * 8);
#define PG8_SA(b, h) (((b) * 2 + (h)) * HTB)
#define PG8_SB(b, h) ((4 + (b) * 2 + (h)) * HTB)
#define PG8_STAGE(bufoff, gbase, voff) do { _Pragma("unroll") for (int _i = 0; _i < 2; ++_i) \
        __builtin_amdgcn_global_load_lds((const unsigned*)((const char*)(gbase) + (voff)[_i]), (PG8_LAS unsigned*)(lds + (bufoff) + ldsw + _i * 8192), 16, 0, 0); } while (0)
#define PG8_LDA(dst, b, h) do { _Pragma("unroll") for (int m = 0; m < 4; ++m) _Pragma("unroll") for (int k = 0; k < 2; ++k) dst[m][k] = *(const PG8_LAS bf16x8*)(lds + PG8_SA(b, h) + aoff + m * 2048 + k * 1024); } while (0)
#define PG8_LDB(dst, b, h) do { _Pragma("unroll") for (int n = 0; n < 2; ++n) _Pragma("unroll") for (int k = 0; k < 2; ++k) dst[n][k] = *(const PG8_LAS bf16x8*)(lds + PG8_SB(b, h) + boff + n * 2048 + k * 1024); } while (0)
#define PG8_MMA(ai, bj, At, Bt) do { __builtin_amdgcn_s_setprio(1); _Pragma("unroll") for (int m = 0; m < 4; ++m) _Pragma("unroll") for (int n = 0; n < 2; ++n) _Pragma("unroll") for (int k = 0; k < 2; ++k) \
        acc[ai][bj][m][n] = __builtin_amdgcn_mfma_f32_16x16x32_bf16(Bt[n][k], At[m][k], acc[ai][bj][m][n], 0, 0, 0); __builtin_amdgcn_s_setprio(0); } while (0)
#define PG8_WAIT_V(n) asm volatile("s_waitcnt vmcnt(" #n ")" ::: "memory")
#define PG8_WAIT_L(n) asm volatile("s_waitcnt lgkmcnt(" #n ")" ::: "memory")
#define PG8_BAR __builtin_amdgcn_s_barrier()
#define PG8_SCHED __builtin_amdgcn_sched_barrier(0)
    Unit cur, nxt; int ui = 0;
    if (!S.next(0, cur)) return;
    f32x4 acc[2][2][4][2];
#pragma unroll
    for (int a = 0; a < 2; ++a)
#pragma unroll
        for (int b = 0; b < 2; ++b)
#pragma unroll
            for (int m = 0; m < 4; ++m)
#pragma unroll
                for (int n = 0; n < 2; ++n) acc[a][b][m][n] = (f32x4){0.f, 0.f, 0.f, 0.f};
    bf16x8 At[4][2], B0[2][2], B1[2][2];
    const char* cA = (const char*)(cur.z ? g.A2 : g.A) + (size_t)cur.pm * tstep; const char* cB = (const char*)(cur.z ? g.Bt2 : g.Bt) + (size_t)cur.pn * tstep;
    S.a_ready(cur);
    if constexpr (SP2) {
        PG8_STAGE(PG8_SB(0, 0), cB, voffB); PG8_STAGE(PG8_SB(0, 1), cB + hstep, voffB); PG8_STAGE(PG8_SA(0, 0), cA, voffA); PG8_STAGE(PG8_SA(0, 1), cA + hstep, voffA);
        if (wr == 1) PG8_BAR;
        PG8_WAIT_V(2); PG8_BAR;
        PG8_STAGE(PG8_SB(1, 0), cB + kstep, voffB); PG8_STAGE(PG8_SA(1, 0), cA + kstep, voffA); PG8_STAGE(PG8_SB(1, 1), cB + hstep + kstep, voffB);
        PG8_WAIT_V(6); PG8_BAR;
    } else {
        PG8_STAGE(PG8_SB(0, 0), cB, voffB); PG8_STAGE(PG8_SA(0, 0), cA, voffA); PG8_STAGE(PG8_SB(0, 1), cB + hstep, voffB); PG8_STAGE(PG8_SA(0, 1), cA + hstep, voffA);
        if (wr == 1) PG8_BAR;
        PG8_WAIT_V(4); PG8_BAR;
        PG8_STAGE(PG8_SB(1, 0), cB + kstep, voffB); PG8_STAGE(PG8_SA(1, 0), cA + kstep, voffA); PG8_STAGE(PG8_SB(1, 1), cB + hstep + kstep, voffB);
        PG8_WAIT_V(6); PG8_BAR;
    }
    for (;;) {
        const bool has_next = S.next(ui + 1, nxt);
        const char* nA = has_next ? (const char*)(nxt.z ? g.A2 : g.A) + (size_t)nxt.pm * tstep : cA; const char* nB = has_next ? (const char*)(nxt.z ? g.Bt2 : g.Bt) + (size_t)nxt.pn * tstep : cB;
        for (int t = 0; t < nt; t += 2) {
            const bool last = (t == nt - 2);
            const char* a1 = cA + (size_t)(t + 1) * kstep;
            const char* a2 = last ? nA : cA + (size_t)(t + 2) * kstep; const char* b2 = last ? nB : cB + (size_t)(t + 2) * kstep;
            const char* a3 = a2 + kstep; const char* b3 = b2 + kstep;
            if (last && has_next) S.a_ready(nxt);
            if constexpr (SP2) {
            PG8_LDB(B0, 0, 0); PG8_LDB(B1, 0, 1); PG8_SCHED; PG8_LDA(At, 0, 0); PG8_STAGE(PG8_SA(1, 1), a1 + hstep, voffA);
            PG8_WAIT_V(8); PG8_WAIT_L(0); PG8_BAR; PG8_MMA(0, 0, At, B0); PG8_MMA(0, 1, At, B1); PG8_BAR; PG8_SCHED;
            PG8_LDA(At, 0, 1); PG8_STAGE(PG8_SB(0, 0), b2, voffB); PG8_STAGE(PG8_SB(0, 1), b2 + hstep, voffB); PG8_STAGE(PG8_SA(0, 0), a2, voffA);
            PG8_WAIT_V(8); PG8_WAIT_L(0); PG8_BAR; PG8_MMA(1, 0, At, B0); PG8_MMA(1, 1, At, B1); PG8_BAR; PG8_SCHED;
            PG8_LDB(B0, 1, 0); PG8_LDB(B1, 1, 1); PG8_SCHED; PG8_LDA(At, 1, 0); PG8_STAGE(PG8_SA(0, 1), a2 + hstep, voffA);
            PG8_WAIT_V(8); PG8_WAIT_L(0); PG8_BAR; PG8_MMA(0, 0, At, B0); PG8_MMA(0, 1, At, B1); PG8_BAR; PG8_SCHED;
            PG8_LDA(At, 1, 1); PG8_STAGE(PG8_SB(1, 0), b3, voffB); PG8_STAGE(PG8_SB(1, 1), b3 + hstep, voffB); PG8_STAGE(PG8_SA(1, 0), a3, voffA);
            PG8_WAIT_V(8); PG8_WAIT_L(0); PG8_BAR; PG8_MMA(1, 0, At, B0); PG8_MMA(1, 1, At, B1); PG8_BAR; PG8_SCHED;
            } else {
            PG8_LDB(B0, 0, 0); PG8_SCHED; PG8_LDA(At, 0, 0); PG8_STAGE(PG8_SA(1, 1), a1 + hstep, voffA);
            PG8_WAIT_L(8); PG8_BAR; PG8_WAIT_L(0); PG8_MMA(0, 0, At, B0); PG8_BAR; PG8_SCHED;
            PG8_LDB(B1, 0, 1); PG8_STAGE(PG8_SB(0, 0), b2, voffB);
            PG8_BAR; PG8_WAIT_L(0); PG8_MMA(0, 1, At, B1); PG8_BAR;
            PG8_LDA(At, 0, 1); PG8_STAGE(PG8_SA(0, 0), a2, voffA);
            PG8_BAR; PG8_WAIT_L(0); PG8_MMA(1, 0, At, B0); PG8_BAR; PG8_SCHED;
            PG8_STAGE(PG8_SB(0, 1), b2 + hstep, voffB);
            PG8_WAIT_V(6); PG8_BAR; PG8_MMA(1, 1, At, B1); PG8_BAR;
            PG8_LDB(B0, 1, 0); PG8_SCHED; PG8_LDA(At, 1, 0); PG8_STAGE(PG8_SA(0, 1), a2 + hstep, voffA);
            PG8_WAIT_L(8); PG8_BAR; PG8_WAIT_L(0); PG8_MMA(0, 0, At, B0); PG8_BAR; PG8_SCHED;
            PG8_LDB(B1, 1, 1); PG8_STAGE(PG8_SB(1, 0), b3, voffB);
            PG8_BAR; PG8_WAIT_L(0); PG8_MMA(0, 1, At, B1); PG8_BAR;
            PG8_LDA(At, 1, 1); PG8_STAGE(PG8_SA(1, 0), a3, voffA);
            PG8_BAR; PG8_WAIT_L(0); PG8_MMA(1, 0, At, B0); PG8_BAR; PG8_SCHED;
            PG8_STAGE(PG8_SB(1, 1), b3 + hstep, voffB);
            PG8_WAIT_V(6); PG8_BAR; PG8_MMA(1, 1, At, B1); PG8_BAR;
            }
        }
        if constexpr (ALIGN_EPI) { if (wr == 0) PG8_BAR; }
        if constexpr (!Epi::AFTER_DRAIN) { E(acc, cur, wr, wc, fr, fq); S.done(cur); }
        if (!has_next) break;
        if (!Epi::keep(cur)) {
#pragma unroll
        for (int a = 0; a < 2; ++a)
#pragma unroll
            for (int b = 0; b < 2; ++b)
#pragma unroll
                for (int m = 0; m < 4; ++m)
#pragma unroll
                    for (int n = 0; n < 2; ++n) acc[a][b][m][n] = (f32x4){0.f, 0.f, 0.f, 0.f}; }
        cur = nxt; cA = nA; cB = nB; ++ui;
        if constexpr (ALIGN_EPI) { if (wr == 1) PG8_BAR; }
    }
    PG8_WAIT_V(0);
    if constexpr (!ALIGN_EPI) { if (wr == 0) PG8_BAR; }
    PG8_BAR;
    if constexpr (Epi::AFTER_DRAIN) { E.fused(acc, cur, wr, wc, fr, fq, lds, wid, lane); S.done(cur); }
#undef PG8_SA
#undef PG8_SB
#undef PG8_STAGE
#undef PG8_LDA
#undef PG8_LDB
#undef PG8_MMA
#undef PG8_WAIT_V
#undef PG8_WAIT_L
#undef PG8_BAR
#undef PG8_SCHED
}
}

typedef pg8::Unit PUnit;
struct EpiInproj {
    static constexpr bool PERM = true, AFTER_DRAIN = false;
    unsigned char* ws;
    static __device__ __forceinline__ bool keep(const PUnit&) { return false; }
    __device__ __forceinline__ void operator()(f32x4 (&acc)[2][2][4][2], const PUnit& u, int wr, int wc, int fr, int fq) const {
        const int n0 = u.pn * 256;
        bf16_t* dst; int pitch, c0, mode = 0;
        if (n0 < 512) { dst = (bf16_t*)(ws + WS_NQ); pitch = 512; c0 = n0; mode = 1; }
        else if (n0 < 1280) { dst = (bf16_t*)(ws + WS_KV6); pitch = 768; c0 = n0 - 512; }
        else if (n0 < 1792) { dst = (bf16_t*)(ws + WS_DQ); pitch = 512; c0 = n0 - 1280; mode = 1; }
        else if (n0 < 2304) { dst = (bf16_t*)(ws + WS_DK); pitch = 512; c0 = n0 - 1792; }
        else if (n0 < 2816) { dst = (bf16_t*)(ws + WS_DV); pitch = 512; c0 = n0 - 2304; }
        else if (n0 < 3840) { dst = (bf16_t*)(ws + WS_GA); pitch = 1024; c0 = n0 - 2816; mode = 2; }
        else if (n0 < 4864) { dst = (bf16_t*)(ws + WS_GB); pitch = 1024; c0 = n0 - 3840; mode = 2; }
        else { dst = (bf16_t*)(ws + WS_NG); pitch = 32; c0 = 0; mode = 3; }
        asm volatile("" : "+v"(fr), "+v"(fq));
        const int row0 = u.pm * 256 + wr * 64 + fr, col0 = wc * 32 + 8 * fq;
#pragma unroll
        for (int ai = 0; ai < 2; ++ai)
#pragma unroll
            for (int m = 0; m < 4; ++m) { bf16_t* rowp = dst + (size_t)(row0 + ai * 128 + m * 16) * pitch + c0 + col0;
#pragma unroll
                for (int bj = 0; bj < 2; ++bj) { f32x4 v0 = acc[ai][bj][m][0], v1 = acc[ai][bj][m][1];
                    if (mode == 1) { v0 = v0 * QSCALE; v1 = v1 * QSCALE; }
                    else if (mode >= 2) {
#pragma unroll
                        for (int i = 0; i < 4; ++i) { v0[i] = sigm(v0[i]); v1[i] = sigm(v1[i]); } }
                    if (mode != 3 || (bj == 0 && wc == 0)) { u32x4 w; w.x = cvtpk(v0[0], v0[1]); w.y = cvtpk(v0[2], v0[3]); w.z = cvtpk(v1[0], v1[1]); w.w = cvtpk(v1[2], v1[3]); *(u32x4*)(rowp + bj * 128) = w; } } }
    }
};
struct EpiMerge {
    static constexpr bool PERM = true, AFTER_DRAIN = false;
    const bf16_t* GA; const bf16_t* GB; bf16_t* MG;
    static __device__ __forceinline__ bool keep(const PUnit& u) { return u.z == 0; }
    __device__ __forceinline__ void operator()(f32x4 (&acc)[2][2][4][2], const PUnit& u, int wr, int wc, int fr, int fq) const {
        asm volatile("" : "+v"(fr), "+v"(fq));
        const int row0 = u.pm * 256 + wr * 64 + fr, col0 = u.pn * 256 + wc * 32 + 8 * fq;
#pragma unroll
        for (int ai = 0; ai < 2; ++ai)
#pragma unroll
            for (int m = 0; m < 4; ++m) { const size_t ro = (size_t)(row0 + ai * 128 + m * 16) * DM + col0;
#pragma unroll
                for (int bj = 0; bj < 2; ++bj) { const size_t off = ro + bj * 128;
                    const u32x4 gb = *(const u32x4*)(GB + off);
                    const f32x4 b0 = {bflo(gb.x), bfhi(gb.x), bflo(gb.y), bfhi(gb.y)}, b1 = {bflo(gb.z), bfhi(gb.z), bflo(gb.w), bfhi(gb.w)};
                    if (u.z == 0) { const u32x4 ga = *(const u32x4*)(GA + off);
                        const f32x4 a0 = {bflo(ga.x), bfhi(ga.x), bflo(ga.y), bfhi(ga.y)}, a1 = {bflo(ga.z), bfhi(ga.z), bflo(ga.w), bfhi(ga.w)};
#pragma unroll
                        for (int i = 0; i < 4; ++i) { acc[ai][bj][m][0][i] *= a0[i] * __builtin_amdgcn_rcpf(fmaxf(b0[i], 1e-30f)); acc[ai][bj][m][1][i] *= a1[i] * __builtin_amdgcn_rcpf(fmaxf(b1[i], 1e-30f)); } }
                    else { const f32x4 v0 = acc[ai][bj][m][0] * b0, v1 = acc[ai][bj][m][1] * b1;
                        u32x4 w; w.x = cvtpk(v0[0], v0[1]); w.y = cvtpk(v0[2], v0[3]); w.z = cvtpk(v1[0], v1[1]); w.w = cvtpk(v1[2], v1[3]); *(u32x4*)(MG + off) = w; } } }
    }
};
struct MergeOrder {
    int G, c;
    __device__ __forceinline__ bool next(int i, PUnit& u) const { const int t = (i >> 1) * G + c; if (t >= 512) return false;
        int wgid = t; { const int q = 512 / 8, xcd = wgid % 8, off = wgid / 8; wgid = xcd * q + off; }
        u.pm = (wgid >> 5) * 8 + (wgid & 7); u.pn = (wgid >> 3) & 3; u.z = i & 1; return true; }
    __device__ __forceinline__ void a_ready(const PUnit&) const {}
    __device__ __forceinline__ void done(const PUnit&) const {}
};
struct EpiOut {
    static constexpr bool PERM = false, AFTER_DRAIN = false;
    const float* hin; float* hout;
    static __device__ __forceinline__ bool keep(const PUnit&) { return false; }
    __device__ __forceinline__ void operator()(f32x4 (&acc)[2][2][4][2], const PUnit& u, int wr, int wc, int fr, int fq) const {
        asm volatile("" : "+v"(fr), "+v"(fq));
        const int row0 = u.pm * 256 + wr * 64 + fr, col0 = u.pn * 256 + wc * 32 + 4 * fq;
#pragma unroll
        for (int ai = 0; ai < 2; ++ai)
#pragma unroll
            for (int m = 0; m < 4; ++m) { const size_t ro = (size_t)(row0 + ai * 128 + m * 16) * DM + col0;
#pragma unroll
                for (int bj = 0; bj < 2; ++bj)
#pragma unroll
                    for (int n = 0; n < 2; ++n) { const size_t off = ro + bj * 128 + n * 16; *(f32x4*)(hout + off) = *(const f32x4*)(hin + off) + acc[ai][bj][m][n]; } }
    }
};
__device__ __forceinline__ void phase_inproj_pg8(PRef p, int l, LAS unsigned char* lds) {
    unsigned char* ws = p.ws;
    const bf16_t* W = (const bf16_t*)(ws + WS_WIN) + (size_t)l * NPAD * DM;
    pg8::Gemm g{(const bf16_t*)(ws + WS_XN), W, (const bf16_t*)(ws + WS_XN), W, NTOK, NPAD, DM};
    pg8::StaticOrder S; S.init(NTOK, NPAD, (int)gridDim.x, (int)blockIdx.x);
    EpiInproj E{ws};
    pg8::gemm_phase<EpiInproj, pg8::StaticOrder, true, true>(lds, g, S, E);
}
__device__ __forceinline__ void phase_merge_pg8(PRef p, int l, LAS unsigned char* lds) {
    unsigned char* ws = p.ws;
    pg8::Gemm g{(const bf16_t*)(ws + WS_NQ), (const bf16_t*)(ws + WS_WA) + (size_t)l * DM * 512, (const bf16_t*)(ws + WS_DQ), (const bf16_t*)(ws + WS_WB) + (size_t)l * DM * 512, NTOK, DM, 512};
    MergeOrder S{(int)gridDim.x, (int)blockIdx.x};
    EpiMerge E{(const bf16_t*)(ws + WS_GA), (const bf16_t*)(ws + WS_GB), (bf16_t*)(ws + WS_XN)};
    pg8::gemm_phase<EpiMerge, MergeOrder, true, true>(lds, g, S, E);
}
__device__ __forceinline__ void phase_outproj_pg8(PRef p, int l, LAS unsigned char* lds) {
    unsigned char* ws = p.ws;
    const bf16_t* WO = (const bf16_t*)(ws + WS_WO) + (size_t)l * DM * DM;
    pg8::Gemm g{(const bf16_t*)(ws + WS_XN), WO, (const bf16_t*)(ws + WS_XN), WO, NTOK, DM, DM};
    pg8::StaticOrder S; S.init(NTOK, DM, (int)gridDim.x, (int)blockIdx.x);
    EpiOut E{(l == 0) ? p.x : p.out, p.out};
    pg8::gemm_phase<EpiOut, pg8::StaticOrder, true, true>(lds, g, S, E);
}

__device__ __forceinline__ void phase_inproj(PRef p, int l, LAS unsigned char* lds) {
    SG_IDS
    unsigned char* ws = p.ws;
    const bf16_t* XN = (const bf16_t*)(ws + WS_XN); const bf16_t* W = (const bf16_t*)(ws + WS_WIN) + (size_t)l * NPAD * DM;
    constexpr int NT = 39, GRP = 16;
    for (int u = blockIdx.x; u < 256 * NT; u += gridDim.x) {
        const int grp = u / (GRP * NT), rem = u % (GRP * NT), pn = rem / GRP, pm = grp * GRP + rem % GRP;
        const int m0 = pm * 128, n0 = pn * 128;
        f32x4 acc[2][4]; SG_ZERO(acc);
        sg_kloop(acc, ARowLin{(const char*)(XN + (size_t)m0 * DM), 2048}, 128, W + (size_t)n0 * DM, DM, 16, lds);
        bf16_t* dst; int pitch, c0, mode = 0;
        if (n0 < 512) { dst = (bf16_t*)(ws + WS_NQ); pitch = 512; c0 = n0; mode = 1; }
        else if (n0 < 1280) { dst = (bf16_t*)(ws + WS_KV6); pitch = 768; c0 = n0 - 512; }
        else if (n0 < 1792) { dst = (bf16_t*)(ws + WS_DQ); pitch = 512; c0 = n0 - 1280; mode = 1; }
        else if (n0 < 2304) { dst = (bf16_t*)(ws + WS_DK); pitch = 512; c0 = n0 - 1792; }
        else if (n0 < 2816) { dst = (bf16_t*)(ws + WS_DV); pitch = 512; c0 = n0 - 2304; }
        else if (n0 < 3840) { dst = (bf16_t*)(ws + WS_GA); pitch = 1024; c0 = n0 - 2816; mode = 2; }
        else if (n0 < 4864) { dst = (bf16_t*)(ws + WS_GB); pitch = 1024; c0 = n0 - 3840; mode = 2; }
        else { dst = (bf16_t*)(ws + WS_NG); pitch = 32; c0 = 0; mode = 3; }
#pragma unroll
        for (int m = 0; m < 2; ++m)
#pragma unroll
            for (int n = 0; n < 4; ++n) {
                const int row = m0 + SG_ROW(m), col = SG_COL(n); f32x4 v = acc[m][n];
                if (mode == 1) v = v * QSCALE;
                else if (mode >= 2) { v[0] = sigm(v[0]); v[1] = sigm(v[1]); v[2] = sigm(v[2]); v[3] = sigm(v[3]); }
                if (mode != 3 || col < 32) st4bf(dst + (size_t)row * pitch + c0 + col, v);
            }
    }
}

__device__ __forceinline__ void stage_k(LAS unsigned char* kdst, const bf16_t* src  , int pitch, int tid) {
    const int row = tid & 63, ch = tid >> 6;
    *(LAS u32x4*)(kdst + ch * 1024 + row * 16) = *(const u32x4*)(src + (size_t)row * pitch + ch * 8);
}
template <int NDB> __device__ __forceinline__ void stage_v(LAS unsigned char* vdst, const bf16_t* src, int pitch, int tid) {
#pragma unroll
    for (int i = 0; i < NDB / 2; ++i) { const int pc = tid + 512 * i, pw = pc >> 6, ln = pc & 63, db = pw >> 2, rg = pw & 3;
        *(LAS u32x4*)(vdst + pw * 1024 + ln * 16) = *(const u32x4*)(src + (size_t)(16 * rg + (ln >> 2)) * pitch + db * 32 + (ln & 3) * 8); }
}
__device__ __forceinline__ void qkt(f32x16& p0, f32x16& p1, LAS const unsigned char* K, const bf16x8 (&qr)[4], int r32, int hi) {
    LAS const unsigned char* kb = K + hi * 1024 + r32 * 16;
    p0 = (f32x16){0.f}; p1 = (f32x16){0.f};
#pragma unroll
    for (int d0 = 0; d0 < 4; ++d0) {
        const bf16x8 b0 = *(LAS const bf16x8*)(kb + d0 * 2048), b1 = *(LAS const bf16x8*)(kb + d0 * 2048 + 512);
        p0 = MFMA32(b0, qr[d0], p0); p1 = MFMA32(b1, qr[d0], p1);
    }
    __builtin_amdgcn_sched_barrier(0);
}
template <int NDB> __device__ __forceinline__ void pv(f32x16 (&o)[NDB], const f32x16& p0, const f32x16& p1, LAS const unsigned char* V, int lane, int hi) {
    u32x4 pw[4];
    pw[0] = (u32x4){cvtpk(p0[0], p0[1]), cvtpk(p0[2], p0[3]), cvtpk(p0[4], p0[5]), cvtpk(p0[6], p0[7])};
    pw[1] = (u32x4){cvtpk(p0[8], p0[9]), cvtpk(p0[10], p0[11]), cvtpk(p0[12], p0[13]), cvtpk(p0[14], p0[15])};
    pw[2] = (u32x4){cvtpk(p1[0], p1[1]), cvtpk(p1[2], p1[3]), cvtpk(p1[4], p1[5]), cvtpk(p1[6], p1[7])};
    pw[3] = (u32x4){cvtpk(p1[8], p1[9]), cvtpk(p1[10], p1[11]), cvtpk(p1[12], p1[13]), cvtpk(p1[14], p1[15])};
    LAS const unsigned char* vb = V + ((lane >> 4) & 1) * 32 + (lane & 3) * 8 + (4 * hi + ((lane & 15) >> 2)) * 64;
#pragma unroll
    for (int d0 = 0; d0 < NDB; ++d0)
#pragma unroll
        for (int ks = 0; ks < 4; ++ks) {
            const s16x4 lo = vtr(vb + d0 * 4096 + ks * 1024), hh = vtr(vb + d0 * 4096 + ks * 1024 + 512);
            const bf16x8 vf = (bf16x8){lo[0], lo[1], lo[2], lo[3], hh[0], hh[1], hh[2], hh[3]};
            o[d0] = MFMA32(__builtin_bit_cast(bf16x8, pw[ks]), vf, o[d0]);
            if (ks == 3) __builtin_amdgcn_sched_barrier(0);
        }
}
constexpr float SM_THR = 6.0f;
constexpr float NEG = -1e30f;
template <int NDB> __device__ __forceinline__ void softmax_pv(f32x16& s0, f32x16& s1, float& m, float& l, f32x16 (&o)[NDB], LAS float* wsf, LAS const unsigned char* V, int lane, int r32, int hi) {
    float rm = fmaxf(s0[0], s1[0]);
#pragma unroll
    for (int r = 1; r < 16; ++r) rm = fmaxf(rm, fmaxf(s0[r], s1[r]));
    rm = fmaxf(rm, __shfl_xor(rm, 32));
    if (__any(rm > m + SM_THR)) {
        const float mn = fmaxf(m, rm), f = ex2(m - mn); l *= f; m = mn;
        if (hi == 0) wsf[r32] = f;
#pragma unroll
        for (int r = 0; r < 16; ++r) { const float fr_ = wsf[crow(r, hi)];
#pragma unroll
            for (int d = 0; d < NDB; ++d) o[d][r] *= fr_; }
    }
    float sum = 0.f;
#pragma unroll
    for (int r = 0; r < 16; ++r) { s0[r] = ex2(s0[r] - m); s1[r] = ex2(s1[r] - m); sum += s0[r] + s1[r]; }
    l += sum;
    pv<NDB>(o, s0, s1, V, lane, hi);
}

__device__ __forceinline__ float gelu_tanh(float x) { const float u = 0.7978845608f * (x + 0.044715f * x * x * x); const float e = __expf(2.f * u); return 0.5f * x * (2.f - 2.f / (1.f + e)); }

__device__ __forceinline__ void compress_unit(PRef p, int l, int u, LAS unsigned char* lds) {
    SG_IDS
    unsigned char* ws = p.ws;
    const int kv = u >> 5, m0 = (u & 31) * 128;
    const bf16_t* KV6 = (const bf16_t*)(ws + WS_KV6);
    struct ARowC { const bf16_t* KV6; int m0, kv; __device__ __forceinline__ const char* operator()(int r) const { const int mm = m0 + r, g = mm >> 11, tok = (mm & 2047) * 16; return (const char*)(KV6 + (size_t)tok * 768 + kv * 128 + g * 64); } };
    f32x4 acc[2][4]; SG_ZERO(acc);
    sg_kloop(acc, ARowC{KV6, m0, kv}, 768 * 2, (const bf16_t*)(ws + WS_WC1) + (size_t)(l * 2 + kv) * 128 * 2048, 2048, 32, lds);
    LAS bf16_t* Ht = (LAS bf16_t*)(lds + 32768);
    LAS float* W2 = (LAS float*)(lds + 32768 + 34816);
    const float* cb1 = (const float*)(ws + WS_MISC) + (l * 2 + kv) * 128;
#pragma unroll
    for (int m = 0; m < 2; ++m)
#pragma unroll
        for (int n = 0; n < 4; ++n) { const int row = SG_ROW(m), col = SG_COL(n); const f32x4 b = *(const f32x4*)(cb1 + col); f32x4 v = acc[m][n] + b;
            u32x2 w; w.x = cvtpk(gelu_tanh(v[0]), gelu_tanh(v[1])); w.y = cvtpk(gelu_tanh(v[2]), gelu_tanh(v[3])); *(LAS u32x2*)(Ht + row * 136 + col) = w; }
    const float* w2g = p.cmp_w2 + (size_t)(l * 2 + kv) * 128 * 64;
    for (int i = tid; i < 128 * 64 / 4; i += 512) *(LAS f32x4*)(W2 + i * 4) = *(const f32x4*)(w2g + i * 4);
    __syncthreads();
    const int d = tid & 63; const float b2 = p.cmp_b2[(l * 2 + kv) * 64 + d];
    bf16_t* dstb = (bf16_t*)(ws + WS_MISC + 65536 + (size_t)kv * 524288);
    for (int i = 0; i < 16; ++i) { const int row = (tid >> 6) + 8 * i; float s = b2;
#pragma unroll 8
        for (int f = 0; f < 128; ++f) s += bf1(Ht[row * 136 + f]) * W2[f * 64 + d];
        const int mm = m0 + row, g = mm >> 11, bi = mm & 2047;
        dstb[((size_t)bi * 2 + g) * 64 + d] = f2bf(s); }
    __syncthreads();
}

__device__ __forceinline__ void diff_unit(PRef p, int l, int u, LAS unsigned char* lds) {
    int tid_ = threadIdx.x; asm volatile("" : "+v"(tid_));
    const int tid = tid_, lane = tid & 63, r32 = lane & 31, hi = lane >> 5, wid = __builtin_amdgcn_readfirstlane(tid >> 6);
    unsigned char* ws = p.ws;
    const int c = 15 - (u >> 6), b = (u & 63) >> 2, hd = u & 3;
    const int cm = wid >> 2, qq = wid & 3, t0 = 128 * c + 32 * qq, tq = t0 + r32;
    const size_t tokb = (size_t)b * TSEQ;
    bf16_t* DQ = (bf16_t*)(ws + WS_DQ); const bf16_t* DK = (const bf16_t*)(ws + WS_DK); const bf16_t* DV = (const bf16_t*)(ws + WS_DV);
    bf16x8 qr[4];
    { const bf16_t* qp = DQ + (tokb + tq) * 512 + hd * 128 + cm * 64 + hi * 8;
#pragma unroll
      for (int d0 = 0; d0 < 4; ++d0) qr[d0] = *(const bf16x8*)(qp + d0 * 16); }
    const float sl2 = alibi_slope(9 + hd) * LOG2E;
    const float cbh = sl2 * (float)(4 * hi);
#define CB(r) fmaf(sl2, (float)(((r) & 3) + 8 * ((r) >> 2)), cbh)
    f32x16 o[4];
#pragma unroll
    for (int d = 0; d < 4; ++d) o[d] = (f32x16){0.f};
    float m = NEG, lsum = 0.f;
    LAS float* wsf = (LAS float*)(lds + LDS_MISC + 1024 + wid * 128);
    LAS unsigned char* Kt = lds; LAS unsigned char* Vt = lds + 16384;
    const int jmax_w = (t0 + 31) >> 6;
    for (int j = 2 * c + 1; j >= 0; --j) {
        __syncthreads();
        { const bf16_t* ksrc = DK + (tokb + 64 * j) * 512 + hd * 128; stage_k(Kt, ksrc, 512, tid); stage_k(Kt + 8192, ksrc + 64, 512, tid);
          stage_v<4>(Vt, DV + (tokb + 64 * j) * 512 + hd * 128, 512, tid); }
        __syncthreads();
        if (j <= jmax_w) {
            f32x16 s0, s1; qkt(s0, s1, Kt + cm * 8192, qr, r32, hi);
            const float tc = sl2 * (float)(64 * j - 128 * c);
            const bool diag = (64 * j + 63 > t0); const int lim = tq - 64 * j;
#pragma unroll
            for (int r = 0; r < 16; ++r) { s0[r] += CB(r) + tc; s1[r] += CB(r) + (tc + 32.f * sl2);
                if (diag) { if (crow(r, hi) > lim) s0[r] = NEG; if (crow(r, hi) + 32 > lim) s1[r] = NEG; } }
            softmax_pv<4>(s0, s1, m, lsum, o, wsf, Vt, lane, r32, hi);
        }
    }
    __syncthreads();
    const float lam = ((const float*)(ws + WS_MISC + 4096))[l];
    const float lam_init = 0.8f - 0.6f * expf(-0.3f * (float)l);
    const float ltot = lsum + __shfl_xor(lsum, 32);
    if (hi == 0) wsf[r32] = (cm == 0 ? 1.f : lam) / ltot;
    LAS float* X = (LAS float*)(lds + cm * 65536);
#pragma unroll
    for (int r = 0; r < 16; ++r) { const float f = wsf[crow(r, hi)]; const int q = 32 * qq + crow(r, hi);
#pragma unroll
        for (int d = 0; d < 4; ++d) X[q * 128 + d * 32 + r32] = o[d][r] * f; }
    __syncthreads();
    { const int q = tid >> 2, qt = tid & 3; LAS const float* x0 = (LAS const float*)lds + q * 128 + qt * 32; LAS const float* x1 = x0 + 16384;
      float v[32]; float ss = 0.f;
#pragma unroll
      for (int i = 0; i < 32; ++i) { v[i] = x0[i] - x1[i]; ss += v[i] * v[i]; }
      ss += __shfl_xor(ss, 1); ss += __shfl_xor(ss, 2);
      const float rstd = rsqrtf(ss * (1.f / 128.f) + 1e-5f) * (1.f - lam_init);
      const float* sg = p.diff_subln_g + l * 128 + qt * 32;
      bf16_t* dst = DQ + (tokb + 128 * c + q) * 512 + hd * 128 + qt * 32;
#pragma unroll
      for (int i = 0; i < 32; i += 8) { u32x4 w; w.x = cvtpk(v[i] * rstd * sg[i], v[i + 1] * rstd * sg[i + 1]); w.y = cvtpk(v[i + 2] * rstd * sg[i + 2], v[i + 3] * rstd * sg[i + 3]);
          w.z = cvtpk(v[i + 4] * rstd * sg[i + 4], v[i + 5] * rstd * sg[i + 5]); w.w = cvtpk(v[i + 6] * rstd * sg[i + 6], v[i + 7] * rstd * sg[i + 7]); *(u32x4*)(dst + i) = w; } }
    __syncthreads();
}

__device__ __forceinline__ void nsa_unit(PRef p, int l, int u, LAS unsigned char* lds) {
    int tid_ = threadIdx.x; asm volatile("" : "+v"(tid_));
    const int tid = tid_, lane = tid & 63, r32 = lane & 31, hi = lane >> 5, wid = __builtin_amdgcn_readfirstlane(tid >> 6);
    unsigned char* ws = p.ws;
    const int c = 31 - (u >> 5), b = (u & 31) >> 1, g = u & 1;
    const int hl = wid >> 1, qh = wid & 1, h = g * 4 + hl, t0 = 64 * c + 32 * qh, tq = t0 + r32, ql = 32 * qh + r32;
    const size_t tokb = (size_t)b * TSEQ;
    bf16_t* NQ = (bf16_t*)(ws + WS_NQ); const bf16_t* KV6 = (const bf16_t*)(ws + WS_KV6); const bf16_t* NG = (const bf16_t*)(ws + WS_NG);
    const bf16_t* KC = (const bf16_t*)(ws + WS_MISC + 65536); const bf16_t* VC = (const bf16_t*)(ws + WS_MISC + 65536 + 524288);
    bf16x8 qr[4];
    { const bf16_t* qp = NQ + (tokb + tq) * 512 + h * 64 + hi * 8;
#pragma unroll
      for (int d0 = 0; d0 < 4; ++d0) qr[d0] = *(const bf16x8*)(qp + d0 * 16); }
    const float sl2 = alibi_slope(h + 1) * LOG2E;
    const float cbh = sl2 * (float)(4 * hi);
    LAS float* wsf = (LAS float*)(lds + LDS_MISC + 1024 + wid * 128);
    LAS unsigned char* Kt = lds; LAS unsigned char* Vt = lds + 16384;
    LAS float* IMPH = (LAS float*)(lds + 32768);
    LAS float* VAL = (LAS float*)(lds + 65536);
    LAS unsigned* MASK = (LAS unsigned*)(lds + 73728);
    const float g0 = bf1(NG[(tokb + tq) * 32 + h * 3 + 0]), g1 = bf1(NG[(tokb + tq) * 32 + h * 3 + 1]), g2 = bf1(NG[(tokb + tq) * 32 + h * 3 + 2]);
    f32x16 oacc[2];
    __syncthreads();
    { const bf16_t* ksrc = KC + ((size_t)b * 128 * 2 + g) * 64; const bf16_t* vsrc = VC + ((size_t)b * 128 * 2 + g) * 64;
      stage_k(Kt, ksrc, 128, tid); stage_k(Kt + 8192, ksrc + 64 * 128, 128, tid);
      stage_v<2>(Vt, vsrc, 128, tid); stage_v<2>(Vt + 8192, vsrc + 64 * 128, 128, tid);
      if (tid < 64) MASK[tid] = 0u; }
    __syncthreads();
    {
        f32x16 s[4];
        qkt(s[0], s[1], Kt, qr, r32, hi); qkt(s[2], s[3], Kt + 8192, qr, r32, hi);
        int nmax = (tq - 31) >> 4; if (nmax > 126) nmax = 126;
        float rm = NEG;
#pragma unroll
        for (int k = 0; k < 4; ++k)
#pragma unroll
            for (int r = 0; r < 16; ++r) { const int n = 32 * k + crow(r, hi); float v = s[k][r] + 16.f * CB(r) + sl2 * (float)(512 * k);
                v = (n <= nmax) ? v : NEG; s[k][r] = v; rm = fmaxf(rm, v); }
        rm = fmaxf(rm, __shfl_xor(rm, 32));
        float sum = 0.f;
#pragma unroll
        for (int k = 0; k < 4; ++k)
#pragma unroll
            for (int r = 0; r < 16; ++r) { const float e = ex2(s[k][r] - rm); s[k][r] = e; sum += e; }
        sum += __shfl_xor(sum, 32);
        const float inv = (nmax >= 0) ? 1.f / sum : 0.f;
#pragma unroll
        for (int k = 0; k < 4; ++k)
#pragma unroll
            for (int r = 0; r < 16; ++r) s[k][r] *= inv;
        float prev = 0.f;
#pragma unroll
        for (int k = 0; k < 4; ++k)
#pragma unroll
            for (int a = 0; a < 4; ++a) { const int i = 4 * k + a; const float Bi = 0.5f * s[k][4 * a + 3]; const float Ai = (s[k][4 * a] + s[k][4 * a + 1]) + (s[k][4 * a + 2] + Bi);
                const float rc = __shfl_xor(Bi, 32); const float add = hi ? rc : prev; prev = rc;
                IMPH[(hl * 64 + ql) * 32 + 2 * i + hi] = Ai + add; }
        f32x16 o[2]; o[0] = (f32x16){0.f}; o[1] = (f32x16){0.f};
        pv<2>(o, s[0], s[1], Vt, lane, hi); pv<2>(o, s[2], s[3], Vt + 8192, lane, hi);
        if (hi == 0) wsf[r32] = g0;
#pragma unroll
        for (int r = 0; r < 16; ++r) { const float f = wsf[crow(r, hi)]; oacc[0][r] = o[0][r] * f; oacc[1][r] = o[1][r] * f; }
        asm volatile("" : "+v"(oacc[0]), "+v"(oacc[1]));
    }
    __syncthreads();
    { const int q = tid >> 3, mg = tid & 7;
#pragma unroll
      for (int i = 0; i < 4; ++i) { const int mb = 4 * mg + i; float v = ((IMPH[(0 * 64 + q) * 32 + mb] + IMPH[(1 * 64 + q) * 32 + mb]) + IMPH[(2 * 64 + q) * 32 + mb]) + IMPH[(3 * 64 + q) * 32 + mb];
          if (mb == 0 || mb == c || mb == c - 1) v = 1e9f; if (mb > c) v = -1.f; VAL[q * 32 + mb] = v; } }
    __syncthreads();
    { const int q = tid >> 3, mg = tid & 7; unsigned bits = 0u;
      float mine[4];
#pragma unroll
      for (int i = 0; i < 4; ++i) mine[i] = VAL[q * 32 + 4 * mg + i];
      int cnt0 = 0, cnt1 = 0, cnt2 = 0, cnt3 = 0;
#pragma unroll 4
      for (int m2 = 0; m2 < 32; ++m2) { const float v2 = VAL[q * 32 + m2]; const int rel = m2 - 4 * mg;
          cnt0 += (int)(v2 > mine[0]) | ((int)(v2 == mine[0]) & (int)(rel < 0));
          cnt1 += (int)(v2 > mine[1]) | ((int)(v2 == mine[1]) & (int)(rel < 1));
          cnt2 += (int)(v2 > mine[2]) | ((int)(v2 == mine[2]) & (int)(rel < 2));
          cnt3 += (int)(v2 > mine[3]) | ((int)(v2 == mine[3]) & (int)(rel < 3)); }
      bits = ((cnt0 < 8) ? 1u : 0u) | ((cnt1 < 8) ? 2u : 0u) | ((cnt2 < 8) ? 4u : 0u) | ((cnt3 < 8) ? 8u : 0u);
      bits <<= 4 * mg;
      if (bits) __hip_atomic_fetch_or(&MASK[q], bits, __ATOMIC_RELAXED, __HIP_MEMORY_SCOPE_WORKGROUP); }
    __syncthreads();
    const unsigned vmask = (c >= 31) ? 0xffffffffu : ((2u << c) - 1u);
    if (wid == 0) { unsigned mk = MASK[lane] & vmask;
#pragma unroll
        for (int o_ = 1; o_ < 64; o_ <<= 1) mk |= __shfl_xor(mk, o_);
        if (lane == 0) MASK[64] = mk; }
    __syncthreads();
    const unsigned mymask = MASK[ql] & vmask;
    unsigned uni = __builtin_amdgcn_readfirstlane(MASK[64]);
    {
        f32x16 o[2]; o[0] = (f32x16){0.f}; o[1] = (f32x16){0.f}; float m = NEG, lsum = 0.f;
        while (uni) {
            const int j = 31 - __builtin_clz(uni); uni &= ~(1u << j);
            __syncthreads();
            stage_k(Kt, KV6 + (tokb + 64 * j) * 768 + 256 + g * 64, 768, tid); stage_v<2>(Vt, KV6 + (tokb + 64 * j) * 768 + 384 + g * 64, 768, tid);
            __syncthreads();
            const bool sel = (mymask >> j) & 1u;
            if (__any(sel)) {
                f32x16 s0, s1; qkt(s0, s1, Kt, qr, r32, hi);
                const float tc = sl2 * (float)(64 * (j - c)); const int lim = (j == c) ? ql : 64;
#pragma unroll
                for (int r = 0; r < 16; ++r) { s0[r] += CB(r) + tc; s1[r] += CB(r) + (tc + 32.f * sl2);
                    if (!sel || crow(r, hi) > lim) s0[r] = NEG; if (!sel || crow(r, hi) + 32 > lim) s1[r] = NEG; }
                softmax_pv<2>(s0, s1, m, lsum, o, wsf, Vt, lane, r32, hi);
            }
        }
        const float ltot = lsum + __shfl_xor(lsum, 32);
        if (hi == 0) wsf[r32] = g1 / ltot;
#pragma unroll
        for (int r = 0; r < 16; ++r) { const float f = wsf[crow(r, hi)]; oacc[0][r] += o[0][r] * f; oacc[1][r] += o[1][r] * f; }
        asm volatile("" : "+v"(oacc[0]), "+v"(oacc[1]));
    }
    {
        f32x16 o[2]; o[0] = (f32x16){0.f}; o[1] = (f32x16){0.f}; float m = NEG, lsum = 0.f;
        const int jlo = c - 8 < 0 ? 0 : c - 8;
        for (int j = c; j >= jlo; --j) {
            __syncthreads();
            stage_k(Kt, KV6 + (tokb + 64 * j) * 768 + 512 + g * 64, 768, tid); stage_v<2>(Vt, KV6 + (tokb + 64 * j) * 768 + 640 + g * 64, 768, tid);
            __syncthreads();
            f32x16 s0, s1; qkt(s0, s1, Kt, qr, r32, hi);
            const float tc = sl2 * (float)(64 * (j - c));
            const int lim = (j == c) ? ql : 64;
            const int low = (j == c - 8) ? ql : -1;
#pragma unroll
            for (int r = 0; r < 16; ++r) { s0[r] += CB(r) + tc; s1[r] += CB(r) + (tc + 32.f * sl2);
                const int k0 = crow(r, hi), k1 = k0 + 32;
                if (k0 > lim || k0 <= low) s0[r] = NEG; if (k1 > lim || k1 <= low) s1[r] = NEG; }
            softmax_pv<2>(s0, s1, m, lsum, o, wsf, Vt, lane, r32, hi);
        }
        const float ltot = lsum + __shfl_xor(lsum, 32);
        if (hi == 0) wsf[r32] = g2 / ltot;
#pragma unroll
        for (int r = 0; r < 16; ++r) { const float f = wsf[crow(r, hi)]; oacc[0][r] += o[0][r] * f; oacc[1][r] += o[1][r] * f; }
        asm volatile("" : "+v"(oacc[0]), "+v"(oacc[1]));
    }
#pragma unroll
    for (int r = 0; r < 16; ++r) { bf16_t* dst = NQ + (tokb + t0 + crow(r, hi)) * 512 + h * 64 + r32; dst[0] = f2bf(oacc[0][r]); dst[32] = f2bf(oacc[1][r]); }
    __syncthreads();
}

__device__ __forceinline__ int next_unit(unsigned* ctr, LAS unsigned char* lds) {
    LAS int* bc = (LAS int*)(lds + LDS_MISC);
    __syncthreads();
    if (threadIdx.x == 0) bc[0] = (int)__hip_atomic_fetch_add(ctr, 1u, __ATOMIC_RELAXED, __HIP_MEMORY_SCOPE_AGENT);
    __syncthreads();
    return __builtin_amdgcn_readfirstlane(bc[0]);
}

__device__ __forceinline__ void phase_merge(PRef p, int l, LAS unsigned char* lds) {
    SG_IDS
    unsigned char* ws = p.ws;
    const bf16_t* YA = (const bf16_t*)(ws + WS_NQ); const bf16_t* YB = (const bf16_t*)(ws + WS_DQ);
    const bf16_t* WA = (const bf16_t*)(ws + WS_WA) + (size_t)l * DM * 512; const bf16_t* WB = (const bf16_t*)(ws + WS_WB) + (size_t)l * DM * 512;
    const bf16_t* GA = (const bf16_t*)(ws + WS_GA); const bf16_t* GB = (const bf16_t*)(ws + WS_GB); bf16_t* MG = (bf16_t*)(ws + WS_XN);
    for (int u = blockIdx.x; u < 256 * 8; u += gridDim.x) {
        const int pm = (u >> 7) * 16 + (u & 15), pn = (u >> 4) & 7, m0 = pm * 128, n0 = pn * 128;
        f32x4 acc[2][4], t[2][4]; SG_ZERO(acc);
        sg_kloop(acc, ARowLin{(const char*)(YA + (size_t)m0 * 512), 1024}, 128, WA + (size_t)n0 * 512, 512, 8, lds);
#pragma unroll
        for (int m = 0; m < 2; ++m)
#pragma unroll
            for (int n = 0; n < 4; ++n) { const u32x2 gw = *(const u32x2*)(GA + (size_t)(m0 + SG_ROW(m)) * DM + n0 + SG_COL(n));
                t[m][n] = acc[m][n] * (f32x4){bflo(gw.x), bfhi(gw.x), bflo(gw.y), bfhi(gw.y)}; }
        SG_ZERO(acc);
        sg_kloop(acc, ARowLin{(const char*)(YB + (size_t)m0 * 512), 1024}, 128, WB + (size_t)n0 * 512, 512, 8, lds);
#pragma unroll
        for (int m = 0; m < 2; ++m)
#pragma unroll
            for (int n = 0; n < 4; ++n) { const size_t off = (size_t)(m0 + SG_ROW(m)) * DM + n0 + SG_COL(n); const u32x2 gw = *(const u32x2*)(GB + off);
                st4bf(MG + off, t[m][n] + acc[m][n] * (f32x4){bflo(gw.x), bfhi(gw.x), bflo(gw.y), bfhi(gw.y)}); }
    }
}
__device__ __forceinline__ void phase_outproj(PRef p, int l, LAS unsigned char* lds) {
    SG_IDS
    unsigned char* ws = p.ws;
    const bf16_t* MG = (const bf16_t*)(ws + WS_XN); const bf16_t* WO = (const bf16_t*)(ws + WS_WO) + (size_t)l * DM * DM;
    const float* hin = (l == 0) ? p.x : p.out; float* hout = p.out;
    for (int u = blockIdx.x; u < 256 * 8; u += gridDim.x) {
        const int pm = (u >> 7) * 16 + (u & 15), pn = (u >> 4) & 7, m0 = pm * 128, n0 = pn * 128;
        f32x4 acc[2][4]; SG_ZERO(acc);
        sg_kloop(acc, ARowLin{(const char*)(MG + (size_t)m0 * DM), 2048}, 128, WO + (size_t)n0 * DM, DM, 16, lds);
#pragma unroll
        for (int m = 0; m < 2; ++m)
#pragma unroll
            for (int n = 0; n < 4; ++n) { const size_t off = (size_t)(m0 + SG_ROW(m)) * DM + n0 + SG_COL(n); *(f32x4*)(hout + off) = *(const f32x4*)(hin + off) + acc[m][n]; }
    }
}

__device__ __forceinline__ void phase_router(PRef p, int l, LAS unsigned char* lds) {
    int tid_ = threadIdx.x; asm volatile("" : "+v"(tid_));
    const int tid = tid_, lane = tid & 63, wid = tid >> 6;
    unsigned char* ws = p.ws;
    LAS float* RW = (LAS float*)lds;
    LAS unsigned* cntl = (LAS unsigned*)(lds + 81920);
    LAS unsigned* lbase = (LAS unsigned*)(lds + 81920 + 64);
    LAS unsigned* loc = (LAS unsigned*)(lds + 82048);
    LAS float* wloc = (LAS float*)(lds + 82048 + 16384);
    const float* gwp = p.router_grp_w + (size_t)l * DM * 4; const float* ewp = p.router_exp_w + (size_t)l * DM * 16;
    __syncthreads();
    for (int k = tid; k < DM; k += 512) {
        const f32x4 a = *(const f32x4*)(gwp + k * 4);
#pragma unroll
        for (int i = 0; i < 4; ++i) RW[i * 1024 + k] = a[i];
#pragma unroll
        for (int q4 = 0; q4 < 4; ++q4) { const f32x4 e = *(const f32x4*)(ewp + k * 16 + q4 * 4);
#pragma unroll
            for (int i = 0; i < 4; ++i) RW[(4 + q4 * 4 + i) * 1024 + k] = e[i]; }
    }
    const float* gb = p.router_grp_b + l * 4; const float* eb = p.router_exp_b + l * 16;
    const float* g2 = p.norm2_g + (size_t)l * DM;
    unsigned* ecnt = (unsigned*)(ws + WS_CTL) + CW_ECNT + 64 * l;
    unsigned* LIST = (unsigned*)(ws + WS_LIST); float* WL = (float*)(ws + WS_WL);
    bf16_t* XN = (bf16_t*)(ws + WS_XN);
    for (int ch = blockIdx.x; ch < NTOK / 128; ch += gridDim.x) {
        __syncthreads();
        if (tid < 16) cntl[tid] = 0u;
        __syncthreads();
        for (int i = 0; i < 16; ++i) {
            const int tok = ch * 128 + wid * 16 + i;
            const float* xrow = p.out + (size_t)tok * DM;
            f32x4 v[4]; float s = 0.f;
#pragma unroll
            for (int j = 0; j < 4; ++j) { v[j] = *(const f32x4*)(xrow + (64 * j + lane) * 4); s += (v[j][0] * v[j][0] + v[j][1] * v[j][1]) + (v[j][2] * v[j][2] + v[j][3] * v[j][3]); }
            const float rstd = rsqrtf(wave_sum(s) * (1.f / 1024.f) + 1e-6f);
#pragma unroll
            for (int j = 0; j < 4; ++j) { const f32x4 gg = *(const f32x4*)(g2 + (64 * j + lane) * 4); v[j] = v[j] * rstd * gg; st4bf(XN + (size_t)tok * DM + (64 * j + lane) * 4, v[j]); }
            float lg[20];
#pragma unroll
            for (int cc = 0; cc < 20; ++cc) { float a = 0.f;
#pragma unroll
                for (int j = 0; j < 4; ++j) { const f32x4 w = *(LAS const f32x4*)(RW + cc * 1024 + (64 * j + lane) * 4); a += (v[j][0] * w[0] + v[j][1] * w[1]) + (v[j][2] * w[2] + v[j][3] * w[3]); }
                lg[cc] = wave_sum(a); }
            if (lane == 0) {
                float gl[4];
#pragma unroll
                for (int q4 = 0; q4 < 4; ++q4) gl[q4] = lg[q4] + gb[q4];
                int gi = 0; float gm = gl[0];
#pragma unroll
                for (int q4 = 1; q4 < 4; ++q4) if (gl[q4] > gm) { gm = gl[q4]; gi = q4; }
                float gs = 0.f;
#pragma unroll
                for (int q4 = 0; q4 < 4; ++q4) gs += __expf(gl[q4] - gm);
                const float gwt = 1.f / gs;
                float el[4];
#pragma unroll
                for (int e = 0; e < 4; ++e) el[e] = (gi == 0 ? lg[4 + e] : gi == 1 ? lg[8 + e] : gi == 2 ? lg[12 + e] : lg[16 + e]) + eb[gi * 4 + e];
                int i1 = 0; float v1 = el[0];
#pragma unroll
                for (int e = 1; e < 4; ++e) if (el[e] > v1) { v1 = el[e]; i1 = e; }
                int i2 = -1; float v2 = -3.0e38f;
#pragma unroll
                for (int e = 0; e < 4; ++e) if (e != i1 && el[e] > v2) { v2 = el[e]; i2 = e; }
                const float ex = __expf(v2 - v1), w1 = gwt / (1.f + ex), w2 = gwt * ex / (1.f + ex);
                const int e1 = gi * 4 + i1, e2 = gi * 4 + i2;
                const unsigned s1 = __hip_atomic_fetch_add(&cntl[e1], 1u, __ATOMIC_RELAXED, __HIP_MEMORY_SCOPE_WORKGROUP); loc[e1 * 256 + s1] = (unsigned)tok * 2u; wloc[e1 * 256 + s1] = w1;
                const unsigned s2 = __hip_atomic_fetch_add(&cntl[e2], 1u, __ATOMIC_RELAXED, __HIP_MEMORY_SCOPE_WORKGROUP); loc[e2 * 256 + s2] = (unsigned)tok * 2u + 1u; wloc[e2 * 256 + s2] = w2;
            }
        }
        __syncthreads();
        if (tid < 16) lbase[tid] = __hip_atomic_fetch_add(&ecnt[tid], cntl[tid], __ATOMIC_RELAXED, __HIP_MEMORY_SCOPE_AGENT);
        __syncthreads();
        for (int e = 0; e < 16; ++e) { const unsigned n = cntl[e], bs = lbase[e];
            for (unsigned i = tid; i < n; i += 512) { LIST[(size_t)e * NTOK + bs + i] = loc[e * 256 + i]; WL[(size_t)e * NTOK + bs + i] = wloc[e * 256 + i]; } }
    }
}

struct MoeUnit { int e, tile, n, hoff; };
__device__ __forceinline__ bool moe_find(LAS const int* cnts, int ut, MoeUnit& mu) {
    int pre = 0;
    for (int e = 0; e < 16; ++e) { const int cn = cnts[e], nt = (cn + 127) >> 7; if (ut < pre + nt) { mu.e = e; mu.tile = ut - pre; mu.n = cn - mu.tile * 128; if (mu.n > 128) mu.n = 128; mu.hoff = (pre + mu.tile) * 128; return true; } pre += nt; }
    return false;
}
__device__ __forceinline__ void phase_moe1(PRef p, int l, LAS unsigned char* lds) {
    SG_IDS
    unsigned char* ws = p.ws;
    LAS int* cnts = (LAS int*)(lds + LDS_MISC + 64);
    const unsigned* ecnt = (const unsigned*)(ws + WS_CTL) + CW_ECNT + 64 * l;
    __syncthreads();
    if (tid < 16) cnts[tid] = (int)__hip_atomic_load(&ecnt[tid], __ATOMIC_RELAXED, __HIP_MEMORY_SCOPE_AGENT);
    __syncthreads();
    const unsigned* LIST = (const unsigned*)(ws + WS_LIST); const float* WL = (const float*)(ws + WS_WL);
    const char* XN = (const char*)(ws + WS_XN); bf16_t* H = (bf16_t*)(ws + WS_H);
    for (int ut = blockIdx.x;; ut += gridDim.x) {
        MoeUnit mu; if (!moe_find(cnts, ut, mu)) break;
        const unsigned* lst = LIST + (size_t)mu.e * NTOK + mu.tile * 128;
        const bf16_t* W = (const bf16_t*)(ws + WS_WGU) + (size_t)(l * 16 + mu.e) * 256 * DM;
        f32x4 ag[2][4], au[2][4]; SG_ZERO(ag); SG_ZERO(au);
        sg_kloop(ag, ARowGather{lst, mu.n, XN}, 128, W, DM, 16, lds);
        sg_kloop(au, ARowGather{lst, mu.n, XN}, 128, W + (size_t)128 * DM, DM, 16, lds);
        const float* wl = WL + (size_t)mu.e * NTOK + mu.tile * 128;
#pragma unroll
        for (int m = 0; m < 2; ++m) { const int rl = SG_ROW(m); const float wgt = (rl < mu.n) ? wl[rl] : 0.f;
#pragma unroll
            for (int n = 0; n < 4; ++n) { f32x4 gv = ag[m][n], uv = au[m][n], hv;
#pragma unroll
                for (int i = 0; i < 4; ++i) hv[i] = gv[i] * sigm(gv[i]) * uv[i] * wgt;
                st4bf(H + (size_t)(mu.hoff + rl) * 128 + SG_COL(n), hv); } }
    }
}
__device__ __forceinline__ void phase_moe2(PRef p, int l, LAS unsigned char* lds) {
    SG_IDS
    unsigned char* ws = p.ws;
    LAS int* cnts = (LAS int*)(lds + LDS_MISC + 64);
    const unsigned* ecnt = (const unsigned*)(ws + WS_CTL) + CW_ECNT + 64 * l;
    __syncthreads();
    if (tid < 16) cnts[tid] = (int)__hip_atomic_load(&ecnt[tid], __ATOMIC_RELAXED, __HIP_MEMORY_SCOPE_AGENT);
    __syncthreads();
    const unsigned* LIST = (const unsigned*)(ws + WS_LIST); const bf16_t* H = (const bf16_t*)(ws + WS_H);
    bf16_t* Y0 = (bf16_t*)(ws + WS_GA); bf16_t* Y1 = (bf16_t*)(ws + WS_GB);
    for (int u = blockIdx.x;; u += gridDim.x) {
        MoeUnit mu; if (!moe_find(cnts, u >> 3, mu)) break;
        const int pn = u & 7;
        const unsigned* lst = LIST + (size_t)mu.e * NTOK + mu.tile * 128;
        const bf16_t* W = (const bf16_t*)(ws + WS_WD) + (size_t)(l * 16 + mu.e) * DM * 128 + (size_t)pn * 128 * 128;
        f32x4 acc[2][4]; SG_ZERO(acc);
        sg_kloop(acc, ARowLin{(const char*)(H + (size_t)mu.hoff * 128), 256}, 128, W, 128, 2, lds);
#pragma unroll
        for (int m = 0; m < 2; ++m) { const int rl = SG_ROW(m);
            if (rl < mu.n) { const unsigned ent = lst[rl]; bf16_t* dst = ((ent & 1u) ? Y1 : Y0) + (size_t)(ent >> 1) * DM + pn * 128;
#pragma unroll
                for (int n = 0; n < 4; ++n) st4bf(dst + SG_COL(n), acc[m][n]); } }
    }
}

__device__ __forceinline__ void phase_combine(PRef p, int l) {
    int tid_ = threadIdx.x; asm volatile("" : "+v"(tid_));
    const int tid = tid_, lane = tid & 63, wid = tid >> 6;
    unsigned char* ws = p.ws;
    const int gw = blockIdx.x * 8 + wid, NGW = gridDim.x * 8;
    const bf16_t* Y0 = (const bf16_t*)(ws + WS_GA); const bf16_t* Y1 = (const bf16_t*)(ws + WS_GB); bf16_t* XN = (bf16_t*)(ws + WS_XN);
    const bool last = (l == DEPTH - 1);
    const float* g = last ? p.final_norm_g : p.norm1_g + (size_t)(l + 1) * DM;
    for (int mrow = gw; mrow < NTOK; mrow += NGW) {
        float* hrow = p.out + (size_t)mrow * DM;
        f32x4 v[4]; float s = 0.f;
#pragma unroll
        for (int j = 0; j < 4; ++j) { const int cidx = (64 * j + lane) * 4; v[j] = *(const f32x4*)(hrow + cidx);
            const u32x2 a = *(const u32x2*)(Y0 + (size_t)mrow * DM + cidx), b2 = *(const u32x2*)(Y1 + (size_t)mrow * DM + cidx);
            v[j] = v[j] + (f32x4){bflo(a.x), bfhi(a.x), bflo(a.y), bfhi(a.y)} + (f32x4){bflo(b2.x), bfhi(b2.x), bflo(b2.y), bfhi(b2.y)};
            s += (v[j][0] * v[j][0] + v[j][1] * v[j][1]) + (v[j][2] * v[j][2] + v[j][3] * v[j][3]); }
        const float rstd = rsqrtf(wave_sum(s) * (1.f / 1024.f) + 1e-6f);
#pragma unroll
        for (int j = 0; j < 4; ++j) { const int cidx = (64 * j + lane) * 4; const f32x4 gg = *(const f32x4*)(g + cidx);
            if (last) *(f32x4*)(hrow + cidx) = v[j] * rstd * gg;
            else { *(f32x4*)(hrow + cidx) = v[j]; st4bf(XN + (size_t)mrow * DM + cidx, v[j] * rstd * gg); } }
    }
}


#define XB_TMO      128
#define XB_XCNT(j)  (256  + 64 * (j))
#define XB_XSUB(j)  (1280 + 64 * (j))
#define XB_XGEN(j)  (2304 + 64 * (j))
#define XB_TOP      3328
#define XB_TOPGEN   3392
#define XCD_BAR_WORDS 3456
#define XB_SPIN_CAP (1u << 18)
__device__ __forceinline__ unsigned xb_ld(unsigned* p)              { return __hip_atomic_load(p, __ATOMIC_RELAXED, __HIP_MEMORY_SCOPE_AGENT); }
__device__ __forceinline__ unsigned xb_add(unsigned* p, unsigned v) { return __hip_atomic_fetch_add(p, v, __ATOMIC_RELAXED, __HIP_MEMORY_SCOPE_AGENT); }
__device__ __forceinline__ unsigned xb_xcc_id() { return (unsigned)__builtin_amdgcn_s_getreg((3 << 11) | 20) & 0xFu; }
#define XB_SPIN(cond, bar) do { unsigned _sp = 0; while (cond) { __builtin_amdgcn_s_sleep(1); \
    if ((++_sp & 255u) == 0u) { if (xb_ld(&(bar)[XB_TMO])) break; if (_sp > XB_SPIN_CAP) { atomicAdd(&(bar)[XB_TMO], 1u); break; } } } } while (0)
struct XcdBarrier { unsigned* bar; unsigned x; volatile LAS unsigned* st; };
__device__ __forceinline__ XcdBarrier xcd_barrier_post(unsigned* bar, volatile LAS unsigned* st) {
    XcdBarrier b; b.bar = bar; b.x = xb_xcc_id(); b.st = st;
    if (threadIdx.x == 0) (void)xb_add(&bar[XB_XCNT(b.x)], 1u);
    return b;
}
__device__ __forceinline__ void xcd_barrier_complete(unsigned* bar, unsigned x, unsigned& nloc, unsigned& nx) {
    const unsigned G = gridDim.x * gridDim.y * gridDim.z;
    unsigned sum, cnt, mine, sp = 0u;
    for (;;) {
        sum = 0u; cnt = 0u; mine = 0u;
#pragma unroll
        for (unsigned j = 0; j < 16; ++j) { const unsigned c = xb_ld(&bar[XB_XCNT(j)]); sum += c; cnt += (c > 0u) ? 1u : 0u; mine = (j == x) ? c : mine; }
        if (sum == G) break;
        __builtin_amdgcn_s_sleep(1);
        if ((++sp & 255u) == 0u) { if (xb_ld(&bar[XB_TMO])) break; if (sp > XB_SPIN_CAP) { atomicAdd(&bar[XB_TMO], 1u); break; } }
    }
    nloc = mine > 0u ? mine : 1u; nx = cnt > 0u ? cnt : 1u;
}
__device__ __forceinline__ void xcd_barrier(const XcdBarrier& b) {
    asm volatile("s_waitcnt vmcnt(0)" ::: "memory");
    __syncthreads();
    if (threadIdx.x == 0) {
        unsigned* bar = b.bar;
        __builtin_amdgcn_s_waitcnt(0);
        unsigned nloc = b.st[0], nx = b.st[1];
        if (nloc == 0u) { xcd_barrier_complete(bar, b.x, nloc, nx); b.st[0] = nloc; b.st[1] = nx; }
        const unsigned old = xb_add(&bar[XB_XSUB(b.x)], 1u);
        const unsigned gen = old / nloc;
        if (old + 1u == (gen + 1u) * nloc) {
            __builtin_amdgcn_fence(__ATOMIC_RELEASE, "agent");
            asm volatile("s_waitcnt vmcnt(0)" ::: "memory");
            const unsigned og = xb_add(&bar[XB_TOP], 1u);
            const unsigned tg = og / nx;
            if (og + 1u == (tg + 1u) * nx) xb_add(&bar[XB_TOPGEN], 1u);
            else XB_SPIN(xb_ld(&bar[XB_TOPGEN]) == tg, bar);
            __builtin_amdgcn_fence(__ATOMIC_ACQUIRE, "agent");
            xb_add(&bar[XB_XGEN(b.x)], 1u);
            asm volatile("s_waitcnt vmcnt(0)" ::: "memory");
        } else {
            XB_SPIN(xb_ld(&bar[XB_XGEN(b.x)]) == gen, bar);
            __builtin_amdgcn_fence(__ATOMIC_ACQUIRE, "agent");
            asm volatile("s_waitcnt vmcnt(0)" ::: "memory");
        }
    }
    __syncthreads();
}

template <int K> __device__ __forceinline__ void run_phase(PRef p, int l, LAS unsigned char* lds) {
    unsigned* ctl = (unsigned*)(p.ws + WS_CTL);
    if (K == 0) phase_prologue(p, lds);
    if (K == 1) phase_inproj_pg8(p, l, lds);
    if (K == 2) { unsigned* ctr = ctl + CW_QCTR + 64 * (l * 2 + 0);
        for (;;) { const int u = next_unit(ctr, lds); if (u >= 64 + 1024) break; if (u < 64) compress_unit(p, l, u, lds); else diff_unit(p, l, u - 64, lds); } }
    if (K == 3) { unsigned* ctr = ctl + CW_QCTR + 64 * (l * 2 + 1);
        for (;;) { const int u = next_unit(ctr, lds); if (u >= 1024) break; nsa_unit(p, l, u, lds); } }
    if (K == 4) phase_merge_pg8(p, l, lds);
    if (K == 5) phase_outproj_pg8(p, l, lds);
    if (K == 6) phase_router(p, l, lds);
    if (K == 7) phase_moe1(p, l, lds);
    if (K == 8) phase_moe2(p, l, lds);
    if (K == 9) phase_combine(p, l);
}
#if MK_MULTI
template <int K> __global__ void __launch_bounds__(512, 2) mk_one(Params p) {
    extern __shared__ __attribute__((aligned(16))) unsigned char lds_raw[];
    const __attribute__((address_space(4))) Params* pp_ = (const __attribute__((address_space(4))) Params*)__builtin_amdgcn_kernarg_segment_ptr();
    run_phase<K>(*pp_, p.ph_lo, (LAS unsigned char*)lds_raw);
}
template <int K> static void launch_one(int grid, hipStream_t stream, Params p, int l) {
    static bool attr = false;
    if (!attr) { (void)hipFuncSetAttribute((const void*)mk_one<K>, hipFuncAttributeMaxDynamicSharedMemorySize, LDS_BYTES); attr = true; }
    p.ph_lo = l; p.ph_hi = l + 1;
    hipLaunchKernelGGL(mk_one<K>, dim3(grid), dim3(512), LDS_BYTES, stream, p);
}
#else
__global__ void __launch_bounds__(512, 2) mk_fwd(Params p) {
    extern __shared__ __attribute__((aligned(16))) unsigned char lds_raw[];
    LAS unsigned char* lds = (LAS unsigned char*)lds_raw;
    cg::grid_group grid = cg::this_grid();
    volatile LAS unsigned* bst = (volatile LAS unsigned*)(lds + LDS_MISC + 256);
    if (threadIdx.x < 2) bst[threadIdx.x] = 0u;
    __syncthreads();
    const XcdBarrier bar = xcd_barrier_post((unsigned*)(p.ws + WS_CTL) + CW_BAR, bst);
#define SEAM() xcd_barrier(bar)
#define RUN(K, l) do { const __attribute__((address_space(4))) Params* pp_ = (const __attribute__((address_space(4))) Params*)__builtin_amdgcn_kernarg_segment_ptr(); asm volatile("" : "+s"(pp_)); run_phase<K>(*pp_, l, lds); } while (0)
    RUN(0, 0); grid.sync();
    for (int l = 0; l < DEPTH; ++l) {
        RUN(1, l); SEAM();
        RUN(2, l); SEAM();
        RUN(3, l); SEAM();
        RUN(4, l); SEAM();
        RUN(5, l); SEAM();
        RUN(6, l); SEAM();
        RUN(7, l); SEAM();
        RUN(8, l); SEAM();
        RUN(9, l); if (l + 1 < DEPTH) SEAM();
    }
}
#endif

extern "C" void kernel_launch(void* const* d_in, const int* in_sizes, int n_in, void* d_out, int out_size, void* d_ws, size_t ws_size, hipStream_t stream) {
    static int grid = 0;
    if (grid == 0) {
        if (n_in != 22 || in_sizes[0] != NTOK * DM || out_size != NTOK * DM || ws_size < WS_END) { fprintf(stderr, "kernel_launch: unexpected shapes (n_in %d, in0 %d, out %d, ws %zu)\n", n_in, n_in > 0 ? in_sizes[0] : -1, out_size, ws_size); grid = -1; return; }
        int dev = 0, cus = 0, per_cu = 1;
        (void)hipGetDevice(&dev); (void)hipDeviceGetAttribute(&cus, hipDeviceAttributeMultiprocessorCount, dev);
#if !MK_MULTI
        (void)hipFuncSetAttribute((const void*)mk_fwd, hipFuncAttributeMaxDynamicSharedMemorySize, LDS_BYTES);
        (void)hipOccupancyMaxActiveBlocksPerMultiprocessor(&per_cu, (const void*)mk_fwd, 512, LDS_BYTES);
        if (per_cu < 1) { fprintf(stderr, "kernel_launch: occupancy query says %d blocks per CU\n", per_cu); per_cu = 1; }
#endif
        (void)hipGetLastError();
        grid = cus * per_cu;
    }
    if (grid < 0) return;
    (void)hipMemsetAsync((char*)d_ws + WS_CTL, 0, CTL_BYTES, stream);
    Params p{};
    const float** pp = (const float**)&p;
    for (int i = 0; i < 22; ++i) pp[i] = (const float*)d_in[i];
    p.out = (float*)d_out; p.ws = (unsigned char*)d_ws;
#if MK_MULTI
    launch_one<0>(grid, stream, p, 0);
    for (int l = 0; l < DEPTH; ++l) {
        launch_one<1>(grid, stream, p, l); launch_one<2>(grid, stream, p, l); launch_one<3>(grid, stream, p, l); launch_one<4>(grid, stream, p, l); launch_one<5>(grid, stream, p, l);
        launch_one<6>(grid, stream, p, l); launch_one<7>(grid, stream, p, l); launch_one<8>(grid, stream, p, l); launch_one<9>(grid, stream, p, l);
    }
#else
    p.ph_lo = 0; p.ph_hi = NPHASE;
    void* args[] = {&p};
    hipError_t e = hipLaunchCooperativeKernel((const void*)mk_fwd, dim3(grid), dim3(512), args, LDS_BYTES, stream);
    if (e != hipSuccess) fprintf(stderr, "cooperative launch failed: %s (grid %d)\n", hipGetErrorString(e), grid);
#endif
}
```

```cpp
#include <hip/hip_runtime.h>
#include <hip/hip_cooperative_groups.h>
#include <cstdio>
#include <cstdint>
namespace cg = cooperative_groups;

#ifndef MK_MULTI
#define MK_MULTI 0
#endif

#define LAS __attribute__((address_space(3)))
typedef unsigned short bf16_t;
typedef short bf16x8 __attribute__((ext_vector_type(8)));
typedef short s16x4 __attribute__((ext_vector_type(4)));
typedef float f32x2 __attribute__((ext_vector_type(2)));
typedef float f32x4 __attribute__((ext_vector_type(4)));
typedef float f32x16 __attribute__((ext_vector_type(16)));
typedef unsigned u32x2 __attribute__((ext_vector_type(2)));
typedef unsigned u32x4 __attribute__((ext_vector_type(4)));
typedef __bf16 bf16x2_t __attribute__((ext_vector_type(2)));

constexpr int NTOK = 32768, DM = 1024, TSEQ = 2048, NBATCH = 16, DEPTH = 2;
constexpr int INCOLS = 4888, NPAD = 5120;
constexpr float LOG2E = 1.4426950408889634f;
constexpr float QSCALE = 0.125f * LOG2E;
constexpr int NPHASE = 1 + 9 * DEPTH;

constexpr size_t MiB = 1u << 20;
constexpr size_t WS_CTL = 0, CTL_BYTES = 65536;
constexpr size_t WS_WIN = 1 * MiB;
constexpr size_t WS_WA = 21 * MiB;
constexpr size_t WS_WB = 23 * MiB;
constexpr size_t WS_WO = 25 * MiB;
constexpr size_t WS_WC1 = 29 * MiB;
constexpr size_t WS_WGU = 31 * MiB;
constexpr size_t WS_WD = 47 * MiB;
constexpr size_t WS_MISC = 55 * MiB;
constexpr size_t WS_LIST = 58 * MiB;
constexpr size_t WS_WL = 60 * MiB;
constexpr size_t WS_XN = 64 * MiB;
constexpr size_t WS_NQ = 128 * MiB;
constexpr size_t WS_KV6 = 160 * MiB;
constexpr size_t WS_NG = 208 * MiB;
constexpr size_t WS_DQ = 210 * MiB;
constexpr size_t WS_DK = 242 * MiB;
constexpr size_t WS_DV = 274 * MiB;
constexpr size_t WS_GA = 306 * MiB;
constexpr size_t WS_GB = 370 * MiB;
constexpr size_t WS_END = 434 * MiB;
constexpr size_t WS_H = WS_DK;
constexpr int CW_QCTR = 64;
constexpr int CW_ECNT = 1024;
constexpr int CW_BAR = 4096;

constexpr int LDS_BYTES = 147456;
constexpr int LDS_MISC = 131072;

struct Params {
    const float* x; const float* norm1_g; const float* w_in; const float* cmp_pe; const float* cmp_w1; const float* cmp_b1; const float* cmp_w2; const float* cmp_b2;
    const float* diff_lambda; const float* diff_subln_g; const float* w_branch_a; const float* w_branch_b; const float* w_out; const float* norm2_g;
    const float* router_grp_w; const float* router_grp_b; const float* router_exp_w; const float* router_exp_b; const float* exp_w_gate; const float* exp_w_up; const float* exp_w_down; const float* final_norm_g;
    float* out; unsigned char* ws; int ph_lo, ph_hi;
};

typedef const __attribute__((address_space(4))) Params& PRef;

__device__ __forceinline__ unsigned cvtpk(float lo, float hi) { f32x2 v = {lo, hi}; bf16x2_t b = __builtin_convertvector(v, bf16x2_t); return __builtin_bit_cast(unsigned, b); }
__device__ __forceinline__ float bflo(unsigned u) { return __uint_as_float(u << 16); }
__device__ __forceinline__ float bfhi(unsigned u) { return __uint_as_float(u & 0xffff0000u); }
__device__ __forceinline__ float bf1(bf16_t b) { return __uint_as_float(((unsigned)b) << 16); }
__device__ __forceinline__ bf16_t f2bf(float f) { return (bf16_t)(cvtpk(f, 0.f) & 0xffffu); }
__device__ __forceinline__ int crow(int r, int hi) { return (r & 3) + 8 * (r >> 2) + 4 * hi; }
__device__ __forceinline__ float wave_sum(float v) {
#pragma unroll
    for (int o = 1; o < 64; o <<= 1) v += __shfl_xor(v, o);
    return v;
}
__device__ __forceinline__ float sigm(float x) { return 1.f / (1.f + __expf(-x)); }
__device__ __forceinline__ float ex2(float x) { return __builtin_amdgcn_exp2f(x); }
__device__ __forceinline__ float alibi_slope(int i  ) { return exp2f(-8.0f * (float)i / 12.0f); }
__device__ __forceinline__ s16x4 vtr(LAS const unsigned char* p) { return __builtin_bit_cast(s16x4, __builtin_amdgcn_ds_read_tr16_b64_v4i16((LAS s16x4*)p)); }
#define MFMA32(a, b, c) __builtin_amdgcn_mfma_f32_32x32x16_bf16(a, b, c, 0, 0, 0)
#define MFMA16(a, b, c) __builtin_amdgcn_mfma_f32_16x16x32_bf16(a, b, c, 0, 0, 0)

struct ARowLin { const char* base; size_t stride; __device__ __forceinline__ const char* operator()(int r) const { return base + (size_t)r * stride; } };
struct ARowGather { const unsigned* list; int n; const char* xn; __device__ __forceinline__ const char* operator()(int r) const { const int i = r < n ? r : n - 1; return xn + (size_t)(list[i] >> 1) * 2048; } };

template <class ARow>
__device__ __forceinline__ void sg_kloop(f32x4 (&acc)[2][4], const ARow& arow, int kstepA, const bf16_t* Bt, int ldb, int nt, LAS unsigned char* lds) {
    int tid_ = threadIdx.x; asm volatile("" : "+v"(tid_));
    const int tid = tid_, lane = tid & 63, wid = tid >> 6, wr = wid >> 1, wc = wid & 1, fr = lane & 15, fq = lane >> 4;
    const int lrow = tid >> 3, lch = tid & 7;
    const char* pa0 = arow(lrow) + lch * 16; const char* pa1 = arow(lrow + 64) + lch * 16;
    const char* pb0 = (const char*)(Bt + (size_t)lrow * ldb) + lch * 16; const char* pb1 = (const char*)(Bt + (size_t)(lrow + 64) * ldb) + lch * 16;
    const int wofs0 = lrow * 128 + ((lch ^ ((lrow >> 1) & 7)) << 4), wofs1 = wofs0 + 64 * 128;
    u32x4 ra0 = *(const u32x4*)pa0, ra1 = *(const u32x4*)pa1, rb0 = *(const u32x4*)pb0, rb1 = *(const u32x4*)pb1;
    for (int t = 0; t < nt; ++t) {
        __syncthreads();
        *(LAS u32x4*)(lds + wofs0) = ra0; *(LAS u32x4*)(lds + wofs1) = ra1; *(LAS u32x4*)(lds + 16384 + wofs0) = rb0; *(LAS u32x4*)(lds + 16384 + wofs1) = rb1;
        __syncthreads();
        if (t + 1 < nt) { pa0 += kstepA; pa1 += kstepA; pb0 += 128; pb1 += 128; ra0 = *(const u32x4*)pa0; ra1 = *(const u32x4*)pa1; rb0 = *(const u32x4*)pb0; rb1 = *(const u32x4*)pb1; }
#pragma unroll
        for (int ks = 0; ks < 2; ++ks) {
            bf16x8 af[2], bfr[4];
            const int ch = ks * 4 + fq;
#pragma unroll
            for (int m = 0; m < 2; ++m) { const int row = wr * 32 + m * 16 + fr; af[m] = *(LAS const bf16x8*)(lds + row * 128 + ((ch ^ ((row >> 1) & 7)) << 4)); }
#pragma unroll
            for (int n = 0; n < 4; ++n) { const int row = wc * 64 + n * 16 + fr; bfr[n] = *(LAS const bf16x8*)(lds + 16384 + row * 128 + ((ch ^ ((row >> 1) & 7)) << 4)); }
#pragma unroll
            for (int m = 0; m < 2; ++m)
#pragma unroll
                for (int n = 0; n < 4; ++n) acc[m][n] = MFMA16(bfr[n], af[m], acc[m][n]);
        }
    }
}
#define SG_ZERO(acc) do { _Pragma("unroll") for (int m_ = 0; m_ < 2; ++m_) _Pragma("unroll") for (int n_ = 0; n_ < 4; ++n_) acc[m_][n_] = (f32x4){0.f, 0.f, 0.f, 0.f}; } while (0)
#define SG_IDS int tid_ = threadIdx.x; asm volatile("" : "+v"(tid_)); const int tid = tid_, lane = tid & 63, wid = tid >> 6, wr = wid >> 1, wc = wid & 1, fr = lane & 15, fq = lane >> 4; (void)tid; (void)lane; (void)wid;
#define SG_ROW(m) (wr * 32 + (m) * 16 + fr)
#define SG_COL(n) (wc * 64 + (n) * 16 + 4 * fq)
__device__ __forceinline__ void st4bf(bf16_t* dst, f32x4 v) { u32x2 w; w.x = cvtpk(v[0], v[1]); w.y = cvtpk(v[2], v[3]); *(u32x2*)dst = w; }

__device__ __forceinline__ void transpose_item(const float* W, int ldw, int src_col, int valid, bf16_t* WT, int K, int dst_row, int k0, LAS float* scr, int lane) {
#pragma unroll 8
    for (int i = 0; i < 32; ++i) { const int kk = 2 * i + (lane >> 5), c = lane & 31; scr[kk * 33 + c] = (c < valid) ? W[(size_t)(k0 + kk) * ldw + src_col + c] : 0.f; }
    asm volatile("s_waitcnt lgkmcnt(0)" ::: "memory");
    const int c = lane & 7;
#pragma unroll
    for (int j = 0; j < 4; ++j) { const int n = (lane >> 3) + 8 * j; LAS const float* s = scr + (8 * c) * 33 + n;
        u32x4 o; o.x = cvtpk(s[0 * 33], s[1 * 33]); o.y = cvtpk(s[2 * 33], s[3 * 33]); o.z = cvtpk(s[4 * 33], s[5 * 33]); o.w = cvtpk(s[6 * 33], s[7 * 33]);
        *(u32x4*)(WT + (size_t)(dst_row + n) * K + k0 + 8 * c) = o; }
    asm volatile("s_waitcnt lgkmcnt(0)" ::: "memory");
}
__device__ __forceinline__ void norm_row_bf16(const float* xrow, const float* g, bf16_t* orow, int lane) {
    f32x4 v[4]; float s = 0.f;
#pragma unroll
    for (int j = 0; j < 4; ++j) { v[j] = *(const f32x4*)(xrow + (64 * j + lane) * 4); s += (v[j][0] * v[j][0] + v[j][1] * v[j][1]) + (v[j][2] * v[j][2] + v[j][3] * v[j][3]); }
    const float rstd = rsqrtf(wave_sum(s) * (1.f / 1024.f) + 1e-6f);
#pragma unroll
    for (int j = 0; j < 4; ++j) { const f32x4 gg = *(const f32x4*)(g + (64 * j + lane) * 4); f32x4 o = v[j] * rstd * gg; st4bf(orow + (64 * j + lane) * 4, o); }
}

__device__ __forceinline__ void phase_prologue(PRef p, LAS unsigned char* lds) {
    int tid_ = threadIdx.x; asm volatile("" : "+v"(tid_));
    const int tid = tid_, lane = tid & 63, wid = tid >> 6;
    const int gw = blockIdx.x * 8 + wid, NGW = gridDim.x * 8;
    LAS float* scr = (LAS float*)(lds + wid * 8448);
    unsigned char* ws = p.ws;
    constexpr int I_IN = 16 * 160, I_A = 8 * 32, I_O = 16 * 32, I_C1 = 2 * 32 * 4, I_G = 16 * 16 * 4, I_D = 16 * 2 * 32;
    constexpr int I_LAYER = I_IN + 2 * I_A + I_O + I_C1 + 2 * I_G + I_D;
    for (int it = gw; it < DEPTH * I_LAYER; it += NGW) {
        const int l = it / I_LAYER; int r = it % I_LAYER;
        if (r < I_IN) { const int kb = r / 160, nb = r % 160, n0 = nb * 32; int src, valid = 32;
            if (n0 < 1280) src = n0; else if (n0 < 4864) src = n0 + 24; else { src = 1280 + (n0 - 4864); valid = (n0 == 4864) ? 24 : 0; if (valid == 0) src = 0; }
            transpose_item(p.w_in + (size_t)l * DM * INCOLS, INCOLS, src, valid, (bf16_t*)(ws + WS_WIN) + (size_t)l * NPAD * DM, DM, n0, kb * 64, scr, lane); continue; }
        r -= I_IN;
        if (r < I_A) { const int kb = r / 32, nb = r % 32; transpose_item(p.w_branch_a + (size_t)l * 512 * DM, DM, nb * 32, 32, (bf16_t*)(ws + WS_WA) + (size_t)l * DM * 512, 512, nb * 32, kb * 64, scr, lane); continue; }
        r -= I_A;
        if (r < I_A) { const int kb = r / 32, nb = r % 32; transpose_item(p.w_branch_b + (size_t)l * 512 * DM, DM, nb * 32, 32, (bf16_t*)(ws + WS_WB) + (size_t)l * DM * 512, 512, nb * 32, kb * 64, scr, lane); continue; }
        r -= I_A;
        if (r < I_O) { const int kb = r / 32, nb = r % 32; transpose_item(p.w_out + (size_t)l * DM * DM, DM, nb * 32, 32, (bf16_t*)(ws + WS_WO) + (size_t)l * DM * DM, DM, nb * 32, kb * 64, scr, lane); continue; }
        r -= I_O;
        if (r < I_C1) { const int kv = r / 128, r2 = r % 128, kb = r2 / 4, nb = r2 % 4;
            transpose_item(p.cmp_w1 + (size_t)(l * 2 + kv) * 2048 * 128, 128, nb * 32, 32, (bf16_t*)(ws + WS_WC1) + (size_t)(l * 2 + kv) * 128 * 2048, 2048, nb * 32, kb * 64, scr, lane); continue; }
        r -= I_C1;
        if (r < 2 * I_G) { const int which = r / I_G, r2 = r % I_G, e = r2 / 64, r3 = r2 % 64, kb = r3 / 4, nb = r3 % 4;
            const float* W = (which ? p.exp_w_up : p.exp_w_gate) + (size_t)(l * 16 + e) * DM * 128;
            transpose_item(W, 128, nb * 32, 32, (bf16_t*)(ws + WS_WGU) + (size_t)(l * 16 + e) * 256 * DM, DM, which * 128 + nb * 32, kb * 64, scr, lane); continue; }
        r -= 2 * I_G;
        { const int e = r / 64, r3 = r % 64, kb = r3 / 32, nb = r3 % 32;
            transpose_item(p.exp_w_down + (size_t)(l * 16 + e) * 128 * DM, DM, nb * 32, 32, (bf16_t*)(ws + WS_WD) + (size_t)(l * 16 + e) * DM * 128, 128, nb * 32, kb * 64, scr, lane); }
    }
    for (int m0 = gw * 4; m0 < NTOK; m0 += NGW * 4) {
        f32x4 v[4][4];
#pragma unroll
        for (int rr = 0; rr < 4; ++rr)
#pragma unroll
            for (int j = 0; j < 4; ++j) v[rr][j] = *(const f32x4*)(p.x + (size_t)(m0 + rr) * DM + (64 * j + lane) * 4);
#pragma unroll
        for (int rr = 0; rr < 4; ++rr) { float ss = 0.f;
#pragma unroll
            for (int j = 0; j < 4; ++j) ss += (v[rr][j][0] * v[rr][j][0] + v[rr][j][1] * v[rr][j][1]) + (v[rr][j][2] * v[rr][j][2] + v[rr][j][3] * v[rr][j][3]);
            const float rstd = rsqrtf(wave_sum(ss) * (1.f / 1024.f) + 1e-6f);
#pragma unroll
            for (int j = 0; j < 4; ++j) { const f32x4 gg = *(const f32x4*)(p.norm1_g + (64 * j + lane) * 4); st4bf((bf16_t*)(ws + WS_XN) + (size_t)(m0 + rr) * DM + (64 * j + lane) * 4, v[rr][j] * rstd * gg); } }
    }
    __syncthreads();
    if (blockIdx.x < 8) {
        const int l = blockIdx.x >> 2, kv = (blockIdx.x >> 1) & 1, jh = blockIdx.x & 1, j = jh * 64 + lane;
        const float* pe = p.cmp_pe + (size_t)(l * 2 + kv) * 2048; const float* w1 = p.cmp_w1 + (size_t)(l * 2 + kv) * 2048 * 128;
        float s = 0.f;
        for (int f = wid * 256; f < wid * 256 + 256; ++f) s += pe[f] * w1[(size_t)f * 128 + j];
        LAS float* part = (LAS float*)(lds + 70000);
        part[wid * 64 + lane] = s;
        __syncthreads();
        if (wid == 0) { float t = p.cmp_b1[(l * 2 + kv) * 128 + j];
#pragma unroll
            for (int w = 0; w < 8; ++w) t += part[w * 64 + lane];
            ((float*)(ws + WS_MISC))[(l * 2 + kv) * 128 + j] = t; }
    }
    if (blockIdx.x == 8 && wid < DEPTH) {
        const int l = wid; const float* lp = p.diff_lambda + l * 256;
        const float a = wave_sum(lp[lane] * lp[64 + lane]), b = wave_sum(lp[128 + lane] * lp[192 + lane]);
        const float lam_init = 0.8f - 0.6f * expf(-0.3f * (float)l);
        if (lane == 0) ((float*)(ws + WS_MISC + 4096))[l] = expf(a) - expf(b) + lam_init;
    }
}

namespace pg8 {
#define PG8_LAS __attribute__((address_space(3)))
constexpr int BM = 256, BK = 64, HALF = 128, HTB = HALF * BK * 2  , STAGE_BYTES = 8 * HTB, NXCD = 8, WGM = 8;

__host__ __device__ __forceinline__ int lds_byte(int r, int c) { const int st = (r >> 4) * 2 + (c >> 5), rr = r & 15, cc = c & 31, ob = rr * 64 + cc * 2; return st * 1024 + (ob ^ (((ob >> 9) & 1) << 5)); }
__host__ __device__ __forceinline__ void stage_rc(int b, int& R, int& C) { const int st = b / 1024, sb = b % 1024, swz = sb ^ (((sb >> 9) & 1) << 5); R = (st >> 1) * 16 + swz / 64; C = (st & 1) * 32 + (swz % 64) / 2; }
__host__ __device__ __forceinline__ int perm32(int rho) { const int n = rho >> 4, i = rho & 15; return 8 * (i >> 2) + 4 * n + (i & 3); }

struct Unit { int pm, pn, z; };
struct Gemm { const bf16_t* A; const bf16_t* Bt; const bf16_t* A2; const bf16_t* Bt2; int M, N, K; };

struct StaticOrder {
    int nM, nN, nwg, G, c;
    __host__ __device__ void init(int M, int N, int G_, int c_) { nM = M / BM; nN = N / BM; nwg = nM * nN; G = G_; c = c_; }
    __host__ __device__ bool next(int i, Unit& u) const {
        const long L = (long)i * G + c; if (L >= nwg) return false;
        int wgid = (int)L; { const int q = nwg / NXCD, r = nwg % NXCD, xcd = wgid % NXCD, off = wgid / NXCD; wgid = (xcd < r ? xcd * (q + 1) : r * (q + 1) + (xcd - r) * q) + off; }
        const int nig = WGM * nN, gid = wgid / nig, fm = gid * WGM, gsz = (nM - fm) < WGM ? (nM - fm) : WGM;
        u.pm = fm + ((wgid % nig) % gsz); u.pn = (wgid % nig) / gsz; u.z = 0; return true;
    }
    __device__ __forceinline__ void a_ready(const Unit&) const {}
    __device__ __forceinline__ void done(const Unit&) const {}
};

template <class Epi, class Sched, bool ALIGN_EPI = false, bool SP2 = false>
__device__ __forceinline__ void gemm_phase(PG8_LAS unsigned char* lds, const Gemm g, const Sched& S, const Epi& E) {
    int tid_ = threadIdx.x; asm volatile("" : "+v"(tid_));
    const int tid = tid_, wid = __builtin_amdgcn_readfirstlane(tid >> 6), lane = tid & 63, wr = wid >> 2, wc = wid & 3, fr = lane & 15, fq = lane >> 4;
    const int K = g.K, nt = K / BK;
    unsigned voffA[2], voffB[2];
#pragma unroll
    for (int i = 0; i < 2; ++i) { int R, C; stage_rc(tid * 16 + i * 8192, R, C); const int Rb = Epi::PERM ? ((R & ~31) + perm32(R & 31)) : R;
        voffA[i] = (unsigned)(R * K + C) * 2u; voffB[i] = (unsigned)(Rb * K + C) * 2u; }
    const size_t kstep = (size_t)(BK * 2);
    const size_t hstep = (size_t)HALF * K * 2;
    const size_t tstep = 2 * hstep;
    const unsigned ldsw = (unsigned)wid * 1024u;
    const int aoff = lds_byte(wr * 64 + fr, fq * 8), boff = lds_byte(wc * 32 + fr, fq * 8);
#define PG8_SA(b, h) (((b) * 2 + (h)) * HTB)
#define PG8_SB(b, h) ((4 + (b) * 2 + (h)) * HTB)
#define PG8_STAGE(bufoff, gbase, voff) do { _Pragma("unroll") for (int _i = 0; _i < 2; ++_i) \
        __builtin_amdgcn_global_load_lds((const unsigned*)((const char*)(gbase) + (voff)[_i]), (PG8_LAS unsigned*)(lds + (bufoff) + ldsw + _i * 8192), 16, 0, 0); } while (0)
#define PG8_LDA(dst, b, h) do { _Pragma("unroll") for (int m = 0; m < 4; ++m) _Pragma("unroll") for (int k = 0; k < 2; ++k) dst[m][k] = *(const PG8_LAS bf16x8*)(lds + PG8_SA(b, h) + aoff + m * 2048 + k * 1024); } while (0)
#define PG8_LDB(dst, b, h) do { _Pragma("unroll") for (int n = 0; n < 2; ++n) _Pragma("unroll") for (int k = 0; k < 2; ++k) dst[n][k] = *(const PG8_LAS bf16x8*)(lds + PG8_SB(b, h) + boff + n * 2048 + k * 1024); } while (0)
#define PG8_MMA(ai, bj, At, Bt) do { __builtin_amdgcn_s_setprio(1); _Pragma("unroll") for (int m = 0; m < 4; ++m) _Pragma("unroll") for (int n = 0; n < 2; ++n) _Pragma("unroll") for (int k = 0; k < 2; ++k) \
        acc[ai][bj][m][n] = __builtin_amdgcn_mfma_f32_16x16x32_bf16(Bt[n][k], At[m][k], acc[ai][bj][m][n], 0, 0, 0); __builtin_amdgcn_s_setprio(0); } while (0)
#define PG8_WAIT_V(n) asm volatile("s_waitcnt vmcnt(" #n ")" ::: "memory")
#define PG8_WAIT_L(n) asm volatile("s_waitcnt lgkmcnt(" #n ")" ::: "memory")
#define PG8_BAR __builtin_amdgcn_s_barrier()
#define PG8_SCHED __builtin_amdgcn_sched_barrier(0)
    Unit cur, nxt; int ui = 0;
    if (!S.next(0, cur)) return;
    f32x4 acc[2][2][4][2];
#pragma unroll
    for (int a = 0; a < 2; ++a)
#pragma unroll
        for (int b = 0; b < 2; ++b)
#pragma unroll
            for (int m = 0; m < 4; ++m)
#pragma unroll
                for (int n = 0; n < 2; ++n) acc[a][b][m][n] = (f32x4){0.f, 0.f, 0.f, 0.f};
    bf16x8 At[4][2], B0[2][2], B1[2][2];
    const char* cA = (const char*)(cur.z ? g.A2 : g.A) + (size_t)cur.pm * tstep; const char* cB = (const char*)(cur.z ? g.Bt2 : g.Bt) + (size_t)cur.pn * tstep;
    S.a_ready(cur);
    if constexpr (SP2) {
        PG8_STAGE(PG8_SB(0, 0), cB, voffB); PG8_STAGE(PG8_SB(0, 1), cB + hstep, voffB); PG8_STAGE(PG8_SA(0, 0), cA, voffA); PG8_STAGE(PG8_SA(0, 1), cA + hstep, voffA);
        if (wr == 1) PG8_BAR;
        PG8_WAIT_V(2); PG8_BAR;
        PG8_STAGE(PG8_SB(1, 0), cB + kstep, voffB); PG8_STAGE(PG8_SA(1, 0), cA + kstep, voffA); PG8_STAGE(PG8_SB(1, 1), cB + hstep + kstep, voffB);
        PG8_WAIT_V(6); PG8_BAR;
    } else {
        PG8_STAGE(PG8_SB(0, 0), cB, voffB); PG8_STAGE(PG8_SA(0, 0), cA, voffA); PG8_STAGE(PG8_SB(0, 1), cB + hstep, voffB); PG8_STAGE(PG8_SA(0, 1), cA + hstep, voffA);
        if (wr == 1) PG8_BAR;
        PG8_WAIT_V(4); PG8_BAR;
        PG8_STAGE(PG8_SB(1, 0), cB + kstep, voffB); PG8_STAGE(PG8_SA(1, 0), cA + kstep, voffA); PG8_STAGE(PG8_SB(1, 1), cB + hstep + kstep, voffB);
        PG8_WAIT_V(6); PG8_BAR;
    }
    for (;;) {
        const bool has_next = S.next(ui + 1, nxt);
        const char* nA = has_next ? (const char*)(nxt.z ? g.A2 : g.A) + (size_t)nxt.pm * tstep : cA; const char* nB = has_next ? (const char*)(nxt.z ? g.Bt2 : g.Bt) + (size_t)nxt.pn * tstep : cB;
        for (int t = 0; t < nt; t += 2) {
            const bool last = (t == nt - 2);
            const char* a1 = cA + (size_t)(t + 1) * kstep;
            const char* a2 = last ? nA : cA + (size_t)(t + 2) * kstep; const char* b2 = last ? nB : cB + (size_t)(t + 2) * kstep;
            const char* a3 = a2 + kstep; const char* b3 = b2 + kstep;
            if (last && has_next) S.a_ready(nxt);
            if constexpr (SP2) {
            PG8_LDB(B0, 0, 0); PG8_LDB(B1, 0, 1); PG8_SCHED; PG8_LDA(At, 0, 0); PG8_STAGE(PG8_SA(1, 1), a1 + hstep, voffA);
            PG8_WAIT_V(8); PG8_WAIT_L(0); PG8_BAR; PG8_MMA(0, 0, At, B0); PG8_MMA(0, 1, At, B1); PG8_BAR; PG8_SCHED;
            PG8_LDA(At, 0, 1); PG8_STAGE(PG8_SB(0, 0), b2, voffB); PG8_STAGE(PG8_SB(0, 1), b2 + hstep, voffB); PG8_STAGE(PG8_SA(0, 0), a2, voffA);
            PG8_WAIT_V(8); PG8_WAIT_L(0); PG8_BAR; PG8_MMA(1, 0, At, B0); PG8_MMA(1, 1, At, B1); PG8_BAR; PG8_SCHED;
            PG8_LDB(B0, 1, 0); PG8_LDB(B1, 1, 1); PG8_SCHED; PG8_LDA(At, 1, 0); PG8_STAGE(PG8_SA(0, 1), a2 + hstep, voffA);
            PG8_WAIT_V(8); PG8_WAIT_L(0); PG8_BAR; PG8_MMA(0, 0, At, B0); PG8_MMA(0, 1, At, B1); PG8_BAR; PG8_SCHED;
            PG8_LDA(At, 1, 1); PG8_STAGE(PG8_SB(1, 0), b3, voffB); PG8_STAGE(PG8_SB(1, 1), b3 + hstep, voffB); PG8_STAGE(PG8_SA(1, 0), a3, voffA);
            PG8_WAIT_V(8); PG8_WAIT_L(0); PG8_BAR; PG8_MMA(1, 0, At, B0); PG8_MMA(1, 1, At, B1); PG8_BAR; PG8_SCHED;
            } else {
            PG8_LDB(B0, 0, 0); PG8_SCHED; PG8_LDA(At, 0, 0); PG8_STAGE(PG8_SA(1, 1), a1 + hstep, voffA);
            PG8_WAIT_L(8); PG8_BAR; PG8_WAIT_L(0); PG8_MMA(0, 0, At, B0); PG8_BAR; PG8_SCHED;
            PG8_LDB(B1, 0, 1); PG8_STAGE(PG8_SB(0, 0), b2, voffB);
            PG8_BAR; PG8_WAIT_L(0); PG8_MMA(0, 1, At, B1); PG8_BAR;
            PG8_LDA(At, 0, 1); PG8_STAGE(PG8_SA(0, 0), a2, voffA);
            PG8_BAR; PG8_WAIT_L(0); PG8_MMA(1, 0, At, B0); PG8_BAR; PG8_SCHED;
            PG8_STAGE(PG8_SB(0, 1), b2 + hstep, voffB);
            PG8_WAIT_V(6); PG8_BAR; PG8_MMA(1, 1, At, B1); PG8_BAR;
            PG8_LDB(B0, 1, 0); PG8_SCHED; PG8_LDA(At, 1, 0); PG8_STAGE(PG8_SA(0, 1), a2 + hstep, voffA);
            PG8_WAIT_L(8); PG8_BAR; PG8_WAIT_L(0); PG8_MMA(0, 0, At, B0); PG8_BAR; PG8_SCHED;
            PG8_LDB(B1, 1, 1); PG8_STAGE(PG8_SB(1, 0), b3, voffB);
            PG8_BAR; PG8_WAIT_L(0); PG8_MMA(0, 1, At, B1); PG8_BAR;
            PG8_LDA(At, 1, 1); PG8_STAGE(PG8_SA(1, 0), a3, voffA);
            PG8_BAR; PG8_WAIT_L(0); PG8_MMA(1, 0, At, B0); PG8_BAR; PG8_SCHED;
            PG8_STAGE(PG8_SB(1, 1), b3 + hstep, voffB);
            PG8_WAIT_V(6); PG8_BAR; PG8_MMA(1, 1, At, B1); PG8_BAR;
            }
        }
        if constexpr (ALIGN_EPI) { if (wr == 0) PG8_BAR; }
        if constexpr (!Epi::AFTER_DRAIN) { E(acc, cur, wr, wc, fr, fq); S.done(cur); }
        if (!has_next) break;
        if (!Epi::keep(cur)) {
#pragma unroll
        for (int a = 0; a < 2; ++a)
#pragma unroll
            for (int b = 0; b < 2; ++b)
#pragma unroll
                for (int m = 0; m < 4; ++m)
#pragma unroll
                    for (int n = 0; n < 2; ++n) acc[a][b][m][n] = (f32x4){0.f, 0.f, 0.f, 0.f}; }
        cur = nxt; cA = nA; cB = nB; ++ui;
        if constexpr (ALIGN_EPI) { if (wr == 1) PG8_BAR; }
    }
    PG8_WAIT_V(0);
    if constexpr (!ALIGN_EPI) { if (wr == 0) PG8_BAR; }
    PG8_BAR;
    if constexpr (Epi::AFTER_DRAIN) { E.fused(acc, cur, wr, wc, fr, fq, lds, wid, lane); S.done(cur); }
#undef PG8_SA
#undef PG8_SB
#undef PG8_STAGE
#undef PG8_LDA
#undef PG8_LDB
#undef PG8_MMA
#undef PG8_WAIT_V
#undef PG8_WAIT_L
#undef PG8_BAR
#undef PG8_SCHED
}
}

typedef pg8::Unit PUnit;
struct EpiInproj {
    static constexpr bool PERM = true, AFTER_DRAIN = false;
    unsigned char* ws;
    static __device__ __forceinline__ bool keep(const PUnit&) { return false; }
    __device__ __forceinline__ void operator()(f32x4 (&acc)[2][2][4][2], const PUnit& u, int wr, int wc, int fr, int fq) const {
        const int n0 = u.pn * 256;
        bf16_t* dst; int pitch, c0, mode = 0;
        if (n0 < 512) { dst = (bf16_t*)(ws + WS_NQ); pitch = 512; c0 = n0; mode = 1; }
        else if (n0 < 1280) { dst = (bf16_t*)(ws + WS_KV6); pitch = 768; c0 = n0 - 512; }
        else if (n0 < 1792) { dst = (bf16_t*)(ws + WS_DQ); pitch = 512; c0 = n0 - 1280; mode = 1; }
        else if (n0 < 2304) { dst = (bf16_t*)(ws + WS_DK); pitch = 512; c0 = n0 - 1792; }
        else if (n0 < 2816) { dst = (bf16_t*)(ws + WS_DV); pitch = 512; c0 = n0 - 2304; }
        else if (n0 < 3840) { dst = (bf16_t*)(ws + WS_GA); pitch = 1024; c0 = n0 - 2816; mode = 2; }
        else if (n0 < 4864) { dst = (bf16_t*)(ws + WS_GB); pitch = 1024; c0 = n0 - 3840; mode = 2; }
        else { dst = (bf16_t*)(ws + WS_NG); pitch = 32; c0 = 0; mode = 3; }
        asm volatile("" : "+v"(fr), "+v"(fq));
        const int row0 = u.pm * 256 + wr * 64 + fr, col0 = wc * 32 + 8 * fq;
#pragma unroll
        for (int ai = 0; ai < 2; ++ai)
#pragma unroll
            for (int m = 0; m < 4; ++m) { bf16_t* rowp = dst + (size_t)(row0 + ai * 128 + m * 16) * pitch + c0 + col0;
#pragma unroll
                for (int bj = 0; bj < 2; ++bj) { f32x4 v0 = acc[ai][bj][m][0], v1 = acc[ai][bj][m][1];
                    if (mode == 1) { v0 = v0 * QSCALE; v1 = v1 * QSCALE; }
                    else if (mode >= 2) {
#pragma unroll
                        for (int i = 0; i < 4; ++i) { v0[i] = sigm(v0[i]); v1[i] = sigm(v1[i]); } }
                    if (mode != 3 || (bj == 0 && wc == 0)) { u32x4 w; w.x = cvtpk(v0[0], v0[1]); w.y = cvtpk(v0[2], v0[3]); w.z = cvtpk(v1[0], v1[1]); w.w = cvtpk(v1[2], v1[3]); *(u32x4*)(rowp + bj * 128) = w; } } }
    }
};
struct EpiMerge {
    static constexpr bool PERM = true, AFTER_DRAIN = false;
    const bf16_t* GA; const bf16_t* GB; bf16_t* MG;
    static __device__ __forceinline__ bool keep(const PUnit& u) { return u.z == 0; }
    __device__ __forceinline__ void operator()(f32x4 (&acc)[2][2][4][2], const PUnit& u, int wr, int wc, int fr, int fq) const {
        asm volatile("" : "+v"(fr), "+v"(fq));
        const int row0 = u.pm * 256 + wr * 64 + fr, col0 = u.pn * 256 + wc * 32 + 8 * fq;
#pragma unroll
        for (int ai = 0; ai < 2; ++ai)
#pragma unroll
            for (int m = 0; m < 4; ++m) { const size_t ro = (size_t)(row0 + ai * 128 + m * 16) * DM + col0;
#pragma unroll
                for (int bj = 0; bj < 2; ++bj) { const size_t off = ro + bj * 128;
                    const u32x4 gb = *(const u32x4*)(GB + off);
                    const f32x4 b0 = {bflo(gb.x), bfhi(gb.x), bflo(gb.y), bfhi(gb.y)}, b1 = {bflo(gb.z), bfhi(gb.z), bflo(gb.w), bfhi(gb.w)};
                    if (u.z == 0) { const u32x4 ga = *(const u32x4*)(GA + off);
                        const f32x4 a0 = {bflo(ga.x), bfhi(ga.x), bflo(ga.y), bfhi(ga.y)}, a1 = {bflo(ga.z), bfhi(ga.z), bflo(ga.w), bfhi(ga.w)};
#pragma unroll
                        for (int i = 0; i < 4; ++i) { acc[ai][bj][m][0][i] *= a0[i] * __builtin_amdgcn_rcpf(fmaxf(b0[i], 1e-30f)); acc[ai][bj][m][1][i] *= a1[i] * __builtin_amdgcn_rcpf(fmaxf(b1[i], 1e-30f)); } }
                    else { const f32x4 v0 = acc[ai][bj][m][0] * b0, v1 = acc[ai][bj][m][1] * b1;
                        u32x4 w; w.x = cvtpk(v0[0], v0[1]); w.y = cvtpk(v0[2], v0[3]); w.z = cvtpk(v1[0], v1[1]); w.w = cvtpk(v1[2], v1[3]); *(u32x4*)(MG + off) = w; } } }
    }
};
struct MergeOrder {
    int G, c;
    __device__ __forceinline__ bool next(int i, PUnit& u) const { const int t = (i >> 1) * G + c; if (t >= 512) return false;
        int wgid = t; { const int q = 512 / 8, xcd = wgid % 8, off = wgid / 8; wgid = xcd * q + off; }
        u.pm = (wgid >> 5) * 8 + (wgid & 7); u.pn = (wgid >> 3) & 3; u.z = i & 1; return true; }
    __device__ __forceinline__ void a_ready(const PUnit&) const {}
    __device__ __forceinline__ void done(const PUnit&) const {}
};
struct EpiOut {
    static constexpr bool PERM = false, AFTER_DRAIN = false;
    const float* hin; float* hout;
    static __device__ __forceinline__ bool keep(const PUnit&) { return false; }
    __device__ __forceinline__ void operator()(f32x4 (&acc)[2][2][4][2], const PUnit& u, int wr, int wc, int fr, int fq) const {
        asm volatile("" : "+v"(fr), "+v"(fq));
        const int row0 = u.pm * 256 + wr * 64 + fr, col0 = u.pn * 256 + wc * 32 + 4 * fq;
#pragma unroll
        for (int ai = 0; ai < 2; ++ai)
#pragma unroll
            for (int m = 0; m < 4; ++m) { const size_t ro = (size_t)(row0 + ai * 128 + m * 16) * DM + col0;
#pragma unroll
                for (int bj = 0; bj < 2; ++bj)
#pragma unroll
                    for (int n = 0; n < 2; ++n) { const size_t off = ro + bj * 128 + n * 16; *(f32x4*)(hout + off) = *(const f32x4*)(hin + off) + acc[ai][bj][m][n]; } }
    }
};
__device__ __forceinline__ void phase_inproj_pg8(PRef p, int l, LAS unsigned char* lds) {
    unsigned char* ws = p.ws;
    const bf16_t* W = (const bf16_t*)(ws + WS_WIN) + (size_t)l * NPAD * DM;
    pg8::Gemm g{(const bf16_t*)(ws + WS_XN), W, (const bf16_t*)(ws + WS_XN), W, NTOK, NPAD, DM};
    pg8::StaticOrder S; S.init(NTOK, NPAD, (int)gridDim.x, (int)blockIdx.x);
    EpiInproj E{ws};
    pg8::gemm_phase<EpiInproj, pg8::StaticOrder, true, true>(lds, g, S, E);
}
__device__ __forceinline__ void phase_merge_pg8(PRef p, int l, LAS unsigned char* lds) {
    unsigned char* ws = p.ws;
    pg8::Gemm g{(const bf16_t*)(ws + WS_NQ), (const bf16_t*)(ws + WS_WA) + (size_t)l * DM * 512, (const bf16_t*)(ws + WS_DQ), (const bf16_t*)(ws + WS_WB) + (size_t)l * DM * 512, NTOK, DM, 512};
    MergeOrder S{(int)gridDim.x, (int)blockIdx.x};
    EpiMerge E{(const bf16_t*)(ws + WS_GA), (const bf16_t*)(ws + WS_GB), (bf16_t*)(ws + WS_XN)};
    pg8::gemm_phase<EpiMerge, MergeOrder, true, true>(lds, g, S, E);
}
__device__ __forceinline__ void phase_outproj_pg8(PRef p, int l, LAS unsigned char* lds, bool dry = false) {
    unsigned char* ws = p.ws;
    const bf16_t* WO = (const bf16_t*)(ws + WS_WO) + (size_t)l * DM * DM;
    pg8::Gemm g{(const bf16_t*)(ws + WS_XN), WO, (const bf16_t*)(ws + WS_XN), WO, NTOK, DM, DM};
    pg8::StaticOrder S; S.init(NTOK, DM, (int)gridDim.x, (int)blockIdx.x);
    EpiOut E{(l == 0) ? p.x : p.out, dry ? (float*)(ws + WS_GA) : p.out};
    pg8::gemm_phase<EpiOut, pg8::StaticOrder, true, true>(lds, g, S, E);
}

__device__ __forceinline__ void phase_inproj(PRef p, int l, LAS unsigned char* lds) {
    SG_IDS
    unsigned char* ws = p.ws;
    const bf16_t* XN = (const bf16_t*)(ws + WS_XN); const bf16_t* W = (const bf16_t*)(ws + WS_WIN) + (size_t)l * NPAD * DM;
    constexpr int NT = 39, GRP = 16;
    for (int u = blockIdx.x; u < 256 * NT; u += gridDim.x) {
        const int grp = u / (GRP * NT), rem = u % (GRP * NT), pn = rem / GRP, pm = grp * GRP + rem % GRP;
        const int m0 = pm * 128, n0 = pn * 128;
        f32x4 acc[2][4]; SG_ZERO(acc);
        sg_kloop(acc, ARowLin{(const char*)(XN + (size_t)m0 * DM), 2048}, 128, W + (size_t)n0 * DM, DM, 16, lds);
        bf16_t* dst; int pitch, c0, mode = 0;
        if (n0 < 512) { dst = (bf16_t*)(ws + WS_NQ); pitch = 512; c0 = n0; mode = 1; }
        else if (n0 < 1280) { dst = (bf16_t*)(ws + WS_KV6); pitch = 768; c0 = n0 - 512; }
        else if (n0 < 1792) { dst = (bf16_t*)(ws + WS_DQ); pitch = 512; c0 = n0 - 1280; mode = 1; }
        else if (n0 < 2304) { dst = (bf16_t*)(ws + WS_DK); pitch = 512; c0 = n0 - 1792; }
        else if (n0 < 2816) { dst = (bf16_t*)(ws + WS_DV); pitch = 512; c0 = n0 - 2304; }
        else if (n0 < 3840) { dst = (bf16_t*)(ws + WS_GA); pitch = 1024; c0 = n0 - 2816; mode = 2; }
        else if (n0 < 4864) { dst = (bf16_t*)(ws + WS_GB); pitch = 1024; c0 = n0 - 3840; mode = 2; }
        else { dst = (bf16_t*)(ws + WS_NG); pitch = 32; c0 = 0; mode = 3; }
#pragma unroll
        for (int m = 0; m < 2; ++m)
#pragma unroll
            for (int n = 0; n < 4; ++n) {
                const int row = m0 + SG_ROW(m), col = SG_COL(n); f32x4 v = acc[m][n];
                if (mode == 1) v = v * QSCALE;
                else if (mode >= 2) { v[0] = sigm(v[0]); v[1] = sigm(v[1]); v[2] = sigm(v[2]); v[3] = sigm(v[3]); }
                if (mode != 3 || col < 32) st4bf(dst + (size_t)row * pitch + c0 + col, v);
            }
    }
}

__device__ __forceinline__ void stage_k(LAS unsigned char* kdst, const bf16_t* src  , int pitch, int tid) {
    const int row = tid & 63, ch = tid >> 6;
    *(LAS u32x4*)(kdst + ch * 1024 + row * 16) = *(const u32x4*)(src + (size_t)row * pitch + ch * 8);
}
template <int NDB> __device__ __forceinline__ void stage_v(LAS unsigned char* vdst, const bf16_t* src, int pitch, int tid) {
#pragma unroll
    for (int i = 0; i < NDB / 2; ++i) { const int pc = tid + 512 * i, pw = pc >> 6, ln = pc & 63, db = pw >> 2, rg = pw & 3;
        *(LAS u32x4*)(vdst + pw * 1024 + ln * 16) = *(const u32x4*)(src + (size_t)(16 * rg + (ln >> 2)) * pitch + db * 32 + (ln & 3) * 8); }
}
__device__ __forceinline__ void qkt(f32x16& p0, f32x16& p1, LAS const unsigned char* K, const bf16x8 (&qr)[4], int r32, int hi) {
    LAS const unsigned char* kb = K + hi * 1024 + r32 * 16;
    p0 = (f32x16){0.f}; p1 = (f32x16){0.f};
#pragma unroll
    for (int d0 = 0; d0 < 4; ++d0) {
        const bf16x8 b0 = *(LAS const bf16x8*)(kb + d0 * 2048), b1 = *(LAS const bf16x8*)(kb + d0 * 2048 + 512);
        p0 = MFMA32(b0, qr[d0], p0); p1 = MFMA32(b1, qr[d0], p1);
    }
    __builtin_amdgcn_sched_barrier(0);
}
template <int NDB> __device__ __forceinline__ void pv(f32x16 (&o)[NDB], const f32x16& p0, const f32x16& p1, LAS const unsigned char* V, int lane, int hi) {
    u32x4 pw[4];
    pw[0] = (u32x4){cvtpk(p0[0], p0[1]), cvtpk(p0[2], p0[3]), cvtpk(p0[4], p0[5]), cvtpk(p0[6], p0[7])};
    pw[1] = (u32x4){cvtpk(p0[8], p0[9]), cvtpk(p0[10], p0[11]), cvtpk(p0[12], p0[13]), cvtpk(p0[14], p0[15])};
    pw[2] = (u32x4){cvtpk(p1[0], p1[1]), cvtpk(p1[2], p1[3]), cvtpk(p1[4], p1[5]), cvtpk(p1[6], p1[7])};
    pw[3] = (u32x4){cvtpk(p1[8], p1[9]), cvtpk(p1[10], p1[11]), cvtpk(p1[12], p1[13]), cvtpk(p1[14], p1[15])};
    LAS const unsigned char* vb = V + ((lane >> 4) & 1) * 32 + (lane & 3) * 8 + (4 * hi + ((lane & 15) >> 2)) * 64;
#pragma unroll
    for (int d0 = 0; d0 < NDB; ++d0)
#pragma unroll
        for (int ks = 0; ks < 4; ++ks) {
            const s16x4 lo = vtr(vb + d0 * 4096 + ks * 1024), hh = vtr(vb + d0 * 4096 + ks * 1024 + 512);
            const bf16x8 vf = (bf16x8){lo[0], lo[1], lo[2], lo[3], hh[0], hh[1], hh[2], hh[3]};
            o[d0] = MFMA32(__builtin_bit_cast(bf16x8, pw[ks]), vf, o[d0]);
            if (ks == 3) __builtin_amdgcn_sched_barrier(0);
        }
}
constexpr float SM_THR = 6.0f;
constexpr float NEG = -1e30f;
template <int NDB> __device__ __forceinline__ void softmax_pv(f32x16& s0, f32x16& s1, float& m, float& l, f32x16 (&o)[NDB], LAS float* wsf, LAS const unsigned char* V, int lane, int r32, int hi) {
    float rm = fmaxf(s0[0], s1[0]);
#pragma unroll
    for (int r = 1; r < 16; ++r) rm = fmaxf(rm, fmaxf(s0[r], s1[r]));
    rm = fmaxf(rm, __shfl_xor(rm, 32));
    if (__any(rm > m + SM_THR)) {
        const float mn = fmaxf(m, rm), f = ex2(m - mn); l *= f; m = mn;
        if (hi == 0) wsf[r32] = f;
#pragma unroll
        for (int r = 0; r < 16; ++r) { const float fr_ = wsf[crow(r, hi)];
#pragma unroll
            for (int d = 0; d < NDB; ++d) o[d][r] *= fr_; }
    }
    float sum = 0.f;
#pragma unroll
    for (int r = 0; r < 16; ++r) { s0[r] = ex2(s0[r] - m); s1[r] = ex2(s1[r] - m); sum += s0[r] + s1[r]; }
    l += sum;
    pv<NDB>(o, s0, s1, V, lane, hi);
}

__device__ __forceinline__ float gelu_tanh(float x) { const float u = 0.7978845608f * (x + 0.044715f * x * x * x); const float e = __expf(2.f * u); return 0.5f * x * (2.f - 2.f / (1.f + e)); }

__device__ __forceinline__ void compress_unit(PRef p, int l, int u, LAS unsigned char* lds) {
    SG_IDS
    unsigned char* ws = p.ws;
    const int kv = u >> 5, m0 = (u & 31) * 128;
    const bf16_t* KV6 = (const bf16_t*)(ws + WS_KV6);
    struct ARowC { const bf16_t* KV6; int m0, kv; __device__ __forceinline__ const char* operator()(int r) const { const int mm = m0 + r, g = mm >> 11, tok = (mm & 2047) * 16; return (const char*)(KV6 + (size_t)tok * 768 + kv * 128 + g * 64); } };
    f32x4 acc[2][4]; SG_ZERO(acc);
    sg_kloop(acc, ARowC{KV6, m0, kv}, 768 * 2, (const bf16_t*)(ws + WS_WC1) + (size_t)(l * 2 + kv) * 128 * 2048, 2048, 32, lds);
    LAS bf16_t* Ht = (LAS bf16_t*)(lds + 32768);
    LAS float* W2 = (LAS float*)(lds + 32768 + 34816);
    const float* cb1 = (const float*)(ws + WS_MISC) + (l * 2 + kv) * 128;
#pragma unroll
    for (int m = 0; m < 2; ++m)
#pragma unroll
        for (int n = 0; n < 4; ++n) { const int row = SG_ROW(m), col = SG_COL(n); const f32x4 b = *(const f32x4*)(cb1 + col); f32x4 v = acc[m][n] + b;
            u32x2 w; w.x = cvtpk(gelu_tanh(v[0]), gelu_tanh(v[1])); w.y = cvtpk(gelu_tanh(v[2]), gelu_tanh(v[3])); *(LAS u32x2*)(Ht + row * 136 + col) = w; }
    const float* w2g = p.cmp_w2 + (size_t)(l * 2 + kv) * 128 * 64;
    for (int i = tid; i < 128 * 64 / 4; i += 512) *(LAS f32x4*)(W2 + i * 4) = *(const f32x4*)(w2g + i * 4);
    __syncthreads();
    const int d = tid & 63; const float b2 = p.cmp_b2[(l * 2 + kv) * 64 + d];
    bf16_t* dstb = (bf16_t*)(ws + WS_MISC + 65536 + (size_t)kv * 524288);
    for (int i = 0; i < 16; ++i) { const int row = (tid >> 6) + 8 * i; float s = b2;
#pragma unroll 8
        for (int f = 0; f < 128; ++f) s += bf1(Ht[row * 136 + f]) * W2[f * 64 + d];
        const int mm = m0 + row, g = mm >> 11, bi = mm & 2047;
        dstb[((size_t)bi * 2 + g) * 64 + d] = f2bf(s); }
    __syncthreads();
}

__device__ __forceinline__ void diff_unit(PRef p, int l, int u, LAS unsigned char* lds, bool dry = false) {
    int tid_ = threadIdx.x; asm volatile("" : "+v"(tid_));
    const int tid = tid_, lane = tid & 63, r32 = lane & 31, hi = lane >> 5, wid = __builtin_amdgcn_readfirstlane(tid >> 6);
    unsigned char* ws = p.ws;
    const int c = 15 - (u >> 6), b = (u & 63) >> 2, hd = u & 3;
    const int cm = wid >> 2, qq = wid & 3, t0 = 128 * c + 32 * qq, tq = t0 + r32;
    const size_t tokb = (size_t)b * TSEQ;
    bf16_t* DQ = (bf16_t*)(ws + WS_DQ); const bf16_t* DK = (const bf16_t*)(ws + WS_DK); const bf16_t* DV = (const bf16_t*)(ws + WS_DV);
    bf16x8 qr[4];
    { const bf16_t* qp = DQ + (tokb + tq) * 512 + hd * 128 + cm * 64 + hi * 8;
#pragma unroll
      for (int d0 = 0; d0 < 4; ++d0) qr[d0] = *(const bf16x8*)(qp + d0 * 16); }
    const float sl2 = alibi_slope(9 + hd) * LOG2E;
    const float cbh = sl2 * (float)(4 * hi);
#define CB(r) fmaf(sl2, (float)(((r) & 3) + 8 * ((r) >> 2)), cbh)
    f32x16 o[4];
#pragma unroll
    for (int d = 0; d < 4; ++d) o[d] = (f32x16){0.f};
    float m = NEG, lsum = 0.f;
    LAS float* wsf = (LAS float*)(lds + LDS_MISC + 1024 + wid * 128);
    LAS unsigned char* Kt = lds; LAS unsigned char* Vt = lds + 16384;
    const int jmax_w = (t0 + 31) >> 6;
    for (int j = 2 * c + 1; j >= 0; --j) {
        __syncthreads();
        { const bf16_t* ksrc = DK + (tokb + 64 * j) * 512 + hd * 128; stage_k(Kt, ksrc, 512, tid); stage_k(Kt + 8192, ksrc + 64, 512, tid);
          stage_v<4>(Vt, DV + (tokb + 64 * j) * 512 + hd * 128, 512, tid); }
        __syncthreads();
        if (j <= jmax_w) {
            f32x16 s0, s1; qkt(s0, s1, Kt + cm * 8192, qr, r32, hi);
            const float tc = sl2 * (float)(64 * j - 128 * c);
            const bool diag = (64 * j + 63 > t0); const int lim = tq - 64 * j;
#pragma unroll
            for (int r = 0; r < 16; ++r) { s0[r] += CB(r) + tc; s1[r] += CB(r) + (tc + 32.f * sl2);
                if (diag) { if (crow(r, hi) > lim) s0[r] = NEG; if (crow(r, hi) + 32 > lim) s1[r] = NEG; } }
            softmax_pv<4>(s0, s1, m, lsum, o, wsf, Vt, lane, r32, hi);
        }
    }
    __syncthreads();
    const float lam = ((const float*)(ws + WS_MISC + 4096))[l];
    const float lam_init = 0.8f - 0.6f * expf(-0.3f * (float)l);
    const float ltot = lsum + __shfl_xor(lsum, 32);
    if (hi == 0) wsf[r32] = (cm == 0 ? 1.f : lam) / ltot;
    LAS float* X = (LAS float*)(lds + cm * 65536);
#pragma unroll
    for (int r = 0; r < 16; ++r) { const float f = wsf[crow(r, hi)]; const int q = 32 * qq + crow(r, hi);
#pragma unroll
        for (int d = 0; d < 4; ++d) X[q * 128 + d * 32 + r32] = o[d][r] * f; }
    __syncthreads();
    { const int q = tid >> 2, qt = tid & 3; LAS const float* x0 = (LAS const float*)lds + q * 128 + qt * 32; LAS const float* x1 = x0 + 16384;
      float v[32]; float ss = 0.f;
#pragma unroll
      for (int i = 0; i < 32; ++i) { v[i] = x0[i] - x1[i]; ss += v[i] * v[i]; }
      ss += __shfl_xor(ss, 1); ss += __shfl_xor(ss, 2);
      const float rstd = rsqrtf(ss * (1.f / 128.f) + 1e-5f) * (1.f - lam_init);
      const float* sg = p.diff_subln_g + l * 128 + qt * 32;
      bf16_t* dst = (dry ? (bf16_t*)(ws + WS_XN) + (size_t)NTOK * 512 : DQ) + (tokb + 128 * c + q) * 512 + hd * 128 + qt * 32;
#pragma unroll
      for (int i = 0; i < 32; i += 8) { u32x4 w; w.x = cvtpk(v[i] * rstd * sg[i], v[i + 1] * rstd * sg[i + 1]); w.y = cvtpk(v[i + 2] * rstd * sg[i + 2], v[i + 3] * rstd * sg[i + 3]);
          w.z = cvtpk(v[i + 4] * rstd * sg[i + 4], v[i + 5] * rstd * sg[i + 5]); w.w = cvtpk(v[i + 6] * rstd * sg[i + 6], v[i + 7] * rstd * sg[i + 7]); *(u32x4*)(dst + i) = w; } }
    __syncthreads();
}

__device__ __forceinline__ void nsa_unit(PRef p, int l, int u, LAS unsigned char* lds, bool dry = false) {
    int tid_ = threadIdx.x; asm volatile("" : "+v"(tid_));
    const int tid = tid_, lane = tid & 63, r32 = lane & 31, hi = lane >> 5, wid = __builtin_amdgcn_readfirstlane(tid >> 6);
    unsigned char* ws = p.ws;
    const int c = 31 - (u >> 5), b = (u & 31) >> 1, g = u & 1;
    const int hl = wid >> 1, qh = wid & 1, h = g * 4 + hl, t0 = 64 * c + 32 * qh, tq = t0 + r32, ql = 32 * qh + r32;
    const size_t tokb = (size_t)b * TSEQ;
    bf16_t* NQ = (bf16_t*)(ws + WS_NQ); const bf16_t* KV6 = (const bf16_t*)(ws + WS_KV6); const bf16_t* NG = (const bf16_t*)(ws + WS_NG);
    const bf16_t* KC = (const bf16_t*)(ws + WS_MISC + 65536); const bf16_t* VC = (const bf16_t*)(ws + WS_MISC + 65536 + 524288);
    bf16x8 qr[4];
    { const bf16_t* qp = NQ + (tokb + tq) * 512 + h * 64 + hi * 8;
#pragma unroll
      for (int d0 = 0; d0 < 4; ++d0) qr[d0] = *(const bf16x8*)(qp + d0 * 16); }
    const float sl2 = alibi_slope(h + 1) * LOG2E;
    const float cbh = sl2 * (float)(4 * hi);
    LAS float* wsf = (LAS float*)(lds + LDS_MISC + 1024 + wid * 128);
    LAS unsigned char* Kt = lds; LAS unsigned char* Vt = lds + 16384;
    LAS float* IMPH = (LAS float*)(lds + 32768);
    LAS float* VAL = (LAS float*)(lds + 65536);
    LAS unsigned* MASK = (LAS unsigned*)(lds + 73728);
    const float g0 = bf1(NG[(tokb + tq) * 32 + h * 3 + 0]), g1 = bf1(NG[(tokb + tq) * 32 + h * 3 + 1]), g2 = bf1(NG[(tokb + tq) * 32 + h * 3 + 2]);
    f32x16 oacc[2];
    __syncthreads();
    { const bf16_t* ksrc = KC + ((size_t)b * 128 * 2 + g) * 64; const bf16_t* vsrc = VC + ((size_t)b * 128 * 2 + g) * 64;
      stage_k(Kt, ksrc, 128, tid); stage_k(Kt + 8192, ksrc + 64 * 128, 128, tid);
      stage_v<2>(Vt, vsrc, 128, tid); stage_v<2>(Vt + 8192, vsrc + 64 * 128, 128, tid);
      if (tid < 64) MASK[tid] = 0u; }
    __syncthreads();
    {
        f32x16 s[4];
        qkt(s[0], s[1], Kt, qr, r32, hi); qkt(s[2], s[3], Kt + 8192, qr, r32, hi);
        int nmax = (tq - 31) >> 4; if (nmax > 126) nmax = 126;
        float rm = NEG;
#pragma unroll
        for (int k = 0; k < 4; ++k)
#pragma unroll
            for (int r = 0; r < 16; ++r) { const int n = 32 * k + crow(r, hi); float v = s[k][r] + 16.f * CB(r) + sl2 * (float)(512 * k);
                v = (n <= nmax) ? v : NEG; s[k][r] = v; rm = fmaxf(rm, v); }
        rm = fmaxf(rm, __shfl_xor(rm, 32));
        float sum = 0.f;
#pragma unroll
        for (int k = 0; k < 4; ++k)
#pragma unroll
            for (int r = 0; r < 16; ++r) { const float e = ex2(s[k][r] - rm); s[k][r] = e; sum += e; }
        sum += __shfl_xor(sum, 32);
        const float inv = (nmax >= 0) ? 1.f / sum : 0.f;
#pragma unroll
        for (int k = 0; k < 4; ++k)
#pragma unroll
            for (int r = 0; r < 16; ++r) s[k][r] *= inv;
        float prev = 0.f;
#pragma unroll
        for (int k = 0; k < 4; ++k)
#pragma unroll
            for (int a = 0; a < 4; ++a) { const int i = 4 * k + a; const float Bi = 0.5f * s[k][4 * a + 3]; const float Ai = (s[k][4 * a] + s[k][4 * a + 1]) + (s[k][4 * a + 2] + Bi);
                const float rc = __shfl_xor(Bi, 32); const float add = hi ? rc : prev; prev = rc;
                IMPH[(hl * 64 + ql) * 32 + 2 * i + hi] = Ai + add; }
        f32x16 o[2]; o[0] = (f32x16){0.f}; o[1] = (f32x16){0.f};
        pv<2>(o, s[0], s[1], Vt, lane, hi); pv<2>(o, s[2], s[3], Vt + 8192, lane, hi);
        if (hi == 0) wsf[r32] = g0;
#pragma unroll
        for (int r = 0; r < 16; ++r) { const float f = wsf[crow(r, hi)]; oacc[0][r] = o[0][r] * f; oacc[1][r] = o[1][r] * f; }
        asm volatile("" : "+v"(oacc[0]), "+v"(oacc[1]));
    }
    __syncthreads();
    { const int q = tid >> 3, mg = tid & 7;
#pragma unroll
      for (int i = 0; i < 4; ++i) { const int mb = 4 * mg + i; float v = ((IMPH[(0 * 64 + q) * 32 + mb] + IMPH[(1 * 64 + q) * 32 + mb]) + IMPH[(2 * 64 + q) * 32 + mb]) + IMPH[(3 * 64 + q) * 32 + mb];
          if (mb == 0 || mb == c || mb == c - 1) v = 1e9f; if (mb > c) v = -1.f; VAL[q * 32 + mb] = v; } }
    __syncthreads();
    { const int q = tid >> 3, mg = tid & 7; unsigned bits = 0u;
      float mine[4];
#pragma unroll
      for (int i = 0; i < 4; ++i) mine[i] = VAL[q * 32 + 4 * mg + i];
      int cnt0 = 0, cnt1 = 0, cnt2 = 0, cnt3 = 0;
#pragma unroll 4
      for (int m2 = 0; m2 < 32; ++m2) { const float v2 = VAL[q * 32 + m2]; const int rel = m2 - 4 * mg;
          cnt0 += (int)(v2 > mine[0]) | ((int)(v2 == mine[0]) & (int)(rel < 0));
          cnt1 += (int)(v2 > mine[1]) | ((int)(v2 == mine[1]) & (int)(rel < 1));
          cnt2 += (int)(v2 > mine[2]) | ((int)(v2 == mine[2]) & (int)(rel < 2));
          cnt3 += (int)(v2 > mine[3]) | ((int)(v2 == mine[3]) & (int)(rel < 3)); }
      bits = ((cnt0 < 8) ? 1u : 0u) | ((cnt1 < 8) ? 2u : 0u) | ((cnt2 < 8) ? 4u : 0u) | ((cnt3 < 8) ? 8u : 0u);
      bits <<= 4 * mg;
      if (bits) __hip_atomic_fetch_or(&MASK[q], bits, __ATOMIC_RELAXED, __HIP_MEMORY_SCOPE_WORKGROUP); }
    __syncthreads();
    const unsigned vmask = (c >= 31) ? 0xffffffffu : ((2u << c) - 1u);
    if (wid == 0) { unsigned mk = MASK[lane] & vmask;
#pragma unroll
        for (int o_ = 1; o_ < 64; o_ <<= 1) mk |= __shfl_xor(mk, o_);
        if (lane == 0) MASK[64] = mk; }
    __syncthreads();
    const unsigned mymask = MASK[ql] & vmask;
    unsigned uni = __builtin_amdgcn_readfirstlane(MASK[64]);
    {
        f32x16 o[2]; o[0] = (f32x16){0.f}; o[1] = (f32x16){0.f}; float m = NEG, lsum = 0.f;
        while (uni) {
            const int j = 31 - __builtin_clz(uni); uni &= ~(1u << j);
            __syncthreads();
            stage_k(Kt, KV6 + (tokb + 64 * j) * 768 + 256 + g * 64, 768, tid); stage_v<2>(Vt, KV6 + (tokb + 64 * j) * 768 + 384 + g * 64, 768, tid);
            __syncthreads();
            const bool sel = (mymask >> j) & 1u;
            if (__any(sel)) {
                f32x16 s0, s1; qkt(s0, s1, Kt, qr, r32, hi);
                const float tc = sl2 * (float)(64 * (j - c)); const int lim = (j == c) ? ql : 64;
#pragma unroll
                for (int r = 0; r < 16; ++r) { s0[r] += CB(r) + tc; s1[r] += CB(r) + (tc + 32.f * sl2);
                    if (!sel || crow(r, hi) > lim) s0[r] = NEG; if (!sel || crow(r, hi) + 32 > lim) s1[r] = NEG; }
                softmax_pv<2>(s0, s1, m, lsum, o, wsf, Vt, lane, r32, hi);
            }
        }
        const float ltot = lsum + __shfl_xor(lsum, 32);
        if (hi == 0) wsf[r32] = g1 / ltot;
#pragma unroll
        for (int r = 0; r < 16; ++r) { const float f = wsf[crow(r, hi)]; oacc[0][r] += o[0][r] * f; oacc[1][r] += o[1][r] * f; }
        asm volatile("" : "+v"(oacc[0]), "+v"(oacc[1]));
    }
    {
        f32x16 o[2]; o[0] = (f32x16){0.f}; o[1] = (f32x16){0.f}; float m = NEG, lsum = 0.f;
        const int jlo = c - 8 < 0 ? 0 : c - 8;
        for (int j = c; j >= jlo; --j) {
            __syncthreads();
            stage_k(Kt, KV6 + (tokb + 64 * j) * 768 + 512 + g * 64, 768, tid); stage_v<2>(Vt, KV6 + (tokb + 64 * j) * 768 + 640 + g * 64, 768, tid);
            __syncthreads();
            f32x16 s0, s1; qkt(s0, s1, Kt, qr, r32, hi);
            const float tc = sl2 * (float)(64 * (j - c));
            const int lim = (j == c) ? ql : 64;
            const int low = (j == c - 8) ? ql : -1;
#pragma unroll
            for (int r = 0; r < 16; ++r) { s0[r] += CB(r) + tc; s1[r] += CB(r) + (tc + 32.f * sl2);
                const int k0 = crow(r, hi), k1 = k0 + 32;
                if (k0 > lim || k0 <= low) s0[r] = NEG; if (k1 > lim || k1 <= low) s1[r] = NEG; }
            softmax_pv<2>(s0, s1, m, lsum, o, wsf, Vt, lane, r32, hi);
        }
        const float ltot = lsum + __shfl_xor(lsum, 32);
        if (hi == 0) wsf[r32] = g2 / ltot;
#pragma unroll
        for (int r = 0; r < 16; ++r) { const float f = wsf[crow(r, hi)]; oacc[0][r] += o[0][r] * f; oacc[1][r] += o[1][r] * f; }
        asm volatile("" : "+v"(oacc[0]), "+v"(oacc[1]));
    }
#pragma unroll
    for (int r = 0; r < 16; ++r) { bf16_t* dst = (dry ? (bf16_t*)(ws + WS_XN) : NQ) + (tokb + t0 + crow(r, hi)) * 512 + h * 64 + r32; dst[0] = f2bf(oacc[0][r]); dst[32] = f2bf(oacc[1][r]); }
    __syncthreads();
}

__device__ __forceinline__ int next_unit(unsigned* ctr, LAS unsigned char* lds) {
    LAS int* bc = (LAS int*)(lds + LDS_MISC);
    __syncthreads();
    if (threadIdx.x == 0) bc[0] = (int)__hip_atomic_fetch_add(ctr, 1u, __ATOMIC_RELAXED, __HIP_MEMORY_SCOPE_AGENT);
    __syncthreads();
    return __builtin_amdgcn_readfirstlane(bc[0]);
}

__device__ __forceinline__ void phase_merge(PRef p, int l, LAS unsigned char* lds) {
    SG_IDS
    unsigned char* ws = p.ws;
    const bf16_t* YA = (const bf16_t*)(ws + WS_NQ); const bf16_t* YB = (const bf16_t*)(ws + WS_DQ);
    const bf16_t* WA = (const bf16_t*)(ws + WS_WA) + (size_t)l * DM * 512; const bf16_t* WB = (const bf16_t*)(ws + WS_WB) + (size_t)l * DM * 512;
    const bf16_t* GA = (const bf16_t*)(ws + WS_GA); const bf16_t* GB = (const bf16_t*)(ws + WS_GB); bf16_t* MG = (bf16_t*)(ws + WS_XN);
    for (int u = blockIdx.x; u < 256 * 8; u += gridDim.x) {
        const int pm = (u >> 7) * 16 + (u & 15), pn = (u >> 4) & 7, m0 = pm * 128, n0 = pn * 128;
        f32x4 acc[2][4], t[2][4]; SG_ZERO(acc);
        sg_kloop(acc, ARowLin{(const char*)(YA + (size_t)m0 * 512), 1024}, 128, WA + (size_t)n0 * 512, 512, 8, lds);
#pragma unroll
        for (int m = 0; m < 2; ++m)
#pragma unroll
            for (int n = 0; n < 4; ++n) { const u32x2 gw = *(const u32x2*)(GA + (size_t)(m0 + SG_ROW(m)) * DM + n0 + SG_COL(n));
                t[m][n] = acc[m][n] * (f32x4){bflo(gw.x), bfhi(gw.x), bflo(gw.y), bfhi(gw.y)}; }
        SG_ZERO(acc);
        sg_kloop(acc, ARowLin{(const char*)(YB + (size_t)m0 * 512), 1024}, 128, WB + (size_t)n0 * 512, 512, 8, lds);
#pragma unroll
        for (int m = 0; m < 2; ++m)
#pragma unroll
            for (int n = 0; n < 4; ++n) { const size_t off = (size_t)(m0 + SG_ROW(m)) * DM + n0 + SG_COL(n); const u32x2 gw = *(const u32x2*)(GB + off);
                st4bf(MG + off, t[m][n] + acc[m][n] * (f32x4){bflo(gw.x), bfhi(gw.x), bflo(gw.y), bfhi(gw.y)}); }
    }
}
__device__ __forceinline__ void phase_outproj(PRef p, int l, LAS unsigned char* lds) {
    SG_IDS
    unsigned char* ws = p.ws;
    const bf16_t* MG = (const bf16_t*)(ws + WS_XN); const bf16_t* WO = (const bf16_t*)(ws + WS_WO) + (size_t)l * DM * DM;
    const float* hin = (l == 0) ? p.x : p.out; float* hout = p.out;
    for (int u = blockIdx.x; u < 256 * 8; u += gridDim.x) {
        const int pm = (u >> 7) * 16 + (u & 15), pn = (u >> 4) & 7, m0 = pm * 128, n0 = pn * 128;
        f32x4 acc[2][4]; SG_ZERO(acc);
        sg_kloop(acc, ARowLin{(const char*)(MG + (size_t)m0 * DM), 2048}, 128, WO + (size_t)n0 * DM, DM, 16, lds);
#pragma unroll
        for (int m = 0; m < 2; ++m)
#pragma unroll
            for (int n = 0; n < 4; ++n) { const size_t off = (size_t)(m0 + SG_ROW(m)) * DM + n0 + SG_COL(n); *(f32x4*)(hout + off) = *(const f32x4*)(hin + off) + acc[m][n]; }
    }
}

constexpr size_t WS_RSTD = WS_MISC + 2 * MiB;
__device__ __forceinline__ void phase_router(PRef p, int l, LAS unsigned char* lds, bool dry = false) {
    int tid_ = threadIdx.x; asm volatile("" : "+v"(tid_));
    const int tid = tid_, lane = tid & 63, wid = tid >> 6;
    unsigned char* ws = p.ws;
    constexpr int WP = 1028;
    LAS float* WT = (LAS float*)lds;
    LAS unsigned* cntl = (LAS unsigned*)(lds + 82432);
    LAS unsigned* lbase = (LAS unsigned*)(lds + 82432 + 64);
    LAS unsigned* loc = (LAS unsigned*)(lds + 82560);
    LAS float* wloc = (LAS float*)(lds + 82560 + 16384);
    LAS float* GL = (LAS float*)(lds + 115328);
    const float* gwp = p.router_grp_w + (size_t)l * DM * 4; const float* ewp = p.router_exp_w + (size_t)l * DM * 16;
    const float* g2 = p.norm2_g + (size_t)l * DM;
    __syncthreads();
    for (int k = tid; k < DM; k += 512) {
        const float gk = g2[k]; GL[k] = gk;
        const f32x4 a = *(const f32x4*)(gwp + k * 4);
#pragma unroll
        for (int i = 0; i < 4; ++i) WT[i * WP + k] = a[i] * gk;
#pragma unroll
        for (int q4 = 0; q4 < 4; ++q4) { const f32x4 e = *(const f32x4*)(ewp + k * 16 + q4 * 4);
#pragma unroll
            for (int i = 0; i < 4; ++i) WT[(4 + q4 * 4 + i) * WP + k] = e[i] * gk; }
    }
    const float* gb = p.router_grp_b + l * 4; const float* eb = p.router_exp_b + l * 16;
    unsigned* ecnt = (unsigned*)(ws + WS_CTL) + CW_ECNT + 64 * l + (dry ? 32 : 0);
    unsigned* LIST = (unsigned*)(ws + (dry ? WS_NQ : WS_LIST)); float* WL = (float*)(ws + (dry ? WS_NQ + 4 * MiB : WS_WL));
    bf16_t* XN = (bf16_t*)(ws + WS_XN); float* RSTD = (float*)(ws + WS_RSTD);
    const int n = lane & 15, kq = lane >> 4;
    for (int ch = blockIdx.x; ch < NTOK / 128; ch += gridDim.x) {
        __syncthreads();
        if (tid < 16) cntl[tid] = 0u;
        __syncthreads();
        const int tok = ch * 128 + wid * 16 + n;
        const float* xr = p.out + (size_t)tok * DM + kq * 256;
        bf16_t* xo = XN + (size_t)tok * DM + kq * 256;
        LAS const float* w0 = WT + n * WP + kq * 256;
        LAS const float* w1 = WT + (16 + (n & 3)) * WP + kq * 256;
        f32x4 acc0 = {0.f, 0.f, 0.f, 0.f}, acc1 = {0.f, 0.f, 0.f, 0.f}; float ss = 0.f;
        f32x4 xa[8], xb[8];
#pragma unroll
        for (int u = 0; u < 8; ++u) xa[u] = *(const f32x4*)(xr + 4 * u);
#define ROUTER_BATCH(XC, XN_, jb) do { \
        if ((jb) + 8 < 64) { _Pragma("unroll") for (int u = 0; u < 8; ++u) XN_[u] = *(const f32x4*)(xr + 4 * ((jb) + 8 + u)); } \
        _Pragma("unroll") for (int u = 0; u < 8; ++u) { const int jj = (jb) + u; const f32x4 xv = XC[u], gv = *(LAS const f32x4*)(GL + kq * 256 + 4 * jj); \
            const f32x4 a0 = *(LAS const f32x4*)(w0 + 4 * jj), a1 = *(LAS const f32x4*)(w1 + 4 * jj); \
            ss += (xv[0] * xv[0] + xv[1] * xv[1]) + (xv[2] * xv[2] + xv[3] * xv[3]); \
            st4bf(xo + 4 * jj, xv * gv); \
            _Pragma("unroll") for (int i = 0; i < 4; ++i) { acc0 = __builtin_amdgcn_mfma_f32_16x16x4f32(a0[i], xv[i], acc0, 0, 0, 0); acc1 = __builtin_amdgcn_mfma_f32_16x16x4f32(a1[i], xv[i], acc1, 0, 0, 0); } } } while (0)
        for (int jb = 0; jb < 64; jb += 16) { ROUTER_BATCH(xa, xb, jb); ROUTER_BATCH(xb, xa, jb + 8); }
#undef ROUTER_BATCH
        ss += __shfl_xor(ss, 16); ss += __shfl_xor(ss, 32);
        const float rstd = rsqrtf(ss * (1.f / 1024.f) + 1e-6f);
        if (kq == 0) RSTD[tok] = rstd;
        int gi = 0; float gwt = 0.f;
        { float gl[4];
#pragma unroll
          for (int r = 0; r < 4; ++r) gl[r] = acc0[r] * rstd + gb[r];
          float gm = gl[0];
#pragma unroll
          for (int r = 1; r < 4; ++r) if (gl[r] > gm) { gm = gl[r]; gi = r; }
          float gs = 0.f;
#pragma unroll
          for (int r = 0; r < 4; ++r) gs += __expf(gl[r] - gm);
          gwt = 1.f / gs; }
        gi = __shfl(gi, n); gwt = __shfl(gwt, n);
        const int mygrp = (kq == 0) ? 3 : kq - 1;
        if (mygrp == gi) {
            float el[4];
#pragma unroll
            for (int r = 0; r < 4; ++r) el[r] = ((kq == 0) ? acc1[r] : acc0[r]) * rstd + eb[mygrp * 4 + r];
            int i1 = 0; float v1 = el[0];
#pragma unroll
            for (int e = 1; e < 4; ++e) if (el[e] > v1) { v1 = el[e]; i1 = e; }
            int i2 = -1; float v2 = -3.0e38f;
#pragma unroll
            for (int e = 0; e < 4; ++e) if (e != i1 && el[e] > v2) { v2 = el[e]; i2 = e; }
            const float ex = __expf(v2 - v1), w1_ = gwt / (1.f + ex), w2_ = gwt * ex / (1.f + ex);
            const int e1 = gi * 4 + i1, e2 = gi * 4 + i2;
            const unsigned s1 = __hip_atomic_fetch_add(&cntl[e1], 1u, __ATOMIC_RELAXED, __HIP_MEMORY_SCOPE_WORKGROUP); loc[e1 * 256 + s1] = (unsigned)tok * 2u; wloc[e1 * 256 + s1] = w1_;
            const unsigned s2 = __hip_atomic_fetch_add(&cntl[e2], 1u, __ATOMIC_RELAXED, __HIP_MEMORY_SCOPE_WORKGROUP); loc[e2 * 256 + s2] = (unsigned)tok * 2u + 1u; wloc[e2 * 256 + s2] = w2_;
        }
        __syncthreads();
        if (tid < 16) lbase[tid] = __hip_atomic_fetch_add(&ecnt[tid], cntl[tid], __ATOMIC_RELAXED, __HIP_MEMORY_SCOPE_AGENT);
        __syncthreads();
        for (int e = 0; e < 16; ++e) { const unsigned nn = cntl[e], bs = lbase[e];
            for (unsigned i = tid; i < nn; i += 512) { LIST[(size_t)e * NTOK + bs + i] = loc[e * 256 + i]; WL[(size_t)e * NTOK + bs + i] = wloc[e * 256 + i]; } }
    }
}

struct MoeUnit { int e, tile, n, hoff; };
__device__ __forceinline__ bool moe_find(LAS const int* cnts, int ut, MoeUnit& mu) {
    int pre = 0;
    for (int e = 0; e < 16; ++e) { const int cn = cnts[e], nt = (cn + 127) >> 7; if (ut < pre + nt) { mu.e = e; mu.tile = ut - pre; mu.n = cn - mu.tile * 128; if (mu.n > 128) mu.n = 128; mu.hoff = (pre + mu.tile) * 128; return true; } pre += nt; }
    return false;
}
__device__ __forceinline__ void phase_moe1(PRef p, int l, LAS unsigned char* lds) {
    SG_IDS
    unsigned char* ws = p.ws;
    LAS int* cnts = (LAS int*)(lds + LDS_MISC + 64);
    const unsigned* ecnt = (const unsigned*)(ws + WS_CTL) + CW_ECNT + 64 * l;
    __syncthreads();
    if (tid < 16) cnts[tid] = (int)__hip_atomic_load(&ecnt[tid], __ATOMIC_RELAXED, __HIP_MEMORY_SCOPE_AGENT);
    __syncthreads();
    const unsigned* LIST = (const unsigned*)(ws + WS_LIST); const float* WL = (const float*)(ws + WS_WL);
    const char* XN = (const char*)(ws + WS_XN); bf16_t* H = (bf16_t*)(ws + WS_H);
    for (int ut = blockIdx.x;; ut += gridDim.x) {
        MoeUnit mu; if (!moe_find(cnts, ut, mu)) break;
        const unsigned* lst = LIST + (size_t)mu.e * NTOK + mu.tile * 128;
        const bf16_t* W = (const bf16_t*)(ws + WS_WGU) + (size_t)(l * 16 + mu.e) * 256 * DM;
        f32x4 ag[2][4], au[2][4]; SG_ZERO(ag); SG_ZERO(au);
        sg_kloop(ag, ARowGather{lst, mu.n, XN}, 128, W, DM, 16, lds);
        sg_kloop(au, ARowGather{lst, mu.n, XN}, 128, W + (size_t)128 * DM, DM, 16, lds);
        const float* wl = WL + (size_t)mu.e * NTOK + mu.tile * 128;
#pragma unroll
        for (int m = 0; m < 2; ++m) { const int rl = SG_ROW(m); const float wgt = (rl < mu.n) ? wl[rl] : 0.f;
            const float rs = ((const float*)(ws + WS_RSTD))[lst[rl < mu.n ? rl : mu.n - 1] >> 1];
#pragma unroll
            for (int n = 0; n < 4; ++n) { f32x4 gv = ag[m][n] * rs, uv = au[m][n] * rs, hv;
#pragma unroll
                for (int i = 0; i < 4; ++i) hv[i] = gv[i] * sigm(gv[i]) * uv[i] * wgt;
                st4bf(H + (size_t)(mu.hoff + rl) * 128 + SG_COL(n), hv); } }
    }
}
__device__ __forceinline__ void phase_moe2(PRef p, int l, LAS unsigned char* lds) {
    SG_IDS
    unsigned char* ws = p.ws;
    LAS int* cnts = (LAS int*)(lds + LDS_MISC + 64);
    const unsigned* ecnt = (const unsigned*)(ws + WS_CTL) + CW_ECNT + 64 * l;
    __syncthreads();
    if (tid < 16) cnts[tid] = (int)__hip_atomic_load(&ecnt[tid], __ATOMIC_RELAXED, __HIP_MEMORY_SCOPE_AGENT);
    __syncthreads();
    const unsigned* LIST = (const unsigned*)(ws + WS_LIST); const bf16_t* H = (const bf16_t*)(ws + WS_H);
    bf16_t* Y0 = (bf16_t*)(ws + WS_GA); bf16_t* Y1 = (bf16_t*)(ws + WS_GB);
    for (int u = blockIdx.x;; u += gridDim.x) {
        MoeUnit mu; if (!moe_find(cnts, u >> 3, mu)) break;
        const int pn = u & 7;
        const unsigned* lst = LIST + (size_t)mu.e * NTOK + mu.tile * 128;
        const bf16_t* W = (const bf16_t*)(ws + WS_WD) + (size_t)(l * 16 + mu.e) * DM * 128 + (size_t)pn * 128 * 128;
        f32x4 acc[2][4]; SG_ZERO(acc);
        sg_kloop(acc, ARowLin{(const char*)(H + (size_t)mu.hoff * 128), 256}, 128, W, 128, 2, lds);
#pragma unroll
        for (int m = 0; m < 2; ++m) { const int rl = SG_ROW(m);
            if (rl < mu.n) { const unsigned ent = lst[rl]; bf16_t* dst = ((ent & 1u) ? Y1 : Y0) + (size_t)(ent >> 1) * DM + pn * 128;
#pragma unroll
                for (int n = 0; n < 4; ++n) st4bf(dst + SG_COL(n), acc[m][n]); } }
    }
}

__device__ __forceinline__ void phase_combine(PRef p, int l, bool dry = false) {
    int tid_ = threadIdx.x; asm volatile("" : "+v"(tid_));
    const int tid = tid_, lane = tid & 63, wid = tid >> 6;
    unsigned char* ws = p.ws;
    const int gw = blockIdx.x * 8 + wid, NGW = gridDim.x * 8;
    const bf16_t* Y0 = (const bf16_t*)(ws + WS_GA); const bf16_t* Y1 = (const bf16_t*)(ws + WS_GB); bf16_t* XN = (bf16_t*)(ws + WS_XN);
    const bool last = (l == DEPTH - 1);
    const float* g = last ? p.final_norm_g : p.norm1_g + (size_t)(l + 1) * DM;
    for (int m0 = gw * 4; m0 < NTOK; m0 += NGW * 4) {
        f32x4 v[4][4]; u32x2 ya[4][4], yb[4][4];
#pragma unroll
        for (int rr = 0; rr < 4; ++rr)
#pragma unroll
            for (int j = 0; j < 4; ++j) { const size_t off = (size_t)(m0 + rr) * DM + (64 * j + lane) * 4; v[rr][j] = *(const f32x4*)(p.out + off); ya[rr][j] = *(const u32x2*)(Y0 + off); yb[rr][j] = *(const u32x2*)(Y1 + off); }
#pragma unroll
        for (int rr = 0; rr < 4; ++rr) {
            float s = 0.f;
#pragma unroll
            for (int j = 0; j < 4; ++j) { const u32x2 a = ya[rr][j], b2 = yb[rr][j];
                v[rr][j] = v[rr][j] + (f32x4){bflo(a.x), bfhi(a.x), bflo(a.y), bfhi(a.y)} + (f32x4){bflo(b2.x), bfhi(b2.x), bflo(b2.y), bfhi(b2.y)};
                s += (v[rr][j][0] * v[rr][j][0] + v[rr][j][1] * v[rr][j][1]) + (v[rr][j][2] * v[rr][j][2] + v[rr][j][3] * v[rr][j][3]); }
            const float rstd = rsqrtf(wave_sum(s) * (1.f / 1024.f) + 1e-6f);
            float* hrow = (dry ? (float*)(ws + WS_NQ) : p.out) + (size_t)(m0 + rr) * DM;
#pragma unroll
            for (int j = 0; j < 4; ++j) { const int cidx = (64 * j + lane) * 4; const f32x4 gg = *(const f32x4*)(g + cidx);
                if (last) *(f32x4*)(hrow + cidx) = v[rr][j] * rstd * gg;
                else { *(f32x4*)(hrow + cidx) = v[rr][j]; st4bf(XN + (size_t)(m0 + rr) * DM + cidx, v[rr][j] * rstd * gg); } }
        }
    }
}

#define XB_TMO      128
#define XB_XCNT(j)  (256  + 64 * (j))
#define XB_XSUB(j)  (1280 + 64 * (j))
#define XB_XGEN(j)  (2304 + 64 * (j))
#define XB_TOP      3328
#define XB_TOPGEN   3392
#define XCD_BAR_WORDS 3456
#define XB_SPIN_CAP (1u << 18)
__device__ __forceinline__ unsigned xb_ld(unsigned* p)              { return __hip_atomic_load(p, __ATOMIC_RELAXED, __HIP_MEMORY_SCOPE_AGENT); }
__device__ __forceinline__ unsigned xb_add(unsigned* p, unsigned v) { return __hip_atomic_fetch_add(p, v, __ATOMIC_RELAXED, __HIP_MEMORY_SCOPE_AGENT); }
__device__ __forceinline__ unsigned xb_xcc_id() { return (unsigned)__builtin_amdgcn_s_getreg((3 << 11) | 20) & 0xFu; }
#define XB_SPIN(cond, bar) do { unsigned _sp = 0; while (cond) { __builtin_amdgcn_s_sleep(1); \
    if ((++_sp & 255u) == 0u) { if (xb_ld(&(bar)[XB_TMO])) break; if (_sp > XB_SPIN_CAP) { atomicAdd(&(bar)[XB_TMO], 1u); break; } } } } while (0)
struct XcdBarrier { unsigned* bar; unsigned x; volatile LAS unsigned* st; };
__device__ __forceinline__ XcdBarrier xcd_barrier_post(unsigned* bar, volatile LAS unsigned* st) {
    XcdBarrier b; b.bar = bar; b.x = xb_xcc_id(); b.st = st;
    if (threadIdx.x == 0) (void)xb_add(&bar[XB_XCNT(b.x)], 1u);
    return b;
}
__device__ __forceinline__ void xcd_barrier_complete(unsigned* bar, unsigned x, unsigned& nloc, unsigned& nx) {
    const unsigned G = gridDim.x * gridDim.y * gridDim.z;
    unsigned sum, cnt, mine, sp = 0u;
    for (;;) {
        sum = 0u; cnt = 0u; mine = 0u;
#pragma unroll
        for (unsigned j = 0; j < 16; ++j) { const unsigned c = xb_ld(&bar[XB_XCNT(j)]); sum += c; cnt += (c > 0u) ? 1u : 0u; mine = (j == x) ? c : mine; }
        if (sum == G) break;
        __builtin_amdgcn_s_sleep(1);
        if ((++sp & 255u) == 0u) { if (xb_ld(&bar[XB_TMO])) break; if (sp > XB_SPIN_CAP) { atomicAdd(&bar[XB_TMO], 1u); break; } }
    }
    nloc = mine > 0u ? mine : 1u; nx = cnt > 0u ? cnt : 1u;
}
__device__ __forceinline__ void xcd_barrier(const XcdBarrier& b) {
    asm volatile("s_waitcnt vmcnt(0)" ::: "memory");
    __syncthreads();
    if (threadIdx.x == 0) {
        unsigned* bar = b.bar;
        __builtin_amdgcn_s_waitcnt(0);
        unsigned nloc = b.st[0], nx = b.st[1];
        if (nloc == 0u) { xcd_barrier_complete(bar, b.x, nloc, nx); b.st[0] = nloc; b.st[1] = nx; }
        const unsigned old = xb_add(&bar[XB_XSUB(b.x)], 1u);
        const unsigned gen = old / nloc;
        if (old + 1u == (gen + 1u) * nloc) {
            __builtin_amdgcn_fence(__ATOMIC_RELEASE, "agent");
            asm volatile("s_waitcnt vmcnt(0)" ::: "memory");
            const unsigned og = xb_add(&bar[XB_TOP], 1u);
            const unsigned tg = og / nx;
            if (og + 1u == (tg + 1u) * nx) xb_add(&bar[XB_TOPGEN], 1u);
            else XB_SPIN(xb_ld(&bar[XB_TOPGEN]) == tg, bar);
            __builtin_amdgcn_fence(__ATOMIC_ACQUIRE, "agent");
            xb_add(&bar[XB_XGEN(b.x)], 1u);
            asm volatile("s_waitcnt vmcnt(0)" ::: "memory");
        } else {
            XB_SPIN(xb_ld(&bar[XB_XGEN(b.x)]) == gen, bar);
            __builtin_amdgcn_fence(__ATOMIC_ACQUIRE, "agent");
            asm volatile("s_waitcnt vmcnt(0)" ::: "memory");
        }
    }
    __syncthreads();
}

template <int K> __device__ __forceinline__ void run_phase(PRef p, int l, LAS unsigned char* lds, bool dry = false) {
    unsigned* ctl = (unsigned*)(p.ws + WS_CTL);
    if (K == 0) phase_prologue(p, lds);
    if (K == 1) phase_inproj_pg8(p, l, lds);
    if (K == 2) { unsigned* ctr = ctl + CW_QCTR + 64 * (l * 2 + 0) + (dry ? 16 : 0);
        for (;;) { const int u = next_unit(ctr, lds); if (u >= 64 + 1024) break; if (u < 64) compress_unit(p, l, u, lds); else diff_unit(p, l, u - 64, lds, dry); } }
    if (K == 3) { unsigned* ctr = ctl + CW_QCTR + 64 * (l * 2 + 1) + (dry ? 16 : 0);
        for (;;) { const int u = next_unit(ctr, lds); if (u >= 1024) break; nsa_unit(p, l, u, lds, dry); } }
    if (K == 4) phase_merge_pg8(p, l, lds);
    if (K == 5) phase_outproj_pg8(p, l, lds, dry);
    if (K == 6) phase_router(p, l, lds, dry);
    if (K == 7) phase_moe1(p, l, lds);
    if (K == 8) phase_moe2(p, l, lds);
    if (K == 9) phase_combine(p, l, dry);
}
#if MK_MULTI
template <int K> __global__ void __launch_bounds__(512, 2) mk_one(Params p) {
    extern __shared__ __attribute__((aligned(16))) unsigned char lds_raw[];
    const __attribute__((address_space(4))) Params* pp_ = (const __attribute__((address_space(4))) Params*)__builtin_amdgcn_kernarg_segment_ptr();
    run_phase<K>(*pp_, p.ph_lo, (LAS unsigned char*)lds_raw);
}
template <int K> static void launch_one(int grid, hipStream_t stream, Params p, int l) {
    static bool attr = false;
    if (!attr) { (void)hipFuncSetAttribute((const void*)mk_one<K>, hipFuncAttributeMaxDynamicSharedMemorySize, LDS_BYTES); attr = true; }
    p.ph_lo = l; p.ph_hi = l + 1;
    hipLaunchKernelGGL(mk_one<K>, dim3(grid), dim3(512), LDS_BYTES, stream, p);
}
#else
__global__ void __launch_bounds__(512, 2) mk_fwd(Params p) {
    extern __shared__ __attribute__((aligned(16))) unsigned char lds_raw[];
    LAS unsigned char* lds = (LAS unsigned char*)lds_raw;
    cg::grid_group grid = cg::this_grid();
    volatile LAS unsigned* bst = (volatile LAS unsigned*)(lds + LDS_MISC + 256);
    if (threadIdx.x < 2) bst[threadIdx.x] = 0u;
    __syncthreads();
    const XcdBarrier bar = xcd_barrier_post((unsigned*)(p.ws + WS_CTL) + CW_BAR, bst);
#define SEAM() xcd_barrier(bar)
#ifndef PROBE_DUP
#define PROBE_DUP -1
#endif
#ifndef PROBE_DUP2
#define PROBE_DUP2 -1
#endif
#define RUN(K, l) do { const __attribute__((address_space(4))) Params* pp_ = (const __attribute__((address_space(4))) Params*)__builtin_amdgcn_kernarg_segment_ptr(); asm volatile("" : "+s"(pp_)); \
    if (K == PROBE_DUP || K == PROBE_DUP2) { run_phase<K>(*pp_, l, lds, true); SEAM(); } run_phase<K>(*pp_, l, lds); } while (0)
    RUN(0, 0); grid.sync();
    for (int l = 0; l < DEPTH; ++l) {
        RUN(1, l); SEAM();
        RUN(2, l); SEAM();
        RUN(3, l); SEAM();
        RUN(4, l); SEAM();
        RUN(5, l); SEAM();
        RUN(6, l); SEAM();
        RUN(7, l); SEAM();
        RUN(8, l); SEAM();
        RUN(9, l); if (l + 1 < DEPTH) SEAM();
    }
}
#endif

extern "C" void kernel_launch(void* const* d_in, const int* in_sizes, int n_in, void* d_out, int out_size, void* d_ws, size_t ws_size, hipStream_t stream) {
    static int grid = 0;
    if (grid == 0) {
        if (n_in != 22 || in_sizes[0] != NTOK * DM || out_size != NTOK * DM || ws_size < WS_END) { fprintf(stderr, "kernel_launch: unexpected shapes (n_in %d, in0 %d, out %d, ws %zu)\n", n_in, n_in > 0 ? in_sizes[0] : -1, out_size, ws_size); grid = -1; return; }
        int dev = 0, cus = 0, per_cu = 1;
        (void)hipGetDevice(&dev); (void)hipDeviceGetAttribute(&cus, hipDeviceAttributeMultiprocessorCount, dev);
#if !MK_MULTI
        (void)hipFuncSetAttribute((const void*)mk_fwd, hipFuncAttributeMaxDynamicSharedMemorySize, LDS_BYTES);
        (void)hipOccupancyMaxActiveBlocksPerMultiprocessor(&per_cu, (const void*)mk_fwd, 512, LDS_BYTES);
        if (per_cu < 1) { fprintf(stderr, "kernel_launch: occupancy query says %d blocks per CU\n", per_cu); per_cu = 1; }
#endif
        (void)hipGetLastError();
        grid = cus * per_cu;
    }
    if (grid < 0) return;
    (void)hipMemsetAsync((char*)d_ws + WS_CTL, 0, CTL_BYTES, stream);
    Params p{};
    const float** pp = (const float**)&p;
    for (int i = 0; i < 22; ++i) pp[i] = (const float*)d_in[i];
    p.out = (float*)d_out; p.ws = (unsigned char*)d_ws;
#if MK_MULTI
    launch_one<0>(grid, stream, p, 0);
    for (int l = 0; l < DEPTH; ++l) {
        launch_one<1>(grid, stream, p, l); launch_one<2>(grid, stream, p, l); launch_one<3>(grid, stream, p, l); launch_one<4>(grid, stream, p, l); launch_one<5>(grid, stream, p, l);
        launch_one<6>(grid, stream, p, l); launch_one<7>(grid, stream, p, l); launch_one<8>(grid, stream, p, l); launch_one<9>(grid, stream, p, l);
    }
#else
    p.ph_lo = 0; p.ph_hi = NPHASE;
    void* args[] = {&p};
    hipError_t e = hipLaunchCooperativeKernel((const void*)mk_fwd, dim3(grid), dim3(512), args, LDS_BYTES, stream);
    if (e != hipSuccess) fprintf(stderr, "cooperative launch failed: %s (grid %d)\n", hipGetErrorString(e), grid);
#endif
}
```

```cpp
#include <hip/hip_runtime.h>
#include <hip/hip_cooperative_groups.h>
#include <cstdio>
#include <cstdint>
namespace cg = cooperative_groups;

#ifndef MK_MULTI
#define MK_MULTI 0
#endif

#define LAS __attribute__((address_space(3)))
typedef unsigned short bf16_t;
typedef short bf16x8 __attribute__((ext_vector_type(8)));
typedef short s16x4 __attribute__((ext_vector_type(4)));
typedef float f32x2 __attribute__((ext_vector_type(2)));
typedef float f32x4 __attribute__((ext_vector_type(4)));
typedef float f32x16 __attribute__((ext_vector_type(16)));
typedef unsigned u32x2 __attribute__((ext_vector_type(2)));
typedef unsigned u32x4 __attribute__((ext_vector_type(4)));
typedef __bf16 bf16x2_t __attribute__((ext_vector_type(2)));

constexpr int NTOK = 32768, DM = 1024, TSEQ = 2048, NBATCH = 16, DEPTH = 2;
constexpr int INCOLS = 4888, NPAD = 5120;
constexpr float LOG2E = 1.4426950408889634f;
constexpr float QSCALE = 0.125f * LOG2E;
constexpr int NPHASE = 1 + 9 * DEPTH;

constexpr size_t MiB = 1u << 20;
constexpr size_t WS_CTL = 0, CTL_BYTES = 65536;
constexpr size_t WS_WIN = 1 * MiB;
constexpr size_t WS_WA = 21 * MiB;
constexpr size_t WS_WB = 23 * MiB;
constexpr size_t WS_WO = 25 * MiB;
constexpr size_t WS_WC1 = 29 * MiB;
constexpr size_t WS_WGU = 31 * MiB;
constexpr size_t WS_WD = 47 * MiB;
constexpr size_t WS_MISC = 55 * MiB;
constexpr size_t WS_LIST = 58 * MiB;
constexpr size_t WS_WL = 60 * MiB;
constexpr size_t WS_XN = 64 * MiB;
constexpr size_t WS_NQ = 128 * MiB;
constexpr size_t WS_KV6 = 160 * MiB;
constexpr size_t WS_NG = 208 * MiB;
constexpr size_t WS_DQ = 210 * MiB;
constexpr size_t WS_DK = 242 * MiB;
constexpr size_t WS_DV = 274 * MiB;
constexpr size_t WS_GA = 306 * MiB;
constexpr size_t WS_GB = 370 * MiB;
constexpr size_t WS_END = 434 * MiB;
constexpr size_t WS_H = WS_DK;
constexpr int CW_QCTR = 64;
constexpr int CW_ECNT = 1024;
constexpr int CW_BAR = 4096;

constexpr int LDS_BYTES = 147456;
constexpr int LDS_MISC = 131072;

struct Params {
    const float* x; const float* norm1_g; const float* w_in; const float* cmp_pe; const float* cmp_w1; const float* cmp_b1; const float* cmp_w2; const float* cmp_b2;
    const float* diff_lambda; const float* diff_subln_g; const float* w_branch_a; const float* w_branch_b; const float* w_out; const float* norm2_g;
    const float* router_grp_w; const float* router_grp_b; const float* router_exp_w; const float* router_exp_b; const float* exp_w_gate; const float* exp_w_up; const float* exp_w_down; const float* final_norm_g;
    float* out; unsigned char* ws; int ph_lo, ph_hi;
};

typedef const __attribute__((address_space(4))) Params& PRef;

__device__ __forceinline__ unsigned cvtpk(float lo, float hi) { f32x2 v = {lo, hi}; bf16x2_t b = __builtin_convertvector(v, bf16x2_t); return __builtin_bit_cast(unsigned, b); }
__device__ __forceinline__ float bflo(unsigned u) { return __uint_as_float(u << 16); }
__device__ __forceinline__ float bfhi(unsigned u) { return __uint_as_float(u & 0xffff0000u); }
__device__ __forceinline__ float bf1(bf16_t b) { return __uint_as_float(((unsigned)b) << 16); }
__device__ __forceinline__ bf16_t f2bf(float f) { return (bf16_t)(cvtpk(f, 0.f) & 0xffffu); }
__device__ __forceinline__ int crow(int r, int hi) { return (r & 3) + 8 * (r >> 2) + 4 * hi; }
__device__ __forceinline__ float wave_sum(float v) {
#pragma unroll
    for (int o = 1; o < 64; o <<= 1) v += __shfl_xor(v, o);
    return v;
}
__device__ __forceinline__ float sigm(float x) { return __builtin_amdgcn_rcpf(1.f + __builtin_amdgcn_exp2f(-1.4426950408889634f * x)); }
__device__ __forceinline__ float ex2(float x) { return __builtin_amdgcn_exp2f(x); }
__device__ __forceinline__ float alibi_slope(int i  ) { return exp2f(-8.0f * (float)i / 12.0f); }
__device__ __forceinline__ s16x4 vtr(LAS const unsigned char* p) { return __builtin_bit_cast(s16x4, __builtin_amdgcn_ds_read_tr16_b64_v4i16((LAS s16x4*)p)); }
#define MFMA32(a, b, c) __builtin_amdgcn_mfma_f32_32x32x16_bf16(a, b, c, 0, 0, 0)
#define MFMA16(a, b, c) __builtin_amdgcn_mfma_f32_16x16x32_bf16(a, b, c, 0, 0, 0)

struct ARowLin { const char* base; size_t stride; __device__ __forceinline__ const char* operator()(int r) const { return base + (size_t)r * stride; } };
struct ARowGather { const unsigned* list; int n; const char* xn; __device__ __forceinline__ const char* operator()(int r) const { const int i = r < n ? r : n - 1; return xn + (size_t)(list[i] >> 1) * 2048; } };

template <class ARow>
__device__ __forceinline__ void sg_kloop(f32x4 (&acc)[2][4], const ARow& arow, int kstepA, const bf16_t* Bt, int ldb, int nt, LAS unsigned char* lds) {
    int tid_ = threadIdx.x; asm volatile("" : "+v"(tid_));
    const int tid = tid_, lane = tid & 63, wid = tid >> 6, wr = wid >> 1, wc = wid & 1, fr = lane & 15, fq = lane >> 4;
    const int lrow = tid >> 3, lch = tid & 7;
    const char* pa0 = arow(lrow) + lch * 16; const char* pa1 = arow(lrow + 64) + lch * 16;
    const char* pb0 = (const char*)(Bt + (size_t)lrow * ldb) + lch * 16; const char* pb1 = (const char*)(Bt + (size_t)(lrow + 64) * ldb) + lch * 16;
    const int wofs0 = lrow * 128 + ((lch ^ ((lrow >> 1) & 7)) << 4), wofs1 = wofs0 + 64 * 128;
    u32x4 ra0 = *(const u32x4*)pa0, ra1 = *(const u32x4*)pa1, rb0 = *(const u32x4*)pb0, rb1 = *(const u32x4*)pb1;
    for (int t = 0; t < nt; ++t) {
        __syncthreads();
        *(LAS u32x4*)(lds + wofs0) = ra0; *(LAS u32x4*)(lds + wofs1) = ra1; *(LAS u32x4*)(lds + 16384 + wofs0) = rb0; *(LAS u32x4*)(lds + 16384 + wofs1) = rb1;
        __syncthreads();
        if (t + 1 < nt) { pa0 += kstepA; pa1 += kstepA; pb0 += 128; pb1 += 128; ra0 = *(const u32x4*)pa0; ra1 = *(const u32x4*)pa1; rb0 = *(const u32x4*)pb0; rb1 = *(const u32x4*)pb1; }
#pragma unroll
        for (int ks = 0; ks < 2; ++ks) {
            bf16x8 af[2], bfr[4];
            const int ch = ks * 4 + fq;
#pragma unroll
            for (int m = 0; m < 2; ++m) { const int row = wr * 32 + m * 16 + fr; af[m] = *(LAS const bf16x8*)(lds + row * 128 + ((ch ^ ((row >> 1) & 7)) << 4)); }
#pragma unroll
            for (int n = 0; n < 4; ++n) { const int row = wc * 64 + n * 16 + fr; bfr[n] = *(LAS const bf16x8*)(lds + 16384 + row * 128 + ((ch ^ ((row >> 1) & 7)) << 4)); }
#pragma unroll
            for (int m = 0; m < 2; ++m)
#pragma unroll
                for (int n = 0; n < 4; ++n) acc[m][n] = MFMA16(bfr[n], af[m], acc[m][n]);
        }
    }
}
#define SG_ZERO(acc) do { _Pragma("unroll") for (int m_ = 0; m_ < 2; ++m_) _Pragma("unroll") for (int n_ = 0; n_ < 4; ++n_) acc[m_][n_] = (f32x4){0.f, 0.f, 0.f, 0.f}; } while (0)
#define SG_IDS int tid_ = threadIdx.x; asm volatile("" : "+v"(tid_)); const int tid = tid_, lane = tid & 63, wid = tid >> 6, wr = wid >> 1, wc = wid & 1, fr = lane & 15, fq = lane >> 4; (void)tid; (void)lane; (void)wid;
#define SG_ROW(m) (wr * 32 + (m) * 16 + fr)
#define SG_COL(n) (wc * 64 + (n) * 16 + 4 * fq)
__device__ __forceinline__ void st4bf(bf16_t* dst, f32x4 v) { u32x2 w; w.x = cvtpk(v[0], v[1]); w.y = cvtpk(v[2], v[3]); *(u32x2*)dst = w; }

__device__ __forceinline__ void transpose_item(const float* W, int ldw, int src_col, int valid, bf16_t* WT, int K, int dst_row, int k0, LAS float* scr, int lane) {
    const int kq = lane >> 3, c4 = (lane & 7) * 4;
    if ((valid == 32) && ((src_col & 3) == 0) && ((ldw & 3) == 0)) {
        f32x4 v[8];
#pragma unroll
        for (int i = 0; i < 8; ++i) v[i] = *(const f32x4*)(W + (size_t)(k0 + 8 * i + kq) * ldw + src_col + c4);
#pragma unroll
        for (int i = 0; i < 8; ++i) { LAS float* d = scr + (8 * i + kq) * 33 + c4; d[0] = v[i][0]; d[1] = v[i][1]; d[2] = v[i][2]; d[3] = v[i][3]; }
    } else {
        float v[32];
#pragma unroll
        for (int i = 0; i < 32; ++i) { const int kk = 2 * i + (lane >> 5), c = lane & 31; v[i] = (c < valid) ? W[(size_t)(k0 + kk) * ldw + src_col + c] : 0.f; }
#pragma unroll
        for (int i = 0; i < 32; ++i) { const int kk = 2 * i + (lane >> 5), c = lane & 31; scr[kk * 33 + c] = v[i]; }
    }
    asm volatile("s_waitcnt lgkmcnt(0)" ::: "memory");
    const int c = lane & 7;
#pragma unroll
    for (int j = 0; j < 4; ++j) { const int n = (lane >> 3) + 8 * j; LAS const float* s = scr + (8 * c) * 33 + n;
        u32x4 o; o.x = cvtpk(s[0 * 33], s[1 * 33]); o.y = cvtpk(s[2 * 33], s[3 * 33]); o.z = cvtpk(s[4 * 33], s[5 * 33]); o.w = cvtpk(s[6 * 33], s[7 * 33]);
        *(u32x4*)(WT + (size_t)(dst_row + n) * K + k0 + 8 * c) = o; }
    asm volatile("s_waitcnt lgkmcnt(0)" ::: "memory");
}
__device__ __forceinline__ void norm_row_bf16(const float* xrow, const float* g, bf16_t* orow, int lane) {
    f32x4 v[4]; float s = 0.f;
#pragma unroll
    for (int j = 0; j < 4; ++j) { v[j] = *(const f32x4*)(xrow + (64 * j + lane) * 4); s += (v[j][0] * v[j][0] + v[j][1] * v[j][1]) + (v[j][2] * v[j][2] + v[j][3] * v[j][3]); }
    const float rstd = rsqrtf(wave_sum(s) * (1.f / 1024.f) + 1e-6f);
#pragma unroll
    for (int j = 0; j < 4; ++j) { const f32x4 gg = *(const f32x4*)(g + (64 * j + lane) * 4); f32x4 o = v[j] * rstd * gg; st4bf(orow + (64 * j + lane) * 4, o); }
}

__device__ __forceinline__ void phase_prologue(PRef p, LAS unsigned char* lds) {
    int tid_ = threadIdx.x; asm volatile("" : "+v"(tid_));
    const int tid = tid_, lane = tid & 63, wid = tid >> 6;
    const int gw = blockIdx.x * 8 + wid, NGW = gridDim.x * 8;
    LAS float* scr = (LAS float*)(lds + wid * 8448);
    unsigned char* ws = p.ws;
    constexpr int I_IN = 16 * 160, I_A = 8 * 32, I_O = 16 * 32, I_C1 = 2 * 32 * 4, I_G = 16 * 16 * 4, I_D = 16 * 2 * 32;
    constexpr int I_LAYER = I_IN + 2 * I_A + I_O + I_C1 + 2 * I_G + I_D;
    for (int it = gw; it < DEPTH * I_LAYER; it += NGW) {
        const int l = it / I_LAYER; int r = it % I_LAYER;
        if (r < I_IN) { const int kb = r / 160, nb = r % 160, n0 = nb * 32; int src, valid = 32;
            if (n0 < 1280) src = n0; else if (n0 < 4864) src = n0 + 24; else { src = 1280 + (n0 - 4864); valid = (n0 == 4864) ? 24 : 0; if (valid == 0) src = 0; }
            transpose_item(p.w_in + (size_t)l * DM * INCOLS, INCOLS, src, valid, (bf16_t*)(ws + WS_WIN) + (size_t)l * NPAD * DM, DM, n0, kb * 64, scr, lane); continue; }
        r -= I_IN;
        if (r < I_A) { const int kb = r / 32, nb = r % 32; transpose_item(p.w_branch_a + (size_t)l * 512 * DM, DM, nb * 32, 32, (bf16_t*)(ws + WS_WA) + (size_t)l * DM * 512, 512, nb * 32, kb * 64, scr, lane); continue; }
        r -= I_A;
        if (r < I_A) { const int kb = r / 32, nb = r % 32; transpose_item(p.w_branch_b + (size_t)l * 512 * DM, DM, nb * 32, 32, (bf16_t*)(ws + WS_WB) + (size_t)l * DM * 512, 512, nb * 32, kb * 64, scr, lane); continue; }
        r -= I_A;
        if (r < I_O) { const int kb = r / 32, nb = r % 32; transpose_item(p.w_out + (size_t)l * DM * DM, DM, nb * 32, 32, (bf16_t*)(ws + WS_WO) + (size_t)l * DM * DM, DM, nb * 32, kb * 64, scr, lane); continue; }
        r -= I_O;
        if (r < I_C1) { const int kv = r / 128, r2 = r % 128, kb = r2 / 4, nb = r2 % 4;
            transpose_item(p.cmp_w1 + (size_t)(l * 2 + kv) * 2048 * 128, 128, nb * 32, 32, (bf16_t*)(ws + WS_WC1) + (size_t)(l * 2 + kv) * 128 * 2048, 2048, nb * 32, kb * 64, scr, lane); continue; }
        r -= I_C1;
        if (r < 2 * I_G) { const int which = r / I_G, r2 = r % I_G, e = r2 / 64, r3 = r2 % 64, kb = r3 / 4, nb = r3 % 4;
            const float* W = (which ? p.exp_w_up : p.exp_w_gate) + (size_t)(l * 16 + e) * DM * 128;
            transpose_item(W, 128, nb * 32, 32, (bf16_t*)(ws + WS_WGU) + (size_t)(l * 16 + e) * 256 * DM, DM, which * 128 + nb * 32, kb * 64, scr, lane); continue; }
        r -= 2 * I_G;
        { const int e = r / 64, r3 = r % 64, kb = r3 / 32, nb = r3 % 32;
            transpose_item(p.exp_w_down + (size_t)(l * 16 + e) * 128 * DM, DM, nb * 32, 32, (bf16_t*)(ws + WS_WD) + (size_t)(l * 16 + e) * DM * 128, 128, nb * 32, kb * 64, scr, lane); }
    }
    for (int m0 = gw * 4; m0 < NTOK; m0 += NGW * 4) {
        f32x4 v[4][4];
#pragma unroll
        for (int rr = 0; rr < 4; ++rr)
#pragma unroll
            for (int j = 0; j < 4; ++j) v[rr][j] = *(const f32x4*)(p.x + (size_t)(m0 + rr) * DM + (64 * j + lane) * 4);
#pragma unroll
        for (int rr = 0; rr < 4; ++rr) { float ss = 0.f;
#pragma unroll
            for (int j = 0; j < 4; ++j) ss += (v[rr][j][0] * v[rr][j][0] + v[rr][j][1] * v[rr][j][1]) + (v[rr][j][2] * v[rr][j][2] + v[rr][j][3] * v[rr][j][3]);
            const float rstd = rsqrtf(wave_sum(ss) * (1.f / 1024.f) + 1e-6f);
#pragma unroll
            for (int j = 0; j < 4; ++j) { const f32x4 gg = *(const f32x4*)(p.norm1_g + (64 * j + lane) * 4); st4bf((bf16_t*)(ws + WS_XN) + (size_t)(m0 + rr) * DM + (64 * j + lane) * 4, v[rr][j] * rstd * gg); } }
    }
    __syncthreads();
    if (blockIdx.x < 8) {
        const int l = blockIdx.x >> 2, kv = (blockIdx.x >> 1) & 1, jh = blockIdx.x & 1, j = jh * 64 + lane;
        const float* pe = p.cmp_pe + (size_t)(l * 2 + kv) * 2048; const float* w1 = p.cmp_w1 + (size_t)(l * 2 + kv) * 2048 * 128;
        float s = 0.f;
        for (int f = wid * 256; f < wid * 256 + 256; ++f) s += pe[f] * w1[(size_t)f * 128 + j];
        LAS float* part = (LAS float*)(lds + 70000);
        part[wid * 64 + lane] = s;
        __syncthreads();
        if (wid == 0) { float t = p.cmp_b1[(l * 2 + kv) * 128 + j];
#pragma unroll
            for (int w = 0; w < 8; ++w) t += part[w * 64 + lane];
            ((float*)(ws + WS_MISC))[(l * 2 + kv) * 128 + j] = t; }
    }
    if (blockIdx.x == 8 && wid < DEPTH) {
        const int l = wid; const float* lp = p.diff_lambda + l * 256;
        const float a = wave_sum(lp[lane] * lp[64 + lane]), b = wave_sum(lp[128 + lane] * lp[192 + lane]);
        const float lam_init = 0.8f - 0.6f * expf(-0.3f * (float)l);
        if (lane == 0) ((float*)(ws + WS_MISC + 4096))[l] = expf(a) - expf(b) + lam_init;
    }
}

namespace pg8 {
#define PG8_LAS __attribute__((address_space(3)))
constexpr int BM = 256, BK = 64, HALF = 128, HTB = HALF * BK * 2  , STAGE_BYTES = 8 * HTB, NXCD = 8, WGM = 8;

__host__ __device__ __forceinline__ int lds_byte(int r, int c) { const int st = (r >> 4) * 2 + (c >> 5), rr = r & 15, cc = c & 31, ob = rr * 64 + cc * 2; return st * 1024 + (ob ^ (((ob >> 9) & 1) << 5)); }
__host__ __device__ __forceinline__ void stage_rc(int b, int& R, int& C) { const int st = b / 1024, sb = b % 1024, swz = sb ^ (((sb >> 9) & 1) << 5); R = (st >> 1) * 16 + swz / 64; C = (st & 1) * 32 + (swz % 64) / 2; }
__host__ __device__ __forceinline__ int perm32(int rho) { const int n = rho >> 4, i = rho & 15; return 8 * (i >> 2) + 4 * n + (i & 3); }

struct Unit { int pm, pn, z; };
struct Gemm { const bf16_t* A; const bf16_t* Bt; const bf16_t* A2; const bf16_t* Bt2; int M, N, K; };

struct StaticOrder {
    int nM, nN, nwg, G, c;
    __host__ __device__ void init(int M, int N, int G_, int c_) { nM = M / BM; nN = N / BM; nwg = nM * nN; G = G_; c = c_; }
    __host__ __device__ bool next(int i, Unit& u) const {
        const long L = (long)i * G + c; if (L >= nwg) return false;
        int wgid = (int)L; { const int q = nwg / NXCD, r = nwg % NXCD, xcd = wgid % NXCD, off = wgid / NXCD; wgid = (xcd < r ? xcd * (q + 1) : r * (q + 1) + (xcd - r) * q) + off; }
        const int nig = WGM * nN, gid = wgid / nig, fm = gid * WGM, gsz = (nM - fm) < WGM ? (nM - fm) : WGM;
        u.pm = fm + ((wgid % nig) % gsz); u.pn = (wgid % nig) / gsz; u.z = 0; return true;
    }
    __device__ __forceinline__ void a_ready(const Unit&) const {}
    __device__ __forceinline__ void done(const Unit&) const {}
};

template <class Epi, class Sched, bool ALIGN_EPI = false, bool SP2 = false>
__device__ __forceinline__ void gemm_phase(PG8_LAS unsigned char* lds, const Gemm g, const Sched& S, const Epi& E) {
    int tid_ = threadIdx.x; asm volatile("" : "+v"(tid_));
    const int tid = tid_, wid = __builtin_amdgcn_readfirstlane(tid >> 6), lane = tid & 63, wr = wid >> 2, wc = wid & 3, fr = lane & 15, fq = lane >> 4;
    const int K = g.K, nt = K / BK;
    unsigned voffA[2], voffB[2];
#pragma unroll
    for (int i = 0; i < 2; ++i) { int R, C; stage_rc(tid * 16 + i * 8192, R, C); const int Rb = Epi::PERM ? ((R & ~31) + perm32(R & 31)) : R;
        voffA[i] = (unsigned)(R * K + C) * 2u; voffB[i] = (unsigned)(Rb * K + C) * 2u; }
    const size_t kstep = (size_t)(BK * 2);
    const size_t hstep = (size_t)HALF * K * 2;
    const size_t tstep = 2 * hstep;
    const unsigned ldsw = (unsigned)wid * 1024u;
    const int aoff = lds_byte(wr * 64 + fr, fq * 8), boff = lds_byte(wc * 32 + fr, fq * 8);
#define PG8_SA(b, h) (((b) * 2 + (h)) * HTB)
#define PG8_SB(b, h) ((4 + (b) * 2 + (h)) * HTB)
#define PG8_STAGE(bufoff, gbase, voff) do { _Pragma("unroll") for (int _i = 0; _i < 2; ++_i) \
        __builtin_amdgcn_global_load_lds((const unsigned*)((const char*)(gbase) + (voff)[_i]), (PG8_LAS unsigned*)(lds + (bufoff) + ldsw + _i * 8192), 16, 0, 0); } while (0)
#define PG8_LDA(dst, b, h) do { _Pragma("unroll") for (int m = 0; m < 4; ++m) _Pragma("unroll") for (int k = 0; k < 2; ++k) dst[m][k] = *(const PG8_LAS bf16x8*)(lds + PG8_SA(b, h) + aoff + m * 2048 + k * 1024); } while (0)
#define PG8_LDB(dst, b, h) do { _Pragma("unroll") for (int n = 0; n < 2; ++n) _Pragma("unroll") for (int k = 0; k < 2; ++k) dst[n][k] = *(const PG8_LAS bf16x8*)(lds + PG8_SB(b, h) + boff + n * 2048 + k * 1024); } while (0)
#define PG8_MMA(ai, bj, At, Bt) do { __builtin_amdgcn_s_setprio(1); _Pragma("unroll") for (int m = 0; m < 4; ++m) _Pragma("unroll") for (int n = 0; n < 2; ++n) _Pragma("unroll") for (int k = 0; k < 2; ++k) \
        acc[ai][bj][m][n] = __builtin_amdgcn_mfma_f32_16x16x32_bf16(Bt[n][k], At[m][k], acc[ai][bj][m][n], 0, 0, 0); __builtin_amdgcn_s_setprio(0); } while (0)
#define PG8_WAIT_V(n) asm volatile("s_waitcnt vmcnt(" #n ")" ::: "memory")
#define PG8_WAIT_L(n) asm volatile("s_waitcnt lgkmcnt(" #n ")" ::: "memory")
#define PG8_BAR __builtin_amdgcn_s_barrier()
#define PG8_SCHED __builtin_amdgcn_sched_barrier(0)
    Unit cur, nxt; int ui = 0;
    if (!S.next(0, cur)) return;
    f32x4 acc[2][2][4][2];
#pragma unroll
    for (int a = 0; a < 2; ++a)
#pragma unroll
        for (int b = 0; b < 2; ++b)
#pragma unroll
            for (int m = 0; m < 4; ++m)
#pragma unroll
                for (int n = 0; n < 2; ++n) acc[a][b][m][n] = (f32x4){0.f, 0.f, 0.f, 0.f};
    bf16x8 At[4][2], B0[2][2], B1[2][2];
    const char* cA = (const char*)(cur.z ? g.A2 : g.A) + (size_t)cur.pm * tstep; const char* cB = (const char*)(cur.z ? g.Bt2 : g.Bt) + (size_t)cur.pn * tstep;
    S.a_ready(cur);
    if constexpr (SP2) {
        PG8_STAGE(PG8_SB(0, 0), cB, voffB); PG8_STAGE(PG8_SB(0, 1), cB + hstep, voffB); PG8_STAGE(PG8_SA(0, 0), cA, voffA); PG8_STAGE(PG8_SA(0, 1), cA + hstep, voffA);
        if (wr == 1) PG8_BAR;
        PG8_WAIT_V(2); PG8_BAR;
        PG8_STAGE(PG8_SB(1, 0), cB + kstep, voffB); PG8_STAGE(PG8_SA(1, 0), cA + kstep, voffA); PG8_STAGE(PG8_SB(1, 1), cB + hstep + kstep, voffB);
        PG8_WAIT_V(6); PG8_BAR;
    } else {
        PG8_STAGE(PG8_SB(0, 0), cB, voffB); PG8_STAGE(PG8_SA(0, 0), cA, voffA); PG8_STAGE(PG8_SB(0, 1), cB + hstep, voffB); PG8_STAGE(PG8_SA(0, 1), cA + hstep, voffA);
        if (wr == 1) PG8_BAR;
        PG8_WAIT_V(4); PG8_BAR;
        PG8_STAGE(PG8_SB(1, 0), cB + kstep, voffB); PG8_STAGE(PG8_SA(1, 0), cA + kstep, voffA); PG8_STAGE(PG8_SB(1, 1), cB + hstep + kstep, voffB);
        PG8_WAIT_V(6); PG8_BAR;
    }
    for (;;) {
        const bool has_next = S.next(ui + 1, nxt);
        const char* nA = has_next ? (const char*)(nxt.z ? g.A2 : g.A) + (size_t)nxt.pm * tstep : cA; const char* nB = has_next ? (const char*)(nxt.z ? g.Bt2 : g.Bt) + (size_t)nxt.pn * tstep : cB;
        for (int t = 0; t < nt; t += 2) {
            const bool last = (t == nt - 2);
            const char* a1 = cA + (size_t)(t + 1) * kstep;
            const char* a2 = last ? nA : cA + (size_t)(t + 2) * kstep; const char* b2 = last ? nB : cB + (size_t)(t + 2) * kstep;
            const char* a3 = a2 + kstep; const char* b3 = b2 + kstep;
            if (last && has_next) S.a_ready(nxt);
            if constexpr (SP2) {
            PG8_LDB(B0, 0, 0); PG8_LDB(B1, 0, 1); PG8_SCHED; PG8_LDA(At, 0, 0); PG8_STAGE(PG8_SA(1, 1), a1 + hstep, voffA);
            PG8_WAIT_V(8); PG8_WAIT_L(0); PG8_BAR; PG8_MMA(0, 0, At, B0); PG8_MMA(0, 1, At, B1); PG8_BAR; PG8_SCHED;
            PG8_LDA(At, 0, 1); PG8_STAGE(PG8_SB(0, 0), b2, voffB); PG8_STAGE(PG8_SB(0, 1), b2 + hstep, voffB); PG8_STAGE(PG8_SA(0, 0), a2, voffA);
            PG8_WAIT_V(8); PG8_WAIT_L(0); PG8_BAR; PG8_MMA(1, 0, At, B0); PG8_MMA(1, 1, At, B1); PG8_BAR; PG8_SCHED;
            PG8_LDB(B0, 1, 0); PG8_LDB(B1, 1, 1); PG8_SCHED; PG8_LDA(At, 1, 0); PG8_STAGE(PG8_SA(0, 1), a2 + hstep, voffA);
            PG8_WAIT_V(8); PG8_WAIT_L(0); PG8_BAR; PG8_MMA(0, 0, At, B0); PG8_MMA(0, 1, At, B1); PG8_BAR; PG8_SCHED;
            PG8_LDA(At, 1, 1); PG8_STAGE(PG8_SB(1, 0), b3, voffB); PG8_STAGE(PG8_SB(1, 1), b3 + hstep, voffB); PG8_STAGE(PG8_SA(1, 0), a3, voffA);
            PG8_WAIT_V(8); PG8_WAIT_L(0); PG8_BAR; PG8_MMA(1, 0, At, B0); PG8_MMA(1, 1, At, B1); PG8_BAR; PG8_SCHED;
            } else {
            PG8_LDB(B0, 0, 0); PG8_SCHED; PG8_LDA(At, 0, 0); PG8_STAGE(PG8_SA(1, 1), a1 + hstep, voffA);
            PG8_WAIT_L(8); PG8_BAR; PG8_WAIT_L(0); PG8_MMA(0, 0, At, B0); PG8_BAR; PG8_SCHED;
            PG8_LDB(B1, 0, 1); PG8_STAGE(PG8_SB(0, 0), b2, voffB);
            PG8_BAR; PG8_WAIT_L(0); PG8_MMA(0, 1, At, B1); PG8_BAR;
            PG8_LDA(At, 0, 1); PG8_STAGE(PG8_SA(0, 0), a2, voffA);
            PG8_BAR; PG8_WAIT_L(0); PG8_MMA(1, 0, At, B0); PG8_BAR; PG8_SCHED;
            PG8_STAGE(PG8_SB(0, 1), b2 + hstep, voffB);
            PG8_WAIT_V(6); PG8_BAR; PG8_MMA(1, 1, At, B1); PG8_BAR;
            PG8_LDB(B0, 1, 0); PG8_SCHED; PG8_LDA(At, 1, 0); PG8_STAGE(PG8_SA(0, 1), a2 + hstep, voffA);
            PG8_WAIT_L(8); PG8_BAR; PG8_WAIT_L(0); PG8_MMA(0, 0, At, B0); PG8_BAR; PG8_SCHED;
            PG8_LDB(B1, 1, 1); PG8_STAGE(PG8_SB(1, 0), b3, voffB);
            PG8_BAR; PG8_WAIT_L(0); PG8_MMA(0, 1, At, B1); PG8_BAR;
            PG8_LDA(At, 1, 1); PG8_STAGE(PG8_SA(1, 0), a3, voffA);
            PG8_BAR; PG8_WAIT_L(0); PG8_MMA(1, 0, At, B0); PG8_BAR; PG8_SCHED;
            PG8_STAGE(PG8_SB(1, 1), b3 + hstep, voffB);
            PG8_WAIT_V(6); PG8_BAR; PG8_MMA(1, 1, At, B1); PG8_BAR;
            }
        }
        if constexpr (ALIGN_EPI) { if (wr == 0) PG8_BAR; }
        if constexpr (!Epi::AFTER_DRAIN) { E(acc, cur, wr, wc, fr, fq); S.done(cur); }
        if (!has_next) break;
        if (!Epi::keep(cur)) {
#pragma unroll
        for (int a = 0; a < 2; ++a)
#pragma unroll
            for (int b = 0; b < 2; ++b)
#pragma unroll
                for (int m = 0; m < 4; ++m)
#pragma unroll
                    for (int n = 0; n < 2; ++n) acc[a][b][m][n] = (f32x4){0.f, 0.f, 0.f, 0.f}; }
        cur = nxt; cA = nA; cB = nB; ++ui;
        if constexpr (ALIGN_EPI) { if (wr == 1) PG8_BAR; }
    }
    PG8_WAIT_V(0);
    if constexpr (!ALIGN_EPI) { if (wr == 0) PG8_BAR; }
    PG8_BAR;
    if constexpr (Epi::AFTER_DRAIN) { E.fused(acc, cur, wr, wc, fr, fq, lds, wid, lane); S.done(cur); }
#undef PG8_SA
#undef PG8_SB
#undef PG8_STAGE
#undef PG8_LDA
#undef PG8_LDB
#undef PG8_MMA
#undef PG8_WAIT_V
#undef PG8_WAIT_L
#undef PG8_BAR
#undef PG8_SCHED
}
}

typedef pg8::Unit PUnit;
struct EpiInproj {
    static constexpr bool PERM = true, AFTER_DRAIN = false;
    unsigned char* ws;
    static __device__ __forceinline__ bool keep(const PUnit&) { return false; }
    __device__ __forceinline__ void operator()(f32x4 (&acc)[2][2][4][2], const PUnit& u, int wr, int wc, int fr, int fq) const {
        const int n0 = u.pn * 256;
        bf16_t* dst; int pitch, c0, mode = 0;
        if (n0 < 512) { dst = (bf16_t*)(ws + WS_NQ); pitch = 512; c0 = n0; mode = 1; }
        else if (n0 < 1280) { dst = (bf16_t*)(ws + WS_KV6); pitch = 768; c0 = n0 - 512; }
        else if (n0 < 1792) { dst = (bf16_t*)(ws + WS_DQ); pitch = 512; c0 = n0 - 1280; mode = 1; }
        else if (n0 < 2304) { dst = (bf16_t*)(ws + WS_DK); pitch = 512; c0 = n0 - 1792; }
        else if (n0 < 2816) { dst = (bf16_t*)(ws + WS_DV); pitch = 512; c0 = n0 - 2304; }
        else if (n0 < 3840) { dst = (bf16_t*)(ws + WS_GA); pitch = 1024; c0 = n0 - 2816; mode = 2; }
        else if (n0 < 4864) { dst = (bf16_t*)(ws + WS_GB); pitch = 1024; c0 = n0 - 3840; mode = 2; }
        else { dst = (bf16_t*)(ws + WS_NG); pitch = 32; c0 = 0; mode = 3; }
        asm volatile("" : "+v"(fr), "+v"(fq));
        const int row0 = u.pm * 256 + wr * 64 + fr, col0 = wc * 32 + 8 * fq;
#pragma unroll
        for (int ai = 0; ai < 2; ++ai)
#pragma unroll
            for (int m = 0; m < 4; ++m) { bf16_t* rowp = dst + (size_t)(row0 + ai * 128 + m * 16) * pitch + c0 + col0;
#pragma unroll
                for (int bj = 0; bj < 2; ++bj) { f32x4 v0 = acc[ai][bj][m][0], v1 = acc[ai][bj][m][1];
                    if (mode == 1) { v0 = v0 * QSCALE; v1 = v1 * QSCALE; }
                    else if (mode >= 2) {
#pragma unroll
                        for (int i = 0; i < 4; ++i) { v0[i] = sigm(v0[i]); v1[i] = sigm(v1[i]); } }
                    if (mode != 3 || (bj == 0 && wc == 0)) { u32x4 w; w.x = cvtpk(v0[0], v0[1]); w.y = cvtpk(v0[2], v0[3]); w.z = cvtpk(v1[0], v1[1]); w.w = cvtpk(v1[2], v1[3]); *(u32x4*)(rowp + bj * 128) = w; } } }
    }
};
struct EpiMerge {
    static constexpr bool PERM = true, AFTER_DRAIN = false;
    const bf16_t* GA; const bf16_t* GB; bf16_t* MG;
    static __device__ __forceinline__ bool keep(const PUnit& u) { return u.z == 0; }
    __device__ __forceinline__ void operator()(f32x4 (&acc)[2][2][4][2], const PUnit& u, int wr, int wc, int fr, int fq) const {
        asm volatile("" : "+v"(fr), "+v"(fq));
        const int row0 = u.pm * 256 + wr * 64 + fr, col0 = u.pn * 256 + wc * 32 + 8 * fq;
#pragma unroll
        for (int ai = 0; ai < 2; ++ai)
#pragma unroll
            for (int m = 0; m < 4; ++m) { const size_t ro = (size_t)(row0 + ai * 128 + m * 16) * DM + col0;
#pragma unroll
                for (int bj = 0; bj < 2; ++bj) { const size_t off = ro + bj * 128;
                    const u32x4 gb = *(const u32x4*)(GB + off);
                    const f32x4 b0 = {bflo(gb.x), bfhi(gb.x), bflo(gb.y), bfhi(gb.y)}, b1 = {bflo(gb.z), bfhi(gb.z), bflo(gb.w), bfhi(gb.w)};
                    if (u.z == 0) { const u32x4 ga = *(const u32x4*)(GA + off);
                        const f32x4 a0 = {bflo(ga.x), bfhi(ga.x), bflo(ga.y), bfhi(ga.y)}, a1 = {bflo(ga.z), bfhi(ga.z), bflo(ga.w), bfhi(ga.w)};
#pragma unroll
                        for (int i = 0; i < 4; ++i) { acc[ai][bj][m][0][i] *= a0[i] * __builtin_amdgcn_rcpf(fmaxf(b0[i], 1e-30f)); acc[ai][bj][m][1][i] *= a1[i] * __builtin_amdgcn_rcpf(fmaxf(b1[i], 1e-30f)); } }
                    else { const f32x4 v0 = acc[ai][bj][m][0] * b0, v1 = acc[ai][bj][m][1] * b1;
                        u32x4 w; w.x = cvtpk(v0[0], v0[1]); w.y = cvtpk(v0[2], v0[3]); w.z = cvtpk(v1[0], v1[1]); w.w = cvtpk(v1[2], v1[3]); *(u32x4*)(MG + off) = w; } } }
    }
};
struct MergeOrder {
    int G, c;
    __device__ __forceinline__ bool next(int i, PUnit& u) const { const int t = (i >> 1) * G + c; if (t >= 512) return false;
        int wgid = t; { const int q = 512 / 8, xcd = wgid % 8, off = wgid / 8; wgid = xcd * q + off; }
        u.pm = (wgid >> 5) * 8 + (wgid & 7); u.pn = (wgid >> 3) & 3; u.z = i & 1; return true; }
    __device__ __forceinline__ void a_ready(const PUnit&) const {}
    __device__ __forceinline__ void done(const PUnit&) const {}
};
struct EpiOut {
    static constexpr bool PERM = false, AFTER_DRAIN = false;
    const float* hin; float* hout;
    static __device__ __forceinline__ bool keep(const PUnit&) { return false; }
    __device__ __forceinline__ void operator()(f32x4 (&acc)[2][2][4][2], const PUnit& u, int wr, int wc, int fr, int fq) const {
        asm volatile("" : "+v"(fr), "+v"(fq));
        const int row0 = u.pm * 256 + wr * 64 + fr, col0 = u.pn * 256 + wc * 32 + 4 * fq;
#pragma unroll
        for (int ai = 0; ai < 2; ++ai)
#pragma unroll
            for (int m = 0; m < 4; ++m) { const size_t ro = (size_t)(row0 + ai * 128 + m * 16) * DM + col0;
#pragma unroll
                for (int bj = 0; bj < 2; ++bj)
#pragma unroll
                    for (int n = 0; n < 2; ++n) { const size_t off = ro + bj * 128 + n * 16; *(f32x4*)(hout + off) = *(const f32x4*)(hin + off) + acc[ai][bj][m][n]; } }
    }
};
__device__ __forceinline__ void phase_inproj_pg8(PRef p, int l, LAS unsigned char* lds) {
    unsigned char* ws = p.ws;
    const bf16_t* W = (const bf16_t*)(ws + WS_WIN) + (size_t)l * NPAD * DM;
    pg8::Gemm g{(const bf16_t*)(ws + WS_XN), W, (const bf16_t*)(ws + WS_XN), W, NTOK, NPAD, DM};
    pg8::StaticOrder S; S.init(NTOK, NPAD, (int)gridDim.x, (int)blockIdx.x);
    EpiInproj E{ws};
    pg8::gemm_phase<EpiInproj, pg8::StaticOrder, true, true>(lds, g, S, E);
}
__device__ __forceinline__ void phase_merge_pg8(PRef p, int l, LAS unsigned char* lds) {
    unsigned char* ws = p.ws;
    pg8::Gemm g{(const bf16_t*)(ws + WS_NQ), (const bf16_t*)(ws + WS_WA) + (size_t)l * DM * 512, (const bf16_t*)(ws + WS_DQ), (const bf16_t*)(ws + WS_WB) + (size_t)l * DM * 512, NTOK, DM, 512};
    MergeOrder S{(int)gridDim.x, (int)blockIdx.x};
    EpiMerge E{(const bf16_t*)(ws + WS_GA), (const bf16_t*)(ws + WS_GB), (bf16_t*)(ws + WS_XN)};
    pg8::gemm_phase<EpiMerge, MergeOrder, true, true>(lds, g, S, E);
}
__device__ __forceinline__ void phase_outproj_pg8(PRef p, int l, LAS unsigned char* lds, bool dry = false) {
    unsigned char* ws = p.ws;
    const bf16_t* WO = (const bf16_t*)(ws + WS_WO) + (size_t)l * DM * DM;
    pg8::Gemm g{(const bf16_t*)(ws + WS_XN), WO, (const bf16_t*)(ws + WS_XN), WO, NTOK, DM, DM};
    pg8::StaticOrder S; S.init(NTOK, DM, (int)gridDim.x, (int)blockIdx.x);
    EpiOut E{(l == 0) ? p.x : p.out, dry ? (float*)(ws + WS_GA) : p.out};
    pg8::gemm_phase<EpiOut, pg8::StaticOrder, true, true>(lds, g, S, E);
}

__device__ __forceinline__ void phase_inproj(PRef p, int l, LAS unsigned char* lds) {
    SG_IDS
    unsigned char* ws = p.ws;
    const bf16_t* XN = (const bf16_t*)(ws + WS_XN); const bf16_t* W = (const bf16_t*)(ws + WS_WIN) + (size_t)l * NPAD * DM;
    constexpr int NT = 39, GRP = 16;
    for (int u = blockIdx.x; u < 256 * NT; u += gridDim.x) {
        const int grp = u / (GRP * NT), rem = u % (GRP * NT), pn = rem / GRP, pm = grp * GRP + rem % GRP;
        const int m0 = pm * 128, n0 = pn * 128;
        f32x4 acc[2][4]; SG_ZERO(acc);
        sg_kloop(acc, ARowLin{(const char*)(XN + (size_t)m0 * DM), 2048}, 128, W + (size_t)n0 * DM, DM, 16, lds);
        bf16_t* dst; int pitch, c0, mode = 0;
        if (n0 < 512) { dst = (bf16_t*)(ws + WS_NQ); pitch = 512; c0 = n0; mode = 1; }
        else if (n0 < 1280) { dst = (bf16_t*)(ws + WS_KV6); pitch = 768; c0 = n0 - 512; }
        else if (n0 < 1792) { dst = (bf16_t*)(ws + WS_DQ); pitch = 512; c0 = n0 - 1280; mode = 1; }
        else if (n0 < 2304) { dst = (bf16_t*)(ws + WS_DK); pitch = 512; c0 = n0 - 1792; }
        else if (n0 < 2816) { dst = (bf16_t*)(ws + WS_DV); pitch = 512; c0 = n0 - 2304; }
        else if (n0 < 3840) { dst = (bf16_t*)(ws + WS_GA); pitch = 1024; c0 = n0 - 2816; mode = 2; }
        else if (n0 < 4864) { dst = (bf16_t*)(ws + WS_GB); pitch = 1024; c0 = n0 - 3840; mode = 2; }
        else { dst = (bf16_t*)(ws + WS_NG); pitch = 32; c0 = 0; mode = 3; }
#pragma unroll
        for (int m = 0; m < 2; ++m)
#pragma unroll
            for (int n = 0; n < 4; ++n) {
                const int row = m0 + SG_ROW(m), col = SG_COL(n); f32x4 v = acc[m][n];
                if (mode == 1) v = v * QSCALE;
                else if (mode >= 2) { v[0] = sigm(v[0]); v[1] = sigm(v[1]); v[2] = sigm(v[2]); v[3] = sigm(v[3]); }
                if (mode != 3 || col < 32) st4bf(dst + (size_t)row * pitch + c0 + col, v);
            }
    }
}

__device__ __forceinline__ int kswz(int row, int ch) { return row * 128 + ((ch ^ ((row >> 1) & 7)) << 4); }
__device__ __forceinline__ void stage_k(LAS unsigned char* kdst, const bf16_t* src  , int pitch, int tid) {
    const int row = tid >> 3, ch = tid & 7;
    *(LAS u32x4*)(kdst + kswz(row, ch)) = *(const u32x4*)(src + (size_t)row * pitch + ch * 8);
}
template <int NDB> __device__ __forceinline__ void stage_v(LAS unsigned char* vdst, const bf16_t* src, int pitch, int tid) {
#pragma unroll
    for (int i = 0; i < NDB / 2; ++i) { const int pc = tid + 512 * i, pw = pc >> 6, ln = pc & 63, db = pw >> 2, rg = pw & 3;
        *(LAS u32x4*)(vdst + pw * 1024 + ln * 16) = *(const u32x4*)(src + (size_t)(16 * rg + (ln >> 2)) * pitch + db * 32 + (ln & 3) * 8); }
}
__device__ __forceinline__ void qkt(f32x16& p0, f32x16& p1, LAS const unsigned char* K, const bf16x8 (&qr)[4], int r32, int hi) {
    p0 = (f32x16){0.f}; p1 = (f32x16){0.f};
#pragma unroll
    for (int d0 = 0; d0 < 4; ++d0) {
        LAS const unsigned char* kb = K + kswz(r32, 2 * d0 + hi);
        const bf16x8 b0 = *(LAS const bf16x8*)(kb), b1 = *(LAS const bf16x8*)(kb + 4096);
        p0 = MFMA32(b0, qr[d0], p0); p1 = MFMA32(b1, qr[d0], p1);
    }
    __builtin_amdgcn_sched_barrier(0);
}
template <int NDB> __device__ __forceinline__ void pv(f32x16 (&o)[NDB], const f32x16& p0, const f32x16& p1, LAS const unsigned char* V, int lane, int hi) {
    u32x4 pw[4];
    pw[0] = (u32x4){cvtpk(p0[0], p0[1]), cvtpk(p0[2], p0[3]), cvtpk(p0[4], p0[5]), cvtpk(p0[6], p0[7])};
    pw[1] = (u32x4){cvtpk(p0[8], p0[9]), cvtpk(p0[10], p0[11]), cvtpk(p0[12], p0[13]), cvtpk(p0[14], p0[15])};
    pw[2] = (u32x4){cvtpk(p1[0], p1[1]), cvtpk(p1[2], p1[3]), cvtpk(p1[4], p1[5]), cvtpk(p1[6], p1[7])};
    pw[3] = (u32x4){cvtpk(p1[8], p1[9]), cvtpk(p1[10], p1[11]), cvtpk(p1[12], p1[13]), cvtpk(p1[14], p1[15])};
    LAS const unsigned char* vb = V + ((lane >> 4) & 1) * 32 + (lane & 3) * 8 + (4 * hi + ((lane & 15) >> 2)) * 64;
#pragma unroll
    for (int d0 = 0; d0 < NDB; ++d0)
#pragma unroll
        for (int ks = 0; ks < 4; ++ks) {
            const s16x4 lo = vtr(vb + d0 * 4096 + ks * 1024), hh = vtr(vb + d0 * 4096 + ks * 1024 + 512);
            const bf16x8 vf = (bf16x8){lo[0], lo[1], lo[2], lo[3], hh[0], hh[1], hh[2], hh[3]};
            o[d0] = MFMA32(__builtin_bit_cast(bf16x8, pw[ks]), vf, o[d0]);
            if (ks == 3) __builtin_amdgcn_sched_barrier(0);
        }
}
constexpr float SM_THR = 6.0f;
constexpr float NEG = -1e30f;
template <int NDB> __device__ __forceinline__ void softmax_pv(f32x16& s0, f32x16& s1, float& m, float& l, f32x16 (&o)[NDB], LAS float* wsf, LAS const unsigned char* V, int lane, int r32, int hi) {
    float rm = fmaxf(s0[0], s1[0]);
#pragma unroll
    for (int r = 1; r < 16; ++r) rm = fmaxf(rm, fmaxf(s0[r], s1[r]));
    rm = fmaxf(rm, __shfl_xor(rm, 32));
    if (__any(rm > m + SM_THR)) {
        const float mn = fmaxf(m, rm), f = ex2(m - mn); l *= f; m = mn;
        if (hi == 0) wsf[r32] = f;
#pragma unroll
        for (int r = 0; r < 16; ++r) { const float fr_ = wsf[crow(r, hi)];
#pragma unroll
            for (int d = 0; d < NDB; ++d) o[d][r] *= fr_; }
    }
    float sum = 0.f;
#pragma unroll
    for (int r = 0; r < 16; ++r) { s0[r] = ex2(s0[r] - m); s1[r] = ex2(s1[r] - m); sum += s0[r] + s1[r]; }
    l += sum;
    pv<NDB>(o, s0, s1, V, lane, hi);
}

__device__ __forceinline__ float gelu_tanh(float x) { const float u = 0.7978845608f * (x + 0.044715f * x * x * x); const float e = __expf(2.f * u); return 0.5f * x * (2.f - 2.f / (1.f + e)); }

__device__ __forceinline__ void compress_unit(PRef p, int l, int u, LAS unsigned char* lds) {
    SG_IDS
    unsigned char* ws = p.ws;
    const int kv = u >> 5, m0 = (u & 31) * 128;
    const bf16_t* KV6 = (const bf16_t*)(ws + WS_KV6);
    struct ARowC { const bf16_t* KV6; int m0, kv; __device__ __forceinline__ const char* operator()(int r) const { const int mm = m0 + r, g = mm >> 11, tok = (mm & 2047) * 16; return (const char*)(KV6 + (size_t)tok * 768 + kv * 128 + g * 64); } };
    f32x4 acc[2][4]; SG_ZERO(acc);
    sg_kloop(acc, ARowC{KV6, m0, kv}, 768 * 2, (const bf16_t*)(ws + WS_WC1) + (size_t)(l * 2 + kv) * 128 * 2048, 2048, 32, lds);
    LAS bf16_t* Ht = (LAS bf16_t*)(lds + 32768);
    LAS float* W2 = (LAS float*)(lds + 32768 + 34816);
    const float* cb1 = (const float*)(ws + WS_MISC) + (l * 2 + kv) * 128;
#pragma unroll
    for (int m = 0; m < 2; ++m)
#pragma unroll
        for (int n = 0; n < 4; ++n) { const int row = SG_ROW(m), col = SG_COL(n); const f32x4 b = *(const f32x4*)(cb1 + col); f32x4 v = acc[m][n] + b;
            u32x2 w; w.x = cvtpk(gelu_tanh(v[0]), gelu_tanh(v[1])); w.y = cvtpk(gelu_tanh(v[2]), gelu_tanh(v[3])); *(LAS u32x2*)(Ht + row * 136 + col) = w; }
    const float* w2g = p.cmp_w2 + (size_t)(l * 2 + kv) * 128 * 64;
    for (int i = tid; i < 128 * 64 / 4; i += 512) *(LAS f32x4*)(W2 + i * 4) = *(const f32x4*)(w2g + i * 4);
    __syncthreads();
    const int d = tid & 63; const float b2 = p.cmp_b2[(l * 2 + kv) * 64 + d];
    bf16_t* dstb = (bf16_t*)(ws + WS_MISC + 65536 + (size_t)kv * 524288);
    for (int i = 0; i < 16; ++i) { const int row = (tid >> 6) + 8 * i; float s = b2;
#pragma unroll 8
        for (int f = 0; f < 128; ++f) s += bf1(Ht[row * 136 + f]) * W2[f * 64 + d];
        const int mm = m0 + row, g = mm >> 11, bi = mm & 2047;
        dstb[((size_t)bi * 2 + g) * 64 + d] = f2bf(s); }
    __syncthreads();
}

__device__ __forceinline__ void diff_unit(PRef p, int l, int u, LAS unsigned char* lds, bool dry = false) {
    int tid_ = threadIdx.x; asm volatile("" : "+v"(tid_));
    const int tid = tid_, lane = tid & 63, r32 = lane & 31, hi = lane >> 5, wid = __builtin_amdgcn_readfirstlane(tid >> 6);
    unsigned char* ws = p.ws;
    const int c = 15 - (u >> 6), b = (u & 63) >> 2, hd = u & 3;
    const int cm = wid >> 2, qq = wid & 3, t0 = 128 * c + 32 * qq, tq = t0 + r32;
    const size_t tokb = (size_t)b * TSEQ;
    bf16_t* DQ = (bf16_t*)(ws + WS_DQ); const bf16_t* DK = (const bf16_t*)(ws + WS_DK); const bf16_t* DV = (const bf16_t*)(ws + WS_DV);
    bf16x8 qr[4];
    { const bf16_t* qp = DQ + (tokb + tq) * 512 + hd * 128 + cm * 64 + hi * 8;
#pragma unroll
      for (int d0 = 0; d0 < 4; ++d0) qr[d0] = *(const bf16x8*)(qp + d0 * 16); }
    asm volatile("" : "+v"(qr[0]), "+v"(qr[1]), "+v"(qr[2]), "+v"(qr[3]));
    const float sl2 = alibi_slope(9 + hd) * LOG2E;
    const float cbh = sl2 * (float)(4 * hi);
#define CB(r) fmaf(sl2, (float)(((r) & 3) + 8 * ((r) >> 2)), cbh)
    f32x16 o[4];
#pragma unroll
    for (int d = 0; d < 4; ++d) o[d] = (f32x16){0.f};
    float m = NEG, lsum = 0.f;
    LAS float* wsf = (LAS float*)(lds + LDS_MISC + 1024 + wid * 128);
    const int jmax_w = (t0 + 31) >> 6;
    u32x4 rk0, rk1, rv0, rv1;
    const int srow = tid >> 3, sch = tid & 7, skw = kswz(srow, sch);
    const int vpw = tid >> 6, vln = tid & 63;
    const bf16_t* kbase = DK + tokb * 512 + hd * 128 + (size_t)srow * 512 + sch * 8;
    const bf16_t* vbase = DV + tokb * 512 + hd * 128 + (size_t)(16 * (vpw & 3) + (vln >> 2)) * 512 + (vpw >> 2) * 32 + (vln & 3) * 8;
#define DLOAD(j) do { const size_t to_ = (size_t)(64 * (j)) * 512; rk0 = *(const u32x4*)(kbase + to_); rk1 = *(const u32x4*)(kbase + to_ + 64); rv0 = *(const u32x4*)(vbase + to_); rv1 = *(const u32x4*)(vbase + to_ + 64); } while (0)
#define DWRITE(sl) do { LAS unsigned char* b_ = lds + (sl) * 32768; *(LAS u32x4*)(b_ + skw) = rk0; *(LAS u32x4*)(b_ + 8192 + skw) = rk1; \
        *(LAS u32x4*)(b_ + 16384 + vpw * 1024 + vln * 16) = rv0; *(LAS u32x4*)(b_ + 16384 + (vpw + 8) * 1024 + vln * 16) = rv1; } while (0)
    int slot = 0;
    DLOAD(2 * c + 1);
    __syncthreads();
    DWRITE(0);
    __syncthreads();
    for (int j = 2 * c + 1; j >= 0; --j) {
        if (j > 0) DLOAD(j - 1);
        LAS unsigned char* Kt = lds + slot * 32768; LAS unsigned char* Vt = Kt + 16384;
        if (j <= jmax_w) {
            f32x16 s0, s1; qkt(s0, s1, Kt + cm * 8192, qr, r32, hi);
            const float tc = sl2 * (float)(64 * j - 128 * c);
            const bool diag = (64 * j + 63 > t0); const int lim = tq - 64 * j;
#pragma unroll
            for (int r = 0; r < 16; ++r) { s0[r] += CB(r) + tc; s1[r] += CB(r) + (tc + 32.f * sl2);
                if (diag) { if (crow(r, hi) > lim) s0[r] = NEG; if (crow(r, hi) + 32 > lim) s1[r] = NEG; } }
            softmax_pv<4>(s0, s1, m, lsum, o, wsf, Vt, lane, r32, hi);
        }
        if (j > 0) DWRITE(slot ^ 1);
        __syncthreads();
        slot ^= 1;
    }
#undef DLOAD
#undef DWRITE
    const float lam = ((const float*)(ws + WS_MISC + 4096))[l];
    const float lam_init = 0.8f - 0.6f * expf(-0.3f * (float)l);
    const float ltot = lsum + __shfl_xor(lsum, 32);
    if (hi == 0) wsf[r32] = (cm == 0 ? 1.f : lam) / ltot;
    LAS float* X = (LAS float*)(lds + cm * 65536);
#pragma unroll
    for (int r = 0; r < 16; ++r) { const float f = wsf[crow(r, hi)]; const int q = 32 * qq + crow(r, hi);
#pragma unroll
        for (int d = 0; d < 4; ++d) X[q * 128 + d * 32 + r32] = o[d][r] * f; }
    __syncthreads();
    { const int q = tid >> 2, qt = tid & 3; LAS const float* x0 = (LAS const float*)lds + q * 128 + qt * 32; LAS const float* x1 = x0 + 16384;
      float v[32]; float ss = 0.f;
#pragma unroll
      for (int i = 0; i < 32; ++i) { v[i] = x0[i] - x1[i]; ss += v[i] * v[i]; }
      ss += __shfl_xor(ss, 1); ss += __shfl_xor(ss, 2);
      const float rstd = rsqrtf(ss * (1.f / 128.f) + 1e-5f) * (1.f - lam_init);
      const float* sg = p.diff_subln_g + l * 128 + qt * 32;
      bf16_t* dst = (dry ? (bf16_t*)(ws + WS_XN) + (size_t)NTOK * 512 : DQ) + (tokb + 128 * c + q) * 512 + hd * 128 + qt * 32;
#pragma unroll
      for (int i = 0; i < 32; i += 8) { u32x4 w; w.x = cvtpk(v[i] * rstd * sg[i], v[i + 1] * rstd * sg[i + 1]); w.y = cvtpk(v[i + 2] * rstd * sg[i + 2], v[i + 3] * rstd * sg[i + 3]);
          w.z = cvtpk(v[i + 4] * rstd * sg[i + 4], v[i + 5] * rstd * sg[i + 5]); w.w = cvtpk(v[i + 6] * rstd * sg[i + 6], v[i + 7] * rstd * sg[i + 7]); *(u32x4*)(dst + i) = w; } }
    __syncthreads();
}

__device__ __forceinline__ void nsa_unit(PRef p, int l, int u, LAS unsigned char* lds, bool dry = false) {
    int tid_ = threadIdx.x; asm volatile("" : "+v"(tid_));
    const int tid = tid_, lane = tid & 63, r32 = lane & 31, hi = lane >> 5, wid = __builtin_amdgcn_readfirstlane(tid >> 6);
    unsigned char* ws = p.ws;
    const int c = 31 - (u >> 5), b = (u & 31) >> 1, g = u & 1;
    const int hl = wid >> 1, qh = wid & 1, h = g * 4 + hl, t0 = 64 * c + 32 * qh, tq = t0 + r32, ql = 32 * qh + r32;
    const size_t tokb = (size_t)b * TSEQ;
    bf16_t* NQ = (bf16_t*)(ws + WS_NQ); const bf16_t* KV6 = (const bf16_t*)(ws + WS_KV6); const bf16_t* NG = (const bf16_t*)(ws + WS_NG);
    const bf16_t* KC = (const bf16_t*)(ws + WS_MISC + 65536); const bf16_t* VC = (const bf16_t*)(ws + WS_MISC + 65536 + 524288);
    bf16x8 qr[4];
    { const bf16_t* qp = NQ + (tokb + tq) * 512 + h * 64 + hi * 8;
#pragma unroll
      for (int d0 = 0; d0 < 4; ++d0) qr[d0] = *(const bf16x8*)(qp + d0 * 16); }
    const float sl2 = alibi_slope(h + 1) * LOG2E;
    const float cbh = sl2 * (float)(4 * hi);
    LAS float* wsf = (LAS float*)(lds + LDS_MISC + 1024 + wid * 128);
    LAS unsigned char* Kt = lds; LAS unsigned char* Vt = lds + 16384;
    LAS float* IMPH = (LAS float*)(lds + 32768);
    LAS float* VAL = (LAS float*)(lds + 65536);
    LAS unsigned* MASK = (LAS unsigned*)(lds + 73728);
    float g0 = bf1(NG[(tokb + tq) * 32 + h * 3 + 0]), g1 = bf1(NG[(tokb + tq) * 32 + h * 3 + 1]), g2 = bf1(NG[(tokb + tq) * 32 + h * 3 + 2]);
    asm volatile("" : "+v"(qr[0]), "+v"(qr[1]), "+v"(qr[2]), "+v"(qr[3]), "+v"(g0), "+v"(g1), "+v"(g2));
    f32x16 oacc[2];
    __syncthreads();
    { const bf16_t* ksrc = KC + ((size_t)b * 128 * 2 + g) * 64; const bf16_t* vsrc = VC + ((size_t)b * 128 * 2 + g) * 64;
      stage_k(Kt, ksrc, 128, tid); stage_k(Kt + 8192, ksrc + 64 * 128, 128, tid);
      stage_v<2>(Vt, vsrc, 128, tid); stage_v<2>(Vt + 8192, vsrc + 64 * 128, 128, tid);
      if (tid < 64) MASK[tid] = 0u; }
    __syncthreads();
    {
        f32x16 s[4];
        qkt(s[0], s[1], Kt, qr, r32, hi); qkt(s[2], s[3], Kt + 8192, qr, r32, hi);
        int nmax = (tq - 31) >> 4; if (nmax > 126) nmax = 126;
        float rm = NEG;
#pragma unroll
        for (int k = 0; k < 4; ++k)
#pragma unroll
            for (int r = 0; r < 16; ++r) { const int n = 32 * k + crow(r, hi); float v = s[k][r] + 16.f * CB(r) + sl2 * (float)(512 * k);
                v = (n <= nmax) ? v : NEG; s[k][r] = v; rm = fmaxf(rm, v); }
        rm = fmaxf(rm, __shfl_xor(rm, 32));
        float sum = 0.f;
#pragma unroll
        for (int k = 0; k < 4; ++k)
#pragma unroll
            for (int r = 0; r < 16; ++r) { const float e = ex2(s[k][r] - rm); s[k][r] = e; sum += e; }
        sum += __shfl_xor(sum, 32);
        const float inv = (nmax >= 0) ? 1.f / sum : 0.f;
#pragma unroll
        for (int k = 0; k < 4; ++k)
#pragma unroll
            for (int r = 0; r < 16; ++r) s[k][r] *= inv;
        float prev = 0.f;
#pragma unroll
        for (int k = 0; k < 4; ++k)
#pragma unroll
            for (int a = 0; a < 4; ++a) { const int i = 4 * k + a; const float Bi = 0.5f * s[k][4 * a + 3]; const float Ai = (s[k][4 * a] + s[k][4 * a + 1]) + (s[k][4 * a + 2] + Bi);
                const float rc = __shfl_xor(Bi, 32); const float add = hi ? rc : prev; prev = rc;
                IMPH[(hl * 64 + ql) * 32 + 2 * i + hi] = Ai + add; }
        f32x16 o[2]; o[0] = (f32x16){0.f}; o[1] = (f32x16){0.f};
        pv<2>(o, s[0], s[1], Vt, lane, hi); pv<2>(o, s[2], s[3], Vt + 8192, lane, hi);
        if (hi == 0) wsf[r32] = g0;
#pragma unroll
        for (int r = 0; r < 16; ++r) { const float f = wsf[crow(r, hi)]; oacc[0][r] = o[0][r] * f; oacc[1][r] = o[1][r] * f; }
        asm volatile("" : "+v"(oacc[0]), "+v"(oacc[1]));
    }
    __syncthreads();
    { const int q = tid >> 3, mg = tid & 7;
#pragma unroll
      for (int i = 0; i < 4; ++i) { const int mb = 4 * mg + i; float v = ((IMPH[(0 * 64 + q) * 32 + mb] + IMPH[(1 * 64 + q) * 32 + mb]) + IMPH[(2 * 64 + q) * 32 + mb]) + IMPH[(3 * 64 + q) * 32 + mb];
          if (mb == 0 || mb == c || mb == c - 1) v = 1e9f; if (mb > c) v = -1.f; VAL[q * 32 + mb] = v; } }
    __syncthreads();
    { const int q = tid >> 3, mg = tid & 7; unsigned bits = 0u;
      float mine[4];
#pragma unroll
      for (int i = 0; i < 4; ++i) mine[i] = VAL[q * 32 + 4 * mg + i];
      int cnt0 = 0, cnt1 = 0, cnt2 = 0, cnt3 = 0;
#pragma unroll 4
      for (int m2 = 0; m2 < 32; ++m2) { const float v2 = VAL[q * 32 + m2]; const int rel = m2 - 4 * mg;
          cnt0 += (int)(v2 > mine[0]) | ((int)(v2 == mine[0]) & (int)(rel < 0));
          cnt1 += (int)(v2 > mine[1]) | ((int)(v2 == mine[1]) & (int)(rel < 1));
          cnt2 += (int)(v2 > mine[2]) | ((int)(v2 == mine[2]) & (int)(rel < 2));
          cnt3 += (int)(v2 > mine[3]) | ((int)(v2 == mine[3]) & (int)(rel < 3)); }
      bits = ((cnt0 < 8) ? 1u : 0u) | ((cnt1 < 8) ? 2u : 0u) | ((cnt2 < 8) ? 4u : 0u) | ((cnt3 < 8) ? 8u : 0u);
      bits <<= 4 * mg;
      if (bits) __hip_atomic_fetch_or(&MASK[q], bits, __ATOMIC_RELAXED, __HIP_MEMORY_SCOPE_WORKGROUP); }
    __syncthreads();
    const unsigned vmask = (c >= 31) ? 0xffffffffu : ((2u << c) - 1u);
    if (wid == 0) { unsigned mk = MASK[lane] & vmask;
#pragma unroll
        for (int o_ = 1; o_ < 64; o_ <<= 1) mk |= __shfl_xor(mk, o_);
        if (lane == 0) MASK[64] = mk; }
    __syncthreads();
    const unsigned mymask = MASK[ql] & vmask;
    unsigned uni = __builtin_amdgcn_readfirstlane(MASK[64]);
    {
        f32x16 o[2]; o[0] = (f32x16){0.f}; o[1] = (f32x16){0.f}; float m = NEG, lsum = 0.f;
        const int jlo = c - 8 < 0 ? 0 : c - 8;
        unsigned rem = uni; int jw = c;
        u32x4 rk, rv;
        const int srow = tid >> 3, sch = tid & 7, skw = kswz(srow, sch), vpw = tid >> 6, vln = tid & 63;
        const bf16_t* kbase = KV6 + tokb * 768 + g * 64 + (size_t)srow * 768 + sch * 8;
        const bf16_t* vbase = KV6 + tokb * 768 + g * 64 + 128 + (size_t)(16 * (vpw & 3) + (vln >> 2)) * 768 + (vpw >> 2) * 32 + (vln & 3) * 8;
#define NNEXT(jv, kv_) do { if (rem) { jv = 31 - __builtin_clz(rem); rem &= ~(1u << jv); kv_ = 1; } else if (jw >= jlo) { jv = jw; --jw; kv_ = 2; } else { jv = 0; kv_ = 0; } } while (0)
#define NLOAD(jv, kv_) do { const size_t to_ = (size_t)(64 * (jv)) * 768 + ((kv_) == 1 ? 256 : 512); rk = *(const u32x4*)(kbase + to_); rv = *(const u32x4*)(vbase + to_); } while (0)
#define NWRITE(sl) do { LAS unsigned char* b_ = lds + (sl) * 16384; *(LAS u32x4*)(b_ + skw) = rk; *(LAS u32x4*)(b_ + 8192 + vpw * 1024 + vln * 16) = rv; } while (0)
        int jc, kc, jn, kn, slot = 0;
        NNEXT(jc, kc);
        NLOAD(jc, kc);
        __syncthreads();
        NWRITE(0);
        __syncthreads();
        while (kc) {
            NNEXT(jn, kn);
            if (kn) NLOAD(jn, kn);
            LAS unsigned char* Kt2 = lds + slot * 16384; LAS unsigned char* Vt2 = Kt2 + 8192;
            const bool sel = (kc == 2) || ((mymask >> jc) & 1u);
            if (__any(sel)) {
                f32x16 s0, s1; qkt(s0, s1, Kt2, qr, r32, hi);
                const float tc = sl2 * (float)(64 * (jc - c));
                const int lim = (jc == c) ? ql : 64;
                const int low = (kc == 2 && jc == c - 8) ? ql : -1;
#pragma unroll
                for (int r = 0; r < 16; ++r) { s0[r] += CB(r) + tc; s1[r] += CB(r) + (tc + 32.f * sl2);
                    const int k0 = crow(r, hi), k1 = k0 + 32;
                    if (!sel || k0 > lim || k0 <= low) s0[r] = NEG; if (!sel || k1 > lim || k1 <= low) s1[r] = NEG; }
                softmax_pv<2>(s0, s1, m, lsum, o, wsf, Vt2, lane, r32, hi);
            }
            if (kn != kc) {
                const float ltot = lsum + __shfl_xor(lsum, 32);
                if (hi == 0) wsf[r32] = (kc == 1 ? g1 : g2) / ltot;
#pragma unroll
                for (int r = 0; r < 16; ++r) { const float f = wsf[crow(r, hi)]; oacc[0][r] += o[0][r] * f; oacc[1][r] += o[1][r] * f; }
                asm volatile("" : "+v"(oacc[0]), "+v"(oacc[1]));
                o[0] = (f32x16){0.f}; o[1] = (f32x16){0.f}; m = NEG; lsum = 0.f;
            }
            if (kn) NWRITE(slot ^ 1);
            __syncthreads();
            slot ^= 1; jc = jn; kc = kn;
        }
#undef NNEXT
#undef NLOAD
#undef NWRITE
    }
#pragma unroll
    for (int r = 0; r < 16; ++r) { bf16_t* dst = (dry ? (bf16_t*)(ws + WS_XN) : NQ) + (tokb + t0 + crow(r, hi)) * 512 + h * 64 + r32; dst[0] = f2bf(oacc[0][r]); dst[32] = f2bf(oacc[1][r]); }
    __syncthreads();
}

__device__ __forceinline__ int next_unit(unsigned* ctr, LAS unsigned char* lds) {
    LAS int* bc = (LAS int*)(lds + LDS_MISC);
    __syncthreads();
    if (threadIdx.x == 0) bc[0] = (int)__hip_atomic_fetch_add(ctr, 1u, __ATOMIC_RELAXED, __HIP_MEMORY_SCOPE_AGENT);
    __syncthreads();
    return __builtin_amdgcn_readfirstlane(bc[0]);
}

__device__ __forceinline__ void phase_merge(PRef p, int l, LAS unsigned char* lds) {
    SG_IDS
    unsigned char* ws = p.ws;
    const bf16_t* YA = (const bf16_t*)(ws + WS_NQ); const bf16_t* YB = (const bf16_t*)(ws + WS_DQ);
    const bf16_t* WA = (const bf16_t*)(ws + WS_WA) + (size_t)l * DM * 512; const bf16_t* WB = (const bf16_t*)(ws + WS_WB) + (size_t)l * DM * 512;
    const bf16_t* GA = (const bf16_t*)(ws + WS_GA); const bf16_t* GB = (const bf16_t*)(ws + WS_GB); bf16_t* MG = (bf16_t*)(ws + WS_XN);
    for (int u = blockIdx.x; u < 256 * 8; u += gridDim.x) {
        const int pm = (u >> 7) * 16 + (u & 15), pn = (u >> 4) & 7, m0 = pm * 128, n0 = pn * 128;
        f32x4 acc[2][4], t[2][4]; SG_ZERO(acc);
        sg_kloop(acc, ARowLin{(const char*)(YA + (size_t)m0 * 512), 1024}, 128, WA + (size_t)n0 * 512, 512, 8, lds);
#pragma unroll
        for (int m = 0; m < 2; ++m)
#pragma unroll
            for (int n = 0; n < 4; ++n) { const u32x2 gw = *(const u32x2*)(GA + (size_t)(m0 + SG_ROW(m)) * DM + n0 + SG_COL(n));
                t[m][n] = acc[m][n] * (f32x4){bflo(gw.x), bfhi(gw.x), bflo(gw.y), bfhi(gw.y)}; }
        SG_ZERO(acc);
        sg_kloop(acc, ARowLin{(const char*)(YB + (size_t)m0 * 512), 1024}, 128, WB + (size_t)n0 * 512, 512, 8, lds);
#pragma unroll
        for (int m = 0; m < 2; ++m)
#pragma unroll
            for (int n = 0; n < 4; ++n) { const size_t off = (size_t)(m0 + SG_ROW(m)) * DM + n0 + SG_COL(n); const u32x2 gw = *(const u32x2*)(GB + off);
                st4bf(MG + off, t[m][n] + acc[m][n] * (f32x4){bflo(gw.x), bfhi(gw.x), bflo(gw.y), bfhi(gw.y)}); }
    }
}
__device__ __forceinline__ void phase_outproj(PRef p, int l, LAS unsigned char* lds) {
    SG_IDS
    unsigned char* ws = p.ws;
    const bf16_t* MG = (const bf16_t*)(ws + WS_XN); const bf16_t* WO = (const bf16_t*)(ws + WS_WO) + (size_t)l * DM * DM;
    const float* hin = (l == 0) ? p.x : p.out; float* hout = p.out;
    for (int u = blockIdx.x; u < 256 * 8; u += gridDim.x) {
        const int pm = (u >> 7) * 16 + (u & 15), pn = (u >> 4) & 7, m0 = pm * 128, n0 = pn * 128;
        f32x4 acc[2][4]; SG_ZERO(acc);
        sg_kloop(acc, ARowLin{(const char*)(MG + (size_t)m0 * DM), 2048}, 128, WO + (size_t)n0 * DM, DM, 16, lds);
#pragma unroll
        for (int m = 0; m < 2; ++m)
#pragma unroll
            for (int n = 0; n < 4; ++n) { const size_t off = (size_t)(m0 + SG_ROW(m)) * DM + n0 + SG_COL(n); *(f32x4*)(hout + off) = *(const f32x4*)(hin + off) + acc[m][n]; }
    }
}

constexpr size_t WS_RSTD = WS_MISC + 2 * MiB;
__device__ __forceinline__ void phase_router(PRef p, int l, LAS unsigned char* lds, bool dry = false) {
    int tid_ = threadIdx.x; asm volatile("" : "+v"(tid_));
    const int tid = tid_, lane = tid & 63, wid = tid >> 6;
    unsigned char* ws = p.ws;
    constexpr int WP = 1028;
    LAS float* WT = (LAS float*)lds;
    LAS unsigned* cntl = (LAS unsigned*)(lds + 82432);
    LAS unsigned* lbase = (LAS unsigned*)(lds + 82432 + 64);
    LAS unsigned* loc = (LAS unsigned*)(lds + 82560);
    LAS float* wloc = (LAS float*)(lds + 82560 + 16384);
    LAS float* GL = (LAS float*)(lds + 115328);
    const float* gwp = p.router_grp_w + (size_t)l * DM * 4; const float* ewp = p.router_exp_w + (size_t)l * DM * 16;
    const float* g2 = p.norm2_g + (size_t)l * DM;
    __syncthreads();
    for (int k = tid; k < DM; k += 512) {
        const float gk = g2[k]; GL[k] = gk;
        const f32x4 a = *(const f32x4*)(gwp + k * 4);
#pragma unroll
        for (int i = 0; i < 4; ++i) WT[i * WP + k] = a[i] * gk;
#pragma unroll
        for (int q4 = 0; q4 < 4; ++q4) { const f32x4 e = *(const f32x4*)(ewp + k * 16 + q4 * 4);
#pragma unroll
            for (int i = 0; i < 4; ++i) WT[(4 + q4 * 4 + i) * WP + k] = e[i] * gk; }
    }
    const float* gb = p.router_grp_b + l * 4; const float* eb = p.router_exp_b + l * 16;
    unsigned* ecnt = (unsigned*)(ws + WS_CTL) + CW_ECNT + 64 * l + (dry ? 32 : 0);
    unsigned* LIST = (unsigned*)(ws + (dry ? WS_NQ : WS_LIST)); float* WL = (float*)(ws + (dry ? WS_NQ + 4 * MiB : WS_WL));
    bf16_t* XN = (bf16_t*)(ws + WS_XN); float* RSTD = (float*)(ws + WS_RSTD);
    const int n = lane & 15, kq = lane >> 4;
    for (int ch = blockIdx.x; ch < NTOK / 128; ch += gridDim.x) {
        __syncthreads();
        if (tid < 16) cntl[tid] = 0u;
        __syncthreads();
        const int tok = ch * 128 + wid * 16 + n;
        const float* xr = p.out + (size_t)tok * DM + kq * 256;
        bf16_t* xo = XN + (size_t)tok * DM + kq * 256;
        LAS const float* w0 = WT + n * WP + kq * 256;
        LAS const float* w1 = WT + (16 + (n & 3)) * WP + kq * 256;
        f32x4 acc0 = {0.f, 0.f, 0.f, 0.f}, acc1 = {0.f, 0.f, 0.f, 0.f}; float ss = 0.f;
        f32x4 xa[8], xb[8];
#pragma unroll
        for (int u = 0; u < 8; ++u) xa[u] = *(const f32x4*)(xr + 4 * u);
#define ROUTER_BATCH(XC, XN_, jb) do { \
        if ((jb) + 8 < 64) { _Pragma("unroll") for (int u = 0; u < 8; ++u) XN_[u] = *(const f32x4*)(xr + 4 * ((jb) + 8 + u)); } \
        _Pragma("unroll") for (int u = 0; u < 8; ++u) { const int jj = (jb) + u; const f32x4 xv = XC[u], gv = *(LAS const f32x4*)(GL + kq * 256 + 4 * jj); \
            const f32x4 a0 = *(LAS const f32x4*)(w0 + 4 * jj), a1 = *(LAS const f32x4*)(w1 + 4 * jj); \
            ss += (xv[0] * xv[0] + xv[1] * xv[1]) + (xv[2] * xv[2] + xv[3] * xv[3]); \
            st4bf(xo + 4 * jj, xv * gv); \
            _Pragma("unroll") for (int i = 0; i < 4; ++i) { acc0 = __builtin_amdgcn_mfma_f32_16x16x4f32(a0[i], xv[i], acc0, 0, 0, 0); acc1 = __builtin_amdgcn_mfma_f32_16x16x4f32(a1[i], xv[i], acc1, 0, 0, 0); } } } while (0)
        for (int jb = 0; jb < 64; jb += 16) { ROUTER_BATCH(xa, xb, jb); ROUTER_BATCH(xb, xa, jb + 8); }
#undef ROUTER_BATCH
        ss += __shfl_xor(ss, 16); ss += __shfl_xor(ss, 32);
        const float rstd = rsqrtf(ss * (1.f / 1024.f) + 1e-6f);
        if (kq == 0) RSTD[tok] = rstd;
        int gi = 0; float gwt = 0.f;
        { float gl[4];
#pragma unroll
          for (int r = 0; r < 4; ++r) gl[r] = acc0[r] * rstd + gb[r];
          float gm = gl[0];
#pragma unroll
          for (int r = 1; r < 4; ++r) if (gl[r] > gm) { gm = gl[r]; gi = r; }
          float gs = 0.f;
#pragma unroll
          for (int r = 0; r < 4; ++r) gs += __expf(gl[r] - gm);
          gwt = 1.f / gs; }
        gi = __shfl(gi, n); gwt = __shfl(gwt, n);
        const int mygrp = (kq == 0) ? 3 : kq - 1;
        if (mygrp == gi) {
            float el[4];
#pragma unroll
            for (int r = 0; r < 4; ++r) el[r] = ((kq == 0) ? acc1[r] : acc0[r]) * rstd + eb[mygrp * 4 + r];
            int i1 = 0; float v1 = el[0];
#pragma unroll
            for (int e = 1; e < 4; ++e) if (el[e] > v1) { v1 = el[e]; i1 = e; }
            int i2 = -1; float v2 = -3.0e38f;
#pragma unroll
            for (int e = 0; e < 4; ++e) if (e != i1 && el[e] > v2) { v2 = el[e]; i2 = e; }
            const float ex = __expf(v2 - v1), w1_ = gwt / (1.f + ex), w2_ = gwt * ex / (1.f + ex);
            const int e1 = gi * 4 + i1, e2 = gi * 4 + i2;
            const unsigned s1 = __hip_atomic_fetch_add(&cntl[e1], 1u, __ATOMIC_RELAXED, __HIP_MEMORY_SCOPE_WORKGROUP); loc[e1 * 256 + s1] = (unsigned)tok * 2u; wloc[e1 * 256 + s1] = w1_;
            const unsigned s2 = __hip_atomic_fetch_add(&cntl[e2], 1u, __ATOMIC_RELAXED, __HIP_MEMORY_SCOPE_WORKGROUP); loc[e2 * 256 + s2] = (unsigned)tok * 2u + 1u; wloc[e2 * 256 + s2] = w2_;
        }
        __syncthreads();
        if (tid < 16) lbase[tid] = __hip_atomic_fetch_add(&ecnt[tid], cntl[tid], __ATOMIC_RELAXED, __HIP_MEMORY_SCOPE_AGENT);
        __syncthreads();
        for (int e = 0; e < 16; ++e) { const unsigned nn = cntl[e], bs = lbase[e];
            for (unsigned i = tid; i < nn; i += 512) { LIST[(size_t)e * NTOK + bs + i] = loc[e * 256 + i]; WL[(size_t)e * NTOK + bs + i] = wloc[e * 256 + i]; } }
    }
}

struct MoeUnit { int e, tile, n, hoff; };
__device__ __forceinline__ bool moe_find(LAS const int* cnts, int ut, MoeUnit& mu) {
    int pre = 0;
    for (int e = 0; e < 16; ++e) { const int cn = cnts[e], nt = (cn + 127) >> 7; if (ut < pre + nt) { mu.e = e; mu.tile = ut - pre; mu.n = cn - mu.tile * 128; if (mu.n > 128) mu.n = 128; mu.hoff = (pre + mu.tile) * 128; return true; } pre += nt; }
    return false;
}
__device__ __forceinline__ void phase_moe1(PRef p, int l, LAS unsigned char* lds) {
    SG_IDS
    unsigned char* ws = p.ws;
    LAS int* cnts = (LAS int*)(lds + LDS_MISC + 64);
    const unsigned* ecnt = (const unsigned*)(ws + WS_CTL) + CW_ECNT + 64 * l;
    __syncthreads();
    if (tid < 16) cnts[tid] = (int)__hip_atomic_load(&ecnt[tid], __ATOMIC_RELAXED, __HIP_MEMORY_SCOPE_AGENT);
    __syncthreads();
    const unsigned* LIST = (const unsigned*)(ws + WS_LIST); const float* WL = (const float*)(ws + WS_WL);
    const char* XN = (const char*)(ws + WS_XN); bf16_t* H = (bf16_t*)(ws + WS_H);
    for (int ut = blockIdx.x;; ut += gridDim.x) {
        MoeUnit mu; if (!moe_find(cnts, ut, mu)) break;
        const unsigned* lst = LIST + (size_t)mu.e * NTOK + mu.tile * 128;
        const bf16_t* W = (const bf16_t*)(ws + WS_WGU) + (size_t)(l * 16 + mu.e) * 256 * DM;
        f32x4 ag[2][4], au[2][4]; SG_ZERO(ag); SG_ZERO(au);
        sg_kloop(ag, ARowGather{lst, mu.n, XN}, 128, W, DM, 16, lds);
        sg_kloop(au, ARowGather{lst, mu.n, XN}, 128, W + (size_t)128 * DM, DM, 16, lds);
        const float* wl = WL + (size_t)mu.e * NTOK + mu.tile * 128;
#pragma unroll
        for (int m = 0; m < 2; ++m) { const int rl = SG_ROW(m); const float wgt = (rl < mu.n) ? wl[rl] : 0.f;
            const float rs = ((const float*)(ws + WS_RSTD))[lst[rl < mu.n ? rl : mu.n - 1] >> 1];
#pragma unroll
            for (int n = 0; n < 4; ++n) { f32x4 gv = ag[m][n] * rs, uv = au[m][n] * rs, hv;
#pragma unroll
                for (int i = 0; i < 4; ++i) hv[i] = gv[i] * sigm(gv[i]) * uv[i] * wgt;
                st4bf(H + (size_t)(mu.hoff + rl) * 128 + SG_COL(n), hv); } }
    }
}
__device__ __forceinline__ void phase_moe2(PRef p, int l, LAS unsigned char* lds) {
    SG_IDS
    unsigned char* ws = p.ws;
    LAS int* cnts = (LAS int*)(lds + LDS_MISC + 64);
    const unsigned* ecnt = (const unsigned*)(ws + WS_CTL) + CW_ECNT + 64 * l;
    __syncthreads();
    if (tid < 16) cnts[tid] = (int)__hip_atomic_load(&ecnt[tid], __ATOMIC_RELAXED, __HIP_MEMORY_SCOPE_AGENT);
    __syncthreads();
    const unsigned* LIST = (const unsigned*)(ws + WS_LIST); const bf16_t* H = (const bf16_t*)(ws + WS_H);
    bf16_t* Y0 = (bf16_t*)(ws + WS_GA); bf16_t* Y1 = (bf16_t*)(ws + WS_GB);
    for (int u = blockIdx.x;; u += gridDim.x) {
        MoeUnit mu; if (!moe_find(cnts, u >> 3, mu)) break;
        const int pn = u & 7;
        const unsigned* lst = LIST + (size_t)mu.e * NTOK + mu.tile * 128;
        const bf16_t* W = (const bf16_t*)(ws + WS_WD) + (size_t)(l * 16 + mu.e) * DM * 128 + (size_t)pn * 128 * 128;
        f32x4 acc[2][4]; SG_ZERO(acc);
        sg_kloop(acc, ARowLin{(const char*)(H + (size_t)mu.hoff * 128), 256}, 128, W, 128, 2, lds);
#pragma unroll
        for (int m = 0; m < 2; ++m) { const int rl = SG_ROW(m);
            if (rl < mu.n) { const unsigned ent = lst[rl]; bf16_t* dst = ((ent & 1u) ? Y1 : Y0) + (size_t)(ent >> 1) * DM + pn * 128;
#pragma unroll
                for (int n = 0; n < 4; ++n) st4bf(dst + SG_COL(n), acc[m][n]); } }
    }
}


__device__ __forceinline__ void phase_moe_fused(PRef p, int l, LAS unsigned char* lds) {
    SG_IDS
    unsigned char* ws = p.ws;
    LAS int* cnts = (LAS int*)(lds + LDS_MISC + 64);
    const unsigned* ecnt = (const unsigned*)(ws + WS_CTL) + CW_ECNT + 64 * l;
    __syncthreads();
    if (tid < 16) cnts[tid] = (int)__hip_atomic_load(&ecnt[tid], __ATOMIC_RELAXED, __HIP_MEMORY_SCOPE_AGENT);
    __syncthreads();
    const unsigned* LIST = (const unsigned*)(ws + WS_LIST); const float* WL = (const float*)(ws + WS_WL);
    const char* XN = (const char*)(ws + WS_XN); const float* RSTD = (const float*)(ws + WS_RSTD);
    bf16_t* Y0 = (bf16_t*)(ws + WS_GA); bf16_t* Y1 = (bf16_t*)(ws + WS_GB);
    const int lrow = tid >> 3, lch = tid & 7;
    const int wofs0 = lrow * 128 + ((lch ^ ((lrow >> 1) & 7)) << 4), wofs1 = wofs0 + 64 * 128;
    LAS unsigned char* As = lds; LAS unsigned char* Bg = lds + 16384; LAS unsigned char* Bu = lds + 32768; LAS unsigned char* Hs = lds + 49152;
    for (int ut = blockIdx.x;; ut += gridDim.x) {
        MoeUnit mu; if (!moe_find(cnts, ut, mu)) break;
        const unsigned* lst = LIST + (size_t)mu.e * NTOK + mu.tile * 128;
        const bf16_t* W = (const bf16_t*)(ws + WS_WGU) + (size_t)(l * 16 + mu.e) * 256 * DM;
        f32x4 ag[2][4], au[2][4]; SG_ZERO(ag); SG_ZERO(au);
        {
            const unsigned e0 = lst[lrow < mu.n ? lrow : mu.n - 1], e1 = lst[lrow + 64 < mu.n ? lrow + 64 : mu.n - 1];
            const char* pa0 = XN + (size_t)(e0 >> 1) * 2048 + lch * 16; const char* pa1 = XN + (size_t)(e1 >> 1) * 2048 + lch * 16;
            const char* pg0 = (const char*)(W + (size_t)lrow * DM) + lch * 16; const char* pg1 = (const char*)(W + (size_t)(lrow + 64) * DM) + lch * 16;
            const char* pu0 = pg0 + (size_t)128 * DM * 2; const char* pu1 = pg1 + (size_t)128 * DM * 2;
            u32x4 ra0 = *(const u32x4*)pa0, ra1 = *(const u32x4*)pa1, rg0 = *(const u32x4*)pg0, rg1 = *(const u32x4*)pg1, ru0 = *(const u32x4*)pu0, ru1 = *(const u32x4*)pu1;
            for (int t = 0; t < 16; ++t) {
                __syncthreads();
                *(LAS u32x4*)(As + wofs0) = ra0; *(LAS u32x4*)(As + wofs1) = ra1; *(LAS u32x4*)(Bg + wofs0) = rg0; *(LAS u32x4*)(Bg + wofs1) = rg1; *(LAS u32x4*)(Bu + wofs0) = ru0; *(LAS u32x4*)(Bu + wofs1) = ru1;
                __syncthreads();
                if (t + 1 < 16) { pa0 += 128; pa1 += 128; pg0 += 128; pg1 += 128; pu0 += 128; pu1 += 128;
                    ra0 = *(const u32x4*)pa0; ra1 = *(const u32x4*)pa1; rg0 = *(const u32x4*)pg0; rg1 = *(const u32x4*)pg1; ru0 = *(const u32x4*)pu0; ru1 = *(const u32x4*)pu1; }
#pragma unroll
                for (int ks = 0; ks < 2; ++ks) {
                    bf16x8 af[2], bg[4], bu[4];
                    const int ch = ks * 4 + fq;
#pragma unroll
                    for (int m = 0; m < 2; ++m) { const int row = wr * 32 + m * 16 + fr; af[m] = *(LAS const bf16x8*)(As + row * 128 + ((ch ^ ((row >> 1) & 7)) << 4)); }
#pragma unroll
                    for (int n = 0; n < 4; ++n) { const int row = wc * 64 + n * 16 + fr; const int o_ = row * 128 + ((ch ^ ((row >> 1) & 7)) << 4); bg[n] = *(LAS const bf16x8*)(Bg + o_); bu[n] = *(LAS const bf16x8*)(Bu + o_); }
#pragma unroll
                    for (int m = 0; m < 2; ++m)
#pragma unroll
                        for (int n = 0; n < 4; ++n) { ag[m][n] = MFMA16(bg[n], af[m], ag[m][n]); au[m][n] = MFMA16(bu[n], af[m], au[m][n]); }
                }
            }
        }
        const float* wl = WL + (size_t)mu.e * NTOK + mu.tile * 128;
#pragma unroll
        for (int m = 0; m < 2; ++m) { const int rl = SG_ROW(m); const float wgt = (rl < mu.n) ? wl[rl] : 0.f;
            const float rs = RSTD[lst[rl < mu.n ? rl : mu.n - 1] >> 1];
#pragma unroll
            for (int n = 0; n < 4; ++n) { f32x4 gv = ag[m][n] * rs, uv = au[m][n] * rs, hv;
#pragma unroll
                for (int i = 0; i < 4; ++i) hv[i] = gv[i] * sigm(gv[i]) * uv[i] * wgt;
                const int chk = 2 * n + (fq >> 1);
                u32x2 w; w.x = cvtpk(hv[0], hv[1]); w.y = cvtpk(hv[2], hv[3]);
                *(LAS u32x2*)(Hs + wc * 16384 + rl * 128 + ((chk ^ ((rl >> 1) & 7)) << 4) + (fq & 1) * 8) = w; } }
        {
            const bf16_t* WD = (const bf16_t*)(ws + WS_WD) + (size_t)(l * 16 + mu.e) * DM * 128;
            const char* pb0 = (const char*)(WD + (size_t)lrow * 128) + lch * 16; const char* pb1 = (const char*)(WD + (size_t)(lrow + 64) * 128) + lch * 16;
            u32x4 r00 = *(const u32x4*)pb0, r01 = *(const u32x4*)pb1, r10 = *(const u32x4*)(pb0 + 128), r11 = *(const u32x4*)(pb1 + 128);
            unsigned ent[2];
#pragma unroll
            for (int m = 0; m < 2; ++m) { const int rl = SG_ROW(m); ent[m] = lst[rl < mu.n ? rl : mu.n - 1]; }
            for (int nt = 0; nt < 8; ++nt) {
                __syncthreads();
                *(LAS u32x4*)(Bg + wofs0) = r00; *(LAS u32x4*)(Bg + wofs1) = r01; *(LAS u32x4*)(Bu + wofs0) = r10; *(LAS u32x4*)(Bu + wofs1) = r11;
                __syncthreads();
                if (nt + 1 < 8) { pb0 += 128 * 128 * 2; pb1 += 128 * 128 * 2; r00 = *(const u32x4*)pb0; r01 = *(const u32x4*)pb1; r10 = *(const u32x4*)(pb0 + 128); r11 = *(const u32x4*)(pb1 + 128); }
                f32x4 acc[2][4]; SG_ZERO(acc);
#pragma unroll
                for (int kt = 0; kt < 2; ++kt)
#pragma unroll
                    for (int ks = 0; ks < 2; ++ks) {
                        bf16x8 af[2], bfr[4];
                        const int ch = ks * 4 + fq;
#pragma unroll
                        for (int m = 0; m < 2; ++m) { const int row = wr * 32 + m * 16 + fr; af[m] = *(LAS const bf16x8*)(Hs + kt * 16384 + row * 128 + ((ch ^ ((row >> 1) & 7)) << 4)); }
#pragma unroll
                        for (int n = 0; n < 4; ++n) { const int row = wc * 64 + n * 16 + fr; bfr[n] = *(LAS const bf16x8*)((kt ? Bu : Bg) + row * 128 + ((ch ^ ((row >> 1) & 7)) << 4)); }
#pragma unroll
                        for (int m = 0; m < 2; ++m)
#pragma unroll
                            for (int n = 0; n < 4; ++n) acc[m][n] = MFMA16(bfr[n], af[m], acc[m][n]);
                    }
#pragma unroll
                for (int m = 0; m < 2; ++m) if (SG_ROW(m) < mu.n) { bf16_t* dst = ((ent[m] & 1u) ? Y1 : Y0) + (size_t)(ent[m] >> 1) * DM + nt * 128;
#pragma unroll
                    for (int n = 0; n < 4; ++n) st4bf(dst + SG_COL(n), acc[m][n]); }
            }
        }
    }
}

__device__ __forceinline__ void phase_combine(PRef p, int l, bool dry = false) {
    int tid_ = threadIdx.x; asm volatile("" : "+v"(tid_));
    const int tid = tid_, lane = tid & 63, wid = tid >> 6;
    unsigned char* ws = p.ws;
    const int gw = blockIdx.x * 8 + wid, NGW = gridDim.x * 8;
    const bf16_t* Y0 = (const bf16_t*)(ws + WS_GA); const bf16_t* Y1 = (const bf16_t*)(ws + WS_GB); bf16_t* XN = (bf16_t*)(ws + WS_XN);
    const bool last = (l == DEPTH - 1);
    const float* g = last ? p.final_norm_g : p.norm1_g + (size_t)(l + 1) * DM;
    for (int m0 = gw * 4; m0 < NTOK; m0 += NGW * 4) {
        f32x4 v[4][4]; u32x2 ya[4][4], yb[4][4];
#pragma unroll
        for (int rr = 0; rr < 4; ++rr)
#pragma unroll
            for (int j = 0; j < 4; ++j) { const size_t off = (size_t)(m0 + rr) * DM + (64 * j + lane) * 4; v[rr][j] = *(const f32x4*)(p.out + off); ya[rr][j] = *(const u32x2*)(Y0 + off); yb[rr][j] = *(const u32x2*)(Y1 + off); }
#pragma unroll
        for (int rr = 0; rr < 4; ++rr) {
            float s = 0.f;
#pragma unroll
            for (int j = 0; j < 4; ++j) { const u32x2 a = ya[rr][j], b2 = yb[rr][j];
                v[rr][j] = v[rr][j] + (f32x4){bflo(a.x), bfhi(a.x), bflo(a.y), bfhi(a.y)} + (f32x4){bflo(b2.x), bfhi(b2.x), bflo(b2.y), bfhi(b2.y)};
                s += (v[rr][j][0] * v[rr][j][0] + v[rr][j][1] * v[rr][j][1]) + (v[rr][j][2] * v[rr][j][2] + v[rr][j][3] * v[rr][j][3]); }
            const float rstd = rsqrtf(wave_sum(s) * (1.f / 1024.f) + 1e-6f);
            float* hrow = (dry ? (float*)(ws + WS_NQ) : p.out) + (size_t)(m0 + rr) * DM;
#pragma unroll
            for (int j = 0; j < 4; ++j) { const int cidx = (64 * j + lane) * 4; const f32x4 gg = *(const f32x4*)(g + cidx);
                if (last) *(f32x4*)(hrow + cidx) = v[rr][j] * rstd * gg;
                else { *(f32x4*)(hrow + cidx) = v[rr][j]; st4bf(XN + (size_t)(m0 + rr) * DM + cidx, v[rr][j] * rstd * gg); } }
        }
    }
}

#define XB_TMO      128
#define XB_XCNT(j)  (256  + 64 * (j))
#define XB_XSUB(j)  (1280 + 64 * (j))
#define XB_XGEN(j)  (2304 + 64 * (j))
#define XB_TOP      3328
#define XB_TOPGEN   3392
#define XCD_BAR_WORDS 3456
#define XB_SPIN_CAP (1u << 18)
__device__ __forceinline__ unsigned xb_ld(unsigned* p)              { return __hip_atomic_load(p, __ATOMIC_RELAXED, __HIP_MEMORY_SCOPE_AGENT); }
__device__ __forceinline__ unsigned xb_add(unsigned* p, unsigned v) { return __hip_atomic_fetch_add(p, v, __ATOMIC_RELAXED, __HIP_MEMORY_SCOPE_AGENT); }
__device__ __forceinline__ unsigned xb_xcc_id() { return (unsigned)__builtin_amdgcn_s_getreg((3 << 11) | 20) & 0xFu; }
#define XB_SPIN(cond, bar) do { unsigned _sp = 0; while (cond) { __builtin_amdgcn_s_sleep(1); \
    if ((++_sp & 255u) == 0u) { if (xb_ld(&(bar)[XB_TMO])) break; if (_sp > XB_SPIN_CAP) { atomicAdd(&(bar)[XB_TMO], 1u); break; } } } } while (0)
struct XcdBarrier { unsigned* bar; unsigned x; volatile LAS unsigned* st; };
__device__ __forceinline__ XcdBarrier xcd_barrier_post(unsigned* bar, volatile LAS unsigned* st) {
    XcdBarrier b; b.bar = bar; b.x = xb_xcc_id(); b.st = st;
    if (threadIdx.x == 0) (void)xb_add(&bar[XB_XCNT(b.x)], 1u);
    return b;
}
__device__ __forceinline__ void xcd_barrier_complete(unsigned* bar, unsigned x, unsigned& nloc, unsigned& nx) {
    const unsigned G = gridDim.x * gridDim.y * gridDim.z;
    unsigned sum, cnt, mine, sp = 0u;
    for (;;) {
        sum = 0u; cnt = 0u; mine = 0u;
#pragma unroll
        for (unsigned j = 0; j < 16; ++j) { const unsigned c = xb_ld(&bar[XB_XCNT(j)]); sum += c; cnt += (c > 0u) ? 1u : 0u; mine = (j == x) ? c : mine; }
        if (sum == G) break;
        __builtin_amdgcn_s_sleep(1);
        if ((++sp & 255u) == 0u) { if (xb_ld(&bar[XB_TMO])) break; if (sp > XB_SPIN_CAP) { atomicAdd(&bar[XB_TMO], 1u); break; } }
    }
    nloc = mine > 0u ? mine : 1u; nx = cnt > 0u ? cnt : 1u;
}
__device__ __forceinline__ void xcd_barrier(const XcdBarrier& b) {
    asm volatile("s_waitcnt vmcnt(0)" ::: "memory");
    __syncthreads();
    if (threadIdx.x == 0) {
        unsigned* bar = b.bar;
        __builtin_amdgcn_s_waitcnt(0);
        unsigned nloc = b.st[0], nx = b.st[1];
        if (nloc == 0u) { xcd_barrier_complete(bar, b.x, nloc, nx); b.st[0] = nloc; b.st[1] = nx; }
        const unsigned old = xb_add(&bar[XB_XSUB(b.x)], 1u);
        const unsigned gen = old / nloc;
        if (old + 1u == (gen + 1u) * nloc) {
            __builtin_amdgcn_fence(__ATOMIC_RELEASE, "agent");
            asm volatile("s_waitcnt vmcnt(0)" ::: "memory");
            const unsigned og = xb_add(&bar[XB_TOP], 1u);
            const unsigned tg = og / nx;
            if (og + 1u == (tg + 1u) * nx) xb_add(&bar[XB_TOPGEN], 1u);
            else XB_SPIN(xb_ld(&bar[XB_TOPGEN]) == tg, bar);
            __builtin_amdgcn_fence(__ATOMIC_ACQUIRE, "agent");
            xb_add(&bar[XB_XGEN(b.x)], 1u);
            asm volatile("s_waitcnt vmcnt(0)" ::: "memory");
        } else {
            XB_SPIN(xb_ld(&bar[XB_XGEN(b.x)]) == gen, bar);
            __builtin_amdgcn_fence(__ATOMIC_ACQUIRE, "agent");
            asm volatile("s_waitcnt vmcnt(0)" ::: "memory");
        }
    }
    __syncthreads();
}

template <int K> __device__ __forceinline__ void run_phase(PRef p, int l, LAS unsigned char* lds, bool dry = false) {
    unsigned* ctl = (unsigned*)(p.ws + WS_CTL);
    if (K == 0) phase_prologue(p, lds);
    if (K == 1) phase_inproj_pg8(p, l, lds);
    if (K == 2) { unsigned* ctr = ctl + CW_QCTR + 64 * (l * 2 + 0) + (dry ? 16 : 0);
        for (;;) { const int u = next_unit(ctr, lds); if (u >= 64 + 1024) break; if (u < 64) compress_unit(p, l, u, lds); else diff_unit(p, l, u - 64, lds, dry); } }
    if (K == 3) { unsigned* ctr = ctl + CW_QCTR + 64 * (l * 2 + 1) + (dry ? 16 : 0);
        for (;;) { const int u = next_unit(ctr, lds); if (u >= 1024) break; nsa_unit(p, l, u, lds, dry); } }
    if (K == 4) phase_merge_pg8(p, l, lds);
    if (K == 5) phase_outproj_pg8(p, l, lds, dry);
    if (K == 6) phase_router(p, l, lds, dry);
    if (K == 7) phase_moe_fused(p, l, lds);
    if (K == 8) phase_moe2(p, l, lds);
    if (K == 9) phase_combine(p, l, dry);
}
#if MK_MULTI
template <int K> __global__ void __launch_bounds__(512, 2) mk_one(Params p) {
    extern __shared__ __attribute__((aligned(16))) unsigned char lds_raw[];
    const __attribute__((address_space(4))) Params* pp_ = (const __attribute__((address_space(4))) Params*)__builtin_amdgcn_kernarg_segment_ptr();
    run_phase<K>(*pp_, p.ph_lo, (LAS unsigned char*)lds_raw);
}
template <int K> static void launch_one(int grid, hipStream_t stream, Params p, int l) {
    static bool attr = false;
    if (!attr) { (void)hipFuncSetAttribute((const void*)mk_one<K>, hipFuncAttributeMaxDynamicSharedMemorySize, LDS_BYTES); attr = true; }
    p.ph_lo = l; p.ph_hi = l + 1;
    hipLaunchKernelGGL(mk_one<K>, dim3(grid), dim3(512), LDS_BYTES, stream, p);
}
#else
__global__ void __launch_bounds__(512, 2) mk_fwd(Params p) {
    extern __shared__ __attribute__((aligned(16))) unsigned char lds_raw[];
    LAS unsigned char* lds = (LAS unsigned char*)lds_raw;
    cg::grid_group grid = cg::this_grid();
    volatile LAS unsigned* bst = (volatile LAS unsigned*)(lds + LDS_MISC + 256);
    if (threadIdx.x < 2) bst[threadIdx.x] = 0u;
    __syncthreads();
    const XcdBarrier bar = xcd_barrier_post((unsigned*)(p.ws + WS_CTL) + CW_BAR, bst);
#define SEAM() xcd_barrier(bar)
#ifndef PROBE_DUP
#define PROBE_DUP -1
#endif
#ifndef PROBE_DUP2
#define PROBE_DUP2 -1
#endif
#define RUN(K, l) do { const __attribute__((address_space(4))) Params* pp_ = (const __attribute__((address_space(4))) Params*)__builtin_amdgcn_kernarg_segment_ptr(); asm volatile("" : "+s"(pp_)); \
    if (K == PROBE_DUP || K == PROBE_DUP2) { run_phase<K>(*pp_, l, lds, true); SEAM(); } run_phase<K>(*pp_, l, lds); } while (0)
    RUN(0, 0); grid.sync();
    for (int l = 0; l < DEPTH; ++l) {
        RUN(1, l); SEAM();
        RUN(2, l); SEAM();
        RUN(3, l); SEAM();
        RUN(4, l); SEAM();
        RUN(5, l); SEAM();
        RUN(6, l); SEAM();
        RUN(7, l); SEAM();
        RUN(9, l); if (l + 1 < DEPTH) SEAM();
    }
}
#endif

extern "C" void kernel_launch(void* const* d_in, const int* in_sizes, int n_in, void* d_out, int out_size, void* d_ws, size_t ws_size, hipStream_t stream) {
    static int grid = 0;
    if (grid == 0) {
        if (n_in != 22 || in_sizes[0] != NTOK * DM || out_size != NTOK * DM || ws_size < WS_END) { fprintf(stderr, "kernel_launch: unexpected shapes (n_in %d, in0 %d, out %d, ws %zu)\n", n_in, n_in > 0 ? in_sizes[0] : -1, out_size, ws_size); grid = -1; return; }
        int dev = 0, cus = 0, per_cu = 1;
        (void)hipGetDevice(&dev); (void)hipDeviceGetAttribute(&cus, hipDeviceAttributeMultiprocessorCount, dev);
#if !MK_MULTI
        (void)hipFuncSetAttribute((const void*)mk_fwd, hipFuncAttributeMaxDynamicSharedMemorySize, LDS_BYTES);
        (void)hipOccupancyMaxActiveBlocksPerMultiprocessor(&per_cu, (const void*)mk_fwd, 512, LDS_BYTES);
        if (per_cu < 1) { fprintf(stderr, "kernel_launch: occupancy query says %d blocks per CU\n", per_cu); per_cu = 1; }
#endif
        (void)hipGetLastError();
        grid = cus * per_cu;
    }
    if (grid < 0) return;
    (void)hipMemsetAsync((char*)d_ws + WS_CTL, 0, CTL_BYTES, stream);
    Params p{};
    const float** pp = (const float**)&p;
    for (int i = 0; i < 22; ++i) pp[i] = (const float*)d_in[i];
    p.out = (float*)d_out; p.ws = (unsigned char*)d_ws;
#if MK_MULTI
    launch_one<0>(grid, stream, p, 0);
    for (int l = 0; l < DEPTH; ++l) {
        launch_one<1>(grid, stream, p, l); launch_one<2>(grid, stream, p, l); launch_one<3>(grid, stream, p, l); launch_one<4>(grid, stream, p, l); launch_one<5>(grid, stream, p, l);
        launch_one<6>(grid, stream, p, l); launch_one<7>(grid, stream, p, l); launch_one<9>(grid, stream, p, l);
    }
#else
    p.ph_lo = 0; p.ph_hi = NPHASE;
    void* args[] = {&p};
    hipError_t e = hipLaunchCooperativeKernel((const void*)mk_fwd, dim3(grid), dim3(512), args, LDS_BYTES, stream);
    if (e != hipSuccess) fprintf(stderr, "cooperative launch failed: %s (grid %d)\n", hipGetErrorString(e), grid);
#endif
}
```

```cpp
#include <hip/hip_runtime.h>
#include <hip/hip_cooperative_groups.h>
#include <cstdio>
#include <cstdint>
namespace cg = cooperative_groups;

#ifndef MK_MULTI
#define MK_MULTI 0
#endif

#define LAS __attribute__((address_space(3)))
typedef unsigned short bf16_t;
typedef short bf16x8 __attribute__((ext_vector_type(8)));
typedef short s16x4 __attribute__((ext_vector_type(4)));
typedef float f32x2 __attribute__((ext_vector_type(2)));
typedef float f32x4 __attribute__((ext_vector_type(4)));
typedef float f32x16 __attribute__((ext_vector_type(16)));
typedef unsigned u32x2 __attribute__((ext_vector_type(2)));
typedef unsigned u32x4 __attribute__((ext_vector_type(4)));
typedef __bf16 bf16x2_t __attribute__((ext_vector_type(2)));

constexpr int NTOK = 32768, DM = 1024, TSEQ = 2048, NBATCH = 16, DEPTH = 2;
constexpr int INCOLS = 4888, NPAD = 5120;
constexpr float LOG2E = 1.4426950408889634f;
constexpr float QSCALE = 0.125f * LOG2E;
constexpr int NPHASE = 1 + 9 * DEPTH;

constexpr size_t MiB = 1u << 20;
constexpr size_t WS_CTL = 0, CTL_BYTES = 65536;
constexpr size_t WS_WIN = 1 * MiB;
constexpr size_t WS_WA = 21 * MiB;
constexpr size_t WS_WB = 23 * MiB;
constexpr size_t WS_WO = 25 * MiB;
constexpr size_t WS_WC1 = 29 * MiB;
constexpr size_t WS_WGU = 31 * MiB;
constexpr size_t WS_WD = 47 * MiB;
constexpr size_t WS_MISC = 55 * MiB;
constexpr size_t WS_LIST = 58 * MiB;
constexpr size_t WS_WL = 60 * MiB;
constexpr size_t WS_XN = 64 * MiB;
constexpr size_t WS_NQ = 128 * MiB;
constexpr size_t WS_KV6 = 160 * MiB;
constexpr size_t WS_NG = 208 * MiB;
constexpr size_t WS_DQ = 210 * MiB;
constexpr size_t WS_DK = 242 * MiB;
constexpr size_t WS_DV = 274 * MiB;
constexpr size_t WS_GA = 306 * MiB;
constexpr size_t WS_GB = 370 * MiB;
constexpr size_t WS_HB = 434 * MiB;
constexpr size_t WS_END = 498 * MiB;
constexpr size_t WS_RSTD = WS_MISC + 2 * MiB;
constexpr size_t WS_RSTD1 = WS_MISC + 2 * MiB + 131072;
constexpr size_t WS_H = WS_DK;
constexpr int CW_QCTR = 64;
constexpr int CW_ECNT = 1024;
constexpr int CW_BAR = 4096;

constexpr int LDS_BYTES = 151552;
constexpr int LDS_MISC = 147456;

struct Params {
    const float* x; const float* norm1_g; const float* w_in; const float* cmp_pe; const float* cmp_w1; const float* cmp_b1; const float* cmp_w2; const float* cmp_b2;
    const float* diff_lambda; const float* diff_subln_g; const float* w_branch_a; const float* w_branch_b; const float* w_out; const float* norm2_g;
    const float* router_grp_w; const float* router_grp_b; const float* router_exp_w; const float* router_exp_b; const float* exp_w_gate; const float* exp_w_up; const float* exp_w_down; const float* final_norm_g;
    float* out; unsigned char* ws; int ph_lo, ph_hi;
};

typedef const __attribute__((address_space(4))) Params& PRef;

constexpr int LDS_WTAB = LDS_MISC + 512;
__device__ __forceinline__ int hw_wave_key() { return (int)(__builtin_amdgcn_s_getreg((5 << 11) | 4) & 63u); }
__device__ __forceinline__ int TIDX() {
    int lane, key;
    asm volatile("v_mbcnt_lo_u32_b32 %0, -1, 0\n\tv_mbcnt_hi_u32_b32 %0, -1, %0\n\ts_getreg_b32 %1, hwreg(HW_REG_HW_ID, 0, 6)" : "=&v"(lane), "=s"(key));
    const int wv = __builtin_amdgcn_readfirstlane(((LAS const int*)(size_t)LDS_WTAB)[key]);
    return wv * 64 + lane;
}
__device__ __forceinline__ int BID() { int b = (int)blockIdx.x; asm volatile("" : "+s"(b)); return b; }
__device__ __forceinline__ int GSZ() { int g = (int)gridDim.x; asm volatile("" : "+s"(g)); return g; }
__device__ __forceinline__ unsigned cvtpk(float lo, float hi) { f32x2 v = {lo, hi}; bf16x2_t b = __builtin_convertvector(v, bf16x2_t); return __builtin_bit_cast(unsigned, b); }
__device__ __forceinline__ float bflo(unsigned u) { return __uint_as_float(u << 16); }
__device__ __forceinline__ float bfhi(unsigned u) { return __uint_as_float(u & 0xffff0000u); }
__device__ __forceinline__ float bf1(bf16_t b) { return __uint_as_float(((unsigned)b) << 16); }
__device__ __forceinline__ bf16_t f2bf(float f) { return (bf16_t)(cvtpk(f, 0.f) & 0xffffu); }
__device__ __forceinline__ int crow(int r, int hi) { return (r & 3) + 8 * (r >> 2) + 4 * hi; }
__device__ __forceinline__ float shx(float v, int m, int lane) { return __int_as_float(__builtin_amdgcn_ds_bpermute((lane ^ m) << 2, __float_as_int(v))); }
__device__ __forceinline__ unsigned shxu(unsigned v, int m, int lane) { return (unsigned)__builtin_amdgcn_ds_bpermute((lane ^ m) << 2, (int)v); }
__device__ __forceinline__ float shl_(float v, int src) { return __int_as_float(__builtin_amdgcn_ds_bpermute(src << 2, __float_as_int(v))); }
__device__ __forceinline__ float wave_sum(float v, int lane) {
#pragma unroll
    for (int o = 1; o < 64; o <<= 1) v += shx(v, o, lane);
    return v;
}
__device__ __forceinline__ float s32(float x) { auto rr = __builtin_amdgcn_permlane32_swap(__float_as_uint(x), __float_as_uint(x), false, false); return __uint_as_float(rr[0]) + __uint_as_float(rr[1]); }
__device__ __forceinline__ float m32(float x) { auto rr = __builtin_amdgcn_permlane32_swap(__float_as_uint(x), __float_as_uint(x), false, false); return fmaxf(__uint_as_float(rr[0]), __uint_as_float(rr[1])); }
__device__ __forceinline__ float o32(float x, int hi) { auto rr = __builtin_amdgcn_permlane32_swap(__float_as_uint(x), __float_as_uint(x), false, false); return hi ? __uint_as_float(rr[0]) : __uint_as_float(rr[1]); }
__device__ __forceinline__ float sigm(float x) { return __builtin_amdgcn_rcpf(1.f + __builtin_amdgcn_exp2f(-1.4426950408889634f * x)); }
__device__ __forceinline__ float ex2(float x) { return __builtin_amdgcn_exp2f(x); }
__device__ __forceinline__ float alibi_slope(int i  ) { return exp2f(-8.0f * (float)i / 12.0f); }
__device__ __forceinline__ s16x4 vtr(LAS const unsigned char* p) { return __builtin_bit_cast(s16x4, __builtin_amdgcn_ds_read_tr16_b64_v4i16((LAS s16x4*)p)); }
#define MFMA32(a, b, c) __builtin_amdgcn_mfma_f32_32x32x16_bf16(a, b, c, 0, 0, 0)
#define MFMA16(a, b, c) __builtin_amdgcn_mfma_f32_16x16x32_bf16(a, b, c, 0, 0, 0)

struct ARowLin { const char* base; size_t stride; __device__ __forceinline__ const char* operator()(int r) const { return base + (size_t)r * stride; } };

template <class ARow>
__device__ __forceinline__ void sg_kloop(f32x4 (&acc)[2][4], const ARow& arow, int kstepA, const bf16_t* Bt, int ldb, int nt, LAS unsigned char* lds) {
    int tid_ = TIDX(); asm volatile("" : "+v"(tid_));
    const int tid = tid_, lane = tid & 63, wid = tid >> 6, wr = wid >> 1, wc = wid & 1, fr = lane & 15, fq = lane >> 4;
    const int lrow = tid >> 3, lch = tid & 7;
    const char* pa0 = arow(lrow) + lch * 16; const char* pa1 = arow(lrow + 64) + lch * 16;
    const char* pb0 = (const char*)(Bt + (size_t)lrow * ldb) + lch * 16; const char* pb1 = (const char*)(Bt + (size_t)(lrow + 64) * ldb) + lch * 16;
    const int wofs0 = lrow * 128 + ((lch ^ ((lrow >> 1) & 7)) << 4), wofs1 = wofs0 + 64 * 128;
    u32x4 ra0 = *(const u32x4*)pa0, ra1 = *(const u32x4*)pa1, rb0 = *(const u32x4*)pb0, rb1 = *(const u32x4*)pb1;
    for (int t = 0; t < nt; ++t) {
        __syncthreads();
        *(LAS u32x4*)(lds + wofs0) = ra0; *(LAS u32x4*)(lds + wofs1) = ra1; *(LAS u32x4*)(lds + 16384 + wofs0) = rb0; *(LAS u32x4*)(lds + 16384 + wofs1) = rb1;
        __syncthreads();
        if (t + 1 < nt) { pa0 += kstepA; pa1 += kstepA; pb0 += 128; pb1 += 128; ra0 = *(const u32x4*)pa0; ra1 = *(const u32x4*)pa1; rb0 = *(const u32x4*)pb0; rb1 = *(const u32x4*)pb1; }
#pragma unroll
        for (int ks = 0; ks < 2; ++ks) {
            bf16x8 af[2], bfr[4];
            const int ch = ks * 4 + fq;
#pragma unroll
            for (int m = 0; m < 2; ++m) { const int row = wr * 32 + m * 16 + fr; af[m] = *(LAS const bf16x8*)(lds + row * 128 + ((ch ^ ((row >> 1) & 7)) << 4)); }
#pragma unroll
            for (int n = 0; n < 4; ++n) { const int row = wc * 64 + n * 16 + fr; bfr[n] = *(LAS const bf16x8*)(lds + 16384 + row * 128 + ((ch ^ ((row >> 1) & 7)) << 4)); }
#pragma unroll
            for (int m = 0; m < 2; ++m)
#pragma unroll
                for (int n = 0; n < 4; ++n) acc[m][n] = MFMA16(bfr[n], af[m], acc[m][n]);
        }
    }
}
#define SG_ZERO(acc) do { _Pragma("unroll") for (int m_ = 0; m_ < 2; ++m_) _Pragma("unroll") for (int n_ = 0; n_ < 4; ++n_) acc[m_][n_] = (f32x4){0.f, 0.f, 0.f, 0.f}; } while (0)
#define SG_IDS int tid_ = TIDX(); asm volatile("" : "+v"(tid_)); const int tid = tid_, lane = tid & 63, wid = tid >> 6, wr = wid >> 1, wc = wid & 1, fr = lane & 15, fq = lane >> 4; (void)tid; (void)lane; (void)wid;
#define SG_ROW(m) (wr * 32 + (m) * 16 + fr)
#define SG_COL(n) (wc * 64 + (n) * 16 + 4 * fq)
__device__ __forceinline__ void st4bf(bf16_t* dst, f32x4 v) { u32x2 w; w.x = cvtpk(v[0], v[1]); w.y = cvtpk(v[2], v[3]); *(u32x2*)dst = w; }

__device__ __forceinline__ void transpose_item(const float* W, int ldw, int src_col, int valid, bf16_t* WT, int K, int dst_row, int k0, LAS float* scr, int lane, const float* gk = nullptr  ) {
    const int kq = lane >> 3, c4 = (lane & 7) * 4;
    if ((valid == 32) && ((src_col & 3) == 0) && ((ldw & 3) == 0)) {
        f32x4 v[8];
#pragma unroll
        for (int i = 0; i < 8; ++i) v[i] = *(const f32x4*)(W + (size_t)(k0 + 8 * i + kq) * ldw + src_col + c4);
        if (gk) {
#pragma unroll
            for (int i = 0; i < 8; ++i) v[i] = v[i] * gk[k0 + 8 * i + kq]; }
#pragma unroll
        for (int i = 0; i < 8; ++i) { LAS float* d = scr + (8 * i + kq) * 33 + c4; d[0] = v[i][0]; d[1] = v[i][1]; d[2] = v[i][2]; d[3] = v[i][3]; }
    } else {
        float v[32];
#pragma unroll
        for (int i = 0; i < 32; ++i) { const int kk = 2 * i + (lane >> 5), c = lane & 31; v[i] = (c < valid) ? W[(size_t)(k0 + kk) * ldw + src_col + c] * (gk ? gk[k0 + kk] : 1.f) : 0.f; }
#pragma unroll
        for (int i = 0; i < 32; ++i) { const int kk = 2 * i + (lane >> 5), c = lane & 31; scr[kk * 33 + c] = v[i]; }
    }
    asm volatile("s_waitcnt lgkmcnt(0)" ::: "memory");
    const int c = lane & 7;
#pragma unroll
    for (int j = 0; j < 4; ++j) { const int n = (lane >> 3) + 8 * j; LAS const float* s = scr + (8 * c) * 33 + n;
        u32x4 o; o.x = cvtpk(s[0 * 33], s[1 * 33]); o.y = cvtpk(s[2 * 33], s[3 * 33]); o.z = cvtpk(s[4 * 33], s[5 * 33]); o.w = cvtpk(s[6 * 33], s[7 * 33]);
        *(u32x4*)(WT + (size_t)(dst_row + n) * K + k0 + 8 * c) = o; }
    asm volatile("s_waitcnt lgkmcnt(0)" ::: "memory");
}
__device__ __forceinline__ void weight_prep(PRef p, int l, LAS unsigned char* lds) {
    int tid_ = TIDX(); asm volatile("" : "+v"(tid_));
    const int tid = tid_, lane = tid & 63, wid = tid >> 6;
    const int gw = BID() * 8 + wid, NGW = GSZ() * 8;
    LAS float* scr = (LAS float*)(lds + wid * 8448);
    unsigned char* ws = p.ws;
    constexpr int I_IN = 16 * 160, I_A = 8 * 32, I_O = 16 * 32, I_C1 = 2 * 32 * 4, I_G = 16 * 16 * 4, I_D = 16 * 2 * 32;
    constexpr int I_LAYER = I_IN + 2 * I_A + I_O + I_C1 + 2 * I_G + I_D;
    for (int it = gw; it < I_LAYER; it += NGW) {
        int r = it;
        if (r < I_IN) { const int kb = r / 160, nb = r % 160, n0 = nb * 32; int src, valid = 32;
            if (n0 < 1280) src = n0; else if (n0 < 4864) src = n0 + 24; else { src = 1280 + (n0 - 4864); valid = (n0 == 4864) ? 24 : 0; if (valid == 0) src = 0; }
            transpose_item(p.w_in + (size_t)l * DM * INCOLS, INCOLS, src, valid, (bf16_t*)(ws + WS_WIN) + (size_t)l * NPAD * DM, DM, n0, kb * 64, scr, lane, p.norm1_g + (size_t)l * DM); continue; }
        r -= I_IN;
        if (r < I_A) { const int kb = r / 32, nb = r % 32; transpose_item(p.w_branch_a + (size_t)l * 512 * DM, DM, nb * 32, 32, (bf16_t*)(ws + WS_WA) + (size_t)l * DM * 512, 512, nb * 32, kb * 64, scr, lane); continue; }
        r -= I_A;
        if (r < I_A) { const int kb = r / 32, nb = r % 32; transpose_item(p.w_branch_b + (size_t)l * 512 * DM, DM, nb * 32, 32, (bf16_t*)(ws + WS_WB) + (size_t)l * DM * 512, 512, nb * 32, kb * 64, scr, lane); continue; }
        r -= I_A;
        if (r < I_O) { const int kb = r / 32, nb = r % 32; transpose_item(p.w_out + (size_t)l * DM * DM, DM, nb * 32, 32, (bf16_t*)(ws + WS_WO) + (size_t)l * DM * DM, DM, nb * 32, kb * 64, scr, lane); continue; }
        r -= I_O;
        if (r < I_C1) { const int kv = r / 128, r2 = r % 128, kb = r2 / 4, nb = r2 % 4;
            transpose_item(p.cmp_w1 + (size_t)(l * 2 + kv) * 2048 * 128, 128, nb * 32, 32, (bf16_t*)(ws + WS_WC1) + (size_t)(l * 2 + kv) * 128 * 2048, 2048, nb * 32, kb * 64, scr, lane); continue; }
        r -= I_C1;
        if (r < 2 * I_G) { const int which = r / I_G, r2 = r % I_G, e = r2 / 64, r3 = r2 % 64, kb = r3 / 4, nb = r3 % 4;
            const float* W = (which ? p.exp_w_up : p.exp_w_gate) + (size_t)(l * 16 + e) * DM * 128;
            transpose_item(W, 128, nb * 32, 32, (bf16_t*)(ws + WS_WGU) + (size_t)(l * 16 + e) * 256 * DM, DM, which * 128 + nb * 32, kb * 64, scr, lane, p.norm2_g + (size_t)l * DM); continue; }
        r -= 2 * I_G;
        { const int e = r / 64, r3 = r % 64, kb = r3 / 32, nb = r3 % 32;
            transpose_item(p.exp_w_down + (size_t)(l * 16 + e) * 128 * DM, DM, nb * 32, 32, (bf16_t*)(ws + WS_WD) + (size_t)(l * 16 + e) * DM * 128, 128, nb * 32, kb * 64, scr, lane); }
    }
}
__device__ __forceinline__ void phase_prologue(PRef p, LAS unsigned char* lds) {
    int tid_ = TIDX(); asm volatile("" : "+v"(tid_));
    const int tid = tid_, lane = tid & 63, wid = tid >> 6;
    const int gw = BID() * 8 + wid, NGW = GSZ() * 8;
    LAS float* scr = (LAS float*)(lds + wid * 8448);
    unsigned char* ws = p.ws;
    weight_prep(p, 0, lds);
    for (int m0 = gw * 4; m0 < NTOK; m0 += NGW * 4) {
        f32x4 v[4][4];
#pragma unroll
        for (int rr = 0; rr < 4; ++rr)
#pragma unroll
            for (int j = 0; j < 4; ++j) v[rr][j] = *(const f32x4*)(p.x + (size_t)(m0 + rr) * DM + (64 * j + lane) * 4);
#pragma unroll
        for (int rr = 0; rr < 4; ++rr) { float ss = 0.f;
#pragma unroll
            for (int j = 0; j < 4; ++j) ss += (v[rr][j][0] * v[rr][j][0] + v[rr][j][1] * v[rr][j][1]) + (v[rr][j][2] * v[rr][j][2] + v[rr][j][3] * v[rr][j][3]);
            const float rstd = rsqrtf(wave_sum(ss, lane) * (1.f / 1024.f) + 1e-6f);
            if (lane == 0) ((float*)(ws + WS_RSTD1))[m0 + rr] = rstd;
#pragma unroll
            for (int j = 0; j < 4; ++j) st4bf((bf16_t*)(ws + WS_HB) + (size_t)(m0 + rr) * DM + (64 * j + lane) * 4, v[rr][j]); }
    }
    __syncthreads();
    if (BID() < 8) {
        const int l = BID() >> 2, kv = (BID() >> 1) & 1, jh = BID() & 1, j = jh * 64 + lane;
        const float* pe = p.cmp_pe + (size_t)(l * 2 + kv) * 2048; const float* w1 = p.cmp_w1 + (size_t)(l * 2 + kv) * 2048 * 128;
        float s = 0.f;
        for (int f = wid * 256; f < wid * 256 + 256; ++f) s += pe[f] * w1[(size_t)f * 128 + j];
        LAS float* part = (LAS float*)(lds + 70000);
        part[wid * 64 + lane] = s;
        __syncthreads();
        if (wid == 0) { float t = p.cmp_b1[(l * 2 + kv) * 128 + j];
#pragma unroll
            for (int w = 0; w < 8; ++w) t += part[w * 64 + lane];
            ((float*)(ws + WS_MISC))[(l * 2 + kv) * 128 + j] = t; }
    }
    if (BID() == 8 && wid < DEPTH) {
        const int l = wid; const float* lp = p.diff_lambda + l * 256;
        const float a = wave_sum(lp[lane] * lp[64 + lane], lane), b = wave_sum(lp[128 + lane] * lp[192 + lane], lane);
        const float lam_init = (l == 0) ? 0.2f : 0.35550906f;
        if (lane == 0) ((float*)(ws + WS_MISC + 4096))[l] = expf(a) - expf(b) + lam_init;
    }
}

namespace pg8 {
#define PG8_LAS __attribute__((address_space(3)))
constexpr int BM = 256, BK = 64, HALF = 128, HTB = HALF * BK * 2  , STAGE_BYTES = 8 * HTB, NXCD = 8, WGM = 8;

__host__ __device__ __forceinline__ int lds_byte(int r, int c) { const int st = (r >> 4) * 2 + (c >> 5), rr = r & 15, cc = c & 31, ob = rr * 64 + cc * 2; return st * 1024 + (ob ^ (((ob >> 9) & 1) << 5)); }
__host__ __device__ __forceinline__ void stage_rc(int b, int& R, int& C) { const int st = b / 1024, sb = b % 1024, swz = sb ^ (((sb >> 9) & 1) << 5); R = (st >> 1) * 16 + swz / 64; C = (st & 1) * 32 + (swz % 64) / 2; }
__host__ __device__ __forceinline__ int perm32(int rho) { const int n = rho >> 4, i = rho & 15; return 8 * (i >> 2) + 4 * n + (i & 3); }

struct Unit { int pm, pn, z; };
struct Gemm { const bf16_t* A; const bf16_t* Bt; const bf16_t* A2; const bf16_t* Bt2; int M, N, K; };

struct StaticOrder {
    int nM, nN, nwg, G, c;
    __host__ __device__ void init(int M, int N, int G_, int c_) { nM = M / BM; nN = N / BM; nwg = nM * nN; G = G_; c = c_; }
    __host__ __device__ bool next(int i, Unit& u) const {
        const long L = (long)i * G + c; if (L >= nwg) return false;
        int wgid = (int)L; { const int q = nwg / NXCD, r = nwg % NXCD, xcd = wgid % NXCD, off = wgid / NXCD; wgid = (xcd < r ? xcd * (q + 1) : r * (q + 1) + (xcd - r) * q) + off; }
        const int nig = WGM * nN, gid = wgid / nig, fm = gid * WGM, gsz = (nM - fm) < WGM ? (nM - fm) : WGM;
        u.pm = fm + ((wgid % nig) % gsz); u.pn = (wgid % nig) / gsz; u.z = 0; return true;
    }
    __device__ __forceinline__ void a_ready(const Unit&) const {}
    __device__ __forceinline__ void done(const Unit&) const {}
};

template <class Epi, class Sched, bool ALIGN_EPI = false, bool SP2 = false>
__device__ __forceinline__ void gemm_phase(PG8_LAS unsigned char* lds, const Gemm g, const Sched& S, const Epi& E) {
    int tid_ = TIDX(); asm volatile("" : "+v"(tid_));
    const int tid = tid_, wid = __builtin_amdgcn_readfirstlane(tid >> 6), lane = tid & 63, wr = wid >> 2, wc = wid & 3, fr = lane & 15, fq = lane >> 4;
    const int K = g.K, nt = K / BK;
    unsigned voffA[2], voffB[2];
#pragma unroll
    for (int i = 0; i < 2; ++i) { int R, C; stage_rc(tid * 16 + i * 8192, R, C); const int Rb = Epi::PERM ? (64 * (R >> 5) + perm32(R & 31)) : R;
        voffA[i] = (unsigned)(R * K + C) * 2u; voffB[i] = (unsigned)(Rb * K + C) * 2u; }
    const size_t kstep = (size_t)(BK * 2);
    const size_t hstep = (size_t)HALF * K * 2;
    const size_t tstep = 2 * hstep;
    const size_t hstepB = Epi::PERM ? (size_t)32 * K * 2 : hstep;
    const unsigned ldsw = (unsigned)wid * 1024u;
    const int aoff = lds_byte(wr * 64 + fr, fq * 8), boff = lds_byte(wc * 32 + fr, fq * 8);
#define PG8_SA(b, h) (((b) * 2 + (h)) * HTB)
#define PG8_SB(b, h) ((4 + (b) * 2 + (h)) * HTB)
#define PG8_STAGE(bufoff, gbase, voff) do { _Pragma("unroll") for (int _i = 0; _i < 2; ++_i) \
        __builtin_amdgcn_global_load_lds((const unsigned*)((const char*)(gbase) + (voff)[_i]), (PG8_LAS unsigned*)(lds + (bufoff) + ldsw + _i * 8192), 16, 0, 0); } while (0)
#define PG8_LDA(dst, b, h) do { _Pragma("unroll") for (int m = 0; m < 4; ++m) _Pragma("unroll") for (int k = 0; k < 2; ++k) dst[m][k] = *(const PG8_LAS bf16x8*)(lds + PG8_SA(b, h) + aoff + m * 2048 + k * 1024); } while (0)
#define PG8_LDB(dst, b, h) do { _Pragma("unroll") for (int n = 0; n < 2; ++n) _Pragma("unroll") for (int k = 0; k < 2; ++k) dst[n][k] = *(const PG8_LAS bf16x8*)(lds + PG8_SB(b, h) + boff + n * 2048 + k * 1024); } while (0)
#define PG8_MMA(ai, bj, At, Bt) do { __builtin_amdgcn_s_setprio(1); _Pragma("unroll") for (int m = 0; m < 4; ++m) _Pragma("unroll") for (int n = 0; n < 2; ++n) _Pragma("unroll") for (int k = 0; k < 2; ++k) \
        acc[ai][bj][m][n] = __builtin_amdgcn_mfma_f32_16x16x32_bf16(Bt[n][k], At[m][k], acc[ai][bj][m][n], 0, 0, 0); __builtin_amdgcn_s_setprio(0); } while (0)
#define PG8_WAIT_V(n) asm volatile("s_waitcnt vmcnt(" #n ")" ::: "memory")
#define PG8_WAIT_L(n) asm volatile("s_waitcnt lgkmcnt(" #n ")" ::: "memory")
#define PG8_BAR __builtin_amdgcn_s_barrier()
#define PG8_SCHED __builtin_amdgcn_sched_barrier(0)
    Unit cur, nxt; int ui = 0;
    if (!S.next(0, cur)) return;
    f32x4 acc[2][2][4][2];
#pragma unroll
    for (int a = 0; a < 2; ++a)
#pragma unroll
        for (int b = 0; b < 2; ++b)
#pragma unroll
            for (int m = 0; m < 4; ++m)
#pragma unroll
                for (int n = 0; n < 2; ++n) acc[a][b][m][n] = (f32x4){0.f, 0.f, 0.f, 0.f};
    bf16x8 At[4][2], B0[2][2], B1[2][2];
    const char* cA = (const char*)(cur.z ? g.A2 : g.A) + (size_t)cur.pm * tstep; const char* cB = (const char*)(cur.z ? g.Bt2 : g.Bt) + (size_t)cur.pn * tstep;
    S.a_ready(cur);
    if constexpr (SP2) {
        PG8_STAGE(PG8_SB(0, 0), cB, voffB); PG8_STAGE(PG8_SB(0, 1), cB + hstepB, voffB); PG8_STAGE(PG8_SA(0, 0), cA, voffA); PG8_STAGE(PG8_SA(0, 1), cA + hstep, voffA);
        if (wr == 1) PG8_BAR;
        PG8_WAIT_V(2); PG8_BAR;
        PG8_STAGE(PG8_SB(1, 0), cB + kstep, voffB); PG8_STAGE(PG8_SA(1, 0), cA + kstep, voffA); PG8_STAGE(PG8_SB(1, 1), cB + hstepB + kstep, voffB);
        PG8_WAIT_V(6); PG8_BAR;
    } else {
        PG8_STAGE(PG8_SB(0, 0), cB, voffB); PG8_STAGE(PG8_SA(0, 0), cA, voffA); PG8_STAGE(PG8_SB(0, 1), cB + hstepB, voffB); PG8_STAGE(PG8_SA(0, 1), cA + hstep, voffA);
        if (wr == 1) PG8_BAR;
        PG8_WAIT_V(4); PG8_BAR;
        PG8_STAGE(PG8_SB(1, 0), cB + kstep, voffB); PG8_STAGE(PG8_SA(1, 0), cA + kstep, voffA); PG8_STAGE(PG8_SB(1, 1), cB + hstepB + kstep, voffB);
        PG8_WAIT_V(6); PG8_BAR;
    }
    for (;;) {
        const bool has_next = S.next(ui + 1, nxt);
        const char* nA = has_next ? (const char*)(nxt.z ? g.A2 : g.A) + (size_t)nxt.pm * tstep : cA; const char* nB = has_next ? (const char*)(nxt.z ? g.Bt2 : g.Bt) + (size_t)nxt.pn * tstep : cB;
        for (int t = 0; t < nt; t += 2) {
            const bool last = (t == nt - 2);
            const char* a1 = cA + (size_t)(t + 1) * kstep;
            const char* a2 = last ? nA : cA + (size_t)(t + 2) * kstep; const char* b2 = last ? nB : cB + (size_t)(t + 2) * kstep;
            const char* a3 = a2 + kstep; const char* b3 = b2 + kstep;
            if (last && has_next) S.a_ready(nxt);
            if constexpr (SP2) {
            PG8_LDB(B0, 0, 0); PG8_LDB(B1, 0, 1); PG8_SCHED; PG8_LDA(At, 0, 0); PG8_STAGE(PG8_SA(1, 1), a1 + hstep, voffA);
            PG8_WAIT_V(8); PG8_WAIT_L(0); PG8_BAR; PG8_MMA(0, 0, At, B0); PG8_MMA(0, 1, At, B1); PG8_BAR; PG8_SCHED;
            PG8_LDA(At, 0, 1); PG8_STAGE(PG8_SB(0, 0), b2, voffB); PG8_STAGE(PG8_SB(0, 1), b2 + hstepB, voffB); PG8_STAGE(PG8_SA(0, 0), a2, voffA);
            PG8_WAIT_V(8); PG8_WAIT_L(0); PG8_BAR; PG8_MMA(1, 0, At, B0); PG8_MMA(1, 1, At, B1); PG8_BAR; PG8_SCHED;
            PG8_LDB(B0, 1, 0); PG8_LDB(B1, 1, 1); PG8_SCHED; PG8_LDA(At, 1, 0); PG8_STAGE(PG8_SA(0, 1), a2 + hstep, voffA);
            PG8_WAIT_V(8); PG8_WAIT_L(0); PG8_BAR; PG8_MMA(0, 0, At, B0); PG8_MMA(0, 1, At, B1); PG8_BAR; PG8_SCHED;
            PG8_LDA(At, 1, 1); PG8_STAGE(PG8_SB(1, 0), b3, voffB); PG8_STAGE(PG8_SB(1, 1), b3 + hstepB, voffB); PG8_STAGE(PG8_SA(1, 0), a3, voffA);
            PG8_WAIT_V(8); PG8_WAIT_L(0); PG8_BAR; PG8_MMA(1, 0, At, B0); PG8_MMA(1, 1, At, B1); PG8_BAR; PG8_SCHED;
            } else {
            PG8_LDB(B0, 0, 0); PG8_SCHED; PG8_LDA(At, 0, 0); PG8_STAGE(PG8_SA(1, 1), a1 + hstep, voffA);
            PG8_WAIT_L(8); PG8_BAR; PG8_WAIT_L(0); PG8_MMA(0, 0, At, B0); PG8_BAR; PG8_SCHED;
            PG8_LDB(B1, 0, 1); PG8_STAGE(PG8_SB(0, 0), b2, voffB);
            PG8_BAR; PG8_WAIT_L(0); PG8_MMA(0, 1, At, B1); PG8_BAR;
            PG8_LDA(At, 0, 1); PG8_STAGE(PG8_SA(0, 0), a2, voffA);
            PG8_BAR; PG8_WAIT_L(0); PG8_MMA(1, 0, At, B0); PG8_BAR; PG8_SCHED;
            PG8_STAGE(PG8_SB(0, 1), b2 + hstepB, voffB);
            PG8_WAIT_V(6); PG8_BAR; PG8_MMA(1, 1, At, B1); PG8_BAR;
            PG8_LDB(B0, 1, 0); PG8_SCHED; PG8_LDA(At, 1, 0); PG8_STAGE(PG8_SA(0, 1), a2 + hstep, voffA);
            PG8_WAIT_L(8); PG8_BAR; PG8_WAIT_L(0); PG8_MMA(0, 0, At, B0); PG8_BAR; PG8_SCHED;
            PG8_LDB(B1, 1, 1); PG8_STAGE(PG8_SB(1, 0), b3, voffB);
            PG8_BAR; PG8_WAIT_L(0); PG8_MMA(0, 1, At, B1); PG8_BAR;
            PG8_LDA(At, 1, 1); PG8_STAGE(PG8_SA(1, 0), a3, voffA);
            PG8_BAR; PG8_WAIT_L(0); PG8_MMA(1, 0, At, B0); PG8_BAR; PG8_SCHED;
            PG8_STAGE(PG8_SB(1, 1), b3 + hstepB, voffB);
            PG8_WAIT_V(6); PG8_BAR; PG8_MMA(1, 1, At, B1); PG8_BAR;
            }
        }
        if constexpr (ALIGN_EPI) { if (wr == 0) PG8_BAR; }
        if constexpr (!Epi::AFTER_DRAIN) { E(acc, cur, wr, wc, fr, fq); S.done(cur); }
        if (!has_next) break;
        if (!Epi::keep(cur)) {
#pragma unroll
        for (int a = 0; a < 2; ++a)
#pragma unroll
            for (int b = 0; b < 2; ++b)
#pragma unroll
                for (int m = 0; m < 4; ++m)
#pragma unroll
                    for (int n = 0; n < 2; ++n) acc[a][b][m][n] = (f32x4){0.f, 0.f, 0.f, 0.f}; }
        cur = nxt; cA = nA; cB = nB; ++ui;
        if constexpr (ALIGN_EPI) { if (wr == 1) PG8_BAR; }
    }
    PG8_WAIT_V(0);
    if constexpr (!ALIGN_EPI) { if (wr == 0) PG8_BAR; }
    PG8_BAR;
    if constexpr (Epi::AFTER_DRAIN) { E.fused(acc, cur, wr, wc, fr, fq, lds, wid, lane); S.done(cur); }
#undef PG8_SA
#undef PG8_SB
#undef PG8_STAGE
#undef PG8_LDA
#undef PG8_LDB
#undef PG8_MMA
#undef PG8_WAIT_V
#undef PG8_WAIT_L
#undef PG8_BAR
#undef PG8_SCHED
}
}

typedef pg8::Unit PUnit;
__device__ __forceinline__ unsigned ror8(unsigned v) { return (unsigned)__builtin_amdgcn_mov_dpp((int)v, 0x128, 0xf, 0xf, true); }
__device__ __forceinline__ void st_lines(bf16_t* px  , size_t pitch8  , const u32x4 w0, const u32x4 w1, bool lo) {
    u32x4 snd, rcv, x, y;
    snd.x = lo ? w1.x : w0.x; snd.y = lo ? w1.y : w0.y; snd.z = lo ? w1.z : w0.z; snd.w = lo ? w1.w : w0.w;
    rcv.x = ror8(snd.x); rcv.y = ror8(snd.y); rcv.z = ror8(snd.z); rcv.w = ror8(snd.w);
    x.x = lo ? w0.x : rcv.x; x.y = lo ? w0.y : rcv.y; x.z = lo ? w0.z : rcv.z; x.w = lo ? w0.w : rcv.w;
    y.x = lo ? rcv.x : w1.x; y.y = lo ? rcv.y : w1.y; y.z = lo ? rcv.z : w1.z; y.w = lo ? rcv.w : w1.w;
    *(u32x4*)px = x; *(u32x4*)(px + pitch8) = y;
}
template <int AB> struct EpiInprojT {
    static constexpr bool PERM = true, AFTER_DRAIN = false;
    unsigned char* ws;
    static __device__ __forceinline__ bool keep(const PUnit&) { return false; }
    __device__ __forceinline__ void operator()(f32x4 (&acc)[2][2][4][2], const PUnit& u, int wr, int wc, int fr, int fq) const {
        const int n0 = u.pn * 256;
        bf16_t* dst; int pitch, c0, mode = 0;
        if (n0 < 512) { dst = (bf16_t*)(ws + WS_NQ); pitch = 512; c0 = n0; mode = 1; }
        else if (n0 < 1280) { dst = (bf16_t*)(ws + WS_KV6); pitch = 768; c0 = n0 - 512; }
        else if (n0 < 1792) { dst = (bf16_t*)(ws + WS_DQ); pitch = 512; c0 = n0 - 1280; mode = 1; }
        else if (n0 < 2304) { dst = (bf16_t*)(ws + WS_DK); pitch = 512; c0 = n0 - 1792; }
        else if (n0 < 2816) { dst = (bf16_t*)(ws + WS_DV); pitch = 512; c0 = n0 - 2304; }
        else if (n0 < 3840) { dst = (bf16_t*)(ws + WS_GA); pitch = 1024; c0 = n0 - 2816; mode = 2; }
        else if (n0 < 4864) { dst = (bf16_t*)(ws + WS_GB); pitch = 1024; c0 = n0 - 3840; mode = 2; }
        else { dst = (bf16_t*)(ws + WS_NG); pitch = 32; c0 = 0; mode = 3; }
        int rsub = 0;
        if (AB == 3 && mode != 3) { dst = (bf16_t*)(ws + WS_XN) + (size_t)BID() * 65536; pitch = 256; c0 = 0; rsub = u.pm * 256; }
        asm volatile("" : "+v"(fr), "+v"(fq));
        const int row0 = u.pm * 256 + wr * 64 + fr;
        const bool lo = (fr & 8) == 0;
        const int rowx = u.pm * 256 + wr * 64 + (fr & 7), colx = wc * 64 + (lo ? 0 : 32) + 8 * fq;
        float rsv[2][4];
#pragma unroll
        for (int ai = 0; ai < 2; ++ai)
#pragma unroll
            for (int m = 0; m < 4; ++m) rsv[ai][m] = ((const float*)(ws + WS_RSTD1))[row0 + ai * 128 + m * 16];
#pragma unroll
        for (int ai = 0; ai < 2; ++ai)
#pragma unroll
            for (int m = 0; m < 4; ++m) {
                const float rs = rsv[ai][m];
                u32x4 w[2];
#pragma unroll
                for (int bj = 0; bj < 2; ++bj) { f32x4 v0 = acc[ai][bj][m][0] * rs, v1 = acc[ai][bj][m][1] * rs;
                    if (AB == 2) { asm volatile("" :: "v"(v0), "v"(v1)); continue; }
                    if (AB == 1) {} else if (mode == 1) { v0 = v0 * QSCALE; v1 = v1 * QSCALE; }
                    else if (mode >= 2) {
#pragma unroll
                        for (int i = 0; i < 4; ++i) { v0[i] = sigm(v0[i]); v1[i] = sigm(v1[i]); } }
                    w[bj].x = cvtpk(v0[0], v0[1]); w[bj].y = cvtpk(v0[2], v0[3]); w[bj].z = cvtpk(v1[0], v1[1]); w[bj].w = cvtpk(v1[2], v1[3]); }
                if (AB == 2) continue;
                if (mode == 3) { if (wc == 0) *(u32x4*)(dst + (size_t)(row0 + ai * 128 + m * 16) * pitch + 8 * fq) = w[0]; }
                else st_lines(dst + (size_t)(rowx - rsub + ai * 128 + m * 16) * pitch + c0 + colx, (size_t)8 * pitch, w[0], w[1], lo); }
    }
};
struct EpiMerge {
    static constexpr bool PERM = true, AFTER_DRAIN = false;
    const bf16_t* GA; const bf16_t* GB; bf16_t* MG;
    static __device__ __forceinline__ bool keep(const PUnit& u) { return u.z == 0; }
    __device__ __forceinline__ void operator()(f32x4 (&acc)[2][2][4][2], const PUnit& u, int wr, int wc, int fr, int fq) const {
        asm volatile("" : "+v"(fr), "+v"(fq));
        const int row0 = u.pm * 256 + wr * 64 + fr, col0 = u.pn * 256 + wc * 64 + 8 * fq;
        const bool lo = (fr & 8) == 0;
        const int rowx = u.pm * 256 + wr * 64 + (fr & 7), colx = u.pn * 256 + wc * 64 + (lo ? 0 : 32) + 8 * fq;
#pragma unroll
        for (int ai = 0; ai < 2; ++ai)
#pragma unroll
            for (int m = 0; m < 4; ++m) { const size_t ro = (size_t)(row0 + ai * 128 + m * 16) * DM + col0;
                u32x4 wq[2];
#pragma unroll
                for (int bj = 0; bj < 2; ++bj) { const size_t off = ro + bj * 32;
                    const u32x4 gb = *(const u32x4*)(GB + off);
                    const f32x4 b0 = {bflo(gb.x), bfhi(gb.x), bflo(gb.y), bfhi(gb.y)}, b1 = {bflo(gb.z), bfhi(gb.z), bflo(gb.w), bfhi(gb.w)};
                    if (u.z == 0) { const u32x4 ga = *(const u32x4*)(GA + off);
                        const f32x4 a0 = {bflo(ga.x), bfhi(ga.x), bflo(ga.y), bfhi(ga.y)}, a1 = {bflo(ga.z), bfhi(ga.z), bflo(ga.w), bfhi(ga.w)};
#pragma unroll
                        for (int i = 0; i < 4; ++i) { acc[ai][bj][m][0][i] *= a0[i] * __builtin_amdgcn_rcpf(fmaxf(b0[i], 1e-30f)); acc[ai][bj][m][1][i] *= a1[i] * __builtin_amdgcn_rcpf(fmaxf(b1[i], 1e-30f)); } }
                    else { const f32x4 v0 = acc[ai][bj][m][0] * b0, v1 = acc[ai][bj][m][1] * b1;
                        wq[bj].x = cvtpk(v0[0], v0[1]); wq[bj].y = cvtpk(v0[2], v0[3]); wq[bj].z = cvtpk(v1[0], v1[1]); wq[bj].w = cvtpk(v1[2], v1[3]); } }
                if (u.z != 0) st_lines(MG + (size_t)(rowx + ai * 128 + m * 16) * DM + colx, (size_t)8 * DM, wq[0], wq[1], lo); }
    }
};
struct MergeOrder {
    int G, c;
    __device__ __forceinline__ bool next(int i, PUnit& u) const { const int t = (i >> 1) * G + c; if (t >= 512) return false;
        int wgid = t; { const int q = 512 / 8, xcd = wgid % 8, off = wgid / 8; wgid = xcd * q + off; }
        u.pm = (wgid >> 5) * 8 + (wgid & 7); u.pn = (wgid >> 3) & 3; u.z = i & 1; return true; }
    __device__ __forceinline__ void a_ready(const PUnit&) const {}
    __device__ __forceinline__ void done(const PUnit&) const {}
};
struct EpiOut {
    static constexpr bool PERM = true, AFTER_DRAIN = false;
    const float* xin; const bf16_t* hin; bf16_t* hout;
    static __device__ __forceinline__ bool keep(const PUnit&) { return false; }
    __device__ __forceinline__ void operator()(f32x4 (&acc)[2][2][4][2], const PUnit& u, int wr, int wc, int fr, int fq) const {
        asm volatile("" : "+v"(fr), "+v"(fq));
        const int row0 = u.pm * 256 + wr * 64 + fr, col0 = u.pn * 256 + wc * 64 + 8 * fq;
        const bool lo = (fr & 8) == 0;
        const int rowx = u.pm * 256 + wr * 64 + (fr & 7), colx = u.pn * 256 + wc * 64 + (lo ? 0 : 32) + 8 * fq;
#pragma unroll
        for (int ai = 0; ai < 2; ++ai)
#pragma unroll
            for (int m = 0; m < 4; ++m) { const size_t ro = (size_t)(row0 + ai * 128 + m * 16) * DM + col0;
                u32x4 wq[2];
#pragma unroll
                for (int bj = 0; bj < 2; ++bj) { const size_t off = ro + bj * 32; f32x4 b0, b1;
                    if (xin) { b0 = *(const f32x4*)(xin + off); b1 = *(const f32x4*)(xin + off + 4); }
                    else { const u32x4 hb = *(const u32x4*)(hin + off); b0 = (f32x4){bflo(hb.x), bfhi(hb.x), bflo(hb.y), bfhi(hb.y)}; b1 = (f32x4){bflo(hb.z), bfhi(hb.z), bflo(hb.w), bfhi(hb.w)}; }
                    const f32x4 v0 = b0 + acc[ai][bj][m][0], v1 = b1 + acc[ai][bj][m][1];
                    wq[bj].x = cvtpk(v0[0], v0[1]); wq[bj].y = cvtpk(v0[2], v0[3]); wq[bj].z = cvtpk(v1[0], v1[1]); wq[bj].w = cvtpk(v1[2], v1[3]); }
                st_lines(hout + (size_t)(rowx + ai * 128 + m * 16) * DM + colx, (size_t)8 * DM, wq[0], wq[1], lo); }
    }
};
typedef EpiInprojT<0> EpiInproj;
template <int AB> __device__ __forceinline__ void phase_inproj_pg8(PRef p, int l, LAS unsigned char* lds) {
    unsigned char* ws = p.ws;
    const bf16_t* W = (const bf16_t*)(ws + WS_WIN) + (size_t)l * NPAD * DM;
    pg8::Gemm g{(const bf16_t*)(ws + WS_HB), W, (const bf16_t*)(ws + WS_HB), W, NTOK, NPAD, DM};
    pg8::StaticOrder S; S.init(NTOK, NPAD, GSZ(), BID());
    EpiInprojT<AB> E{ws};
    pg8::gemm_phase<EpiInprojT<AB>, pg8::StaticOrder, true, true>(lds, g, S, E);
}
__device__ __forceinline__ void phase_merge_pg8(PRef p, int l, LAS unsigned char* lds) {
    unsigned char* ws = p.ws;
    pg8::Gemm g{(const bf16_t*)(ws + WS_NQ), (const bf16_t*)(ws + WS_WA) + (size_t)l * DM * 512, (const bf16_t*)(ws + WS_DQ), (const bf16_t*)(ws + WS_WB) + (size_t)l * DM * 512, NTOK, DM, 512};
    MergeOrder S{GSZ(), BID()};
    EpiMerge E{(const bf16_t*)(ws + WS_GA), (const bf16_t*)(ws + WS_GB), (bf16_t*)(ws + WS_XN)};
    pg8::gemm_phase<EpiMerge, MergeOrder, true, true>(lds, g, S, E);
}
__device__ __forceinline__ void phase_outproj_pg8(PRef p, int l, LAS unsigned char* lds, bool dry = false) {
    unsigned char* ws = p.ws;
    const bf16_t* WO = (const bf16_t*)(ws + WS_WO) + (size_t)l * DM * DM;
    pg8::Gemm g{(const bf16_t*)(ws + WS_XN), WO, (const bf16_t*)(ws + WS_XN), WO, NTOK, DM, DM};
    pg8::StaticOrder S; S.init(NTOK, DM, GSZ(), BID());
    EpiOut E{(const float*)nullptr, (const bf16_t*)(ws + WS_HB), dry ? (bf16_t*)(ws + WS_GA) : (bf16_t*)(ws + WS_HB)};
    pg8::gemm_phase<EpiOut, pg8::StaticOrder, true, true>(lds, g, S, E);
}

__device__ __forceinline__ int kswz(int row, int ch) { return row * 128 + ((ch ^ ((row >> 1) & 7)) << 4); }
__device__ __forceinline__ void stage_k(LAS unsigned char* kdst, const bf16_t* src  , int pitch, int tid) {
    const int row = tid >> 3, ch = tid & 7;
    *(LAS u32x4*)(kdst + kswz(row, ch)) = *(const u32x4*)(src + (size_t)row * pitch + ch * 8);
}
template <int NDB> __device__ __forceinline__ void stage_v(LAS unsigned char* vdst, const bf16_t* src, int pitch, int tid) {
#pragma unroll
    for (int i = 0; i < NDB / 2; ++i) { const int pc = tid + 512 * i, pw = pc >> 6, ln = pc & 63, db = pw >> 2, rg = pw & 3;
        *(LAS u32x4*)(vdst + pw * 1024 + ln * 16) = *(const u32x4*)(src + (size_t)(16 * rg + (ln >> 2)) * pitch + db * 32 + (ln & 3) * 8); }
}
__device__ __forceinline__ void qkt(f32x16& p0, f32x16& p1, LAS const unsigned char* K, const bf16x8 (&qr)[4], int r32, int hi) {
    p0 = (f32x16){0.f}; p1 = (f32x16){0.f};
#pragma unroll
    for (int d0 = 0; d0 < 4; ++d0) {
        LAS const unsigned char* kb = K + kswz(r32, 2 * d0 + hi);
        const bf16x8 b0 = *(LAS const bf16x8*)(kb), b1 = *(LAS const bf16x8*)(kb + 4096);
        p0 = MFMA32(b0, qr[d0], p0); p1 = MFMA32(b1, qr[d0], p1);
    }
    __builtin_amdgcn_sched_barrier(0);
}
template <int NDB> __device__ __forceinline__ void pv(f32x16 (&o)[NDB], const f32x16& p0, const f32x16& p1, LAS const unsigned char* V, int lane, int hi) {
    u32x4 pw[4];
    pw[0] = (u32x4){cvtpk(p0[0], p0[1]), cvtpk(p0[2], p0[3]), cvtpk(p0[4], p0[5]), cvtpk(p0[6], p0[7])};
    pw[1] = (u32x4){cvtpk(p0[8], p0[9]), cvtpk(p0[10], p0[11]), cvtpk(p0[12], p0[13]), cvtpk(p0[14], p0[15])};
    pw[2] = (u32x4){cvtpk(p1[0], p1[1]), cvtpk(p1[2], p1[3]), cvtpk(p1[4], p1[5]), cvtpk(p1[6], p1[7])};
    pw[3] = (u32x4){cvtpk(p1[8], p1[9]), cvtpk(p1[10], p1[11]), cvtpk(p1[12], p1[13]), cvtpk(p1[14], p1[15])};
    LAS const unsigned char* vb = V + ((lane >> 4) & 1) * 32 + (lane & 3) * 8 + (4 * hi + ((lane & 15) >> 2)) * 64;
#pragma unroll
    for (int d0 = 0; d0 < NDB; ++d0)
#pragma unroll
        for (int ks = 0; ks < 4; ++ks) {
            const s16x4 lo = vtr(vb + d0 * 4096 + ks * 1024), hh = vtr(vb + d0 * 4096 + ks * 1024 + 512);
            const bf16x8 vf = (bf16x8){lo[0], lo[1], lo[2], lo[3], hh[0], hh[1], hh[2], hh[3]};
            o[d0] = MFMA32(__builtin_bit_cast(bf16x8, pw[ks]), vf, o[d0]);
            if (ks == 3) __builtin_amdgcn_sched_barrier(0);
        }
}
__device__ __forceinline__ void glds16(const void* gsrc, unsigned lds_dst) {
    unsigned keep;
    asm volatile("s_mov_b32 %0, m0\n\ts_mov_b32 m0, %2\n\ts_nop 0\n\tglobal_load_lds_dwordx4 %1, off\n\ts_mov_b32 m0, %0" : "=&s"(keep) : "v"(gsrc), "s"(lds_dst) : "memory");
}
__device__ __forceinline__ void glds16s(const void* sbase  , unsigned voff  , unsigned lds_dst) {
    unsigned keep;
    asm volatile("s_mov_b32 %0, m0\n\ts_mov_b32 m0, %3\n\ts_nop 0\n\tglobal_load_lds_dwordx4 %1, %2\n\ts_mov_b32 m0, %0" : "=&s"(keep) : "v"(voff), "s"(sbase), "s"(lds_dst) : "memory");
}
__device__ __forceinline__ void qkt_nb(f32x16& p0, f32x16& p1, LAS const unsigned char* K, const bf16x8 (&qr)[4], int r32, int hi) {
#pragma unroll
    for (int d0 = 0; d0 < 4; ++d0) {
        LAS const unsigned char* kb = K + kswz(r32, 2 * d0 + hi);
        const bf16x8 b0 = *(LAS const bf16x8*)(kb), b1 = *(LAS const bf16x8*)(kb + 4096);
        p0 = MFMA32(b0, qr[d0], p0); p1 = MFMA32(b1, qr[d0], p1);
    }
}
#define PACKP(pw, P0, P1) do { pw[0] = (u32x4){cvtpk(P0[0], P0[1]), cvtpk(P0[2], P0[3]), cvtpk(P0[4], P0[5]), cvtpk(P0[6], P0[7])}; \
    pw[1] = (u32x4){cvtpk(P0[8], P0[9]), cvtpk(P0[10], P0[11]), cvtpk(P0[12], P0[13]), cvtpk(P0[14], P0[15])}; \
    pw[2] = (u32x4){cvtpk(P1[0], P1[1]), cvtpk(P1[2], P1[3]), cvtpk(P1[4], P1[5]), cvtpk(P1[6], P1[7])}; \
    pw[3] = (u32x4){cvtpk(P1[8], P1[9]), cvtpk(P1[10], P1[11]), cvtpk(P1[12], P1[13]), cvtpk(P1[14], P1[15])}; } while (0)
template <int NDB> __device__ __forceinline__ void pv_nb(f32x16 (&o)[NDB], const u32x4 (&pw)[4], LAS const unsigned char* V, int lane, int hi) {
    LAS const unsigned char* vb = V + ((lane >> 4) & 1) * 32 + (lane & 3) * 8 + (4 * hi + ((lane & 15) >> 2)) * 64;
#pragma unroll
    for (int d0 = 0; d0 < NDB; ++d0)
#pragma unroll
        for (int ks = 0; ks < 4; ++ks) {
            const s16x4 lo = vtr(vb + d0 * 4096 + ks * 1024), hh = vtr(vb + d0 * 4096 + ks * 1024 + 512);
            const bf16x8 vf = (bf16x8){lo[0], lo[1], lo[2], lo[3], hh[0], hh[1], hh[2], hh[3]};
            o[d0] = MFMA32(__builtin_bit_cast(bf16x8, pw[ks]), vf, o[d0]);
        }
}
__device__ __forceinline__ float rowmax32(const f32x16& a, const f32x16& b) {
    float x = fmaxf(fmaxf(a[0], a[1]), b[0]), y = fmaxf(fmaxf(a[2], a[3]), b[1]);
    x = fmaxf(fmaxf(x, b[2]), b[3]);
#pragma unroll
    for (int r = 4; r < 16; r += 4) { x = fmaxf(fmaxf(x, a[r]), a[r + 1]); y = fmaxf(fmaxf(y, a[r + 2]), a[r + 3]); x = fmaxf(fmaxf(x, b[r]), b[r + 1]); y = fmaxf(fmaxf(y, b[r + 2]), b[r + 3]); }
    const float mm = fmaxf(x, y);
    auto rr = __builtin_amdgcn_permlane32_swap(__float_as_uint(mm), __float_as_uint(mm), false, false);
    return fmaxf(__uint_as_float(rr[0]), __uint_as_float(rr[1]));
}
constexpr float SM_THR = 6.0f;
constexpr float NEG = -1e30f;
template <int NDB> __device__ __forceinline__ void softmax_pv(f32x16& s0, f32x16& s1, float& m, float& l, f32x16 (&o)[NDB], LAS float* wsf, LAS const unsigned char* V, int lane, int r32, int hi) {
    float rm = fmaxf(s0[0], s1[0]);
#pragma unroll
    for (int r = 1; r < 16; ++r) rm = fmaxf(rm, fmaxf(s0[r], s1[r]));
    rm = m32(rm);
    if (__any(rm > m + SM_THR)) {
        const float mn = fmaxf(m, rm), f = ex2(m - mn); l *= f; m = mn;
        if (hi == 0) wsf[r32] = f;
#pragma unroll
        for (int r = 0; r < 16; ++r) { const float fr_ = wsf[crow(r, hi)];
#pragma unroll
            for (int d = 0; d < NDB; ++d) o[d][r] *= fr_; }
    }
    float sum = 0.f;
#pragma unroll
    for (int r = 0; r < 16; ++r) { s0[r] = ex2(s0[r] - m); s1[r] = ex2(s1[r] - m); sum += s0[r] + s1[r]; }
    l += sum;
    pv<NDB>(o, s0, s1, V, lane, hi);
}

#define QFETCH() int qnx_ = 0; if (tid == 0) qnx_ = (int)__hip_atomic_fetch_add(qctr, 1u, __ATOMIC_RELAXED, __HIP_MEMORY_SCOPE_AGENT)
#define QPARK() do { if (tid == 0) ((LAS int*)(lds + LDS_MISC))[1] = qnx_; } while (0)
__device__ __forceinline__ float gelu_tanh(float x) { const float u = 0.7978845608f * (x + 0.044715f * x * x * x); const float e = __expf(2.f * u); return 0.5f * x * (2.f - 2.f / (1.f + e)); }

__device__ __forceinline__ void compress_unit(PRef p, int l, int u, LAS unsigned char* lds, unsigned* qctr) {
    SG_IDS
    unsigned char* ws = p.ws;
    const int kv = u >> 5, m0 = (u & 31) * 128;
    const bf16_t* KV6 = (const bf16_t*)(ws + WS_KV6);
    struct ARowC { const bf16_t* KV6; int m0, kv; __device__ __forceinline__ const char* operator()(int r) const { const int mm = m0 + r, g = mm >> 11, tok = (mm & 2047) * 16; return (const char*)(KV6 + (size_t)tok * 768 + kv * 128 + g * 64); } };
    f32x4 acc[2][4]; SG_ZERO(acc);
    sg_kloop(acc, ARowC{KV6, m0, kv}, 768 * 2, (const bf16_t*)(ws + WS_WC1) + (size_t)(l * 2 + kv) * 128 * 2048, 2048, 32, lds);
    QFETCH();
    LAS bf16_t* Ht = (LAS bf16_t*)(lds + 32768);
    LAS float* W2 = (LAS float*)(lds + 32768 + 34816);
    const float* cb1 = (const float*)(ws + WS_MISC) + (l * 2 + kv) * 128;
#pragma unroll
    for (int m = 0; m < 2; ++m)
#pragma unroll
        for (int n = 0; n < 4; ++n) { const int row = SG_ROW(m), col = SG_COL(n); const f32x4 b = *(const f32x4*)(cb1 + col); f32x4 v = acc[m][n] + b;
            u32x2 w; w.x = cvtpk(gelu_tanh(v[0]), gelu_tanh(v[1])); w.y = cvtpk(gelu_tanh(v[2]), gelu_tanh(v[3])); *(LAS u32x2*)(Ht + row * 136 + col) = w; }
    const float* w2g = p.cmp_w2 + (size_t)(l * 2 + kv) * 128 * 64;
    for (int i = tid; i < 128 * 64 / 4; i += 512) *(LAS f32x4*)(W2 + i * 4) = *(const f32x4*)(w2g + i * 4);
    __syncthreads();
    const int d = tid & 63; const float b2 = p.cmp_b2[(l * 2 + kv) * 64 + d];
    bf16_t* dstb = (bf16_t*)(ws + WS_MISC + 65536 + (size_t)kv * 524288);
    for (int i = 0; i < 16; ++i) { const int row = (tid >> 6) + 8 * i; float s = b2;
#pragma unroll 8
        for (int f = 0; f < 128; ++f) s += bf1(Ht[row * 136 + f]) * W2[f * 64 + d];
        const int mm = m0 + row, g = mm >> 11, bi = mm & 2047;
        dstb[((size_t)bi * 2 + g) * 64 + d] = f2bf(s); }
    QPARK();
    __syncthreads();
}

#ifndef ABL
#define ABL 0
#endif
template <int AB> __device__ __forceinline__ void diff_unit(PRef p, int l, int u, LAS unsigned char* lds, bool dry, unsigned* qctr) {
    int tid_ = TIDX(); asm volatile("" : "+v"(tid_));
    const int tid = tid_, lane = tid & 63, r32 = lane & 31, hi = lane >> 5, wid = __builtin_amdgcn_readfirstlane(tid >> 6);
    unsigned char* ws = p.ws;
    const int c = 15 - (u >> 6), b = (u & 63) >> 2, hd = u & 3;
    const int cm = wid >> 2, qq = wid & 3, t0 = 128 * c + 32 * qq, tq = t0 + r32;
    const size_t tokb = (size_t)b * TSEQ;
    bf16_t* DQ = (bf16_t*)(ws + WS_DQ); const bf16_t* DK = (const bf16_t*)(ws + WS_DK); const bf16_t* DV = (const bf16_t*)(ws + WS_DV);
    const float sl2 = alibi_slope(9 + hd) * LOG2E;
    const float cbh = sl2 * (float)(4 * hi);
#define CB(r) fmaf(sl2, (float)(((r) & 3) + 8 * ((r) >> 2)), cbh)
    f32x16 o[4];
#pragma unroll
    for (int d = 0; d < 4; ++d) o[d] = (f32x16){0.f};
    float m = 0.f, lsum = 0.f; bool seen = false;
    LAS float* wsf = (LAS float*)(lds + LDS_MISC + 1024 + wid * 128);
    const unsigned lds0 = (unsigned)(uintptr_t)lds;
    const int srow = tid >> 3, spos = tid & 7, sch = spos ^ ((srow >> 1) & 7);
    const int vln = lane;
    const bf16_t* kub = DK + tokb * 512 + hd * 128; const bf16_t* vub = DV + tokb * 512 + hd * 128 + (size_t)(16 * (wid & 3)) * 512 + (wid >> 2) * 32;
    const unsigned kvo = (unsigned)(srow * 512 + sch * 8) * 2u, vvo = (unsigned)((vln >> 2) * 512 + (vln & 3) * 8) * 2u;
    const unsigned dk0 = lds0 + wid * 1024, dk1 = dk0 + 8192, dv0 = lds0 + 16384 + wid * 1024, dv1 = dv0 + 8192;
#define DDMA(j, off) do { const size_t to_ = (size_t)(64 * (j)) * 512; const unsigned o_ = (unsigned)(off); \
        glds16s(kub + to_, kvo, (unsigned)__builtin_amdgcn_readfirstlane(dk0 + o_)); glds16s(kub + to_ + 64, kvo, (unsigned)__builtin_amdgcn_readfirstlane(dk1 + o_)); \
        glds16s(vub + to_, vvo, (unsigned)__builtin_amdgcn_readfirstlane(dv0 + o_)); glds16s(vub + to_ + 64, vvo, (unsigned)__builtin_amdgcn_readfirstlane(dv1 + o_)); } while (0)
#define DCIN(A0, A1, j) do { float slv_ = sl2; asm volatile("" : "+v"(slv_)); \
        const float tc_ = slv_ * (float)(64 * (j) - 128 * c) + slv_ * (float)(4 * hi) - m, tc1_ = tc_ + 32.f * slv_; \
        _Pragma("unroll") for (int r = 0; r < 16; ++r) { const float kc_ = (float)((r & 3) + 8 * (r >> 2)); A0[r] = fmaf(slv_, kc_, tc_); A1[r] = fmaf(slv_, kc_, tc1_); } } while (0)
#define DMASK(A0, A1, j, RM, MASKED) do { \
        if (MASKED) { if (64 * (j) + 63 > t0) { const int lim_ = tq - 64 * (j); _Pragma("unroll") for (int r = 0; r < 16; ++r) { if (crow(r, hi) > lim_) A0[r] = NEG; if (crow(r, hi) + 32 > lim_) A1[r] = NEG; } } } \
        RM = rowmax32(A0, A1); } while (0)
#define DRESC(C0, C1, RM) do { const bool real_ = RM > -1e29f; const bool need_ = (RM > SM_THR) || (!seen && real_); seen = seen || real_;     \
        if (__any(need_)) { const float d_ = need_ ? RM : 0.f, f_ = ex2(-d_); m += d_; lsum *= f_; if (hi == 0) wsf[r32] = f_; \
        _Pragma("unroll") for (int r = 0; r < 16; ++r) { C0[r] -= d_; C1[r] -= d_; const float fr_ = wsf[crow(r, hi)]; _Pragma("unroll") for (int d = 0; d < 4; ++d) o[d][r] *= fr_; } } } while (0)
#define DEXP(C0, C1, PW) do { float sum_ = 0.f; \
        if (AB == 1) { _Pragma("unroll") for (int r = 0; r < 16; ++r) { sum_ += C0[r] + C1[r]; } } \
        else if (AB != 5) { _Pragma("unroll") for (int r = 0; r < 16; ++r) { C0[r] = ex2(C0[r]); C1[r] = ex2(C1[r]); sum_ += C0[r] + C1[r]; } } \
        lsum += sum_; PACKP(PW, C0, C1); } while (0)
#define DEND(t) do { if (AB == 6) asm volatile("s_waitcnt vmcnt(0) lgkmcnt(0)" ::: "memory"); else if ((t) + 3 <= J0) asm volatile("s_waitcnt vmcnt(4) lgkmcnt(0)\n\ts_barrier" ::: "memory"); else asm volatile("s_waitcnt vmcnt(0) lgkmcnt(0)\n\ts_barrier" ::: "memory"); \
        { const int tmp_ = oc_; oc_ = on_; on_ = o2_; o2_ = ow_; ow_ = tmp_; } } while (0)
#define SBAR() __builtin_amdgcn_sched_barrier(0)
#define KLD(KF, Kp) do { _Pragma("unroll") for (int d0 = 0; d0 < 4; ++d0) { LAS const unsigned char* kb_ = (Kp) + kswz(r32, 2 * d0 + hi); KF[2 * d0] = *(LAS const bf16x8*)(kb_); KF[2 * d0 + 1] = *(LAS const bf16x8*)(kb_ + 4096); } } while (0)
#define QK8(P0, P1, KF) do { _Pragma("unroll") for (int d0 = 0; d0 < 4; ++d0) { P0 = MFMA32(KF[2 * d0], qr[d0], P0); P1 = MFMA32(KF[2 * d0 + 1], qr[d0], P1); } } while (0)
#define VLDK(VF, Vp, ks) do { _Pragma("unroll") for (int d0 = 0; d0 < 4; ++d0) { const s16x4 lo_ = vtr((Vp) + d0 * 4096 + (ks) * 1024), hh_ = vtr((Vp) + d0 * 4096 + (ks) * 1024 + 512); \
        VF[d0] = (bf16x8){lo_[0], lo_[1], lo_[2], lo_[3], hh_[0], hh_[1], hh_[2], hh_[3]}; } } while (0)
#define MMA4(VF, PWk) do { _Pragma("unroll") for (int d0 = 0; d0 < 4; ++d0) o[d0] = MFMA32(__builtin_bit_cast(bf16x8, PWk), VF[d0], o[d0]); } while (0)
#define DSTEP_N(C0, C1, RMC, N0, N1, RMN, t, MASKED) do { \
        if (AB != 4 && (t) + 3 <= J0) DDMA(J0 - (t) - 3, ow_); \
        bf16x8 kf_[8]; KLD(kf_, lds + on_ + cm * 8192); \
        SBAR(); \
        if (AB != 5) DRESC(C0, C1, RMC); \
        u32x4 pw_[4]; \
        DEXP(C0, C1, pw_); \
        DCIN(N0, N1, J0 - (t) - 1); \
        SBAR(); \
        if (AB != 3) QK8(N0, N1, kf_); \
        int ln_ = lane; asm volatile("" : "+v"(ln_)); LAS const unsigned char* vp_ = lds + oc_ + 16384 + ((ln_ >> 4) & 1) * 32 + (ln_ & 3) * 8 + ((ln_ >> 5) * 4 + ((ln_ & 15) >> 2)) * 64; \
        bf16x8 va_[4], vc_[4]; \
        VLDK(va_, vp_, 0); VLDK(vc_, vp_, 1); SBAR(); \
        if (AB != 2) MMA4(va_, pw_[0]); VLDK(va_, vp_, 2); SBAR(); \
        if (AB != 2) MMA4(vc_, pw_[1]); VLDK(vc_, vp_, 3); SBAR(); \
        if (AB != 5) DMASK(N0, N1, J0 - (t) - 1, RMN, MASKED); else RMN = RMC; \
        if (AB != 2) { MMA4(va_, pw_[2]); MMA4(vc_, pw_[3]); } \
        SBAR(); \
        DEND(t); } while (0)
#define DSTEP_L(C0, C1, RMC, t) do { DRESC(C0, C1, RMC); u32x4 pw_[4]; DEXP(C0, C1, pw_); int ln_ = lane; asm volatile("" : "+v"(ln_)); LAS const unsigned char* vp_ = lds + oc_ + 16384 + ((ln_ >> 4) & 1) * 32 + (ln_ & 3) * 8 + ((ln_ >> 5) * 4 + ((ln_ & 15) >> 2)) * 64; bf16x8 va_[4], vc_[4]; \
        VLDK(va_, vp_, 0); VLDK(vc_, vp_, 1); SBAR(); MMA4(va_, pw_[0]); VLDK(va_, vp_, 2); SBAR(); MMA4(vc_, pw_[1]); VLDK(vc_, vp_, 3); SBAR(); MMA4(va_, pw_[2]); MMA4(vc_, pw_[3]); DEND(t); } while (0)
    const int J0 = 2 * c + 1;
    int oc_ = 0, on_ = 32768, o2_ = 65536, ow_ = 98304;
    __syncthreads();
    DDMA(J0, 0); DDMA(J0 - 1, 32768);
    if (J0 >= 2) DDMA(J0 - 2, 65536);
    bf16x8 qr[4];
    { const bf16_t* qp = DQ + (tokb + tq) * 512 + hd * 128 + cm * 64 + hi * 8;
#pragma unroll
      for (int d0 = 0; d0 < 4; ++d0) qr[d0] = *(const bf16x8*)(qp + d0 * 16); }
    asm volatile("" : "+v"(qr[0]), "+v"(qr[1]), "+v"(qr[2]), "+v"(qr[3]));
    asm volatile("s_waitcnt vmcnt(0)\n\ts_barrier" ::: "memory");
    f32x16 sA0, sA1, sB0, sB1; float rmA, rmB;
    DCIN(sA0, sA1, J0);
    qkt_nb(sA0, sA1, lds + cm * 8192, qr, r32, hi);
    DMASK(sA0, sA1, J0, rmA, true);
    DSTEP_N(sA0, sA1, rmA, sB0, sB1, rmB, 0, true);
    for (int t = 1; t + 1 <= J0 - 1; t += 2) {
        DSTEP_N(sB0, sB1, rmB, sA0, sA1, rmA, t, false); DSTEP_N(sA0, sA1, rmA, sB0, sB1, rmB, t + 1, false);
    }
    DSTEP_L(sB0, sB1, rmB, J0);
#undef DDMA
#undef DCIN
#undef DMASK
#undef DRESC
#undef DEXP
#undef DEND
#undef DSTEP_N
#undef DSTEP_L
#undef KLD
#undef QK8
#undef VLDK
#undef MMA4
#undef SBAR
    QFETCH();
    const float lam = ((const float*)(ws + WS_MISC + 4096))[l];
    const float lam_init = (l == 0) ? 0.2f : 0.35550906f;
    const float ltot = s32(lsum);
    if (hi == 0) wsf[r32] = (cm == 0 ? 1.f : lam) / ltot;
    LAS float* X = (LAS float*)(lds + cm * 65536);
#pragma unroll
    for (int r = 0; r < 16; ++r) { const float f = wsf[crow(r, hi)]; const int q = 32 * qq + crow(r, hi);
#pragma unroll
        for (int d = 0; d < 4; ++d) X[q * 128 + d * 32 + r32] = o[d][r] * f; }
    __syncthreads();
    { const int q = tid >> 2, qt = tid & 3; LAS const float* x0 = (LAS const float*)lds + q * 128 + qt * 32; LAS const float* x1 = x0 + 16384;
      float v[32]; float ss = 0.f;
#pragma unroll
      for (int i = 0; i < 32; ++i) { v[i] = x0[i] - x1[i]; ss += v[i] * v[i]; }
      ss += shx(ss, 1, lane); ss += shx(ss, 2, lane);
      unsigned omlb = (l == 0) ? 0x3f4ccccdu : 0x3f24fd5cu; asm volatile("" : "+s"(omlb)); const float oml = __uint_as_float(omlb);
      const float rstd = rsqrtf(ss * (1.f / 128.f) + 1e-5f) * oml;
      const float* sg = p.diff_subln_g + l * 128 + qt * 32;
      bf16_t* dst = (dry ? (bf16_t*)(ws + WS_XN) + (size_t)NTOK * 512 : DQ) + (tokb + 128 * c + q) * 512 + hd * 128 + qt * 32;
#pragma unroll
      for (int i = 0; i < 32; i += 8) { u32x4 w; w.x = cvtpk(v[i] * rstd * sg[i], v[i + 1] * rstd * sg[i + 1]); w.y = cvtpk(v[i + 2] * rstd * sg[i + 2], v[i + 3] * rstd * sg[i + 3]);
          w.z = cvtpk(v[i + 4] * rstd * sg[i + 4], v[i + 5] * rstd * sg[i + 5]); w.w = cvtpk(v[i + 6] * rstd * sg[i + 6], v[i + 7] * rstd * sg[i + 7]); *(u32x4*)(dst + i) = w; } }
    QPARK();
    __syncthreads();
}

template <int AB> __device__ __forceinline__ void nsa_unit(PRef p, int l, int u, LAS unsigned char* lds, bool dry, unsigned* qctr) {
    int tid_ = TIDX(); asm volatile("" : "+v"(tid_));
    const int tid = tid_, lane = tid & 63, r32 = lane & 31, hi = lane >> 5, wid = __builtin_amdgcn_readfirstlane(tid >> 6);
    unsigned char* ws = p.ws;
    const int c = 31 - (u >> 5), b = (u & 31) >> 1, g = u & 1;
    const int hl = wid >> 1, qh = wid & 1, h = g * 4 + hl, t0 = 64 * c + 32 * qh, tq = t0 + r32, ql = 32 * qh + r32;
    const size_t tokb = (size_t)b * TSEQ;
    bf16_t* NQ = (bf16_t*)(ws + WS_NQ); const bf16_t* KV6 = (const bf16_t*)(ws + WS_KV6); const bf16_t* NG = (const bf16_t*)(ws + WS_NG);
    const bf16_t* KC = (const bf16_t*)(ws + WS_MISC + 65536); const bf16_t* VC = (const bf16_t*)(ws + WS_MISC + 65536 + 524288);
    constexpr int RING_W = 0, RING_S = 65536, CK = 65536, CV = 81920, IMPH_OFF = 98304;
    const unsigned lds0 = (unsigned)(uintptr_t)lds;
    const int jlo = c - 8 < 0 ? 0 : c - 8;
    const unsigned wmask = ((c >= 31) ? 0xffffffffu : ((2u << c) - 1u)) & ~((1u << jlo) - 1u);
    const int srow = tid >> 3, spos = tid & 7, sch = spos ^ ((srow >> 1) & 7);
    const unsigned kvo768 = (unsigned)(srow * 768 + sch * 8) * 2u, vvo768 = (unsigned)((lane >> 2) * 768 + (lane & 3) * 8) * 2u;
    const bf16_t* kub = KV6 + tokb * 768 + g * 64; const bf16_t* vub = KV6 + tokb * 768 + g * 64 + 128 + (size_t)(16 * (wid & 3)) * 768 + (wid >> 2) * 32;
    const unsigned dk = lds0 + wid * 1024, dv = dk + 8192;
#define NDMA(j, kind, off) do { const size_t to_ = (size_t)(64 * (j)) * 768 + ((kind) == 1 ? 256 : 512); const unsigned o_ = (unsigned)(off); \
        glds16s(kub + to_, kvo768, (unsigned)__builtin_amdgcn_readfirstlane(dk + o_)); glds16s(vub + to_, vvo768, (unsigned)__builtin_amdgcn_readfirstlane(dv + o_)); } while (0)
    __syncthreads();
    { const unsigned kvo128 = (unsigned)(srow * 128 + sch * 8) * 2u, vvo128 = (unsigned)((lane >> 2) * 128 + (lane & 3) * 8) * 2u;
      const bf16_t* kcb = KC + ((size_t)b * 128 * 2 + g) * 64; const bf16_t* vcb = VC + ((size_t)b * 128 * 2 + g) * 64 + (size_t)(16 * (wid & 3)) * 128 + (wid >> 2) * 32;
      glds16s(kcb, kvo128, (unsigned)__builtin_amdgcn_readfirstlane(dk + CK)); glds16s(kcb + 64 * 128, kvo128, (unsigned)__builtin_amdgcn_readfirstlane(dk + CK + 8192));
      glds16s(vcb, vvo128, (unsigned)__builtin_amdgcn_readfirstlane(dk + CV)); glds16s(vcb + 64 * 128, vvo128, (unsigned)__builtin_amdgcn_readfirstlane(dk + CV + 8192)); }
    unsigned wd = wmask; int nwd = 0;
#pragma unroll
    for (int i = 0; i < 3; ++i) if (wd) { const int j = 31 - __builtin_clz(wd); wd &= ~(1u << j); NDMA(j, 2, RING_W + i * 16384); ++nwd; }
    bf16x8 qr[4];
    { const bf16_t* qp = NQ + (tokb + tq) * 512 + h * 64 + hi * 8;
#pragma unroll
      for (int d0 = 0; d0 < 4; ++d0) qr[d0] = *(const bf16x8*)(qp + d0 * 16); }
    float g0 = bf1(NG[(tokb + tq) * 32 + h * 3 + 0]), g1 = bf1(NG[(tokb + tq) * 32 + h * 3 + 1]), g2 = bf1(NG[(tokb + tq) * 32 + h * 3 + 2]);
    asm volatile("" : "+v"(qr[0]), "+v"(qr[1]), "+v"(qr[2]), "+v"(qr[3]), "+v"(g0), "+v"(g1), "+v"(g2));
    const float sl2 = alibi_slope(h + 1) * LOG2E;
    const float cbh = sl2 * (float)(4 * hi);
    LAS float* wsf = (LAS float*)(lds + LDS_MISC + 1024 + wid * 128);
    LAS unsigned char* Kt = lds + CK; LAS unsigned char* Vt = lds + CV;
    LAS float* IMPH = (LAS float*)(lds + IMPH_OFF);
    LAS float* VAL = (LAS float*)(lds + CK);
    LAS unsigned* MASK = (LAS unsigned*)(lds + LDS_MISC + 2048);
    f32x16 oacc[2];
    if (tid < 64) MASK[tid] = 0u;
    asm volatile("s_waitcnt vmcnt(0) lgkmcnt(0)\n\ts_barrier" ::: "memory");
    {
        f32x16 s[4];
        qkt(s[0], s[1], Kt, qr, r32, hi); qkt(s[2], s[3], Kt + 8192, qr, r32, hi);
        int nmax = (tq - 31) >> 4; if (nmax > 126) nmax = 126;
        float rm = NEG;
#pragma unroll
        for (int k = 0; k < 4; ++k)
#pragma unroll
            for (int r = 0; r < 16; ++r) { const int n = 32 * k + crow(r, hi); float v = s[k][r] + 16.f * CB(r) + sl2 * (float)(512 * k);
                v = (n <= nmax) ? v : NEG; s[k][r] = v; rm = fmaxf(rm, v); }
        rm = m32(rm);
        float sum = 0.f;
#pragma unroll
        for (int k = 0; k < 4; ++k)
#pragma unroll
            for (int r = 0; r < 16; ++r) { const float e = ex2(s[k][r] - rm); s[k][r] = e; sum += e; }
        sum = s32(sum);
        const float inv = (nmax >= 0) ? 1.f / sum : 0.f;
#pragma unroll
        for (int k = 0; k < 4; ++k)
#pragma unroll
            for (int r = 0; r < 16; ++r) s[k][r] *= inv;
        float prev = 0.f;
#pragma unroll
        for (int k = 0; k < 4; ++k)
#pragma unroll
            for (int a = 0; a < 4; ++a) { const int i = 4 * k + a; const float Bi = 0.5f * s[k][4 * a + 3]; const float Ai = (s[k][4 * a] + s[k][4 * a + 1]) + (s[k][4 * a + 2] + Bi);
                const float rc = o32(Bi, hi); const float add = hi ? rc : prev; prev = rc;
                IMPH[(hl * 64 + ql) * 32 + 2 * i + hi] = Ai + add; }
        f32x16 o[2]; o[0] = (f32x16){0.f}; o[1] = (f32x16){0.f};
        pv<2>(o, s[0], s[1], Vt, lane, hi); pv<2>(o, s[2], s[3], Vt + 8192, lane, hi);
        if (hi == 0) wsf[r32] = g0;
#pragma unroll
        for (int r = 0; r < 16; ++r) { const float f = wsf[crow(r, hi)]; oacc[0][r] = o[0][r] * f; oacc[1][r] = o[1][r] * f; }
        asm volatile("" : "+v"(oacc[0]), "+v"(oacc[1]));
    }
    __syncthreads();
    { const int q = tid >> 3, mg = tid & 7;
#pragma unroll
      for (int i = 0; i < 4; ++i) { const int mb = 4 * mg + i; float v = ((IMPH[(0 * 64 + q) * 32 + mb] + IMPH[(1 * 64 + q) * 32 + mb]) + IMPH[(2 * 64 + q) * 32 + mb]) + IMPH[(3 * 64 + q) * 32 + mb];
          if (mb == 0 || mb == c || mb == c - 1) v = 1e9f; if (mb > c) v = -1.f; VAL[q * 32 + mb] = v; }
      asm volatile("s_waitcnt lgkmcnt(0)" ::: "memory");
      float mine[4];
#pragma unroll
      for (int i = 0; i < 4; ++i) mine[i] = VAL[q * 32 + 4 * mg + i];
      int cnt0 = 0, cnt1 = 0, cnt2 = 0, cnt3 = 0;
#pragma unroll 4
      for (int m2 = 0; m2 < 32; ++m2) { const float v2 = VAL[q * 32 + m2]; const int rel = m2 - 4 * mg;
          cnt0 += (int)(v2 > mine[0]) | ((int)(v2 == mine[0]) & (int)(rel < 0));
          cnt1 += (int)(v2 > mine[1]) | ((int)(v2 == mine[1]) & (int)(rel < 1));
          cnt2 += (int)(v2 > mine[2]) | ((int)(v2 == mine[2]) & (int)(rel < 2));
          cnt3 += (int)(v2 > mine[3]) | ((int)(v2 == mine[3]) & (int)(rel < 3)); }
      unsigned bits = ((cnt0 < 8) ? 1u : 0u) | ((cnt1 < 8) ? 2u : 0u) | ((cnt2 < 8) ? 4u : 0u) | ((cnt3 < 8) ? 8u : 0u);
      bits <<= 4 * mg;
      bits |= shxu(bits, 1, lane); bits |= shxu(bits, 2, lane); bits |= shxu(bits, 4, lane);
      if (mg == 0) MASK[q] = bits; }
    __syncthreads();
    const unsigned vmask = (c >= 31) ? 0xffffffffu : ((2u << c) - 1u);
    const unsigned mymask = MASK[ql] & vmask;
    unsigned uni;
    { unsigned mk = MASK[lane] & vmask;
#pragma unroll
      for (int o_ = 1; o_ < 64; o_ <<= 1) mk |= shxu(mk, o_, lane);
      uni = __builtin_amdgcn_readfirstlane(mk); }
    unsigned sd = uni; int nsd = 0;
#pragma unroll
    for (int i = 0; i < 3; ++i) if (sd) { const int j = 31 - __builtin_clz(sd); sd &= ~(1u << j); NDMA(j, 1, RING_S + i * 16384); ++nsd; }
#define NCIN(A0, A1, j, kind) do { float slv_ = sl2; asm volatile("" : "+v"(slv_)); \
        const float tc_ = slv_ * (float)(64 * ((j) - c)) + slv_ * (float)(4 * hi) - m, tc1_ = tc_ + 32.f * slv_; \
        _Pragma("unroll") for (int r = 0; r < 16; ++r) { const float kc_ = (float)((r & 3) + 8 * (r >> 2)); A0[r] = fmaf(slv_, kc_, tc_); A1[r] = fmaf(slv_, kc_, tc1_); } } while (0)
#define NMASK(A0, A1, j, kind, RM) do { \
        const bool sel_ = ((kind) == 2) || ((mymask >> (j)) & 1u); \
        if ((j) == c || ((kind) == 2 && (j) == c - 8) || !__all(sel_)) { const int lim_ = ((j) == c) ? ql : 64, low_ = ((kind) == 2 && (j) == c - 8) ? ql : -1; \
            _Pragma("unroll") for (int r = 0; r < 16; ++r) { const int k0_ = crow(r, hi), k1_ = k0_ + 32; if (!sel_ || k0_ > lim_ || k0_ <= low_) A0[r] = NEG; if (!sel_ || k1_ > lim_ || k1_ <= low_) A1[r] = NEG; } } \
        RM = rowmax32(A0, A1); } while (0)
#define NRESC(C0, C1, RM) do { const bool real_ = RM > -1e29f; const bool need_ = (RM > SM_THR) || (!seen && real_); seen = seen || real_; \
        if (__any(need_)) { const float d_ = need_ ? RM : 0.f, f_ = ex2(-d_); m += d_; lsum *= f_; if (hi == 0) wsf[r32] = f_; \
        _Pragma("unroll") for (int r = 0; r < 16; ++r) { C0[r] -= d_; C1[r] -= d_; const float fr_ = wsf[crow(r, hi)]; o[0][r] *= fr_; o[1][r] *= fr_; } } } while (0)
#define NEXP(C0, C1, PW) do { float sum_ = 0.f; \
        _Pragma("unroll") for (int r = 0; r < 16; ++r) { C0[r] = ex2(C0[r]); C1[r] = ex2(C1[r]); sum_ += C0[r] + C1[r]; } lsum += sum_; PACKP(PW, C0, C1); } while (0)
#define NSTEP(C0, C1, RMC, N0, N1, RMN, kind) do { \
        if (dcur_) { const int jd_ = 31 - __builtin_clz(dcur_); dcur_ &= ~(1u << jd_); NDMA(jd_, kind, ring_ + ow_); dissued_ = true; } else dissued_ = false; \
        NRESC(C0, C1, RMC); \
        u32x4 pw_[4]; \
        NEXP(C0, C1, pw_); \
        const bool has_ = (ccur_ != 0u); int jn_ = 0; if (has_) { jn_ = 31 - __builtin_clz(ccur_); ccur_ &= ~(1u << jn_); } \
        if (has_) { NCIN(N0, N1, jn_, kind); qkt_nb(N0, N1, lds + ring_ + on_, qr, r32, hi); } \
        __builtin_amdgcn_sched_barrier(0); \
        pv_nb<2>(o, pw_, lds + ring_ + oc_ + 8192, lane, hi); \
        if (has_) NMASK(N0, N1, jn_, kind, RMN); \
        if (dissued_) asm volatile("s_waitcnt vmcnt(2) lgkmcnt(0)\n\ts_barrier" ::: "memory"); else asm volatile("s_waitcnt vmcnt(0) lgkmcnt(0)\n\ts_barrier" ::: "memory"); \
        { const int tmp_ = oc_; oc_ = on_; on_ = o2_; o2_ = ow_; ow_ = tmp_; } \
        more_ = has_; } while (0)
#define NSTREAM(tmask, dmask, kind, ringbase, gate) do { \
        f32x16 o[2]; o[0] = (f32x16){0.f}; o[1] = (f32x16){0.f}; float m = 0.f, lsum = 0.f; bool seen = false; \
        const int ring_ = (ringbase); int oc_ = 0, on_ = 16384, o2_ = 32768, ow_ = 49152; \
        unsigned ccur_ = (tmask), dcur_ = (dmask); bool dissued_ = false, more_ = true; \
        f32x16 sA0, sA1, sB0, sB1; float rmA, rmB = NEG; \
        { const int j0_ = 31 - __builtin_clz(ccur_); ccur_ &= ~(1u << j0_); NCIN(sA0, sA1, j0_, kind); qkt_nb(sA0, sA1, lds + ring_, qr, r32, hi); NMASK(sA0, sA1, j0_, kind, rmA); } \
        for (;;) { NSTEP(sA0, sA1, rmA, sB0, sB1, rmB, kind); if (!more_) break; NSTEP(sB0, sB1, rmB, sA0, sA1, rmA, kind); if (!more_) break; } \
        const float ltot_ = s32(lsum); \
        if (hi == 0) wsf[r32] = (gate) / ltot_; \
        _Pragma("unroll") for (int r = 0; r < 16; ++r) { const float f = wsf[crow(r, hi)]; oacc[0][r] += o[0][r] * f; oacc[1][r] += o[1][r] * f; } \
        asm volatile("" : "+v"(oacc[0]), "+v"(oacc[1])); } while (0)
    if (nsd == 3) asm volatile("s_waitcnt vmcnt(6) lgkmcnt(0)\n\ts_barrier" ::: "memory"); else if (nsd == 2) asm volatile("s_waitcnt vmcnt(4) lgkmcnt(0)\n\ts_barrier" ::: "memory"); else asm volatile("s_waitcnt vmcnt(2) lgkmcnt(0)\n\ts_barrier" ::: "memory");
    if (AB != 1) {
        NSTREAM(wmask, wd, 2, RING_W, g2);
        NSTREAM(uni, sd, 1, RING_S, g1);
    }
#undef NDMA
#undef NCIN
#undef NMASK
#undef NRESC
#undef NEXP
#undef NSTEP
#undef NSTREAM
    QFETCH();
    { LAS bf16_t* stg = (LAS bf16_t*)(lds + wid * 4096);
#pragma unroll
      for (int r = 0; r < 16; ++r) { const int orow = crow(r, hi); stg[orow * 64 + r32] = f2bf(oacc[0][r]); stg[orow * 64 + 32 + r32] = f2bf(oacc[1][r]); }
      asm volatile("s_waitcnt lgkmcnt(0)" ::: "memory");
      bf16_t* ob = (dry ? (bf16_t*)(ws + WS_XN) : NQ) + (tokb + t0) * 512 + h * 64;
      int lane2 = lane; asm volatile("" : "+v"(lane2));
#pragma unroll
      for (int i = 0; i < 4; ++i) { const int row = i * 8 + (lane2 >> 3), ch = lane2 & 7; *(u32x4*)(ob + (size_t)row * 512 + ch * 8) = *(LAS const u32x4*)(stg + row * 64 + ch * 8); } }
    (void)nwd;
    QPARK();
}

__device__ __forceinline__ int next_unit(unsigned* ctr, LAS unsigned char* lds) {
    LAS int* bc = (LAS int*)(lds + LDS_MISC);
    __syncthreads();
    if (TIDX() == 0) bc[0] = (int)__hip_atomic_fetch_add(ctr, 1u, __ATOMIC_RELAXED, __HIP_MEMORY_SCOPE_AGENT);
    __syncthreads();
    return __builtin_amdgcn_readfirstlane(bc[0]);
}


__device__ __forceinline__ void phase_router(PRef p, int l, LAS unsigned char* lds, bool dry = false) {
    int tid_ = TIDX(); asm volatile("" : "+v"(tid_));
    const int tid = tid_, lane = tid & 63, wid = tid >> 6;
    unsigned char* ws = p.ws;
    constexpr int WP = 1028;
    LAS float* WT = (LAS float*)lds;
    LAS unsigned* cntl = (LAS unsigned*)(lds + 82432);
    LAS unsigned* lbase = (LAS unsigned*)(lds + 82432 + 64);
    LAS unsigned* loc = (LAS unsigned*)(lds + 82560);
    LAS float* wloc = (LAS float*)(lds + 82560 + 16384);
    LAS float* GL = (LAS float*)(lds + 115328);
    const float* gwp = p.router_grp_w + (size_t)l * DM * 4; const float* ewp = p.router_exp_w + (size_t)l * DM * 16;
    const float* g2 = p.norm2_g + (size_t)l * DM;
    __syncthreads();
    for (int k = tid; k < DM; k += 512) {
        const float gk = g2[k]; GL[k] = gk;
        const f32x4 a = *(const f32x4*)(gwp + k * 4);
#pragma unroll
        for (int i = 0; i < 4; ++i) WT[i * WP + k] = a[i] * gk;
#pragma unroll
        for (int q4 = 0; q4 < 4; ++q4) { const f32x4 e = *(const f32x4*)(ewp + k * 16 + q4 * 4);
#pragma unroll
            for (int i = 0; i < 4; ++i) WT[(4 + q4 * 4 + i) * WP + k] = e[i] * gk; }
    }
    const float* gb = p.router_grp_b + l * 4; const float* eb = p.router_exp_b + l * 16;
    unsigned* ecnt = (unsigned*)(ws + WS_CTL) + CW_ECNT + 64 * l + (dry ? 32 : 0);
    unsigned* LIST = (unsigned*)(ws + (dry ? WS_NQ : WS_LIST)); float* WL = (float*)(ws + (dry ? WS_NQ + 4 * MiB : WS_WL));
    float* RSTD = (float*)(ws + WS_RSTD);
    const int n = lane & 15, kq = lane >> 4;
    for (int ch = BID(); ch < NTOK / 128; ch += GSZ()) {
        __syncthreads();
        if (tid < 16) cntl[tid] = 0u;
        __syncthreads();
        const int tok = ch * 128 + wid * 16 + n;
        const bf16_t* xr = (const bf16_t*)(ws + WS_HB) + (size_t)tok * DM + kq * 256;
        LAS const float* w0 = WT + n * WP + kq * 256;
        LAS const float* w1 = WT + (16 + (n & 3)) * WP + kq * 256;
        f32x4 acc0 = {0.f, 0.f, 0.f, 0.f}, acc1 = {0.f, 0.f, 0.f, 0.f}; float ss = 0.f;
        u32x4 xa[8], xb[8];
#pragma unroll
        for (int u = 0; u < 8; ++u) xa[u] = *(const u32x4*)(xr + 8 * u);
#define ROUTER_BATCH(XC, XN_, jb) do { \
        if ((jb) + 8 < 32) { _Pragma("unroll") for (int u = 0; u < 8; ++u) XN_[u] = *(const u32x4*)(xr + 8 * ((jb) + 8 + u)); } \
        _Pragma("unroll") for (int u = 0; u < 8; ++u) { const int jj = (jb) + u; const u32x4 xw = XC[u]; \
            const f32x4 x0 = {bflo(xw.x), bfhi(xw.x), bflo(xw.y), bfhi(xw.y)}, x1 = {bflo(xw.z), bfhi(xw.z), bflo(xw.w), bfhi(xw.w)}; \
            const f32x4 a0 = *(LAS const f32x4*)(w0 + 8 * jj), a1 = *(LAS const f32x4*)(w1 + 8 * jj), a2 = *(LAS const f32x4*)(w0 + 8 * jj + 4), a3 = *(LAS const f32x4*)(w1 + 8 * jj + 4); \
            ss += ((x0[0] * x0[0] + x0[1] * x0[1]) + (x0[2] * x0[2] + x0[3] * x0[3])) + ((x1[0] * x1[0] + x1[1] * x1[1]) + (x1[2] * x1[2] + x1[3] * x1[3])); \
            _Pragma("unroll") for (int i = 0; i < 4; ++i) { acc0 = __builtin_amdgcn_mfma_f32_16x16x4f32(a0[i], x0[i], acc0, 0, 0, 0); acc1 = __builtin_amdgcn_mfma_f32_16x16x4f32(a1[i], x0[i], acc1, 0, 0, 0); } \
            _Pragma("unroll") for (int i = 0; i < 4; ++i) { acc0 = __builtin_amdgcn_mfma_f32_16x16x4f32(a2[i], x1[i], acc0, 0, 0, 0); acc1 = __builtin_amdgcn_mfma_f32_16x16x4f32(a3[i], x1[i], acc1, 0, 0, 0); } \
            __builtin_amdgcn_sched_barrier(0); } } while (0)
#pragma unroll 1
        for (int jb = 0; jb < 32; jb += 16) { ROUTER_BATCH(xa, xb, jb); ROUTER_BATCH(xb, xa, jb + 8); }
#undef ROUTER_BATCH
        ss += shx(ss, 16, lane); ss += shx(ss, 32, lane);
        const float rstd = rsqrtf(ss * (1.f / 1024.f) + 1e-6f);
        if (kq == 0) RSTD[tok] = rstd;
        int gi = 0; float gwt = 0.f;
        { float gl[4];
#pragma unroll
          for (int r = 0; r < 4; ++r) gl[r] = acc0[r] * rstd + gb[r];
          float gm = gl[0];
#pragma unroll
          for (int r = 1; r < 4; ++r) if (gl[r] > gm) { gm = gl[r]; gi = r; }
          float gs = 0.f;
#pragma unroll
          for (int r = 0; r < 4; ++r) gs += __expf(gl[r] - gm);
          gwt = 1.f / gs; }
        gi = __builtin_amdgcn_ds_bpermute(n << 2, gi); gwt = shl_(gwt, n);
        const int mygrp = (kq == 0) ? 3 : kq - 1;
        if (mygrp == gi) {
            float el[4];
#pragma unroll
            for (int r = 0; r < 4; ++r) el[r] = ((kq == 0) ? acc1[r] : acc0[r]) * rstd + eb[mygrp * 4 + r];
            int i1 = 0; float v1 = el[0];
#pragma unroll
            for (int e = 1; e < 4; ++e) if (el[e] > v1) { v1 = el[e]; i1 = e; }
            int i2 = -1; float v2 = -3.0e38f;
#pragma unroll
            for (int e = 0; e < 4; ++e) if (e != i1 && el[e] > v2) { v2 = el[e]; i2 = e; }
            const float ex = __expf(v2 - v1), w1_ = gwt / (1.f + ex), w2_ = gwt * ex / (1.f + ex);
            const int e1 = gi * 4 + i1, e2 = gi * 4 + i2;
            const unsigned s1 = __hip_atomic_fetch_add(&cntl[e1], 1u, __ATOMIC_RELAXED, __HIP_MEMORY_SCOPE_WORKGROUP); loc[e1 * 256 + s1] = (unsigned)tok * 2u; wloc[e1 * 256 + s1] = w1_;
            const unsigned s2 = __hip_atomic_fetch_add(&cntl[e2], 1u, __ATOMIC_RELAXED, __HIP_MEMORY_SCOPE_WORKGROUP); loc[e2 * 256 + s2] = (unsigned)tok * 2u + 1u; wloc[e2 * 256 + s2] = w2_;
        }
        __syncthreads();
        if (tid < 16) lbase[tid] = __hip_atomic_fetch_add(&ecnt[tid], cntl[tid], __ATOMIC_RELAXED, __HIP_MEMORY_SCOPE_AGENT);
        __syncthreads();
        for (int e = 0; e < 16; ++e) { const unsigned nn = cntl[e], bs = lbase[e];
            for (unsigned i = tid; i < nn; i += 512) { LIST[(size_t)e * NTOK + bs + i] = loc[e * 256 + i]; WL[(size_t)e * NTOK + bs + i] = wloc[e * 256 + i]; } }
    }
}

struct MoeUnit { int e, tile, n, hoff; };
__device__ __forceinline__ bool moe_find(LAS const int* cnts, int ut, MoeUnit& mu) {
    int pre = 0;
    for (int e = 0; e < 16; ++e) { const int cn = cnts[e], nt = (cn + 127) >> 7; if (ut < pre + nt) { mu.e = e; mu.tile = ut - pre; mu.n = cn - mu.tile * 128; if (mu.n > 128) mu.n = 128; mu.hoff = (pre + mu.tile) * 128; return true; } pre += nt; }
    return false;
}

template <int AB> __device__ __forceinline__ void phase_moe_fused(PRef p, int l, LAS unsigned char* lds) {
    SG_IDS
    unsigned char* ws = p.ws;
    LAS int* cnts = (LAS int*)(lds + LDS_MISC + 64);
    const unsigned* ecnt = (const unsigned*)(ws + WS_CTL) + CW_ECNT + 64 * l;
    __syncthreads();
    if (tid < 16) cnts[tid] = (int)__hip_atomic_load(&ecnt[tid], __ATOMIC_RELAXED, __HIP_MEMORY_SCOPE_AGENT);
    __syncthreads();
    const unsigned* LIST = (const unsigned*)(ws + WS_LIST); const float* WL = (const float*)(ws + WS_WL);
    const char* XN = (const char*)(ws + WS_HB); const float* RSTD = (const float*)(ws + WS_RSTD);
    bf16_t* Y0 = (bf16_t*)(ws + WS_GA); bf16_t* Y1 = (bf16_t*)(ws + WS_GB);
    constexpr int SLOT = 49152;
    const unsigned lds0 = (unsigned)(uintptr_t)lds;
    const int lrow = tid >> 3, lpos = tid & 7, lchk = lpos ^ ((lrow >> 1) & 7);
    const unsigned dw = lds0 + wid * 1024;
    const unsigned wvo = (unsigned)(lrow * DM + lchk * 8) * 2u;
    const unsigned dvo = (unsigned)(((lrow & ~31) + pg8::perm32(lrow & 31)) * 128 + lchk * 8) * 2u;
    MoeUnit mu, mun; int ut = BID();
    if (!moe_find(cnts, ut, mu)) return;
    const char* pa0; const char* pa1; unsigned en0, en1; float wg0, wg1, rs0, rs1;
    const char* pa0n = nullptr; const char* pa1n = nullptr; unsigned en0n = 0, en1n = 0; float wg0n = 0.f, wg1n = 0.f, rs0n = 0.f, rs1n = 0.f;
#define RFL(x) ((unsigned)__builtin_amdgcn_readfirstlane(x))
#define MLOAD1(MU, PA0, PA1, E0_, E1_) do { const unsigned* lst_ = LIST + (size_t)(MU).e * NTOK + (MU).tile * 128; \
        const unsigned g0_ = lst_[lrow < (MU).n ? lrow : (MU).n - 1], g1_ = lst_[lrow + 64 < (MU).n ? lrow + 64 : (MU).n - 1]; \
        PA0 = XN + (size_t)(g0_ >> 1) * 2048 + lchk * 16; PA1 = XN + (size_t)(g1_ >> 1) * 2048 + lchk * 16; \
        const int r0_ = SG_ROW(0), r1_ = SG_ROW(1); E0_ = lst_[r0_ < (MU).n ? r0_ : (MU).n - 1]; E1_ = lst_[r1_ < (MU).n ? r1_ : (MU).n - 1]; } while (0)
#define MLOAD2(MU, E0_, E1_, W0_, W1_, R0_, R1_) do { const float* wl_ = WL + (size_t)(MU).e * NTOK + (MU).tile * 128; const int r0_ = SG_ROW(0), r1_ = SG_ROW(1); \
        const float a0_ = wl_[r0_], a1_ = wl_[r1_]; W0_ = (r0_ < (MU).n) ? a0_ : 0.f; W1_ = (r1_ < (MU).n) ? a1_ : 0.f; R0_ = RSTD[E0_ >> 1]; R1_ = RSTD[E1_ >> 1]; } while (0)
#define ADMA(PA0, PA1, Wp, t, so) do { const int ko_ = (t) * 128; const unsigned o_ = (unsigned)(so); \
        glds16(PA0 + ko_, RFL(dw + o_)); glds16(PA1 + ko_, RFL(dw + o_ + 8192)); \
        glds16s((const char*)(Wp) + ko_, wvo, RFL(dw + o_ + 16384)); glds16s((const char*)((Wp) + (size_t)64 * DM) + ko_, wvo, RFL(dw + o_ + 24576)); \
        glds16s((const char*)((Wp) + (size_t)128 * DM) + ko_, wvo, RFL(dw + o_ + 32768)); glds16s((const char*)((Wp) + (size_t)192 * DM) + ko_, wvo, RFL(dw + o_ + 40960)); } while (0)
#define BDMA(WDp, nt, so) do { const char* b_ = (const char*)((WDp) + (size_t)(nt) * 128 * 128); const unsigned o_ = (unsigned)(so); \
        glds16s(b_, dvo, RFL(dw + o_)); glds16s(b_ + 64 * 128 * 2, dvo, RFL(dw + o_ + 8192)); \
        glds16s(b_ + 128, dvo, RFL(dw + o_ + 16384)); glds16s(b_ + 64 * 128 * 2 + 128, dvo, RFL(dw + o_ + 24576)); } while (0)
#define MWAIT(N) asm volatile("s_waitcnt vmcnt(" #N ") lgkmcnt(0)\n\ts_barrier" ::: "memory")
#define MWAITV(n) do { const int n_ = (n); if (n_ >= 10) MWAIT(10); else if (n_ >= 8) MWAIT(8); else if (n_ >= 6) MWAIT(6); else if (n_ >= 4) MWAIT(4); else MWAIT(0); } while (0)
#define ACOMPUTE(so) do { LAS unsigned char* As = lds + (so); LAS unsigned char* Bg = As + 16384; LAS unsigned char* Bu = As + 32768; \
        _Pragma("unroll") for (int ks = 0; ks < 2; ++ks) { bf16x8 af[2], bg[4], bu[4]; const int ch = ks * 4 + fq; \
            _Pragma("unroll") for (int m = 0; m < 2; ++m) { const int row = wr * 32 + m * 16 + fr; af[m] = *(LAS const bf16x8*)(As + row * 128 + ((ch ^ ((row >> 1) & 7)) << 4)); } \
            _Pragma("unroll") for (int n = 0; n < 4; ++n) { const int row = wc * 64 + n * 16 + fr; const int o_ = row * 128 + ((ch ^ ((row >> 1) & 7)) << 4); bg[n] = *(LAS const bf16x8*)(Bg + o_); bu[n] = *(LAS const bf16x8*)(Bu + o_); } \
            _Pragma("unroll") for (int m = 0; m < 2; ++m) _Pragma("unroll") for (int n = 0; n < 4; ++n) { ag[m][n] = MFMA16(bg[n], af[m], ag[m][n]); au[m][n] = MFMA16(bu[n], af[m], au[m][n]); } } } while (0)
    MLOAD1(mu, pa0, pa1, en0, en1);
    MLOAD2(mu, en0, en1, wg0, wg1, rs0, rs1);
    {
        const bf16_t* W = (const bf16_t*)(ws + WS_WGU) + (size_t)(l * 16 + mu.e) * 256 * DM;
        ADMA(pa0, pa1, W, 0, 0); ADMA(pa0, pa1, W, 1, SLOT);
        MWAIT(6);
    }
    for (;;) {
        const bool has_next = moe_find(cnts, ut + GSZ(), mun);
        const bool full = (mu.n == 128);
        const bf16_t* W = (const bf16_t*)(ws + WS_WGU) + (size_t)(l * 16 + mu.e) * 256 * DM;
        const bf16_t* WD = (const bf16_t*)(ws + WS_WD) + (size_t)(l * 16 + mu.e) * DM * 128;
        f32x4 ag[2][4], au[2][4]; SG_ZERO(ag); SG_ZERO(au);
        int so = 0, so2 = 2 * SLOT;
        for (int t = 0; t < 14; ++t) {
            ADMA(pa0, pa1, W, t + 2, so2);
            ACOMPUTE(so);
            MWAIT(6);
            so += SLOT; if (so == 3 * SLOT) so = 0; so2 += SLOT; if (so2 == 3 * SLOT) so2 = 0;
        }
        BDMA(WD, 0, SLOT);     ACOMPUTE(2 * SLOT); MWAIT(4);
        BDMA(WD, 1, 2 * SLOT); ACOMPUTE(0);        MWAIT(4);
        LAS unsigned char* Hs = lds;
#pragma unroll
        for (int m = 0; m < 2; ++m) { const int rl = SG_ROW(m); const float wgt = m ? wg1 : wg0, rs = m ? rs1 : rs0;
#pragma unroll
            for (int n = 0; n < 4; ++n) { f32x4 gv = ag[m][n] * rs, uv = au[m][n] * rs, hv;
#pragma unroll
                for (int i = 0; i < 4; ++i) hv[i] = gv[i] * sigm(gv[i]) * uv[i] * wgt;
                const int chk = 2 * n + (fq >> 1);
                u32x2 w; w.x = cvtpk(hv[0], hv[1]); w.y = cvtpk(hv[2], hv[3]);
                *(LAS u32x2*)(Hs + wc * 16384 + rl * 128 + ((chk ^ ((rl >> 1) & 7)) << 4) + (fq & 1) * 8) = w; } }
        asm volatile("s_waitcnt lgkmcnt(0)\n\ts_barrier" ::: "memory");
        bf16x8 hf[2][4];
#pragma unroll
        for (int m = 0; m < 2; ++m)
#pragma unroll
            for (int kk = 0; kk < 4; ++kk) { const int row = wr * 32 + m * 16 + fr, ch = (kk & 1) * 4 + fq; hf[m][kk] = *(LAS const bf16x8*)(Hs + (kk >> 1) * 16384 + row * 128 + ((ch ^ ((row >> 1) & 7)) << 4)); }
        asm volatile("s_waitcnt lgkmcnt(0)\n\ts_barrier" ::: "memory");
        const bf16_t* Wn = (const bf16_t*)(ws + WS_WGU) + (size_t)(l * 16 + (has_next ? mun.e : mu.e)) * 256 * DM;
#pragma unroll
        for (int nt = 0; nt < 8; ++nt) {
            const int sb = ((16 + nt) % 3) * SLOT, sb2 = ((18 + nt) % 3) * SLOT;
            int cnew = 0;
            if (nt + 2 < 8) { BDMA(WD, nt + 2, sb2); cnew = 4; }
            else if (has_next) { ADMA(pa0n, pa1n, Wn, nt - 6, sb2); cnew = 6; }
            if (nt == 0 && has_next) MLOAD1(mun, pa0n, pa1n, en0n, en1n);
            if (nt == 4 && has_next) MLOAD2(mun, en0n, en1n, wg0n, wg1n, rs0n, rs1n);
            f32x4 acc[2][4]; SG_ZERO(acc);
#pragma unroll
            for (int kk = 0; kk < 4; ++kk) {
                bf16x8 bfr[4];
                const int ch = (kk & 1) * 4 + fq;
#pragma unroll
                for (int n = 0; n < 4; ++n) { const int row = wc * 64 + n * 16 + fr; bfr[n] = *(LAS const bf16x8*)(lds + sb + (kk >> 1) * 16384 + row * 128 + ((ch ^ ((row >> 1) & 7)) << 4)); }
#pragma unroll
                for (int m = 0; m < 2; ++m)
#pragma unroll
                    for (int n = 0; n < 4; ++n) acc[m][n] = MFMA16(bfr[n], hf[m][kk], acc[m][n]);
            }
            MWAITV(cnew + ((nt > 0 && full && AB != 5) ? 4 : 0));
#pragma unroll
            for (int m = 0; m < 2; ++m) if (SG_ROW(m) < mu.n) { const unsigned en = m ? en1 : en0; bf16_t* dst = ((en & 1u) ? Y1 : Y0) + (size_t)(en >> 1) * DM + nt * 128 + wc * 64 + 8 * fq;
#pragma unroll
                for (int np = 0; np < 2; ++np) { const f32x4 v0 = acc[m][2 * np], v1 = acc[m][2 * np + 1];
                    if (AB == 5) { asm volatile("" :: "v"(v0), "v"(v1)); continue; }
                    u32x4 w; w.x = cvtpk(v0[0], v0[1]); w.y = cvtpk(v0[2], v0[3]); w.z = cvtpk(v1[0], v1[1]); w.w = cvtpk(v1[2], v1[3]); *(u32x4*)(dst + 32 * np) = w; } }
        }
        if (!has_next) break;
        mu = mun; ut += GSZ(); pa0 = pa0n; pa1 = pa1n; en0 = en0n; en1 = en1n; wg0 = wg0n; wg1 = wg1n; rs0 = rs0n; rs1 = rs1n;
    }
#undef RFL
#undef MLOAD1
#undef MLOAD2
#undef ADMA
#undef BDMA
#undef MWAIT
#undef MWAITV
#undef ACOMPUTE
}

__device__ __forceinline__ void phase_combine(PRef p, int l, bool dry = false) {
    int tid_ = TIDX(); asm volatile("" : "+v"(tid_));
    const int tid = tid_, lane = tid & 63, wid = tid >> 6;
    unsigned char* ws = p.ws;
    const int gw = BID() * 8 + wid, NGW = GSZ() * 8;
    const bf16_t* Y0 = (const bf16_t*)(ws + WS_GA); const bf16_t* Y1 = (const bf16_t*)(ws + WS_GB);
    bf16_t* HB = (bf16_t*)(ws + WS_HB); bf16_t* HO = dry ? (bf16_t*)(ws + WS_NQ) : HB; float* OUT = dry ? (float*)(ws + WS_NQ) : p.out;
    const bool last = (l == DEPTH - 1);
    for (int m0 = gw * 4; m0 < NTOK; m0 += NGW * 4) {
        u32x2 hv[4][4], ya[4][4], yb[4][4];
#pragma unroll
        for (int rr = 0; rr < 4; ++rr)
#pragma unroll
            for (int j = 0; j < 4; ++j) { const size_t off = (size_t)(m0 + rr) * DM + (64 * j + lane) * 4; hv[rr][j] = *(const u32x2*)(HB + off); ya[rr][j] = *(const u32x2*)(Y0 + off); yb[rr][j] = *(const u32x2*)(Y1 + off); }
#pragma unroll
        for (int rr = 0; rr < 4; ++rr) {
            f32x4 v[4]; float s = 0.f;
#pragma unroll
            for (int j = 0; j < 4; ++j) { const u32x2 h2 = hv[rr][j], a = ya[rr][j], b2 = yb[rr][j];
                v[j] = (f32x4){bflo(h2.x), bfhi(h2.x), bflo(h2.y), bfhi(h2.y)} + (f32x4){bflo(a.x), bfhi(a.x), bflo(a.y), bfhi(a.y)} + (f32x4){bflo(b2.x), bfhi(b2.x), bflo(b2.y), bfhi(b2.y)};
                s += (v[j][0] * v[j][0] + v[j][1] * v[j][1]) + (v[j][2] * v[j][2] + v[j][3] * v[j][3]); }
            const float rstd = rsqrtf(wave_sum(s, lane) * (1.f / 1024.f) + 1e-6f);
            if (last) {
#pragma unroll
                for (int j = 0; j < 4; ++j) { const int cidx = (64 * j + lane) * 4; const f32x4 gg = *(const f32x4*)(p.final_norm_g + cidx); *(f32x4*)(OUT + (size_t)(m0 + rr) * DM + cidx) = v[j] * rstd * gg; }
            } else {
                if (lane == 0 && !dry) ((float*)(ws + WS_RSTD1))[m0 + rr] = rstd;
#pragma unroll
                for (int j = 0; j < 4; ++j) st4bf(HO + (size_t)(m0 + rr) * DM + (64 * j + lane) * 4, v[j]);
            }
        }
    }
}

#define XB_TMO      128
#define XB_XCNT(j)  (256  + 64 * (j))
#define XB_XSUB(j)  (1280 + 64 * (j))
#define XB_XGEN(j)  (2304 + 64 * (j))
#define XB_TOP      3328
#define XB_TOPGEN   3392
#define XCD_BAR_WORDS 3456
#define XB_SPIN_CAP (1u << 18)
__device__ __forceinline__ unsigned xb_ld(unsigned* p)              { return __hip_atomic_load(p, __ATOMIC_RELAXED, __HIP_MEMORY_SCOPE_AGENT); }
__device__ __forceinline__ unsigned xb_add(unsigned* p, unsigned v) { return __hip_atomic_fetch_add(p, v, __ATOMIC_RELAXED, __HIP_MEMORY_SCOPE_AGENT); }
__device__ __forceinline__ unsigned xb_xcc_id() { return (unsigned)__builtin_amdgcn_s_getreg((3 << 11) | 20) & 0xFu; }
#define XB_SPIN(cond, bar) do { unsigned _sp = 0; while (cond) { __builtin_amdgcn_s_sleep(1); \
    if ((++_sp & 255u) == 0u) { if (xb_ld(&(bar)[XB_TMO])) break; if (_sp > XB_SPIN_CAP) { atomicAdd(&(bar)[XB_TMO], 1u); break; } } } } while (0)
struct XcdBarrier { unsigned* bar; unsigned x; volatile LAS unsigned* st; };
__device__ __forceinline__ XcdBarrier xcd_barrier_post(unsigned* bar, volatile LAS unsigned* st) {
    XcdBarrier b; b.bar = bar; b.x = xb_xcc_id(); b.st = st;
    if (TIDX() == 0) (void)xb_add(&bar[XB_XCNT(b.x)], 1u);
    return b;
}
__device__ __forceinline__ void xcd_barrier_complete(unsigned* bar, unsigned x, unsigned& nloc, unsigned& nx) {
    const unsigned G = gridDim.x * gridDim.y * gridDim.z;
    unsigned sum, cnt, mine, sp = 0u;
    for (;;) {
        sum = 0u; cnt = 0u; mine = 0u;
#pragma unroll
        for (unsigned j = 0; j < 16; ++j) { const unsigned c = xb_ld(&bar[XB_XCNT(j)]); sum += c; cnt += (c > 0u) ? 1u : 0u; mine = (j == x) ? c : mine; }
        if (sum == G) break;
        __builtin_amdgcn_s_sleep(1);
        if ((++sp & 255u) == 0u) { if (xb_ld(&bar[XB_TMO])) break; if (sp > XB_SPIN_CAP) { atomicAdd(&bar[XB_TMO], 1u); break; } }
    }
    nloc = mine > 0u ? mine : 1u; nx = cnt > 0u ? cnt : 1u;
}
__device__ __forceinline__ void xcd_barrier(const XcdBarrier& b_) {
    asm volatile("s_waitcnt vmcnt(0)" ::: "memory");
    __syncthreads();
    if (TIDX() == 0) {
        unsigned* bar = b_.bar; asm volatile("" : "+s"(bar));
        XcdBarrier b; b.bar = bar; b.st = b_.st; b.x = xb_xcc_id();
        __builtin_amdgcn_s_waitcnt(0);
        unsigned nloc = b.st[0], nx = b.st[1];
        if (nloc == 0u) { xcd_barrier_complete(bar, b.x, nloc, nx); b.st[0] = nloc; b.st[1] = nx; }
        const unsigned old = xb_add(&bar[XB_XSUB(b.x)], 1u);
        const unsigned gen = old / nloc;
        if (old + 1u == (gen + 1u) * nloc) {
            __builtin_amdgcn_fence(__ATOMIC_RELEASE, "agent");
            asm volatile("s_waitcnt vmcnt(0)" ::: "memory");
            const unsigned og = xb_add(&bar[XB_TOP], 1u);
            const unsigned tg = og / nx;
            if (og + 1u == (tg + 1u) * nx) xb_add(&bar[XB_TOPGEN], 1u);
            else XB_SPIN(xb_ld(&bar[XB_TOPGEN]) == tg, bar);
            __builtin_amdgcn_fence(__ATOMIC_ACQUIRE, "agent");
            xb_add(&bar[XB_XGEN(b.x)], 1u);
            asm volatile("s_waitcnt vmcnt(0)" ::: "memory");
        } else {
            XB_SPIN(xb_ld(&bar[XB_XGEN(b.x)]) == gen, bar);
            __builtin_amdgcn_fence(__ATOMIC_ACQUIRE, "agent");
            asm volatile("s_waitcnt vmcnt(0)" ::: "memory");
        }
    }
    __syncthreads();
}

template <int K> __device__ __forceinline__ void run_phase(PRef p, int l, LAS unsigned char* lds, bool dry = false) {
    unsigned* ctl = (unsigned*)(p.ws + WS_CTL);
    if (K == 0) phase_prologue(p, lds);
    if (K == 1) { if (dry) phase_inproj_pg8<ABL>(p, l, lds); else { phase_inproj_pg8<0>(p, l, lds); if (l + 1 < DEPTH) { __syncthreads(); weight_prep(p, l + 1, lds); } } }
    if (K == 2) { unsigned* ctr = ctl + CW_QCTR + 64 * (l * 2 + 0) + (dry ? 16 : 0);
        int u = next_unit(ctr, lds);
        while (u < 64 + 1024) { if (u < 64) compress_unit(p, l, u, lds, ctr); else { if (dry) diff_unit<ABL>(p, l, u - 64, lds, true, ctr); else diff_unit<0>(p, l, u - 64, lds, false, ctr); }
            __syncthreads(); u = __builtin_amdgcn_readfirstlane(((LAS int*)(lds + LDS_MISC))[1]); } }
    if (K == 3) { unsigned* ctr = ctl + CW_QCTR + 64 * (l * 2 + 1) + (dry ? 16 : 0);
        int u = next_unit(ctr, lds);
        while (u < 1024) { if (dry) nsa_unit<ABL>(p, l, u, lds, true, ctr); else nsa_unit<0>(p, l, u, lds, false, ctr);
            __syncthreads(); u = __builtin_amdgcn_readfirstlane(((LAS int*)(lds + LDS_MISC))[1]); } }
    if (K == 4) phase_merge_pg8(p, l, lds);
    if (K == 5) phase_outproj_pg8(p, l, lds, dry);
    if (K == 6) phase_router(p, l, lds, dry);
    if (K == 7) { if (dry) phase_moe_fused<ABL>(p, l, lds); else phase_moe_fused<0>(p, l, lds); }
    if (K == 9) phase_combine(p, l, dry);
}
#if MK_MULTI
template <int K> __global__ void __launch_bounds__(512, 2) mk_one(Params p) {
    extern __shared__ __attribute__((aligned(16))) unsigned char lds_raw[];
    const __attribute__((address_space(4))) Params* pp_ = (const __attribute__((address_space(4))) Params*)__builtin_amdgcn_kernarg_segment_ptr();
    if ((threadIdx.x & 63) == 0) ((LAS int*)(size_t)LDS_WTAB)[hw_wave_key()] = (int)(threadIdx.x >> 6);
    __syncthreads();
    run_phase<K>(*pp_, p.ph_lo, (LAS unsigned char*)lds_raw);
}
template <int K> static void launch_one(int grid, hipStream_t stream, Params p, int l) {
    static bool attr = false;
    if (!attr) { (void)hipFuncSetAttribute((const void*)mk_one<K>, hipFuncAttributeMaxDynamicSharedMemorySize, LDS_BYTES); attr = true; }
    p.ph_lo = l; p.ph_hi = l + 1;
    hipLaunchKernelGGL(mk_one<K>, dim3(grid), dim3(512), LDS_BYTES, stream, p);
}
#else
__global__ void __launch_bounds__(512, 2) mk_fwd(Params p) {
    extern __shared__ __attribute__((aligned(16))) unsigned char lds_raw[];
    LAS unsigned char* lds = (LAS unsigned char*)lds_raw;
    volatile LAS unsigned* bst = (volatile LAS unsigned*)(lds + LDS_MISC + 256);
    if ((threadIdx.x & 63) == 0) ((LAS int*)(size_t)LDS_WTAB)[hw_wave_key()] = (int)(threadIdx.x >> 6);
    if (threadIdx.x < 2) bst[threadIdx.x] = 0u;
    __syncthreads();
    const XcdBarrier bar = xcd_barrier_post((unsigned*)(p.ws + WS_CTL) + CW_BAR, bst);
#define SEAM() xcd_barrier(bar)
#ifndef PROBE_DUP
#define PROBE_DUP -1
#endif
#ifndef PROBE_DUP2
#define PROBE_DUP2 -1
#endif
#define RUN(K, l) do { const __attribute__((address_space(4))) Params* pp_ = (const __attribute__((address_space(4))) Params*)__builtin_amdgcn_kernarg_segment_ptr(); asm volatile("" : "+s"(pp_)); \
    if (K == PROBE_DUP || K == PROBE_DUP2) { run_phase<K>(*pp_, l, lds, true); SEAM(); } run_phase<K>(*pp_, l, lds); } while (0)
    RUN(0, 0); SEAM();
    for (int l = 0; l < DEPTH; ++l) {
        RUN(1, l); SEAM();
        RUN(2, l); SEAM();
        RUN(3, l); SEAM();
        RUN(4, l); SEAM();
        RUN(5, l); SEAM();
        RUN(6, l); SEAM();
        RUN(7, l); SEAM();
        RUN(9, l); if (l + 1 < DEPTH) SEAM();
    }
}
#endif

extern "C" void kernel_launch(void* const* d_in, const int* in_sizes, int n_in, void* d_out, int out_size, void* d_ws, size_t ws_size, hipStream_t stream) {
    static int grid = 0;
    if (grid == 0) {
        if (n_in != 22 || in_sizes[0] != NTOK * DM || out_size != NTOK * DM || ws_size < WS_END) { fprintf(stderr, "kernel_launch: unexpected shapes (n_in %d, in0 %d, out %d, ws %zu)\n", n_in, n_in > 0 ? in_sizes[0] : -1, out_size, ws_size); grid = -1; return; }
        int dev = 0, cus = 0, per_cu = 1;
        (void)hipGetDevice(&dev); (void)hipDeviceGetAttribute(&cus, hipDeviceAttributeMultiprocessorCount, dev);
#if !MK_MULTI
        (void)hipFuncSetAttribute((const void*)mk_fwd, hipFuncAttributeMaxDynamicSharedMemorySize, LDS_BYTES);
        (void)hipOccupancyMaxActiveBlocksPerMultiprocessor(&per_cu, (const void*)mk_fwd, 512, LDS_BYTES);
        if (per_cu < 1) { fprintf(stderr, "kernel_launch: occupancy query says %d blocks per CU\n", per_cu); per_cu = 1; }
#endif
        (void)hipGetLastError();
        grid = cus * per_cu;
    }
    if (grid < 0) return;
    (void)hipMemsetAsync((char*)d_ws + WS_CTL, 0, CTL_BYTES, stream);
    Params p{};
    const float** pp = (const float**)&p;
    for (int i = 0; i < 22; ++i) pp[i] = (const float*)d_in[i];
    p.out = (float*)d_out; p.ws = (unsigned char*)d_ws;
#if MK_MULTI
    launch_one<0>(grid, stream, p, 0);
    for (int l = 0; l < DEPTH; ++l) {
        launch_one<1>(grid, stream, p, l); launch_one<2>(grid, stream, p, l); launch_one<3>(grid, stream, p, l); launch_one<4>(grid, stream, p, l); launch_one<5>(grid, stream, p, l);
        launch_one<6>(grid, stream, p, l); launch_one<7>(grid, stream, p, l); launch_one<9>(grid, stream, p, l);
    }
#else
    p.ph_lo = 0; p.ph_hi = NPHASE;
    void* args[] = {&p};
    hipError_t e = hipLaunchCooperativeKernel((const void*)mk_fwd, dim3(grid), dim3(512), args, LDS_BYTES, stream);
    if (e != hipSuccess) fprintf(stderr, "cooperative launch failed: %s (grid %d)\n", hipGetErrorString(e), grid);
#endif
}
```

```cpp
#include <hip/hip_runtime.h>
#include <hip/hip_cooperative_groups.h>
#include <cstdio>
#include <cstdint>
namespace cg = cooperative_groups;

#ifndef MK_MULTI
#define MK_MULTI 0
#endif

#define LAS __attribute__((address_space(3)))
typedef unsigned short bf16_t;
typedef short bf16x8 __attribute__((ext_vector_type(8)));
typedef short s16x4 __attribute__((ext_vector_type(4)));
typedef float f32x2 __attribute__((ext_vector_type(2)));
typedef float f32x4 __attribute__((ext_vector_type(4)));
typedef float f32x16 __attribute__((ext_vector_type(16)));
typedef unsigned u32x2 __attribute__((ext_vector_type(2)));
typedef unsigned u32x4 __attribute__((ext_vector_type(4)));
typedef __bf16 bf16x2_t __attribute__((ext_vector_type(2)));

constexpr int NTOK = 32768, DM = 1024, TSEQ = 2048, NBATCH = 16, DEPTH = 2;
constexpr int INCOLS = 4888, NPAD = 5120;
constexpr float LOG2E = 1.4426950408889634f;
constexpr float QSCALE = 0.125f * LOG2E;
constexpr int NPHASE = 1 + 9 * DEPTH;

constexpr size_t MiB = 1u << 20;
constexpr size_t WS_CTL = 0, CTL_BYTES = 65536;
constexpr size_t WS_WIN = 1 * MiB;
constexpr size_t WS_WA = 21 * MiB;
constexpr size_t WS_WB = 23 * MiB;
constexpr size_t WS_WO = 25 * MiB;
constexpr size_t WS_WC1 = 29 * MiB;
constexpr size_t WS_WGU = 31 * MiB;
constexpr size_t WS_WD = 47 * MiB;
constexpr size_t WS_MISC = 55 * MiB;
constexpr size_t WS_LIST = 58 * MiB;
constexpr size_t WS_WL = 60 * MiB;
constexpr size_t WS_XN = 64 * MiB;
constexpr size_t WS_NQ = 128 * MiB;
constexpr size_t WS_KV6 = 160 * MiB;
constexpr size_t WS_NG = 208 * MiB;
constexpr size_t WS_DQ = 210 * MiB;
constexpr size_t WS_DK = 242 * MiB;
constexpr size_t WS_DV = 274 * MiB;
constexpr size_t WS_GA = 306 * MiB;
constexpr size_t WS_GB = 370 * MiB;
constexpr size_t WS_HB = 434 * MiB;
constexpr size_t WS_END = 498 * MiB;
constexpr size_t WS_RSTD = WS_MISC + 2 * MiB;
constexpr size_t WS_RSTD1 = WS_MISC + 2 * MiB + 131072;
constexpr size_t WS_H = WS_DK;
constexpr int CW_QCTR = 64;
constexpr int CW_ECNT = 1024;
constexpr int CW_BAR = 4096;

constexpr int LDS_BYTES = 151552;
constexpr int LDS_MISC = 147456;

struct Params {
    const float* x; const float* norm1_g; const float* w_in; const float* cmp_pe; const float* cmp_w1; const float* cmp_b1; const float* cmp_w2; const float* cmp_b2;
    const float* diff_lambda; const float* diff_subln_g; const float* w_branch_a; const float* w_branch_b; const float* w_out; const float* norm2_g;
    const float* router_grp_w; const float* router_grp_b; const float* router_exp_w; const float* router_exp_b; const float* exp_w_gate; const float* exp_w_up; const float* exp_w_down; const float* final_norm_g;
    float* out; unsigned char* ws; int ph_lo, ph_hi;
};

typedef const __attribute__((address_space(4))) Params& PRef;

constexpr int LDS_WTAB = LDS_MISC + 512;
__device__ __forceinline__ int hw_wave_key() { return (int)(__builtin_amdgcn_s_getreg((5 << 11) | 4) & 63u); }
__device__ __forceinline__ int TIDX() {
    int lane, key;
    asm volatile("v_mbcnt_lo_u32_b32 %0, -1, 0\n\tv_mbcnt_hi_u32_b32 %0, -1, %0\n\ts_getreg_b32 %1, hwreg(HW_REG_HW_ID, 0, 6)" : "=&v"(lane), "=s"(key));
    const int wv = __builtin_amdgcn_readfirstlane(((LAS const int*)(size_t)LDS_WTAB)[key]);
    return wv * 64 + lane;
}
__device__ __forceinline__ int BID() { int b = (int)blockIdx.x; asm volatile("" : "+s"(b)); return b; }
__device__ __forceinline__ int GSZ() { int g = (int)gridDim.x; asm volatile("" : "+s"(g)); return g; }
__device__ __forceinline__ unsigned cvtpk(float lo, float hi) { f32x2 v = {lo, hi}; bf16x2_t b = __builtin_convertvector(v, bf16x2_t); return __builtin_bit_cast(unsigned, b); }
__device__ __forceinline__ float bflo(unsigned u) { return __uint_as_float(u << 16); }
__device__ __forceinline__ float bfhi(unsigned u) { return __uint_as_float(u & 0xffff0000u); }
__device__ __forceinline__ float bf1(bf16_t b) { return __uint_as_float(((unsigned)b) << 16); }
__device__ __forceinline__ bf16_t f2bf(float f) { return (bf16_t)(cvtpk(f, 0.f) & 0xffffu); }
__device__ __forceinline__ int crow(int r, int hi) { return (r & 3) + 8 * (r >> 2) + 4 * hi; }
__device__ __forceinline__ float shx(float v, int m, int lane) { return __int_as_float(__builtin_amdgcn_ds_bpermute((lane ^ m) << 2, __float_as_int(v))); }
__device__ __forceinline__ unsigned shxu(unsigned v, int m, int lane) { return (unsigned)__builtin_amdgcn_ds_bpermute((lane ^ m) << 2, (int)v); }
__device__ __forceinline__ float shl_(float v, int src) { return __int_as_float(__builtin_amdgcn_ds_bpermute(src << 2, __float_as_int(v))); }
__device__ __forceinline__ float wave_sum(float v, int lane) {
#pragma unroll
    for (int o = 1; o < 64; o <<= 1) v += shx(v, o, lane);
    return v;
}
__device__ __forceinline__ float s32(float x) { auto rr = __builtin_amdgcn_permlane32_swap(__float_as_uint(x), __float_as_uint(x), false, false); return __uint_as_float(rr[0]) + __uint_as_float(rr[1]); }
__device__ __forceinline__ float m32(float x) { auto rr = __builtin_amdgcn_permlane32_swap(__float_as_uint(x), __float_as_uint(x), false, false); return fmaxf(__uint_as_float(rr[0]), __uint_as_float(rr[1])); }
__device__ __forceinline__ float o32(float x, int hi) { auto rr = __builtin_amdgcn_permlane32_swap(__float_as_uint(x), __float_as_uint(x), false, false); return hi ? __uint_as_float(rr[0]) : __uint_as_float(rr[1]); }
__device__ __forceinline__ float sigm(float x) { return __builtin_amdgcn_rcpf(1.f + __builtin_amdgcn_exp2f(-1.4426950408889634f * x)); }
__device__ __forceinline__ float ex2(float x) { return __builtin_amdgcn_exp2f(x); }
__device__ __forceinline__ float alibi_slope(int i  ) { return exp2f(-8.0f * (float)i / 12.0f); }
__device__ __forceinline__ s16x4 vtr(LAS const unsigned char* p) { return __builtin_bit_cast(s16x4, __builtin_amdgcn_ds_read_tr16_b64_v4i16((LAS s16x4*)p)); }
#define MFMA32(a, b, c) __builtin_amdgcn_mfma_f32_32x32x16_bf16(a, b, c, 0, 0, 0)
#define MFMA16(a, b, c) __builtin_amdgcn_mfma_f32_16x16x32_bf16(a, b, c, 0, 0, 0)

struct ARowLin { const char* base; size_t stride; __device__ __forceinline__ const char* operator()(int r) const { return base + (size_t)r * stride; } };

template <class ARow>
__device__ __forceinline__ void sg_kloop(f32x4 (&acc)[2][4], const ARow& arow, int kstepA, const bf16_t* Bt, int ldb, int nt, LAS unsigned char* lds) {
    int tid_ = TIDX(); asm volatile("" : "+v"(tid_));
    const int tid = tid_, lane = tid & 63, wid = tid >> 6, wr = wid >> 1, wc = wid & 1, fr = lane & 15, fq = lane >> 4;
    const int lrow = tid >> 3, lch = tid & 7;
    const char* pa0 = arow(lrow) + lch * 16; const char* pa1 = arow(lrow + 64) + lch * 16;
    const char* pb0 = (const char*)(Bt + (size_t)lrow * ldb) + lch * 16; const char* pb1 = (const char*)(Bt + (size_t)(lrow + 64) * ldb) + lch * 16;
    const int wofs0 = lrow * 128 + ((lch ^ ((lrow >> 1) & 7)) << 4), wofs1 = wofs0 + 64 * 128;
    u32x4 ra0 = *(const u32x4*)pa0, ra1 = *(const u32x4*)pa1, rb0 = *(const u32x4*)pb0, rb1 = *(const u32x4*)pb1;
    for (int t = 0; t < nt; ++t) {
        __syncthreads();
        *(LAS u32x4*)(lds + wofs0) = ra0; *(LAS u32x4*)(lds + wofs1) = ra1; *(LAS u32x4*)(lds + 16384 + wofs0) = rb0; *(LAS u32x4*)(lds + 16384 + wofs1) = rb1;
        __syncthreads();
        if (t + 1 < nt) { pa0 += kstepA; pa1 += kstepA; pb0 += 128; pb1 += 128; ra0 = *(const u32x4*)pa0; ra1 = *(const u32x4*)pa1; rb0 = *(const u32x4*)pb0; rb1 = *(const u32x4*)pb1; }
#pragma unroll
        for (int ks = 0; ks < 2; ++ks) {
            bf16x8 af[2], bfr[4];
            const int ch = ks * 4 + fq;
#pragma unroll
            for (int m = 0; m < 2; ++m) { const int row = wr * 32 + m * 16 + fr; af[m] = *(LAS const bf16x8*)(lds + row * 128 + ((ch ^ ((row >> 1) & 7)) << 4)); }
#pragma unroll
            for (int n = 0; n < 4; ++n) { const int row = wc * 64 + n * 16 + fr; bfr[n] = *(LAS const bf16x8*)(lds + 16384 + row * 128 + ((ch ^ ((row >> 1) & 7)) << 4)); }
#pragma unroll
            for (int m = 0; m < 2; ++m)
#pragma unroll
                for (int n = 0; n < 4; ++n) acc[m][n] = MFMA16(bfr[n], af[m], acc[m][n]);
        }
    }
}
#define SG_ZERO(acc) do { _Pragma("unroll") for (int m_ = 0; m_ < 2; ++m_) _Pragma("unroll") for (int n_ = 0; n_ < 4; ++n_) acc[m_][n_] = (f32x4){0.f, 0.f, 0.f, 0.f}; } while (0)
#define SG_IDS int tid_ = TIDX(); asm volatile("" : "+v"(tid_)); const int tid = tid_, lane = tid & 63, wid = tid >> 6, wr = wid >> 1, wc = wid & 1, fr = lane & 15, fq = lane >> 4; (void)tid; (void)lane; (void)wid;
#define SG_ROW(m) (wr * 32 + (m) * 16 + fr)
#define SG_COL(n) (wc * 64 + (n) * 16 + 4 * fq)
__device__ __forceinline__ void st4bf(bf16_t* dst, f32x4 v) { u32x2 w; w.x = cvtpk(v[0], v[1]); w.y = cvtpk(v[2], v[3]); *(u32x2*)dst = w; }

__device__ __forceinline__ void transpose_item(const float* W, int ldw, int src_col, int valid, bf16_t* WT, int K, int dst_row, int k0, LAS float* scr, int lane, const float* gk = nullptr  ) {
    const int kq = lane >> 3, c4 = (lane & 7) * 4;
    if ((valid == 32) && ((src_col & 3) == 0) && ((ldw & 3) == 0)) {
        f32x4 v[8];
#pragma unroll
        for (int i = 0; i < 8; ++i) v[i] = *(const f32x4*)(W + (size_t)(k0 + 8 * i + kq) * ldw + src_col + c4);
        if (gk) {
#pragma unroll
            for (int i = 0; i < 8; ++i) v[i] = v[i] * gk[k0 + 8 * i + kq]; }
#pragma unroll
        for (int i = 0; i < 8; ++i) { LAS float* d = scr + (8 * i + kq) * 33 + c4; d[0] = v[i][0]; d[1] = v[i][1]; d[2] = v[i][2]; d[3] = v[i][3]; }
    } else {
        float v[32];
#pragma unroll
        for (int i = 0; i < 32; ++i) { const int kk = 2 * i + (lane >> 5), c = lane & 31; v[i] = (c < valid) ? W[(size_t)(k0 + kk) * ldw + src_col + c] * (gk ? gk[k0 + kk] : 1.f) : 0.f; }
#pragma unroll
        for (int i = 0; i < 32; ++i) { const int kk = 2 * i + (lane >> 5), c = lane & 31; scr[kk * 33 + c] = v[i]; }
    }
    asm volatile("s_waitcnt lgkmcnt(0)" ::: "memory");
    const int c = lane & 7;
#pragma unroll
    for (int j = 0; j < 4; ++j) { const int n = (lane >> 3) + 8 * j; LAS const float* s = scr + (8 * c) * 33 + n;
        u32x4 o; o.x = cvtpk(s[0 * 33], s[1 * 33]); o.y = cvtpk(s[2 * 33], s[3 * 33]); o.z = cvtpk(s[4 * 33], s[5 * 33]); o.w = cvtpk(s[6 * 33], s[7 * 33]);
        *(u32x4*)(WT + (size_t)(dst_row + n) * K + k0 + 8 * c) = o; }
    asm volatile("s_waitcnt lgkmcnt(0)" ::: "memory");
}
__device__ __forceinline__ void weight_prep(PRef p, int l, LAS unsigned char* lds) {
    int tid_ = TIDX(); asm volatile("" : "+v"(tid_));
    const int tid = tid_, lane = tid & 63, wid = tid >> 6;
    const int gw = BID() * 8 + wid, NGW = GSZ() * 8;
    LAS float* scr = (LAS float*)(lds + wid * 8448);
    unsigned char* ws = p.ws;
    constexpr int I_IN = 16 * 160, I_A = 8 * 32, I_O = 16 * 32, I_C1 = 2 * 32 * 4, I_G = 16 * 16 * 4, I_D = 16 * 2 * 32;
    constexpr int I_LAYER = I_IN + 2 * I_A + I_O + I_C1 + 2 * I_G + I_D;
    for (int it = gw; it < I_LAYER; it += NGW) {
        int r = it;
        if (r < I_IN) { const int kb = r / 160, nb = r % 160, n0 = nb * 32; int src, valid = 32;
            if (n0 < 1280) src = n0; else if (n0 < 4864) src = n0 + 24; else { src = 1280 + (n0 - 4864); valid = (n0 == 4864) ? 24 : 0; if (valid == 0) src = 0; }
            transpose_item(p.w_in + (size_t)l * DM * INCOLS, INCOLS, src, valid, (bf16_t*)(ws + WS_WIN) + (size_t)l * NPAD * DM, DM, n0, kb * 64, scr, lane, p.norm1_g + (size_t)l * DM); continue; }
        r -= I_IN;
        if (r < I_A) { const int kb = r / 32, nb = r % 32; transpose_item(p.w_branch_a + (size_t)l * 512 * DM, DM, nb * 32, 32, (bf16_t*)(ws + WS_WA) + (size_t)l * DM * 512, 512, nb * 32, kb * 64, scr, lane); continue; }
        r -= I_A;
        if (r < I_A) { const int kb = r / 32, nb = r % 32; transpose_item(p.w_branch_b + (size_t)l * 512 * DM, DM, nb * 32, 32, (bf16_t*)(ws + WS_WB) + (size_t)l * DM * 512, 512, nb * 32, kb * 64, scr, lane); continue; }
        r -= I_A;
        if (r < I_O) { const int kb = r / 32, nb = r % 32; transpose_item(p.w_out + (size_t)l * DM * DM, DM, nb * 32, 32, (bf16_t*)(ws + WS_WO) + (size_t)l * DM * DM, DM, nb * 32, kb * 64, scr, lane); continue; }
        r -= I_O;
        if (r < I_C1) { const int kv = r / 128, r2 = r % 128, kb = r2 / 4, nb = r2 % 4;
            transpose_item(p.cmp_w1 + (size_t)(l * 2 + kv) * 2048 * 128, 128, nb * 32, 32, (bf16_t*)(ws + WS_WC1) + (size_t)(l * 2 + kv) * 128 * 2048, 2048, nb * 32, kb * 64, scr, lane); continue; }
        r -= I_C1;
        if (r < 2 * I_G) { const int which = r / I_G, r2 = r % I_G, e = r2 / 64, r3 = r2 % 64, kb = r3 / 4, nb = r3 % 4;
            const float* W = (which ? p.exp_w_up : p.exp_w_gate) + (size_t)(l * 16 + e) * DM * 128;
            transpose_item(W, 128, nb * 32, 32, (bf16_t*)(ws + WS_WGU) + (size_t)(l * 16 + e) * 256 * DM, DM, which * 128 + nb * 32, kb * 64, scr, lane, p.norm2_g + (size_t)l * DM); continue; }
        r -= 2 * I_G;
        { const int e = r / 64, r3 = r % 64, kb = r3 / 32, nb = r3 % 32;
            transpose_item(p.exp_w_down + (size_t)(l * 16 + e) * 128 * DM, DM, nb * 32, 32, (bf16_t*)(ws + WS_WD) + (size_t)(l * 16 + e) * DM * 128, 128, nb * 32, kb * 64, scr, lane); }
    }
}
__device__ __forceinline__ void phase_prologue(PRef p, LAS unsigned char* lds) {
    int tid_ = TIDX(); asm volatile("" : "+v"(tid_));
    const int tid = tid_, lane = tid & 63, wid = tid >> 6;
    const int gw = BID() * 8 + wid, NGW = GSZ() * 8;
    LAS float* scr = (LAS float*)(lds + wid * 8448);
    unsigned char* ws = p.ws;
    weight_prep(p, 0, lds);
    for (int m0 = gw * 4; m0 < NTOK; m0 += NGW * 4) {
        f32x4 v[4][4];
#pragma unroll
        for (int rr = 0; rr < 4; ++rr)
#pragma unroll
            for (int j = 0; j < 4; ++j) v[rr][j] = *(const f32x4*)(p.x + (size_t)(m0 + rr) * DM + (64 * j + lane) * 4);
#pragma unroll
        for (int rr = 0; rr < 4; ++rr) { float ss = 0.f;
#pragma unroll
            for (int j = 0; j < 4; ++j) ss += (v[rr][j][0] * v[rr][j][0] + v[rr][j][1] * v[rr][j][1]) + (v[rr][j][2] * v[rr][j][2] + v[rr][j][3] * v[rr][j][3]);
            const float rstd = rsqrtf(wave_sum(ss, lane) * (1.f / 1024.f) + 1e-6f);
            if (lane == 0) ((float*)(ws + WS_RSTD1))[m0 + rr] = rstd;
#pragma unroll
            for (int j = 0; j < 4; ++j) st4bf((bf16_t*)(ws + WS_HB) + (size_t)(m0 + rr) * DM + (64 * j + lane) * 4, v[rr][j]); }
    }
    __syncthreads();
    if (BID() < 8) {
        const int l = BID() >> 2, kv = (BID() >> 1) & 1, jh = BID() & 1, j = jh * 64 + lane;
        const float* pe = p.cmp_pe + (size_t)(l * 2 + kv) * 2048; const float* w1 = p.cmp_w1 + (size_t)(l * 2 + kv) * 2048 * 128;
        float s = 0.f;
        for (int f = wid * 256; f < wid * 256 + 256; ++f) s += pe[f] * w1[(size_t)f * 128 + j];
        LAS float* part = (LAS float*)(lds + 70000);
        part[wid * 64 + lane] = s;
        __syncthreads();
        if (wid == 0) { float t = p.cmp_b1[(l * 2 + kv) * 128 + j];
#pragma unroll
            for (int w = 0; w < 8; ++w) t += part[w * 64 + lane];
            ((float*)(ws + WS_MISC))[(l * 2 + kv) * 128 + j] = t; }
    }
    if (BID() == 8 && wid < DEPTH) {
        const int l = wid; const float* lp = p.diff_lambda + l * 256;
        const float a = wave_sum(lp[lane] * lp[64 + lane], lane), b = wave_sum(lp[128 + lane] * lp[192 + lane], lane);
        const float lam_init = (l == 0) ? 0.2f : 0.35550906f;
        if (lane == 0) ((float*)(ws + WS_MISC + 4096))[l] = expf(a) - expf(b) + lam_init;
    }
}

namespace pg8 {
#define PG8_LAS __attribute__((address_space(3)))
constexpr int BM = 256, BK = 64, HALF = 128, HTB = HALF * BK * 2  , STAGE_BYTES = 8 * HTB, NXCD = 8, WGM = 8;

__host__ __device__ __forceinline__ int lds_byte(int r, int c) { const int st = (r >> 4) * 2 + (c >> 5), rr = r & 15, cc = c & 31, ob = rr * 64 + cc * 2; return st * 1024 + (ob ^ (((ob >> 9) & 1) << 5)); }
__host__ __device__ __forceinline__ void stage_rc(int b, int& R, int& C) { const int st = b / 1024, sb = b % 1024, swz = sb ^ (((sb >> 9) & 1) << 5); R = (st >> 1) * 16 + swz / 64; C = (st & 1) * 32 + (swz % 64) / 2; }
__host__ __device__ __forceinline__ int perm32(int rho) { const int n = rho >> 4, i = rho & 15; return 8 * (i >> 2) + 4 * n + (i & 3); }

struct Unit { int pm, pn, z; };
struct Gemm { const bf16_t* A; const bf16_t* Bt; const bf16_t* A2; const bf16_t* Bt2; int M, N, K; };

struct StaticOrder {
    int nM, nN, nwg, G, c;
    __host__ __device__ void init(int M, int N, int G_, int c_) { nM = M / BM; nN = N / BM; nwg = nM * nN; G = G_; c = c_; }
    __host__ __device__ bool next(int i, Unit& u) const {
        const long L = (long)i * G + c; if (L >= nwg) return false;
        int wgid = (int)L; { const int q = nwg / NXCD, r = nwg % NXCD, xcd = wgid % NXCD, off = wgid / NXCD; wgid = (xcd < r ? xcd * (q + 1) : r * (q + 1) + (xcd - r) * q) + off; }
        const int nig = WGM * nN, gid = wgid / nig, fm = gid * WGM, gsz = (nM - fm) < WGM ? (nM - fm) : WGM;
        u.pm = fm + ((wgid % nig) % gsz); u.pn = (wgid % nig) / gsz; u.z = 0; return true;
    }
    __device__ __forceinline__ void a_ready(const Unit&) const {}
    __device__ __forceinline__ void done(const Unit&) const {}
};

template <class Epi, class Sched, bool ALIGN_EPI = false, bool SP2 = false>
__device__ __forceinline__ void gemm_phase(PG8_LAS unsigned char* lds, const Gemm g, const Sched& S, const Epi& E) {
    int tid_ = TIDX(); asm volatile("" : "+v"(tid_));
    const int tid = tid_, wid = __builtin_amdgcn_readfirstlane(tid >> 6), lane = tid & 63, wr = wid >> 2, wc = wid & 3, fr = lane & 15, fq = lane >> 4;
    const int K = g.K, nt = K / BK;
    unsigned voffA[2], voffB[2];
#pragma unroll
    for (int i = 0; i < 2; ++i) { int R, C; stage_rc(tid * 16 + i * 8192, R, C); const int Rb = Epi::PERM ? (64 * (R >> 5) + perm32(R & 31)) : R;
        voffA[i] = (unsigned)(R * K + C) * 2u; voffB[i] = (unsigned)(Rb * K + C) * 2u; }
    const size_t kstep = (size_t)(BK * 2);
    const size_t hstep = (size_t)HALF * K * 2;
    const size_t tstep = 2 * hstep;
    const size_t hstepB = Epi::PERM ? (size_t)32 * K * 2 : hstep;
    const unsigned ldsw = (unsigned)wid * 1024u;
    const int aoff = lds_byte(wr * 64 + fr, fq * 8), boff = lds_byte(wc * 32 + fr, fq * 8);
#define PG8_SA(b, h) (((b) * 2 + (h)) * HTB)
#define PG8_SB(b, h) ((4 + (b) * 2 + (h)) * HTB)
#define PG8_STAGE(bufoff, gbase, voff) do { _Pragma("unroll") for (int _i = 0; _i < 2; ++_i) \
        __builtin_amdgcn_global_load_lds((const unsigned*)((const char*)(gbase) + (voff)[_i]), (PG8_LAS unsigned*)(lds + (bufoff) + ldsw + _i * 8192), 16, 0, 0); } while (0)
#define PG8_LDA(dst, b, h) do { _Pragma("unroll") for (int m = 0; m < 4; ++m) _Pragma("unroll") for (int k = 0; k < 2; ++k) dst[m][k] = *(const PG8_LAS bf16x8*)(lds + PG8_SA(b, h) + aoff + m * 2048 + k * 1024); } while (0)
#define PG8_LDB(dst, b, h) do { _Pragma("unroll") for (int n = 0; n < 2; ++n) _Pragma("unroll") for (int k = 0; k < 2; ++k) dst[n][k] = *(const PG8_LAS bf16x8*)(lds + PG8_SB(b, h) + boff + n * 2048 + k * 1024); } while (0)
#define PG8_MMA(ai, bj, At, Bt) do { __builtin_amdgcn_s_setprio(1); _Pragma("unroll") for (int m = 0; m < 4; ++m) _Pragma("unroll") for (int n = 0; n < 2; ++n) _Pragma("unroll") for (int k = 0; k < 2; ++k) \
        acc[ai][bj][m][n] = __builtin_amdgcn_mfma_f32_16x16x32_bf16(Bt[n][k], At[m][k], acc[ai][bj][m][n], 0, 0, 0); __builtin_amdgcn_s_setprio(0); } while (0)
#define PG8_WAIT_V(n) asm volatile("s_waitcnt vmcnt(" #n ")" ::: "memory")
#define PG8_WAIT_L(n) asm volatile("s_waitcnt lgkmcnt(" #n ")" ::: "memory")
#define PG8_BAR __builtin_amdgcn_s_barrier()
#define PG8_SCHED __builtin_amdgcn_sched_barrier(0)
    Unit cur, nxt; int ui = 0;
    if (!S.next(0, cur)) return;
    f32x4 acc[2][2][4][2];
#pragma unroll
    for (int a = 0; a < 2; ++a)
#pragma unroll
        for (int b = 0; b < 2; ++b)
#pragma unroll
            for (int m = 0; m < 4; ++m)
#pragma unroll
                for (int n = 0; n < 2; ++n) acc[a][b][m][n] = (f32x4){0.f, 0.f, 0.f, 0.f};
    bf16x8 At[4][2], B0[2][2], B1[2][2];
    const char* cA = (const char*)(cur.z ? g.A2 : g.A) + (size_t)cur.pm * tstep; const char* cB = (const char*)(cur.z ? g.Bt2 : g.Bt) + (size_t)cur.pn * tstep;
    S.a_ready(cur);
    if constexpr (SP2) {
        PG8_STAGE(PG8_SB(0, 0), cB, voffB); PG8_STAGE(PG8_SB(0, 1), cB + hstepB, voffB); PG8_STAGE(PG8_SA(0, 0), cA, voffA); PG8_STAGE(PG8_SA(0, 1), cA + hstep, voffA);
        if (wr == 1) PG8_BAR;
        PG8_WAIT_V(2); PG8_BAR;
        PG8_STAGE(PG8_SB(1, 0), cB + kstep, voffB); PG8_STAGE(PG8_SA(1, 0), cA + kstep, voffA); PG8_STAGE(PG8_SB(1, 1), cB + hstepB + kstep, voffB);
        PG8_WAIT_V(6); PG8_BAR;
    } else {
        PG8_STAGE(PG8_SB(0, 0), cB, voffB); PG8_STAGE(PG8_SA(0, 0), cA, voffA); PG8_STAGE(PG8_SB(0, 1), cB + hstepB, voffB); PG8_STAGE(PG8_SA(0, 1), cA + hstep, voffA);
        if (wr == 1) PG8_BAR;
        PG8_WAIT_V(4); PG8_BAR;
        PG8_STAGE(PG8_SB(1, 0), cB + kstep, voffB); PG8_STAGE(PG8_SA(1, 0), cA + kstep, voffA); PG8_STAGE(PG8_SB(1, 1), cB + hstepB + kstep, voffB);
        PG8_WAIT_V(6); PG8_BAR;
    }
    for (;;) {
        const bool has_next = S.next(ui + 1, nxt);
        const char* nA = has_next ? (const char*)(nxt.z ? g.A2 : g.A) + (size_t)nxt.pm * tstep : cA; const char* nB = has_next ? (const char*)(nxt.z ? g.Bt2 : g.Bt) + (size_t)nxt.pn * tstep : cB;
        for (int t = 0; t < nt; t += 2) {
            const bool last = (t == nt - 2);
            const char* a1 = cA + (size_t)(t + 1) * kstep;
            const char* a2 = last ? nA : cA + (size_t)(t + 2) * kstep; const char* b2 = last ? nB : cB + (size_t)(t + 2) * kstep;
            const char* a3 = a2 + kstep; const char* b3 = b2 + kstep;
            if (last && has_next) S.a_ready(nxt);
            if constexpr (SP2) {
            PG8_LDB(B0, 0, 0); PG8_LDB(B1, 0, 1); PG8_SCHED; PG8_LDA(At, 0, 0); PG8_STAGE(PG8_SA(1, 1), a1 + hstep, voffA);
            PG8_WAIT_V(8); PG8_WAIT_L(0); PG8_BAR; PG8_MMA(0, 0, At, B0); PG8_MMA(0, 1, At, B1); PG8_BAR; PG8_SCHED;
            PG8_LDA(At, 0, 1); PG8_STAGE(PG8_SB(0, 0), b2, voffB); PG8_STAGE(PG8_SB(0, 1), b2 + hstepB, voffB); PG8_STAGE(PG8_SA(0, 0), a2, voffA);
            PG8_WAIT_V(8); PG8_WAIT_L(0); PG8_BAR; PG8_MMA(1, 0, At, B0); PG8_MMA(1, 1, At, B1); PG8_BAR; PG8_SCHED;
            PG8_LDB(B0, 1, 0); PG8_LDB(B1, 1, 1); PG8_SCHED; PG8_LDA(At, 1, 0); PG8_STAGE(PG8_SA(0, 1), a2 + hstep, voffA);
            PG8_WAIT_V(8); PG8_WAIT_L(0); PG8_BAR; PG8_MMA(0, 0, At, B0); PG8_MMA(0, 1, At, B1); PG8_BAR; PG8_SCHED;
            PG8_LDA(At, 1, 1); PG8_STAGE(PG8_SB(1, 0), b3, voffB); PG8_STAGE(PG8_SB(1, 1), b3 + hstepB, voffB); PG8_STAGE(PG8_SA(1, 0), a3, voffA);
            PG8_WAIT_V(8); PG8_WAIT_L(0); PG8_BAR; PG8_MMA(1, 0, At, B0); PG8_MMA(1, 1, At, B1); PG8_BAR; PG8_SCHED;
            } else {
            PG8_LDB(B0, 0, 0); PG8_SCHED; PG8_LDA(At, 0, 0); PG8_STAGE(PG8_SA(1, 1), a1 + hstep, voffA);
            PG8_WAIT_L(8); PG8_BAR; PG8_WAIT_L(0); PG8_MMA(0, 0, At, B0); PG8_BAR; PG8_SCHED;
            PG8_LDB(B1, 0, 1); PG8_STAGE(PG8_SB(0, 0), b2, voffB);
            PG8_BAR; PG8_WAIT_L(0); PG8_MMA(0, 1, At, B1); PG8_BAR;
            PG8_LDA(At, 0, 1); PG8_STAGE(PG8_SA(0, 0), a2, voffA);
            PG8_BAR; PG8_WAIT_L(0); PG8_MMA(1, 0, At, B0); PG8_BAR; PG8_SCHED;
            PG8_STAGE(PG8_SB(0, 1), b2 + hstepB, voffB);
            PG8_WAIT_V(6); PG8_BAR; PG8_MMA(1, 1, At, B1); PG8_BAR;
            PG8_LDB(B0, 1, 0); PG8_SCHED; PG8_LDA(At, 1, 0); PG8_STAGE(PG8_SA(0, 1), a2 + hstep, voffA);
            PG8_WAIT_L(8); PG8_BAR; PG8_WAIT_L(0); PG8_MMA(0, 0, At, B0); PG8_BAR; PG8_SCHED;
            PG8_LDB(B1, 1, 1); PG8_STAGE(PG8_SB(1, 0), b3, voffB);
            PG8_BAR; PG8_WAIT_L(0); PG8_MMA(0, 1, At, B1); PG8_BAR;
            PG8_LDA(At, 1, 1); PG8_STAGE(PG8_SA(1, 0), a3, voffA);
            PG8_BAR; PG8_WAIT_L(0); PG8_MMA(1, 0, At, B0); PG8_BAR; PG8_SCHED;
            PG8_STAGE(PG8_SB(1, 1), b3 + hstepB, voffB);
            PG8_WAIT_V(6); PG8_BAR; PG8_MMA(1, 1, At, B1); PG8_BAR;
            }
        }
        if constexpr (ALIGN_EPI) { if (wr == 0) PG8_BAR; }
        if constexpr (!Epi::AFTER_DRAIN) { E(acc, cur, wr, wc, fr, fq); S.done(cur); }
        if (!has_next) break;
        if (!Epi::keep(cur)) {
#pragma unroll
        for (int a = 0; a < 2; ++a)
#pragma unroll
            for (int b = 0; b < 2; ++b)
#pragma unroll
                for (int m = 0; m < 4; ++m)
#pragma unroll
                    for (int n = 0; n < 2; ++n) acc[a][b][m][n] = (f32x4){0.f, 0.f, 0.f, 0.f}; }
        cur = nxt; cA = nA; cB = nB; ++ui;
        if constexpr (ALIGN_EPI) { if (wr == 1) PG8_BAR; }
    }
    PG8_WAIT_V(0);
    if constexpr (!ALIGN_EPI) { if (wr == 0) PG8_BAR; }
    PG8_BAR;
    if constexpr (Epi::AFTER_DRAIN) { E.fused(acc, cur, wr, wc, fr, fq, lds, wid, lane); S.done(cur); }
#undef PG8_SA
#undef PG8_SB
#undef PG8_STAGE
#undef PG8_LDA
#undef PG8_LDB
#undef PG8_MMA
#undef PG8_WAIT_V
#undef PG8_WAIT_L
#undef PG8_BAR
#undef PG8_SCHED
}
}

typedef pg8::Unit PUnit;
__device__ __forceinline__ unsigned ror8(unsigned v) { return (unsigned)__builtin_amdgcn_mov_dpp((int)v, 0x128, 0xf, 0xf, true); }
__device__ __forceinline__ void st_lines(bf16_t* px  , size_t pitch8  , const u32x4 w0, const u32x4 w1, bool lo) {
    u32x4 snd, rcv, x, y;
    snd.x = lo ? w1.x : w0.x; snd.y = lo ? w1.y : w0.y; snd.z = lo ? w1.z : w0.z; snd.w = lo ? w1.w : w0.w;
    rcv.x = ror8(snd.x); rcv.y = ror8(snd.y); rcv.z = ror8(snd.z); rcv.w = ror8(snd.w);
    x.x = lo ? w0.x : rcv.x; x.y = lo ? w0.y : rcv.y; x.z = lo ? w0.z : rcv.z; x.w = lo ? w0.w : rcv.w;
    y.x = lo ? rcv.x : w1.x; y.y = lo ? rcv.y : w1.y; y.z = lo ? rcv.z : w1.z; y.w = lo ? rcv.w : w1.w;
    *(u32x4*)px = x; *(u32x4*)(px + pitch8) = y;
}
template <int AB> struct EpiInprojT {
    static constexpr bool PERM = true, AFTER_DRAIN = false;
    unsigned char* ws;
    static __device__ __forceinline__ bool keep(const PUnit&) { return false; }
    __device__ __forceinline__ void operator()(f32x4 (&acc)[2][2][4][2], const PUnit& u, int wr, int wc, int fr, int fq) const {
        const int n0 = u.pn * 256;
        bf16_t* dst; int pitch, c0, mode = 0;
        if (n0 < 512) { dst = (bf16_t*)(ws + WS_NQ); pitch = 512; c0 = n0; mode = 1; }
        else if (n0 < 1280) { dst = (bf16_t*)(ws + WS_KV6); pitch = 768; c0 = n0 - 512; }
        else if (n0 < 1792) { dst = (bf16_t*)(ws + WS_DQ); pitch = 512; c0 = n0 - 1280; mode = 1; }
        else if (n0 < 2304) { dst = (bf16_t*)(ws + WS_DK); pitch = 512; c0 = n0 - 1792; }
        else if (n0 < 2816) { dst = (bf16_t*)(ws + WS_DV); pitch = 512; c0 = n0 - 2304; }
        else if (n0 < 3840) { dst = (bf16_t*)(ws + WS_GA); pitch = 1024; c0 = n0 - 2816; mode = 2; }
        else if (n0 < 4864) { dst = (bf16_t*)(ws + WS_GB); pitch = 1024; c0 = n0 - 3840; mode = 2; }
        else { dst = (bf16_t*)(ws + WS_NG); pitch = 32; c0 = 0; mode = 3; }
        int rsub = 0;
        if (AB == 3 && mode != 3) { dst = (bf16_t*)(ws + WS_XN) + (size_t)BID() * 65536; pitch = 256; c0 = 0; rsub = u.pm * 256; }
        asm volatile("" : "+v"(fr), "+v"(fq));
        const int row0 = u.pm * 256 + wr * 64 + fr;
        const bool lo = (fr & 8) == 0;
        const int rowx = u.pm * 256 + wr * 64 + (fr & 7), colx = wc * 64 + (lo ? 0 : 32) + 8 * fq;
        float rsv[2][4];
#pragma unroll
        for (int ai = 0; ai < 2; ++ai)
#pragma unroll
            for (int m = 0; m < 4; ++m) rsv[ai][m] = ((const float*)(ws + WS_RSTD1))[row0 + ai * 128 + m * 16];
#pragma unroll
        for (int ai = 0; ai < 2; ++ai)
#pragma unroll
            for (int m = 0; m < 4; ++m) {
                const float rs = rsv[ai][m];
                u32x4 w[2]; u32x2 g8[2];
#pragma unroll
                for (int bj = 0; bj < 2; ++bj) { f32x4 v0 = acc[ai][bj][m][0] * rs, v1 = acc[ai][bj][m][1] * rs;
                    if (AB == 2) { asm volatile("" :: "v"(v0), "v"(v1)); continue; }
                    if (AB == 1) {} else if (mode == 1) { v0 = v0 * QSCALE; v1 = v1 * QSCALE; }
                    else if (mode == 2) { unsigned d0 = 0u, d1 = 0u;
#pragma unroll
                        for (int i = 0; i < 4; ++i) { d0 = __builtin_amdgcn_cvt_pk_u8_f32(fmaf(sigm(v0[i]), 256.f, -0.5f), i, d0); d1 = __builtin_amdgcn_cvt_pk_u8_f32(fmaf(sigm(v1[i]), 256.f, -0.5f), i, d1); }
                        g8[bj].x = d0; g8[bj].y = d1; continue; }
                    else if (mode == 3) {
#pragma unroll
                        for (int i = 0; i < 4; ++i) { v0[i] = sigm(v0[i]); v1[i] = sigm(v1[i]); } }
                    w[bj].x = cvtpk(v0[0], v0[1]); w[bj].y = cvtpk(v0[2], v0[3]); w[bj].z = cvtpk(v1[0], v1[1]); w[bj].w = cvtpk(v1[2], v1[3]); }
                if (AB == 2) continue;
                if (mode == 3) { if (wc == 0) *(u32x4*)(dst + (size_t)(row0 + ai * 128 + m * 16) * pitch + 8 * fq) = w[0]; }
                else if (mode == 2) *(u32x4*)((unsigned char*)dst + (size_t)(row0 - rsub + ai * 128 + m * 16) * (AB == 3 ? 256 : 1024) + c0 + wc * 64 + fq * 16) = (u32x4){g8[0].x, g8[0].y, g8[1].x, g8[1].y};
                else st_lines(dst + (size_t)(rowx - rsub + ai * 128 + m * 16) * pitch + c0 + colx, (size_t)8 * pitch, w[0], w[1], lo); }
    }
};
struct EpiMerge {
    static constexpr bool PERM = true, AFTER_DRAIN = false;
    const bf16_t* GA; const bf16_t* GB; bf16_t* MG;
    static __device__ __forceinline__ bool keep(const PUnit& u) { return u.z == 0; }
    __device__ __forceinline__ void operator()(f32x4 (&acc)[2][2][4][2], const PUnit& u, int wr, int wc, int fr, int fq) const {
        asm volatile("" : "+v"(fr), "+v"(fq));
        const int row0 = u.pm * 256 + wr * 64 + fr, col0 = u.pn * 256 + wc * 64 + 8 * fq;
        const bool lo = (fr & 8) == 0;
        const int rowx = u.pm * 256 + wr * 64 + (fr & 7), colx = u.pn * 256 + wc * 64 + (lo ? 0 : 32) + 8 * fq;
#pragma unroll
        for (int ai = 0; ai < 2; ++ai)
#pragma unroll
            for (int m = 0; m < 4; ++m) { const size_t ro = (size_t)(row0 + ai * 128 + m * 16) * DM + col0;
                u32x4 wq[2];
                const size_t go = (size_t)(row0 + ai * 128 + m * 16) * 1024 + u.pn * 256 + wc * 64 + fq * 16;
                const u32x4 gb = *(const u32x4*)((const unsigned char*)GB + go);
                u32x4 ga = gb; if (u.z == 0) ga = *(const u32x4*)((const unsigned char*)GA + go);
#pragma unroll
                for (int bj = 0; bj < 2; ++bj) {
                    const unsigned gb0 = bj ? gb.z : gb.x, gb1 = bj ? gb.w : gb.y, ga0 = bj ? ga.z : ga.x, ga1 = bj ? ga.w : ga.y;
                    f32x4 b0, b1;
#pragma unroll
                    for (int i = 0; i < 4; ++i) { b0[i] = (float)((gb0 >> (8 * i)) & 0xffu) + 0.5f; b1[i] = (float)((gb1 >> (8 * i)) & 0xffu) + 0.5f; }
                    if (u.z == 0) {
#pragma unroll
                        for (int i = 0; i < 4; ++i) { const float a0 = (float)((ga0 >> (8 * i)) & 0xffu) + 0.5f, a1 = (float)((ga1 >> (8 * i)) & 0xffu) + 0.5f;
                            acc[ai][bj][m][0][i] *= a0 * __builtin_amdgcn_rcpf(b0[i]); acc[ai][bj][m][1][i] *= a1 * __builtin_amdgcn_rcpf(b1[i]); } }
                    else { const f32x4 v0 = acc[ai][bj][m][0] * b0 * (1.f / 256.f), v1 = acc[ai][bj][m][1] * b1 * (1.f / 256.f);
                        wq[bj].x = cvtpk(v0[0], v0[1]); wq[bj].y = cvtpk(v0[2], v0[3]); wq[bj].z = cvtpk(v1[0], v1[1]); wq[bj].w = cvtpk(v1[2], v1[3]); } }
                if (u.z != 0) st_lines(MG + (size_t)(rowx + ai * 128 + m * 16) * DM + colx, (size_t)8 * DM, wq[0], wq[1], lo); }
    }
};
struct MergeOrder {
    int G, c;
    __device__ __forceinline__ bool next(int i, PUnit& u) const { const int t = (i >> 1) * G + c; if (t >= 512) return false;
        int wgid = t; { const int q = 512 / 8, xcd = wgid % 8, off = wgid / 8; wgid = xcd * q + off; }
        u.pm = (wgid >> 5) * 8 + (wgid & 7); u.pn = (wgid >> 3) & 3; u.z = i & 1; return true; }
    __device__ __forceinline__ void a_ready(const PUnit&) const {}
    __device__ __forceinline__ void done(const PUnit&) const {}
};
struct EpiOut {
    static constexpr bool PERM = true, AFTER_DRAIN = false;
    const float* xin; const bf16_t* hin; bf16_t* hout;
    static __device__ __forceinline__ bool keep(const PUnit&) { return false; }
    __device__ __forceinline__ void operator()(f32x4 (&acc)[2][2][4][2], const PUnit& u, int wr, int wc, int fr, int fq) const {
        asm volatile("" : "+v"(fr), "+v"(fq));
        const int row0 = u.pm * 256 + wr * 64 + fr, col0 = u.pn * 256 + wc * 64 + 8 * fq;
        const bool lo = (fr & 8) == 0;
        const int rowx = u.pm * 256 + wr * 64 + (fr & 7), colx = u.pn * 256 + wc * 64 + (lo ? 0 : 32) + 8 * fq;
#pragma unroll
        for (int ai = 0; ai < 2; ++ai)
#pragma unroll
            for (int m = 0; m < 4; ++m) { const size_t ro = (size_t)(row0 + ai * 128 + m * 16) * DM + col0;
                u32x4 wq[2];
#pragma unroll
                for (int bj = 0; bj < 2; ++bj) { const size_t off = ro + bj * 32; f32x4 b0, b1;
                    if (xin) { b0 = *(const f32x4*)(xin + off); b1 = *(const f32x4*)(xin + off + 4); }
                    else { const u32x4 hb = *(const u32x4*)(hin + off); b0 = (f32x4){bflo(hb.x), bfhi(hb.x), bflo(hb.y), bfhi(hb.y)}; b1 = (f32x4){bflo(hb.z), bfhi(hb.z), bflo(hb.w), bfhi(hb.w)}; }
                    const f32x4 v0 = b0 + acc[ai][bj][m][0], v1 = b1 + acc[ai][bj][m][1];
                    wq[bj].x = cvtpk(v0[0], v0[1]); wq[bj].y = cvtpk(v0[2], v0[3]); wq[bj].z = cvtpk(v1[0], v1[1]); wq[bj].w = cvtpk(v1[2], v1[3]); }
                st_lines(hout + (size_t)(rowx + ai * 128 + m * 16) * DM + colx, (size_t)8 * DM, wq[0], wq[1], lo); }
    }
};
typedef EpiInprojT<0> EpiInproj;
template <int AB> __device__ __forceinline__ void phase_inproj_pg8(PRef p, int l, LAS unsigned char* lds) {
    unsigned char* ws = p.ws;
    const bf16_t* W = (const bf16_t*)(ws + WS_WIN) + (size_t)l * NPAD * DM;
    pg8::Gemm g{(const bf16_t*)(ws + WS_HB), W, (const bf16_t*)(ws + WS_HB), W, NTOK, NPAD, DM};
    pg8::StaticOrder S; S.init(NTOK, NPAD, GSZ(), BID());
    EpiInprojT<AB> E{ws};
    pg8::gemm_phase<EpiInprojT<AB>, pg8::StaticOrder, true, true>(lds, g, S, E);
}
__device__ __forceinline__ void phase_merge_pg8(PRef p, int l, LAS unsigned char* lds) {
    unsigned char* ws = p.ws;
    pg8::Gemm g{(const bf16_t*)(ws + WS_NQ), (const bf16_t*)(ws + WS_WA) + (size_t)l * DM * 512, (const bf16_t*)(ws + WS_DQ), (const bf16_t*)(ws + WS_WB) + (size_t)l * DM * 512, NTOK, DM, 512};
    MergeOrder S{GSZ(), BID()};
    EpiMerge E{(const bf16_t*)(ws + WS_GA), (const bf16_t*)(ws + WS_GB), (bf16_t*)(ws + WS_XN)};
    pg8::gemm_phase<EpiMerge, MergeOrder, true, true>(lds, g, S, E);
}
__device__ __forceinline__ void phase_outproj_pg8(PRef p, int l, LAS unsigned char* lds, bool dry = false) {
    unsigned char* ws = p.ws;
    const bf16_t* WO = (const bf16_t*)(ws + WS_WO) + (size_t)l * DM * DM;
    pg8::Gemm g{(const bf16_t*)(ws + WS_XN), WO, (const bf16_t*)(ws + WS_XN), WO, NTOK, DM, DM};
    pg8::StaticOrder S; S.init(NTOK, DM, GSZ(), BID());
    EpiOut E{(const float*)nullptr, (const bf16_t*)(ws + WS_HB), dry ? (bf16_t*)(ws + WS_GA) : (bf16_t*)(ws + WS_HB)};
    pg8::gemm_phase<EpiOut, pg8::StaticOrder, true, true>(lds, g, S, E);
}

__device__ __forceinline__ int kswz(int row, int ch) { return row * 128 + ((ch ^ ((row >> 1) & 7)) << 4); }
__device__ __forceinline__ void stage_k(LAS unsigned char* kdst, const bf16_t* src  , int pitch, int tid) {
    const int row = tid >> 3, ch = tid & 7;
    *(LAS u32x4*)(kdst + kswz(row, ch)) = *(const u32x4*)(src + (size_t)row * pitch + ch * 8);
}
template <int NDB> __device__ __forceinline__ void stage_v(LAS unsigned char* vdst, const bf16_t* src, int pitch, int tid) {
#pragma unroll
    for (int i = 0; i < NDB / 2; ++i) { const int pc = tid + 512 * i, pw = pc >> 6, ln = pc & 63, db = pw >> 2, rg = pw & 3;
        *(LAS u32x4*)(vdst + pw * 1024 + ln * 16) = *(const u32x4*)(src + (size_t)(16 * rg + (ln >> 2)) * pitch + db * 32 + (ln & 3) * 8); }
}
__device__ __forceinline__ void qkt(f32x16& p0, f32x16& p1, LAS const unsigned char* K, const bf16x8 (&qr)[4], int r32, int hi) {
    p0 = (f32x16){0.f}; p1 = (f32x16){0.f};
#pragma unroll
    for (int d0 = 0; d0 < 4; ++d0) {
        LAS const unsigned char* kb = K + kswz(r32, 2 * d0 + hi);
        const bf16x8 b0 = *(LAS const bf16x8*)(kb), b1 = *(LAS const bf16x8*)(kb + 4096);
        p0 = MFMA32(b0, qr[d0], p0); p1 = MFMA32(b1, qr[d0], p1);
    }
    __builtin_amdgcn_sched_barrier(0);
}
template <int NDB> __device__ __forceinline__ void pv(f32x16 (&o)[NDB], const f32x16& p0, const f32x16& p1, LAS const unsigned char* V, int lane, int hi) {
    u32x4 pw[4];
    pw[0] = (u32x4){cvtpk(p0[0], p0[1]), cvtpk(p0[2], p0[3]), cvtpk(p0[4], p0[5]), cvtpk(p0[6], p0[7])};
    pw[1] = (u32x4){cvtpk(p0[8], p0[9]), cvtpk(p0[10], p0[11]), cvtpk(p0[12], p0[13]), cvtpk(p0[14], p0[15])};
    pw[2] = (u32x4){cvtpk(p1[0], p1[1]), cvtpk(p1[2], p1[3]), cvtpk(p1[4], p1[5]), cvtpk(p1[6], p1[7])};
    pw[3] = (u32x4){cvtpk(p1[8], p1[9]), cvtpk(p1[10], p1[11]), cvtpk(p1[12], p1[13]), cvtpk(p1[14], p1[15])};
    LAS const unsigned char* vb = V + ((lane >> 4) & 1) * 32 + (lane & 3) * 8 + (4 * hi + ((lane & 15) >> 2)) * 64;
#pragma unroll
    for (int d0 = 0; d0 < NDB; ++d0)
#pragma unroll
        for (int ks = 0; ks < 4; ++ks) {
            const s16x4 lo = vtr(vb + d0 * 4096 + ks * 1024), hh = vtr(vb + d0 * 4096 + ks * 1024 + 512);
            const bf16x8 vf = (bf16x8){lo[0], lo[1], lo[2], lo[3], hh[0], hh[1], hh[2], hh[3]};
            o[d0] = MFMA32(__builtin_bit_cast(bf16x8, pw[ks]), vf, o[d0]);
            if (ks == 3) __builtin_amdgcn_sched_barrier(0);
        }
}
__device__ __forceinline__ void glds16(const void* gsrc, unsigned lds_dst) {
    unsigned keep;
    asm volatile("s_mov_b32 %0, m0\n\ts_mov_b32 m0, %2\n\ts_nop 0\n\tglobal_load_lds_dwordx4 %1, off\n\ts_mov_b32 m0, %0" : "=&s"(keep) : "v"(gsrc), "s"(lds_dst) : "memory");
}
__device__ __forceinline__ void glds16s(const void* sbase  , unsigned voff  , unsigned lds_dst) {
    unsigned keep;
    asm volatile("s_mov_b32 %0, m0\n\ts_mov_b32 m0, %3\n\ts_nop 0\n\tglobal_load_lds_dwordx4 %1, %2\n\ts_mov_b32 m0, %0" : "=&s"(keep) : "v"(voff), "s"(sbase), "s"(lds_dst) : "memory");
}
__device__ __forceinline__ void qkt_nb(f32x16& p0, f32x16& p1, LAS const unsigned char* K, const bf16x8 (&qr)[4], int r32, int hi) {
#pragma unroll
    for (int d0 = 0; d0 < 4; ++d0) {
        LAS const unsigned char* kb = K + kswz(r32, 2 * d0 + hi);
        const bf16x8 b0 = *(LAS const bf16x8*)(kb), b1 = *(LAS const bf16x8*)(kb + 4096);
        p0 = MFMA32(b0, qr[d0], p0); p1 = MFMA32(b1, qr[d0], p1);
    }
}
#define PACKP(pw, P0, P1) do { pw[0] = (u32x4){cvtpk(P0[0], P0[1]), cvtpk(P0[2], P0[3]), cvtpk(P0[4], P0[5]), cvtpk(P0[6], P0[7])}; \
    pw[1] = (u32x4){cvtpk(P0[8], P0[9]), cvtpk(P0[10], P0[11]), cvtpk(P0[12], P0[13]), cvtpk(P0[14], P0[15])}; \
    pw[2] = (u32x4){cvtpk(P1[0], P1[1]), cvtpk(P1[2], P1[3]), cvtpk(P1[4], P1[5]), cvtpk(P1[6], P1[7])}; \
    pw[3] = (u32x4){cvtpk(P1[8], P1[9]), cvtpk(P1[10], P1[11]), cvtpk(P1[12], P1[13]), cvtpk(P1[14], P1[15])}; } while (0)
template <int NDB> __device__ __forceinline__ void pv_nb(f32x16 (&o)[NDB], const u32x4 (&pw)[4], LAS const unsigned char* V, int lane, int hi) {
    LAS const unsigned char* vb = V + ((lane >> 4) & 1) * 32 + (lane & 3) * 8 + (4 * hi + ((lane & 15) >> 2)) * 64;
#pragma unroll
    for (int d0 = 0; d0 < NDB; ++d0)
#pragma unroll
        for (int ks = 0; ks < 4; ++ks) {
            const s16x4 lo = vtr(vb + d0 * 4096 + ks * 1024), hh = vtr(vb + d0 * 4096 + ks * 1024 + 512);
            const bf16x8 vf = (bf16x8){lo[0], lo[1], lo[2], lo[3], hh[0], hh[1], hh[2], hh[3]};
            o[d0] = MFMA32(__builtin_bit_cast(bf16x8, pw[ks]), vf, o[d0]);
        }
}
__device__ __forceinline__ float rowmax32(const f32x16& a, const f32x16& b) {
    float x = fmaxf(fmaxf(a[0], a[1]), b[0]), y = fmaxf(fmaxf(a[2], a[3]), b[1]);
    x = fmaxf(fmaxf(x, b[2]), b[3]);
#pragma unroll
    for (int r = 4; r < 16; r += 4) { x = fmaxf(fmaxf(x, a[r]), a[r + 1]); y = fmaxf(fmaxf(y, a[r + 2]), a[r + 3]); x = fmaxf(fmaxf(x, b[r]), b[r + 1]); y = fmaxf(fmaxf(y, b[r + 2]), b[r + 3]); }
    const float mm = fmaxf(x, y);
    auto rr = __builtin_amdgcn_permlane32_swap(__float_as_uint(mm), __float_as_uint(mm), false, false);
    return fmaxf(__uint_as_float(rr[0]), __uint_as_float(rr[1]));
}
constexpr float SM_THR = 6.0f;
constexpr float NEG = -1e30f;
template <int NDB> __device__ __forceinline__ void softmax_pv(f32x16& s0, f32x16& s1, float& m, float& l, f32x16 (&o)[NDB], LAS float* wsf, LAS const unsigned char* V, int lane, int r32, int hi) {
    float rm = fmaxf(s0[0], s1[0]);
#pragma unroll
    for (int r = 1; r < 16; ++r) rm = fmaxf(rm, fmaxf(s0[r], s1[r]));
    rm = m32(rm);
    if (__any(rm > m + SM_THR)) {
        const float mn = fmaxf(m, rm), f = ex2(m - mn); l *= f; m = mn;
        if (hi == 0) wsf[r32] = f;
#pragma unroll
        for (int r = 0; r < 16; ++r) { const float fr_ = wsf[crow(r, hi)];
#pragma unroll
            for (int d = 0; d < NDB; ++d) o[d][r] *= fr_; }
    }
    float sum = 0.f;
#pragma unroll
    for (int r = 0; r < 16; ++r) { s0[r] = ex2(s0[r] - m); s1[r] = ex2(s1[r] - m); sum += s0[r] + s1[r]; }
    l += sum;
    pv<NDB>(o, s0, s1, V, lane, hi);
}

#define QFETCH() int qnx_ = 0; if (tid == 0) qnx_ = (int)__hip_atomic_fetch_add(qctr, 1u, __ATOMIC_RELAXED, __HIP_MEMORY_SCOPE_AGENT)
#define QPARK() do { if (tid == 0) ((LAS int*)(lds + LDS_MISC))[1] = qnx_; } while (0)
__device__ __forceinline__ float gelu_tanh(float x) { const float u = 0.7978845608f * (x + 0.044715f * x * x * x); const float e = __expf(2.f * u); return 0.5f * x * (2.f - 2.f / (1.f + e)); }

__device__ __forceinline__ void compress_unit(PRef p, int l, int u, LAS unsigned char* lds, unsigned* qctr) {
    SG_IDS
    unsigned char* ws = p.ws;
    const int kv = u >> 5, m0 = (u & 31) * 128;
    const bf16_t* KV6 = (const bf16_t*)(ws + WS_KV6);
    struct ARowC { const bf16_t* KV6; int m0, kv; __device__ __forceinline__ const char* operator()(int r) const { const int mm = m0 + r, g = mm >> 11, tok = (mm & 2047) * 16; return (const char*)(KV6 + (size_t)tok * 768 + kv * 128 + g * 64); } };
    f32x4 acc[2][4]; SG_ZERO(acc);
    sg_kloop(acc, ARowC{KV6, m0, kv}, 768 * 2, (const bf16_t*)(ws + WS_WC1) + (size_t)(l * 2 + kv) * 128 * 2048, 2048, 32, lds);
    QFETCH();
    LAS bf16_t* Ht = (LAS bf16_t*)(lds + 32768);
    LAS float* W2 = (LAS float*)(lds + 32768 + 34816);
    const float* cb1 = (const float*)(ws + WS_MISC) + (l * 2 + kv) * 128;
#pragma unroll
    for (int m = 0; m < 2; ++m)
#pragma unroll
        for (int n = 0; n < 4; ++n) { const int row = SG_ROW(m), col = SG_COL(n); const f32x4 b = *(const f32x4*)(cb1 + col); f32x4 v = acc[m][n] + b;
            u32x2 w; w.x = cvtpk(gelu_tanh(v[0]), gelu_tanh(v[1])); w.y = cvtpk(gelu_tanh(v[2]), gelu_tanh(v[3])); *(LAS u32x2*)(Ht + row * 136 + col) = w; }
    const float* w2g = p.cmp_w2 + (size_t)(l * 2 + kv) * 128 * 64;
    for (int i = tid; i < 128 * 64 / 4; i += 512) *(LAS f32x4*)(W2 + i * 4) = *(const f32x4*)(w2g + i * 4);
    __syncthreads();
    const int d = tid & 63; const float b2 = p.cmp_b2[(l * 2 + kv) * 64 + d];
    bf16_t* dstb = (bf16_t*)(ws + WS_MISC + 65536 + (size_t)kv * 524288);
    for (int i = 0; i < 16; ++i) { const int row = (tid >> 6) + 8 * i; float s = b2;
#pragma unroll 8
        for (int f = 0; f < 128; ++f) s += bf1(Ht[row * 136 + f]) * W2[f * 64 + d];
        const int mm = m0 + row, g = mm >> 11, bi = mm & 2047;
        dstb[((size_t)bi * 2 + g) * 64 + d] = f2bf(s); }
    QPARK();
    __syncthreads();
}

#ifndef ABL
#define ABL 0
#endif
template <int AB> __device__ __forceinline__ void diff_unit(PRef p, int l, int u, LAS unsigned char* lds, bool dry, unsigned* qctr) {
    int tid_ = TIDX(); asm volatile("" : "+v"(tid_));
    const int tid = tid_, lane = tid & 63, r32 = lane & 31, hi = lane >> 5, wid = __builtin_amdgcn_readfirstlane(tid >> 6);
    unsigned char* ws = p.ws;
    const int c = 15 - (u >> 6), b = (u & 63) >> 2, hd = u & 3;
    const int cm = wid >> 2, qq = wid & 3, t0 = 128 * c + 32 * qq, tq = t0 + r32;
    const size_t tokb = (size_t)b * TSEQ;
    bf16_t* DQ = (bf16_t*)(ws + WS_DQ); const bf16_t* DK = (const bf16_t*)(ws + WS_DK); const bf16_t* DV = (const bf16_t*)(ws + WS_DV);
    const float sl2 = alibi_slope(9 + hd) * LOG2E;
    const float cbh = sl2 * (float)(4 * hi);
#define CB(r) fmaf(sl2, (float)(((r) & 3) + 8 * ((r) >> 2)), cbh)
    f32x16 o[4];
#pragma unroll
    for (int d = 0; d < 4; ++d) o[d] = (f32x16){0.f};
    float m = 0.f, lsum = 0.f; bool seen = false;
    LAS float* wsf = (LAS float*)(lds + LDS_MISC + 1024 + wid * 128);
    const unsigned lds0 = (unsigned)(uintptr_t)lds;
    const int srow = tid >> 3, spos = tid & 7, sch = spos ^ ((srow >> 1) & 7);
    const int vln = lane;
    const bf16_t* kub = DK + tokb * 512 + hd * 128; const bf16_t* vub = DV + tokb * 512 + hd * 128 + (size_t)(16 * (wid & 3)) * 512 + (wid >> 2) * 32;
    const unsigned kvo = (unsigned)(srow * 512 + sch * 8) * 2u, vvo = (unsigned)((vln >> 2) * 512 + (vln & 3) * 8) * 2u;
    const unsigned dk0 = lds0 + wid * 1024, dk1 = dk0 + 8192, dv0 = lds0 + 16384 + wid * 1024, dv1 = dv0 + 8192;
#define DDMA(j, off) do { const size_t to_ = (size_t)(64 * (j)) * 512; const unsigned o_ = (unsigned)(off); \
        glds16s(kub + to_, kvo, (unsigned)__builtin_amdgcn_readfirstlane(dk0 + o_)); glds16s(kub + to_ + 64, kvo, (unsigned)__builtin_amdgcn_readfirstlane(dk1 + o_)); \
        glds16s(vub + to_, vvo, (unsigned)__builtin_amdgcn_readfirstlane(dv0 + o_)); glds16s(vub + to_ + 64, vvo, (unsigned)__builtin_amdgcn_readfirstlane(dv1 + o_)); } while (0)
#define DCIN(A0, A1, j) do { float slv_ = sl2; asm volatile("" : "+v"(slv_)); \
        const float tc_ = slv_ * (float)(64 * (j) - 128 * c) + slv_ * (float)(4 * hi) - m, tc1_ = tc_ + 32.f * slv_; \
        _Pragma("unroll") for (int r = 0; r < 16; ++r) { const float kc_ = (float)((r & 3) + 8 * (r >> 2)); A0[r] = fmaf(slv_, kc_, tc_); A1[r] = fmaf(slv_, kc_, tc1_); } } while (0)
#define DMASK(A0, A1, j, RM, MASKED) do { \
        if (MASKED) { if (64 * (j) + 63 > t0) { const int lim_ = tq - 64 * (j); _Pragma("unroll") for (int r = 0; r < 16; ++r) { if (crow(r, hi) > lim_) A0[r] = NEG; if (crow(r, hi) + 32 > lim_) A1[r] = NEG; } } } \
        RM = rowmax32(A0, A1); } while (0)
#define DRESC(C0, C1, RM) do { const bool real_ = RM > -1e29f; const bool need_ = (RM > SM_THR) || (!seen && real_); seen = seen || real_;     \
        if (__any(need_)) { const float d_ = need_ ? RM : 0.f, f_ = ex2(-d_); m += d_; lsum *= f_; if (hi == 0) wsf[r32] = f_; \
        _Pragma("unroll") for (int r = 0; r < 16; ++r) { C0[r] -= d_; C1[r] -= d_; const float fr_ = wsf[crow(r, hi)]; _Pragma("unroll") for (int d = 0; d < 4; ++d) o[d][r] *= fr_; } } } while (0)
#define DEXP(C0, C1, PW) do { float sum_ = 0.f; \
        if (AB == 1) { _Pragma("unroll") for (int r = 0; r < 16; ++r) { sum_ += C0[r] + C1[r]; } } \
        else if (AB != 5) { _Pragma("unroll") for (int r = 0; r < 16; ++r) { C0[r] = ex2(C0[r]); C1[r] = ex2(C1[r]); sum_ += C0[r] + C1[r]; } } \
        lsum += sum_; PACKP(PW, C0, C1); } while (0)
#define DEND(t) do { if (AB == 6) asm volatile("s_waitcnt vmcnt(0) lgkmcnt(0)" ::: "memory"); else if ((t) + 3 <= J0) asm volatile("s_waitcnt vmcnt(4) lgkmcnt(0)\n\ts_barrier" ::: "memory"); else asm volatile("s_waitcnt vmcnt(0) lgkmcnt(0)\n\ts_barrier" ::: "memory"); \
        { const int tmp_ = oc_; oc_ = on_; on_ = o2_; o2_ = ow_; ow_ = tmp_; } } while (0)
#define SBAR() __builtin_amdgcn_sched_barrier(0)
#define KLD(KF, Kp) do { _Pragma("unroll") for (int d0 = 0; d0 < 4; ++d0) { LAS const unsigned char* kb_ = (Kp) + kswz(r32, 2 * d0 + hi); KF[2 * d0] = *(LAS const bf16x8*)(kb_); KF[2 * d0 + 1] = *(LAS const bf16x8*)(kb_ + 4096); } } while (0)
#define QK8(P0, P1, KF) do { _Pragma("unroll") for (int d0 = 0; d0 < 4; ++d0) { P0 = MFMA32(KF[2 * d0], qr[d0], P0); P1 = MFMA32(KF[2 * d0 + 1], qr[d0], P1); } } while (0)
#define VLDK(VF, Vp, ks) do { _Pragma("unroll") for (int d0 = 0; d0 < 4; ++d0) { const s16x4 lo_ = vtr((Vp) + d0 * 4096 + (ks) * 1024), hh_ = vtr((Vp) + d0 * 4096 + (ks) * 1024 + 512); \
        VF[d0] = (bf16x8){lo_[0], lo_[1], lo_[2], lo_[3], hh_[0], hh_[1], hh_[2], hh_[3]}; } } while (0)
#define MMA4(VF, PWk) do { _Pragma("unroll") for (int d0 = 0; d0 < 4; ++d0) o[d0] = MFMA32(__builtin_bit_cast(bf16x8, PWk), VF[d0], o[d0]); } while (0)
#define DSTEP_N(C0, C1, RMC, N0, N1, RMN, t, MASKED) do { \
        if (AB != 4 && (t) + 3 <= J0) DDMA(J0 - (t) - 3, ow_); \
        bf16x8 kf_[8]; KLD(kf_, lds + on_ + cm * 8192); \
        SBAR(); \
        if (AB != 5) DRESC(C0, C1, RMC); \
        u32x4 pw_[4]; \
        DEXP(C0, C1, pw_); \
        DCIN(N0, N1, J0 - (t) - 1); \
        SBAR(); \
        if (AB != 3) QK8(N0, N1, kf_); \
        int ln_ = lane; asm volatile("" : "+v"(ln_)); LAS const unsigned char* vp_ = lds + oc_ + 16384 + ((ln_ >> 4) & 1) * 32 + (ln_ & 3) * 8 + ((ln_ >> 5) * 4 + ((ln_ & 15) >> 2)) * 64; \
        bf16x8 va_[4], vc_[4]; \
        VLDK(va_, vp_, 0); VLDK(vc_, vp_, 1); SBAR(); \
        if (AB != 2) MMA4(va_, pw_[0]); VLDK(va_, vp_, 2); SBAR(); \
        if (AB != 2) MMA4(vc_, pw_[1]); VLDK(vc_, vp_, 3); SBAR(); \
        if (AB != 5) DMASK(N0, N1, J0 - (t) - 1, RMN, MASKED); else RMN = RMC; \
        if (AB != 2) { MMA4(va_, pw_[2]); MMA4(vc_, pw_[3]); } \
        SBAR(); \
        DEND(t); } while (0)
#define DSTEP_L(C0, C1, RMC, t) do { DRESC(C0, C1, RMC); u32x4 pw_[4]; DEXP(C0, C1, pw_); int ln_ = lane; asm volatile("" : "+v"(ln_)); LAS const unsigned char* vp_ = lds + oc_ + 16384 + ((ln_ >> 4) & 1) * 32 + (ln_ & 3) * 8 + ((ln_ >> 5) * 4 + ((ln_ & 15) >> 2)) * 64; bf16x8 va_[4], vc_[4]; \
        VLDK(va_, vp_, 0); VLDK(vc_, vp_, 1); SBAR(); MMA4(va_, pw_[0]); VLDK(va_, vp_, 2); SBAR(); MMA4(vc_, pw_[1]); VLDK(vc_, vp_, 3); SBAR(); MMA4(va_, pw_[2]); MMA4(vc_, pw_[3]); DEND(t); } while (0)
    const int J0 = 2 * c + 1;
    int oc_ = 0, on_ = 32768, o2_ = 65536, ow_ = 98304;
    __syncthreads();
    DDMA(J0, 0); DDMA(J0 - 1, 32768);
    if (J0 >= 2) DDMA(J0 - 2, 65536);
    bf16x8 qr[4];
    { const bf16_t* qp = DQ + (tokb + tq) * 512 + hd * 128 + cm * 64 + hi * 8;
#pragma unroll
      for (int d0 = 0; d0 < 4; ++d0) qr[d0] = *(const bf16x8*)(qp + d0 * 16); }
    asm volatile("" : "+v"(qr[0]), "+v"(qr[1]), "+v"(qr[2]), "+v"(qr[3]));
    asm volatile("s_waitcnt vmcnt(0)\n\ts_barrier" ::: "memory");
    f32x16 sA0, sA1, sB0, sB1; float rmA, rmB;
    DCIN(sA0, sA1, J0);
    qkt_nb(sA0, sA1, lds + cm * 8192, qr, r32, hi);
    DMASK(sA0, sA1, J0, rmA, true);
    DSTEP_N(sA0, sA1, rmA, sB0, sB1, rmB, 0, true);
    for (int t = 1; t + 1 <= J0 - 1; t += 2) {
        DSTEP_N(sB0, sB1, rmB, sA0, sA1, rmA, t, false); DSTEP_N(sA0, sA1, rmA, sB0, sB1, rmB, t + 1, false);
    }
    DSTEP_L(sB0, sB1, rmB, J0);
#undef DDMA
#undef DCIN
#undef DMASK
#undef DRESC
#undef DEXP
#undef DEND
#undef DSTEP_N
#undef DSTEP_L
#undef KLD
#undef QK8
#undef VLDK
#undef MMA4
#undef SBAR
    QFETCH();
    const float lam = ((const float*)(ws + WS_MISC + 4096))[l];
    const float lam_init = (l == 0) ? 0.2f : 0.35550906f;
    const float ltot = s32(lsum);
    if (hi == 0) wsf[r32] = (cm == 0 ? 1.f : lam) / ltot;
    LAS float* X = (LAS float*)(lds + cm * 65536);
#pragma unroll
    for (int r = 0; r < 16; ++r) { const float f = wsf[crow(r, hi)]; const int q = 32 * qq + crow(r, hi);
#pragma unroll
        for (int d = 0; d < 4; ++d) X[q * 128 + d * 32 + r32] = o[d][r] * f; }
    __syncthreads();
    { const int q = tid >> 2, qt = tid & 3; LAS const float* x0 = (LAS const float*)lds + q * 128 + qt * 32; LAS const float* x1 = x0 + 16384;
      float v[32]; float ss = 0.f;
#pragma unroll
      for (int i = 0; i < 32; ++i) { v[i] = x0[i] - x1[i]; ss += v[i] * v[i]; }
      ss += shx(ss, 1, lane); ss += shx(ss, 2, lane);
      unsigned omlb = (l == 0) ? 0x3f4ccccdu : 0x3f24fd5cu; asm volatile("" : "+s"(omlb)); const float oml = __uint_as_float(omlb);
      const float rstd = rsqrtf(ss * (1.f / 128.f) + 1e-5f) * oml;
      const float* sg = p.diff_subln_g + l * 128 + qt * 32;
      bf16_t* dst = (dry ? (bf16_t*)(ws + WS_XN) + (size_t)NTOK * 512 : DQ) + (tokb + 128 * c + q) * 512 + hd * 128 + qt * 32;
#pragma unroll
      for (int i = 0; i < 32; i += 8) { u32x4 w; w.x = cvtpk(v[i] * rstd * sg[i], v[i + 1] * rstd * sg[i + 1]); w.y = cvtpk(v[i + 2] * rstd * sg[i + 2], v[i + 3] * rstd * sg[i + 3]);
          w.z = cvtpk(v[i + 4] * rstd * sg[i + 4], v[i + 5] * rstd * sg[i + 5]); w.w = cvtpk(v[i + 6] * rstd * sg[i + 6], v[i + 7] * rstd * sg[i + 7]); *(u32x4*)(dst + i) = w; } }
    QPARK();
    __syncthreads();
}

template <int AB> __device__ __forceinline__ void nsa_unit(PRef p, int l, int u, LAS unsigned char* lds, bool dry, unsigned* qctr) {
    int tid_ = TIDX(); asm volatile("" : "+v"(tid_));
    const int tid = tid_, lane = tid & 63, r32 = lane & 31, hi = lane >> 5, wid = __builtin_amdgcn_readfirstlane(tid >> 6);
    unsigned char* ws = p.ws;
    const int c = 31 - (u >> 5), b = (u & 31) >> 1, g = u & 1;
    const int hl = wid >> 1, qh = wid & 1, h = g * 4 + hl, t0 = 64 * c + 32 * qh, tq = t0 + r32, ql = 32 * qh + r32;
    const size_t tokb = (size_t)b * TSEQ;
    bf16_t* NQ = (bf16_t*)(ws + WS_NQ); const bf16_t* KV6 = (const bf16_t*)(ws + WS_KV6); const bf16_t* NG = (const bf16_t*)(ws + WS_NG);
    const bf16_t* KC = (const bf16_t*)(ws + WS_MISC + 65536); const bf16_t* VC = (const bf16_t*)(ws + WS_MISC + 65536 + 524288);
    constexpr int RING_W = 0, RING_S = 65536, CK = 65536, CV = 81920, IMPH_OFF = 98304;
    const unsigned lds0 = (unsigned)(uintptr_t)lds;
    const int jlo = c - 8 < 0 ? 0 : c - 8;
    const unsigned wmask = ((c >= 31) ? 0xffffffffu : ((2u << c) - 1u)) & ~((1u << jlo) - 1u);
    const int srow = tid >> 3, spos = tid & 7, sch = spos ^ ((srow >> 1) & 7);
    const unsigned kvo768 = (unsigned)(srow * 768 + sch * 8) * 2u, vvo768 = (unsigned)((lane >> 2) * 768 + (lane & 3) * 8) * 2u;
    const bf16_t* kub = KV6 + tokb * 768 + g * 64; const bf16_t* vub = KV6 + tokb * 768 + g * 64 + 128 + (size_t)(16 * (wid & 3)) * 768 + (wid >> 2) * 32;
    const unsigned dk = lds0 + wid * 1024, dv = dk + 8192;
#define NDMA(j, kind, off) do { const size_t to_ = (size_t)(64 * (j)) * 768 + ((kind) == 1 ? 256 : 512); const unsigned o_ = (unsigned)(off); \
        glds16s(kub + to_, kvo768, (unsigned)__builtin_amdgcn_readfirstlane(dk + o_)); glds16s(vub + to_, vvo768, (unsigned)__builtin_amdgcn_readfirstlane(dv + o_)); } while (0)
    __syncthreads();
    { const unsigned kvo128 = (unsigned)(srow * 128 + sch * 8) * 2u, vvo128 = (unsigned)((lane >> 2) * 128 + (lane & 3) * 8) * 2u;
      const bf16_t* kcb = KC + ((size_t)b * 128 * 2 + g) * 64; const bf16_t* vcb = VC + ((size_t)b * 128 * 2 + g) * 64 + (size_t)(16 * (wid & 3)) * 128 + (wid >> 2) * 32;
      glds16s(kcb, kvo128, (unsigned)__builtin_amdgcn_readfirstlane(dk + CK)); glds16s(kcb + 64 * 128, kvo128, (unsigned)__builtin_amdgcn_readfirstlane(dk + CK + 8192));
      glds16s(vcb, vvo128, (unsigned)__builtin_amdgcn_readfirstlane(dk + CV)); glds16s(vcb + 64 * 128, vvo128, (unsigned)__builtin_amdgcn_readfirstlane(dk + CV + 8192)); }
    unsigned wd = wmask; int nwd = 0;
#pragma unroll
    for (int i = 0; i < 3; ++i) if (wd) { const int j = 31 - __builtin_clz(wd); wd &= ~(1u << j); NDMA(j, 2, RING_W + i * 16384); ++nwd; }
    bf16x8 qr[4];
    { const bf16_t* qp = NQ + (tokb + tq) * 512 + h * 64 + hi * 8;
#pragma unroll
      for (int d0 = 0; d0 < 4; ++d0) qr[d0] = *(const bf16x8*)(qp + d0 * 16); }
    float g0 = bf1(NG[(tokb + tq) * 32 + h * 3 + 0]), g1 = bf1(NG[(tokb + tq) * 32 + h * 3 + 1]), g2 = bf1(NG[(tokb + tq) * 32 + h * 3 + 2]);
    asm volatile("" : "+v"(qr[0]), "+v"(qr[1]), "+v"(qr[2]), "+v"(qr[3]), "+v"(g0), "+v"(g1), "+v"(g2));
    const float sl2 = alibi_slope(h + 1) * LOG2E;
    const float cbh = sl2 * (float)(4 * hi);
    LAS float* wsf = (LAS float*)(lds + LDS_MISC + 1024 + wid * 128);
    LAS unsigned char* Kt = lds + CK; LAS unsigned char* Vt = lds + CV;
    LAS float* IMPH = (LAS float*)(lds + IMPH_OFF);
    LAS float* VAL = (LAS float*)(lds + CK);
    LAS unsigned* MASK = (LAS unsigned*)(lds + LDS_MISC + 2048);
    f32x16 oacc[2];
    if (tid < 64) MASK[tid] = 0u;
    asm volatile("s_waitcnt vmcnt(0) lgkmcnt(0)\n\ts_barrier" ::: "memory");
    {
        f32x16 s[4];
        qkt(s[0], s[1], Kt, qr, r32, hi); qkt(s[2], s[3], Kt + 8192, qr, r32, hi);
        int nmax = (tq - 31) >> 4; if (nmax > 126) nmax = 126;
        float rm = NEG;
#pragma unroll
        for (int k = 0; k < 4; ++k)
#pragma unroll
            for (int r = 0; r < 16; ++r) { const int n = 32 * k + crow(r, hi); float v = s[k][r] + 16.f * CB(r) + sl2 * (float)(512 * k);
                v = (n <= nmax) ? v : NEG; s[k][r] = v; rm = fmaxf(rm, v); }
        rm = m32(rm);
        float sum = 0.f;
#pragma unroll
        for (int k = 0; k < 4; ++k)
#pragma unroll
            for (int r = 0; r < 16; ++r) { const float e = ex2(s[k][r] - rm); s[k][r] = e; sum += e; }
        sum = s32(sum);
        const float inv = (nmax >= 0) ? 1.f / sum : 0.f;
#pragma unroll
        for (int k = 0; k < 4; ++k)
#pragma unroll
            for (int r = 0; r < 16; ++r) s[k][r] *= inv;
        float prev = 0.f;
#pragma unroll
        for (int k = 0; k < 4; ++k)
#pragma unroll
            for (int a = 0; a < 4; ++a) { const int i = 4 * k + a; const float Bi = 0.5f * s[k][4 * a + 3]; const float Ai = (s[k][4 * a] + s[k][4 * a + 1]) + (s[k][4 * a + 2] + Bi);
                const float rc = o32(Bi, hi); const float add = hi ? rc : prev; prev = rc;
                IMPH[(hl * 64 + ql) * 32 + 2 * i + hi] = Ai + add; }
        f32x16 o[2]; o[0] = (f32x16){0.f}; o[1] = (f32x16){0.f};
        pv<2>(o, s[0], s[1], Vt, lane, hi); pv<2>(o, s[2], s[3], Vt + 8192, lane, hi);
        if (hi == 0) wsf[r32] = g0;
#pragma unroll
        for (int r = 0; r < 16; ++r) { const float f = wsf[crow(r, hi)]; oacc[0][r] = o[0][r] * f; oacc[1][r] = o[1][r] * f; }
        asm volatile("" : "+v"(oacc[0]), "+v"(oacc[1]));
    }
    __syncthreads();
    { const int q = tid >> 3, mg = tid & 7;
#pragma unroll
      for (int i = 0; i < 4; ++i) { const int mb = 4 * mg + i; float v = ((IMPH[(0 * 64 + q) * 32 + mb] + IMPH[(1 * 64 + q) * 32 + mb]) + IMPH[(2 * 64 + q) * 32 + mb]) + IMPH[(3 * 64 + q) * 32 + mb];
          if (mb == 0 || mb == c || mb == c - 1) v = 1e9f; if (mb > c) v = -1.f; VAL[q * 32 + mb] = v; }
      asm volatile("s_waitcnt lgkmcnt(0)" ::: "memory");
      float mine[4];
#pragma unroll
      for (int i = 0; i < 4; ++i) mine[i] = VAL[q * 32 + 4 * mg + i];
      int cnt0 = 0, cnt1 = 0, cnt2 = 0, cnt3 = 0;
#pragma unroll 4
      for (int m2 = 0; m2 < 32; ++m2) { const float v2 = VAL[q * 32 + m2]; const int rel = m2 - 4 * mg;
          cnt0 += (int)(v2 > mine[0]) | ((int)(v2 == mine[0]) & (int)(rel < 0));
          cnt1 += (int)(v2 > mine[1]) | ((int)(v2 == mine[1]) & (int)(rel < 1));
          cnt2 += (int)(v2 > mine[2]) | ((int)(v2 == mine[2]) & (int)(rel < 2));
          cnt3 += (int)(v2 > mine[3]) | ((int)(v2 == mine[3]) & (int)(rel < 3)); }
      unsigned bits = ((cnt0 < 8) ? 1u : 0u) | ((cnt1 < 8) ? 2u : 0u) | ((cnt2 < 8) ? 4u : 0u) | ((cnt3 < 8) ? 8u : 0u);
      bits <<= 4 * mg;
      bits |= shxu(bits, 1, lane); bits |= shxu(bits, 2, lane); bits |= shxu(bits, 4, lane);
      if (mg == 0) MASK[q] = bits; }
    __syncthreads();
    const unsigned vmask = (c >= 31) ? 0xffffffffu : ((2u << c) - 1u);
    const unsigned mymask = MASK[ql] & vmask;
    unsigned uni;
    { unsigned mk = MASK[lane] & vmask;
#pragma unroll
      for (int o_ = 1; o_ < 64; o_ <<= 1) mk |= shxu(mk, o_, lane);
      uni = __builtin_amdgcn_readfirstlane(mk); }
    unsigned sd = uni; int nsd = 0;
#pragma unroll
    for (int i = 0; i < 3; ++i) if (sd) { const int j = 31 - __builtin_clz(sd); sd &= ~(1u << j); NDMA(j, 1, RING_S + i * 16384); ++nsd; }
#define NCIN(A0, A1, j, kind) do { float slv_ = sl2; asm volatile("" : "+v"(slv_)); \
        const float tc_ = slv_ * (float)(64 * ((j) - c)) + slv_ * (float)(4 * hi) - m, tc1_ = tc_ + 32.f * slv_; \
        _Pragma("unroll") for (int r = 0; r < 16; ++r) { const float kc_ = (float)((r & 3) + 8 * (r >> 2)); A0[r] = fmaf(slv_, kc_, tc_); A1[r] = fmaf(slv_, kc_, tc1_); } } while (0)
#define NMASK(A0, A1, j, kind, RM) do { \
        const bool sel_ = ((kind) == 2) || ((mymask >> (j)) & 1u); \
        if ((j) == c || ((kind) == 2 && (j) == c - 8) || !__all(sel_)) { const int lim_ = ((j) == c) ? ql : 64, low_ = ((kind) == 2 && (j) == c - 8) ? ql : -1; \
            _Pragma("unroll") for (int r = 0; r < 16; ++r) { const int k0_ = crow(r, hi), k1_ = k0_ + 32; if (!sel_ || k0_ > lim_ || k0_ <= low_) A0[r] = NEG; if (!sel_ || k1_ > lim_ || k1_ <= low_) A1[r] = NEG; } } \
        RM = rowmax32(A0, A1); } while (0)
#define NRESC(C0, C1, RM) do { const bool real_ = RM > -1e29f; const bool need_ = (RM > SM_THR) || (!seen && real_); seen = seen || real_; \
        if (__any(need_)) { const float d_ = need_ ? RM : 0.f, f_ = ex2(-d_); m += d_; lsum *= f_; if (hi == 0) wsf[r32] = f_; \
        _Pragma("unroll") for (int r = 0; r < 16; ++r) { C0[r] -= d_; C1[r] -= d_; const float fr_ = wsf[crow(r, hi)]; o[0][r] *= fr_; o[1][r] *= fr_; } } } while (0)
#define NEXP(C0, C1, PW) do { float sum_ = 0.f; \
        _Pragma("unroll") for (int r = 0; r < 16; ++r) { C0[r] = ex2(C0[r]); C1[r] = ex2(C1[r]); sum_ += C0[r] + C1[r]; } lsum += sum_; PACKP(PW, C0, C1); } while (0)
#define NSTEP(C0, C1, RMC, N0, N1, RMN, kind) do { \
        if (dcur_) { const int jd_ = 31 - __builtin_clz(dcur_); dcur_ &= ~(1u << jd_); NDMA(jd_, kind, ring_ + ow_); dissued_ = true; } else dissued_ = false; \
        NRESC(C0, C1, RMC); \
        u32x4 pw_[4]; \
        NEXP(C0, C1, pw_); \
        const bool has_ = (ccur_ != 0u); int jn_ = 0; if (has_) { jn_ = 31 - __builtin_clz(ccur_); ccur_ &= ~(1u << jn_); } \
        if (has_) { NCIN(N0, N1, jn_, kind); qkt_nb(N0, N1, lds + ring_ + on_, qr, r32, hi); } \
        __builtin_amdgcn_sched_barrier(0); \
        pv_nb<2>(o, pw_, lds + ring_ + oc_ + 8192, lane, hi); \
        if (has_) NMASK(N0, N1, jn_, kind, RMN); \
        if (dissued_) asm volatile("s_waitcnt vmcnt(2) lgkmcnt(0)\n\ts_barrier" ::: "memory"); else asm volatile("s_waitcnt vmcnt(0) lgkmcnt(0)\n\ts_barrier" ::: "memory"); \
        { const int tmp_ = oc_; oc_ = on_; on_ = o2_; o2_ = ow_; ow_ = tmp_; } \
        more_ = has_; } while (0)
#define NSTREAM(tmask, dmask, kind, ringbase, gate) do { \
        f32x16 o[2]; o[0] = (f32x16){0.f}; o[1] = (f32x16){0.f}; float m = 0.f, lsum = 0.f; bool seen = false; \
        const int ring_ = (ringbase); int oc_ = 0, on_ = 16384, o2_ = 32768, ow_ = 49152; \
        unsigned ccur_ = (tmask), dcur_ = (dmask); bool dissued_ = false, more_ = true; \
        f32x16 sA0, sA1, sB0, sB1; float rmA, rmB = NEG; \
        { const int j0_ = 31 - __builtin_clz(ccur_); ccur_ &= ~(1u << j0_); NCIN(sA0, sA1, j0_, kind); qkt_nb(sA0, sA1, lds + ring_, qr, r32, hi); NMASK(sA0, sA1, j0_, kind, rmA); } \
        for (;;) { NSTEP(sA0, sA1, rmA, sB0, sB1, rmB, kind); if (!more_) break; NSTEP(sB0, sB1, rmB, sA0, sA1, rmA, kind); if (!more_) break; } \
        const float ltot_ = s32(lsum); \
        if (hi == 0) wsf[r32] = (gate) / ltot_; \
        _Pragma("unroll") for (int r = 0; r < 16; ++r) { const float f = wsf[crow(r, hi)]; oacc[0][r] += o[0][r] * f; oacc[1][r] += o[1][r] * f; } \
        asm volatile("" : "+v"(oacc[0]), "+v"(oacc[1])); } while (0)
    if (nsd == 3) asm volatile("s_waitcnt vmcnt(6) lgkmcnt(0)\n\ts_barrier" ::: "memory"); else if (nsd == 2) asm volatile("s_waitcnt vmcnt(4) lgkmcnt(0)\n\ts_barrier" ::: "memory"); else asm volatile("s_waitcnt vmcnt(2) lgkmcnt(0)\n\ts_barrier" ::: "memory");
    if (AB != 1) {
        NSTREAM(wmask, wd, 2, RING_W, g2);
        NSTREAM(uni, sd, 1, RING_S, g1);
    }
#undef NDMA
#undef NCIN
#undef NMASK
#undef NRESC
#undef NEXP
#undef NSTEP
#undef NSTREAM
    QFETCH();
    { LAS bf16_t* stg = (LAS bf16_t*)(lds + wid * 4096);
#pragma unroll
      for (int r = 0; r < 16; ++r) { const int orow = crow(r, hi); stg[orow * 64 + r32] = f2bf(oacc[0][r]); stg[orow * 64 + 32 + r32] = f2bf(oacc[1][r]); }
      asm volatile("s_waitcnt lgkmcnt(0)" ::: "memory");
      bf16_t* ob = (dry ? (bf16_t*)(ws + WS_XN) : NQ) + (tokb + t0) * 512 + h * 64;
      int lane2 = lane; asm volatile("" : "+v"(lane2));
#pragma unroll
      for (int i = 0; i < 4; ++i) { const int row = i * 8 + (lane2 >> 3), ch = lane2 & 7; *(u32x4*)(ob + (size_t)row * 512 + ch * 8) = *(LAS const u32x4*)(stg + row * 64 + ch * 8); } }
    (void)nwd;
    QPARK();
}

__device__ __forceinline__ int next_unit(unsigned* ctr, LAS unsigned char* lds) {
    LAS int* bc = (LAS int*)(lds + LDS_MISC);
    __syncthreads();
    if (TIDX() == 0) bc[0] = (int)__hip_atomic_fetch_add(ctr, 1u, __ATOMIC_RELAXED, __HIP_MEMORY_SCOPE_AGENT);
    __syncthreads();
    return __builtin_amdgcn_readfirstlane(bc[0]);
}


__device__ __forceinline__ void phase_router(PRef p, int l, LAS unsigned char* lds, bool dry = false) {
    int tid_ = TIDX(); asm volatile("" : "+v"(tid_));
    const int tid = tid_, lane = tid & 63, wid = tid >> 6;
    unsigned char* ws = p.ws;
    constexpr int WP = 1028;
    LAS float* WT = (LAS float*)lds;
    LAS unsigned* cntl = (LAS unsigned*)(lds + 82432);
    LAS unsigned* lbase = (LAS unsigned*)(lds + 82432 + 64);
    LAS unsigned* loc = (LAS unsigned*)(lds + 82560);
    LAS float* wloc = (LAS float*)(lds + 82560 + 16384);
    LAS float* GL = (LAS float*)(lds + 115328);
    const float* gwp = p.router_grp_w + (size_t)l * DM * 4; const float* ewp = p.router_exp_w + (size_t)l * DM * 16;
    const float* g2 = p.norm2_g + (size_t)l * DM;
    __syncthreads();
    for (int k = tid; k < DM; k += 512) {
        const float gk = g2[k]; GL[k] = gk;
        const f32x4 a = *(const f32x4*)(gwp + k * 4);
#pragma unroll
        for (int i = 0; i < 4; ++i) WT[i * WP + k] = a[i] * gk;
#pragma unroll
        for (int q4 = 0; q4 < 4; ++q4) { const f32x4 e = *(const f32x4*)(ewp + k * 16 + q4 * 4);
#pragma unroll
            for (int i = 0; i < 4; ++i) WT[(4 + q4 * 4 + i) * WP + k] = e[i] * gk; }
    }
    const float* gb = p.router_grp_b + l * 4; const float* eb = p.router_exp_b + l * 16;
    unsigned* ecnt = (unsigned*)(ws + WS_CTL) + CW_ECNT + 64 * l + (dry ? 32 : 0);
    unsigned* LIST = (unsigned*)(ws + (dry ? WS_NQ : WS_LIST)); float* WL = (float*)(ws + (dry ? WS_NQ + 4 * MiB : WS_WL));
    float* RSTD = (float*)(ws + WS_RSTD);
    const int n = lane & 15, kq = lane >> 4;
    for (int ch = BID(); ch < NTOK / 128; ch += GSZ()) {
        __syncthreads();
        if (tid < 16) cntl[tid] = 0u;
        __syncthreads();
        const int tok = ch * 128 + wid * 16 + n;
        const bf16_t* xr = (const bf16_t*)(ws + WS_HB) + (size_t)tok * DM + kq * 256;
        LAS const float* w0 = WT + n * WP + kq * 256;
        LAS const float* w1 = WT + (16 + (n & 3)) * WP + kq * 256;
        f32x4 acc0 = {0.f, 0.f, 0.f, 0.f}, acc1 = {0.f, 0.f, 0.f, 0.f}; float ss = 0.f;
        u32x4 xa[8], xb[8];
#pragma unroll
        for (int u = 0; u < 8; ++u) xa[u] = *(const u32x4*)(xr + 8 * u);
#define ROUTER_BATCH(XC, XN_, jb) do { \
        if ((jb) + 8 < 32) { _Pragma("unroll") for (int u = 0; u < 8; ++u) XN_[u] = *(const u32x4*)(xr + 8 * ((jb) + 8 + u)); } \
        _Pragma("unroll") for (int u = 0; u < 8; ++u) { const int jj = (jb) + u; const u32x4 xw = XC[u]; \
            const f32x4 x0 = {bflo(xw.x), bfhi(xw.x), bflo(xw.y), bfhi(xw.y)}, x1 = {bflo(xw.z), bfhi(xw.z), bflo(xw.w), bfhi(xw.w)}; \
            const f32x4 a0 = *(LAS const f32x4*)(w0 + 8 * jj), a1 = *(LAS const f32x4*)(w1 + 8 * jj), a2 = *(LAS const f32x4*)(w0 + 8 * jj + 4), a3 = *(LAS const f32x4*)(w1 + 8 * jj + 4); \
            ss += ((x0[0] * x0[0] + x0[1] * x0[1]) + (x0[2] * x0[2] + x0[3] * x0[3])) + ((x1[0] * x1[0] + x1[1] * x1[1]) + (x1[2] * x1[2] + x1[3] * x1[3])); \
            _Pragma("unroll") for (int i = 0; i < 4; ++i) { acc0 = __builtin_amdgcn_mfma_f32_16x16x4f32(a0[i], x0[i], acc0, 0, 0, 0); acc1 = __builtin_amdgcn_mfma_f32_16x16x4f32(a1[i], x0[i], acc1, 0, 0, 0); } \
            _Pragma("unroll") for (int i = 0; i < 4; ++i) { acc0 = __builtin_amdgcn_mfma_f32_16x16x4f32(a2[i], x1[i], acc0, 0, 0, 0); acc1 = __builtin_amdgcn_mfma_f32_16x16x4f32(a3[i], x1[i], acc1, 0, 0, 0); } \
            __builtin_amdgcn_sched_barrier(0); } } while (0)
#pragma unroll 1
        for (int jb = 0; jb < 32; jb += 16) { ROUTER_BATCH(xa, xb, jb); ROUTER_BATCH(xb, xa, jb + 8); }
#undef ROUTER_BATCH
        ss += shx(ss, 16, lane); ss += shx(ss, 32, lane);
        const float rstd = rsqrtf(ss * (1.f / 1024.f) + 1e-6f);
        if (kq == 0) RSTD[tok] = rstd;
        int gi = 0; float gwt = 0.f;
        { float gl[4];
#pragma unroll
          for (int r = 0; r < 4; ++r) gl[r] = acc0[r] * rstd + gb[r];
          float gm = gl[0];
#pragma unroll
          for (int r = 1; r < 4; ++r) if (gl[r] > gm) { gm = gl[r]; gi = r; }
          float gs = 0.f;
#pragma unroll
          for (int r = 0; r < 4; ++r) gs += __expf(gl[r] - gm);
          gwt = 1.f / gs; }
        gi = __builtin_amdgcn_ds_bpermute(n << 2, gi); gwt = shl_(gwt, n);
        const int mygrp = (kq == 0) ? 3 : kq - 1;
        if (mygrp == gi) {
            float el[4];
#pragma unroll
            for (int r = 0; r < 4; ++r) el[r] = ((kq == 0) ? acc1[r] : acc0[r]) * rstd + eb[mygrp * 4 + r];
            int i1 = 0; float v1 = el[0];
#pragma unroll
            for (int e = 1; e < 4; ++e) if (el[e] > v1) { v1 = el[e]; i1 = e; }
            int i2 = -1; float v2 = -3.0e38f;
#pragma unroll
            for (int e = 0; e < 4; ++e) if (e != i1 && el[e] > v2) { v2 = el[e]; i2 = e; }
            const float ex = __expf(v2 - v1), w1_ = gwt / (1.f + ex), w2_ = gwt * ex / (1.f + ex);
            const int e1 = gi * 4 + i1, e2 = gi * 4 + i2;
            const unsigned s1 = __hip_atomic_fetch_add(&cntl[e1], 1u, __ATOMIC_RELAXED, __HIP_MEMORY_SCOPE_WORKGROUP); loc[e1 * 256 + s1] = (unsigned)tok * 2u; wloc[e1 * 256 + s1] = w1_;
            const unsigned s2 = __hip_atomic_fetch_add(&cntl[e2], 1u, __ATOMIC_RELAXED, __HIP_MEMORY_SCOPE_WORKGROUP); loc[e2 * 256 + s2] = (unsigned)tok * 2u + 1u; wloc[e2 * 256 + s2] = w2_;
        }
        __syncthreads();
        if (tid < 16) lbase[tid] = __hip_atomic_fetch_add(&ecnt[tid], cntl[tid], __ATOMIC_RELAXED, __HIP_MEMORY_SCOPE_AGENT);
        __syncthreads();
        for (int e = 0; e < 16; ++e) { const unsigned nn = cntl[e], bs = lbase[e];
            for (unsigned i = tid; i < nn; i += 512) { LIST[(size_t)e * NTOK + bs + i] = loc[e * 256 + i]; WL[(size_t)e * NTOK + bs + i] = wloc[e * 256 + i]; } }
    }
}

struct MoeUnit { int e, tile, n, hoff; };
__device__ __forceinline__ bool moe_find(LAS const int* cnts, int ut, MoeUnit& mu) {
    int pre = 0;
    for (int e = 0; e < 16; ++e) { const int cn = cnts[e], nt = (cn + 127) >> 7; if (ut < pre + nt) { mu.e = e; mu.tile = ut - pre; mu.n = cn - mu.tile * 128; if (mu.n > 128) mu.n = 128; mu.hoff = (pre + mu.tile) * 128; return true; } pre += nt; }
    return false;
}

template <int AB> __device__ __forceinline__ void phase_moe_fused(PRef p, int l, LAS unsigned char* lds) {
    SG_IDS
    unsigned char* ws = p.ws;
    LAS int* cnts = (LAS int*)(lds + LDS_MISC + 64);
    const unsigned* ecnt = (const unsigned*)(ws + WS_CTL) + CW_ECNT + 64 * l;
    __syncthreads();
    if (tid < 16) cnts[tid] = (int)__hip_atomic_load(&ecnt[tid], __ATOMIC_RELAXED, __HIP_MEMORY_SCOPE_AGENT);
    __syncthreads();
    const unsigned* LIST = (const unsigned*)(ws + WS_LIST); const float* WL = (const float*)(ws + WS_WL);
    const char* XN = (const char*)(ws + WS_HB); const float* RSTD = (const float*)(ws + WS_RSTD);
    bf16_t* Y0 = (bf16_t*)(ws + WS_GA); bf16_t* Y1 = (bf16_t*)(ws + WS_GB);
    constexpr int SLOT = 49152;
    const unsigned lds0 = (unsigned)(uintptr_t)lds;
    const int lrow = tid >> 3, lpos = tid & 7, lchk = lpos ^ ((lrow >> 1) & 7);
    const unsigned dw = lds0 + wid * 1024;
    const unsigned wvo = (unsigned)(lrow * DM + lchk * 8) * 2u;
    const unsigned dvo = (unsigned)(((lrow & ~31) + pg8::perm32(lrow & 31)) * 128 + lchk * 8) * 2u;
    MoeUnit mu, mun; int ut = BID();
    if (!moe_find(cnts, ut, mu)) return;
    const char* pa0; const char* pa1; unsigned en0, en1; float wg0, wg1, rs0, rs1;
    const char* pa0n = nullptr; const char* pa1n = nullptr; unsigned en0n = 0, en1n = 0; float wg0n = 0.f, wg1n = 0.f, rs0n = 0.f, rs1n = 0.f;
#define RFL(x) ((unsigned)__builtin_amdgcn_readfirstlane(x))
#define MLOAD1(MU, PA0, PA1, E0_, E1_) do { const unsigned* lst_ = LIST + (size_t)(MU).e * NTOK + (MU).tile * 128; \
        const unsigned g0_ = lst_[lrow < (MU).n ? lrow : (MU).n - 1], g1_ = lst_[lrow + 64 < (MU).n ? lrow + 64 : (MU).n - 1]; \
        PA0 = XN + (size_t)(g0_ >> 1) * 2048 + lchk * 16; PA1 = XN + (size_t)(g1_ >> 1) * 2048 + lchk * 16; \
        const int r0_ = SG_ROW(0), r1_ = SG_ROW(1); E0_ = lst_[r0_ < (MU).n ? r0_ : (MU).n - 1]; E1_ = lst_[r1_ < (MU).n ? r1_ : (MU).n - 1]; } while (0)
#define MLOAD2(MU, E0_, E1_, W0_, W1_, R0_, R1_) do { const float* wl_ = WL + (size_t)(MU).e * NTOK + (MU).tile * 128; const int r0_ = SG_ROW(0), r1_ = SG_ROW(1); \
        const float a0_ = wl_[r0_], a1_ = wl_[r1_]; W0_ = (r0_ < (MU).n) ? a0_ : 0.f; W1_ = (r1_ < (MU).n) ? a1_ : 0.f; R0_ = RSTD[E0_ >> 1]; R1_ = RSTD[E1_ >> 1]; } while (0)
#define ADMA(PA0, PA1, Wp, t, so) do { const int ko_ = (t) * 128; const unsigned o_ = (unsigned)(so); \
        glds16(PA0 + ko_, RFL(dw + o_)); glds16(PA1 + ko_, RFL(dw + o_ + 8192)); \
        glds16s((const char*)(Wp) + ko_, wvo, RFL(dw + o_ + 16384)); glds16s((const char*)((Wp) + (size_t)64 * DM) + ko_, wvo, RFL(dw + o_ + 24576)); \
        glds16s((const char*)((Wp) + (size_t)128 * DM) + ko_, wvo, RFL(dw + o_ + 32768)); glds16s((const char*)((Wp) + (size_t)192 * DM) + ko_, wvo, RFL(dw + o_ + 40960)); } while (0)
#define BDMA(WDp, nt, so) do { const char* b_ = (const char*)((WDp) + (size_t)(nt) * 128 * 128); const unsigned o_ = (unsigned)(so); \
        glds16s(b_, dvo, RFL(dw + o_)); glds16s(b_ + 64 * 128 * 2, dvo, RFL(dw + o_ + 8192)); \
        glds16s(b_ + 128, dvo, RFL(dw + o_ + 16384)); glds16s(b_ + 64 * 128 * 2 + 128, dvo, RFL(dw + o_ + 24576)); } while (0)
#define MWAIT(N) asm volatile("s_waitcnt vmcnt(" #N ") lgkmcnt(0)\n\ts_barrier" ::: "memory")
#define MWAITV(n) do { const int n_ = (n); if (n_ >= 10) MWAIT(10); else if (n_ >= 8) MWAIT(8); else if (n_ >= 6) MWAIT(6); else if (n_ >= 4) MWAIT(4); else MWAIT(0); } while (0)
#define ACOMPUTE(so) do { LAS unsigned char* As = lds + (so); LAS unsigned char* Bg = As + 16384; LAS unsigned char* Bu = As + 32768; \
        _Pragma("unroll") for (int ks = 0; ks < 2; ++ks) { bf16x8 af[2], bg[4], bu[4]; const int ch = ks * 4 + fq; \
            _Pragma("unroll") for (int m = 0; m < 2; ++m) { const int row = wr * 32 + m * 16 + fr; af[m] = *(LAS const bf16x8*)(As + row * 128 + ((ch ^ ((row >> 1) & 7)) << 4)); } \
            _Pragma("unroll") for (int n = 0; n < 4; ++n) { const int row = wc * 64 + n * 16 + fr; const int o_ = row * 128 + ((ch ^ ((row >> 1) & 7)) << 4); bg[n] = *(LAS const bf16x8*)(Bg + o_); bu[n] = *(LAS const bf16x8*)(Bu + o_); } \
            _Pragma("unroll") for (int m = 0; m < 2; ++m) _Pragma("unroll") for (int n = 0; n < 4; ++n) { ag[m][n] = MFMA16(bg[n], af[m], ag[m][n]); au[m][n] = MFMA16(bu[n], af[m], au[m][n]); } } } while (0)
    MLOAD1(mu, pa0, pa1, en0, en1);
    MLOAD2(mu, en0, en1, wg0, wg1, rs0, rs1);
    {
        const bf16_t* W = (const bf16_t*)(ws + WS_WGU) + (size_t)(l * 16 + mu.e) * 256 * DM;
        ADMA(pa0, pa1, W, 0, 0); ADMA(pa0, pa1, W, 1, SLOT);
        MWAIT(6);
    }
    for (;;) {
        const bool has_next = moe_find(cnts, ut + GSZ(), mun);
        const bool full = (mu.n == 128);
        const bf16_t* W = (const bf16_t*)(ws + WS_WGU) + (size_t)(l * 16 + mu.e) * 256 * DM;
        const bf16_t* WD = (const bf16_t*)(ws + WS_WD) + (size_t)(l * 16 + mu.e) * DM * 128;
        f32x4 ag[2][4], au[2][4]; SG_ZERO(ag); SG_ZERO(au);
        int so = 0, so2 = 2 * SLOT;
        for (int t = 0; t < 14; ++t) {
            ADMA(pa0, pa1, W, t + 2, so2);
            ACOMPUTE(so);
            MWAIT(6);
            so += SLOT; if (so == 3 * SLOT) so = 0; so2 += SLOT; if (so2 == 3 * SLOT) so2 = 0;
        }
        BDMA(WD, 0, SLOT);     ACOMPUTE(2 * SLOT); MWAIT(4);
        BDMA(WD, 1, 2 * SLOT); ACOMPUTE(0);        MWAIT(4);
        LAS unsigned char* Hs = lds;
#pragma unroll
        for (int m = 0; m < 2; ++m) { const int rl = SG_ROW(m); const float wgt = m ? wg1 : wg0, rs = m ? rs1 : rs0;
#pragma unroll
            for (int n = 0; n < 4; ++n) { f32x4 gv = ag[m][n] * rs, uv = au[m][n] * rs, hv;
#pragma unroll
                for (int i = 0; i < 4; ++i) hv[i] = gv[i] * sigm(gv[i]) * uv[i] * wgt;
                const int chk = 2 * n + (fq >> 1);
                u32x2 w; w.x = cvtpk(hv[0], hv[1]); w.y = cvtpk(hv[2], hv[3]);
                *(LAS u32x2*)(Hs + wc * 16384 + rl * 128 + ((chk ^ ((rl >> 1) & 7)) << 4) + (fq & 1) * 8) = w; } }
        asm volatile("s_waitcnt lgkmcnt(0)\n\ts_barrier" ::: "memory");
        bf16x8 hf[2][4];
#pragma unroll
        for (int m = 0; m < 2; ++m)
#pragma unroll
            for (int kk = 0; kk < 4; ++kk) { const int row = wr * 32 + m * 16 + fr, ch = (kk & 1) * 4 + fq; hf[m][kk] = *(LAS const bf16x8*)(Hs + (kk >> 1) * 16384 + row * 128 + ((ch ^ ((row >> 1) & 7)) << 4)); }
        asm volatile("s_waitcnt lgkmcnt(0)\n\ts_barrier" ::: "memory");
        const bf16_t* Wn = (const bf16_t*)(ws + WS_WGU) + (size_t)(l * 16 + (has_next ? mun.e : mu.e)) * 256 * DM;
#pragma unroll
        for (int nt = 0; nt < 8; ++nt) {
            const int sb = ((16 + nt) % 3) * SLOT, sb2 = ((18 + nt) % 3) * SLOT;
            int cnew = 0;
            if (nt + 2 < 8) { BDMA(WD, nt + 2, sb2); cnew = 4; }
            else if (has_next) { ADMA(pa0n, pa1n, Wn, nt - 6, sb2); cnew = 6; }
            if (nt == 0 && has_next) MLOAD1(mun, pa0n, pa1n, en0n, en1n);
            if (nt == 4 && has_next) MLOAD2(mun, en0n, en1n, wg0n, wg1n, rs0n, rs1n);
            f32x4 acc[2][4]; SG_ZERO(acc);
#pragma unroll
            for (int kk = 0; kk < 4; ++kk) {
                bf16x8 bfr[4];
                const int ch = (kk & 1) * 4 + fq;
#pragma unroll
                for (int n = 0; n < 4; ++n) { const int row = wc * 64 + n * 16 + fr; bfr[n] = *(LAS const bf16x8*)(lds + sb + (kk >> 1) * 16384 + row * 128 + ((ch ^ ((row >> 1) & 7)) << 4)); }
#pragma unroll
                for (int m = 0; m < 2; ++m)
#pragma unroll
                    for (int n = 0; n < 4; ++n) acc[m][n] = MFMA16(bfr[n], hf[m][kk], acc[m][n]);
            }
            MWAITV(cnew + ((nt > 0 && full && AB != 5) ? 4 : 0));
#pragma unroll
            for (int m = 0; m < 2; ++m) if (SG_ROW(m) < mu.n) { const unsigned en = m ? en1 : en0; bf16_t* dst = ((en & 1u) ? Y1 : Y0) + (size_t)(en >> 1) * DM + nt * 128 + wc * 64 + 8 * fq;
#pragma unroll
                for (int np = 0; np < 2; ++np) { const f32x4 v0 = acc[m][2 * np], v1 = acc[m][2 * np + 1];
                    if (AB == 5) { asm volatile("" :: "v"(v0), "v"(v1)); continue; }
                    u32x4 w; w.x = cvtpk(v0[0], v0[1]); w.y = cvtpk(v0[2], v0[3]); w.z = cvtpk(v1[0], v1[1]); w.w = cvtpk(v1[2], v1[3]); *(u32x4*)(dst + 32 * np) = w; } }
        }
        if (!has_next) break;
        mu = mun; ut += GSZ(); pa0 = pa0n; pa1 = pa1n; en0 = en0n; en1 = en1n; wg0 = wg0n; wg1 = wg1n; rs0 = rs0n; rs1 = rs1n;
    }
#undef RFL
#undef MLOAD1
#undef MLOAD2
#undef ADMA
#undef BDMA
#undef MWAIT
#undef MWAITV
#undef ACOMPUTE
}

__device__ __forceinline__ void phase_combine(PRef p, int l, bool dry = false) {
    int tid_ = TIDX(); asm volatile("" : "+v"(tid_));
    const int tid = tid_, lane = tid & 63, wid = tid >> 6;
    unsigned char* ws = p.ws;
    const int gw = BID() * 8 + wid, NGW = GSZ() * 8;
    const bf16_t* Y0 = (const bf16_t*)(ws + WS_GA); const bf16_t* Y1 = (const bf16_t*)(ws + WS_GB);
    bf16_t* HB = (bf16_t*)(ws + WS_HB); bf16_t* HO = dry ? (bf16_t*)(ws + WS_NQ) : HB; float* OUT = dry ? (float*)(ws + WS_NQ) : p.out;
    const bool last = (l == DEPTH - 1);
    for (int m0 = gw * 4; m0 < NTOK; m0 += NGW * 4) {
        u32x2 hv[4][4], ya[4][4], yb[4][4];
#pragma unroll
        for (int rr = 0; rr < 4; ++rr)
#pragma unroll
            for (int j = 0; j < 4; ++j) { const size_t off = (size_t)(m0 + rr) * DM + (64 * j + lane) * 4; hv[rr][j] = *(const u32x2*)(HB + off); ya[rr][j] = *(const u32x2*)(Y0 + off); yb[rr][j] = *(const u32x2*)(Y1 + off); }
#pragma unroll
        for (int rr = 0; rr < 4; ++rr) {
            f32x4 v[4]; float s = 0.f;
#pragma unroll
            for (int j = 0; j < 4; ++j) { const u32x2 h2 = hv[rr][j], a = ya[rr][j], b2 = yb[rr][j];
                v[j] = (f32x4){bflo(h2.x), bfhi(h2.x), bflo(h2.y), bfhi(h2.y)} + (f32x4){bflo(a.x), bfhi(a.x), bflo(a.y), bfhi(a.y)} + (f32x4){bflo(b2.x), bfhi(b2.x), bflo(b2.y), bfhi(b2.y)};
                s += (v[j][0] * v[j][0] + v[j][1] * v[j][1]) + (v[j][2] * v[j][2] + v[j][3] * v[j][3]); }
            const float rstd = rsqrtf(wave_sum(s, lane) * (1.f / 1024.f) + 1e-6f);
            if (last) {
#pragma unroll
                for (int j = 0; j < 4; ++j) { const int cidx = (64 * j + lane) * 4; const f32x4 gg = *(const f32x4*)(p.final_norm_g + cidx); *(f32x4*)(OUT + (size_t)(m0 + rr) * DM + cidx) = v[j] * rstd * gg; }
            } else {
                if (lane == 0 && !dry) ((float*)(ws + WS_RSTD1))[m0 + rr] = rstd;
#pragma unroll
                for (int j = 0; j < 4; ++j) st4bf(HO + (size_t)(m0 + rr) * DM + (64 * j + lane) * 4, v[j]);
            }
        }
    }
}

#define XB_TMO      128
#define XB_XCNT(j)  (256  + 64 * (j))
#define XB_XSUB(j)  (1280 + 64 * (j))
#define XB_XGEN(j)  (2304 + 64 * (j))
#define XB_TOP      3328
#define XB_TOPGEN   3392
#define XCD_BAR_WORDS 3456
#define XB_SPIN_CAP (1u << 18)
__device__ __forceinline__ unsigned xb_ld(unsigned* p)              { return __hip_atomic_load(p, __ATOMIC_RELAXED, __HIP_MEMORY_SCOPE_AGENT); }
__device__ __forceinline__ unsigned xb_add(unsigned* p, unsigned v) { return __hip_atomic_fetch_add(p, v, __ATOMIC_RELAXED, __HIP_MEMORY_SCOPE_AGENT); }
__device__ __forceinline__ unsigned xb_xcc_id() { return (unsigned)__builtin_amdgcn_s_getreg((3 << 11) | 20) & 0xFu; }
#define XB_SPIN(cond, bar) do { unsigned _sp = 0; while (cond) { __builtin_amdgcn_s_sleep(1); \
    if ((++_sp & 255u) == 0u) { if (xb_ld(&(bar)[XB_TMO])) break; if (_sp > XB_SPIN_CAP) { atomicAdd(&(bar)[XB_TMO], 1u); break; } } } } while (0)
struct XcdBarrier { unsigned* bar; unsigned x; volatile LAS unsigned* st; };
__device__ __forceinline__ XcdBarrier xcd_barrier_post(unsigned* bar, volatile LAS unsigned* st) {
    XcdBarrier b; b.bar = bar; b.x = xb_xcc_id(); b.st = st;
    if (TIDX() == 0) (void)xb_add(&bar[XB_XCNT(b.x)], 1u);
    return b;
}
__device__ __forceinline__ void xcd_barrier_complete(unsigned* bar, unsigned x, unsigned& nloc, unsigned& nx) {
    const unsigned G = gridDim.x * gridDim.y * gridDim.z;
    unsigned sum, cnt, mine, sp = 0u;
    for (;;) {
        sum = 0u; cnt = 0u; mine = 0u;
#pragma unroll
        for (unsigned j = 0; j < 16; ++j) { const unsigned c = xb_ld(&bar[XB_XCNT(j)]); sum += c; cnt += (c > 0u) ? 1u : 0u; mine = (j == x) ? c : mine; }
        if (sum == G) break;
        __builtin_amdgcn_s_sleep(1);
        if ((++sp & 255u) == 0u) { if (xb_ld(&bar[XB_TMO])) break; if (sp > XB_SPIN_CAP) { atomicAdd(&bar[XB_TMO], 1u); break; } }
    }
    nloc = mine > 0u ? mine : 1u; nx = cnt > 0u ? cnt : 1u;
}
__device__ __forceinline__ void xcd_barrier(const XcdBarrier& b_) {
    asm volatile("s_waitcnt vmcnt(0)" ::: "memory");
    __syncthreads();
    if (TIDX() == 0) {
        unsigned* bar = b_.bar; asm volatile("" : "+s"(bar));
        XcdBarrier b; b.bar = bar; b.st = b_.st; b.x = xb_xcc_id();
        __builtin_amdgcn_s_waitcnt(0);
        unsigned nloc = b.st[0], nx = b.st[1];
        if (nloc == 0u) { xcd_barrier_complete(bar, b.x, nloc, nx); b.st[0] = nloc; b.st[1] = nx; }
        const unsigned old = xb_add(&bar[XB_XSUB(b.x)], 1u);
        const unsigned gen = old / nloc;
        if (old + 1u == (gen + 1u) * nloc) {
            __builtin_amdgcn_fence(__ATOMIC_RELEASE, "agent");
            asm volatile("s_waitcnt vmcnt(0)" ::: "memory");
            const unsigned og = xb_add(&bar[XB_TOP], 1u);
            const unsigned tg = og / nx;
            if (og + 1u == (tg + 1u) * nx) xb_add(&bar[XB_TOPGEN], 1u);
            else XB_SPIN(xb_ld(&bar[XB_TOPGEN]) == tg, bar);
            __builtin_amdgcn_fence(__ATOMIC_ACQUIRE, "agent");
            xb_add(&bar[XB_XGEN(b.x)], 1u);
            asm volatile("s_waitcnt vmcnt(0)" ::: "memory");
        } else {
            XB_SPIN(xb_ld(&bar[XB_XGEN(b.x)]) == gen, bar);
            __builtin_amdgcn_fence(__ATOMIC_ACQUIRE, "agent");
            asm volatile("s_waitcnt vmcnt(0)" ::: "memory");
        }
    }
    __syncthreads();
}

template <int K> __device__ __forceinline__ void run_phase(PRef p, int l, LAS unsigned char* lds, bool dry = false) {
    unsigned* ctl = (unsigned*)(p.ws + WS_CTL);
    if (K == 0) phase_prologue(p, lds);
    if (K == 1) { if (dry) phase_inproj_pg8<ABL>(p, l, lds); else { phase_inproj_pg8<0>(p, l, lds); if (l + 1 < DEPTH) { __syncthreads(); weight_prep(p, l + 1, lds); } } }
    if (K == 2) { unsigned* ctr = ctl + CW_QCTR + 64 * (l * 2 + 0) + (dry ? 16 : 0);
        int u = next_unit(ctr, lds);
        while (u < 64 + 1024) { if (u < 64) compress_unit(p, l, u, lds, ctr); else { if (dry) diff_unit<ABL>(p, l, u - 64, lds, true, ctr); else diff_unit<0>(p, l, u - 64, lds, false, ctr); }
            __syncthreads(); u = __builtin_amdgcn_readfirstlane(((LAS int*)(lds + LDS_MISC))[1]); } }
    if (K == 3) { unsigned* ctr = ctl + CW_QCTR + 64 * (l * 2 + 1) + (dry ? 16 : 0);
        int u = next_unit(ctr, lds);
        while (u < 1024) { if (dry) nsa_unit<ABL>(p, l, u, lds, true, ctr); else nsa_unit<0>(p, l, u, lds, false, ctr);
            __syncthreads(); u = __builtin_amdgcn_readfirstlane(((LAS int*)(lds + LDS_MISC))[1]); } }
    if (K == 4) phase_merge_pg8(p, l, lds);
    if (K == 5) phase_outproj_pg8(p, l, lds, dry);
    if (K == 6) phase_router(p, l, lds, dry);
    if (K == 7) { if (dry) phase_moe_fused<ABL>(p, l, lds); else phase_moe_fused<0>(p, l, lds); }
    if (K == 9) phase_combine(p, l, dry);
}
#if MK_MULTI
template <int K> __global__ void __launch_bounds__(512, 2) mk_one(Params p) {
    extern __shared__ __attribute__((aligned(16))) unsigned char lds_raw[];
    const __attribute__((address_space(4))) Params* pp_ = (const __attribute__((address_space(4))) Params*)__builtin_amdgcn_kernarg_segment_ptr();
    if ((threadIdx.x & 63) == 0) ((LAS int*)(size_t)LDS_WTAB)[hw_wave_key()] = (int)(threadIdx.x >> 6);
    __syncthreads();
    run_phase<K>(*pp_, p.ph_lo, (LAS unsigned char*)lds_raw);
}
template <int K> static void launch_one(int grid, hipStream_t stream, Params p, int l) {
    static bool attr = false;
    if (!attr) { (void)hipFuncSetAttribute((const void*)mk_one<K>, hipFuncAttributeMaxDynamicSharedMemorySize, LDS_BYTES); attr = true; }
    p.ph_lo = l; p.ph_hi = l + 1;
    hipLaunchKernelGGL(mk_one<K>, dim3(grid), dim3(512), LDS_BYTES, stream, p);
}
#else
__global__ void __launch_bounds__(512, 2) mk_fwd(Params p) {
    extern __shared__ __attribute__((aligned(16))) unsigned char lds_raw[];
    LAS unsigned char* lds = (LAS unsigned char*)lds_raw;
    volatile LAS unsigned* bst = (volatile LAS unsigned*)(lds + LDS_MISC + 256);
    if ((threadIdx.x & 63) == 0) ((LAS int*)(size_t)LDS_WTAB)[hw_wave_key()] = (int)(threadIdx.x >> 6);
    if (threadIdx.x < 2) bst[threadIdx.x] = 0u;
    __syncthreads();
    const XcdBarrier bar = xcd_barrier_post((unsigned*)(p.ws + WS_CTL) + CW_BAR, bst);
#define SEAM() xcd_barrier(bar)
#ifndef PROBE_DUP
#define PROBE_DUP -1
#endif
#ifndef PROBE_DUP2
#define PROBE_DUP2 -1
#endif
#define RUN(K, l) do { const __attribute__((address_space(4))) Params* pp_ = (const __attribute__((address_space(4))) Params*)__builtin_amdgcn_kernarg_segment_ptr(); asm volatile("" : "+s"(pp_)); \
    if (K == PROBE_DUP || K == PROBE_DUP2) { run_phase<K>(*pp_, l, lds, true); SEAM(); } run_phase<K>(*pp_, l, lds); } while (0)
    RUN(0, 0); SEAM();
    for (int l = 0; l < DEPTH; ++l) {
        RUN(1, l); SEAM();
        RUN(2, l); SEAM();
        RUN(3, l); SEAM();
        RUN(4, l); SEAM();
        RUN(5, l); SEAM();
        RUN(6, l); SEAM();
        RUN(7, l); SEAM();
        RUN(9, l); if (l + 1 < DEPTH) SEAM();
    }
}
#endif

extern "C" void kernel_launch(void* const* d_in, const int* in_sizes, int n_in, void* d_out, int out_size, void* d_ws, size_t ws_size, hipStream_t stream) {
    static int grid = 0;
    if (grid == 0) {
        if (n_in != 22 || in_sizes[0] != NTOK * DM || out_size != NTOK * DM || ws_size < WS_END) { fprintf(stderr, "kernel_launch: unexpected shapes (n_in %d, in0 %d, out %d, ws %zu)\n", n_in, n_in > 0 ? in_sizes[0] : -1, out_size, ws_size); grid = -1; return; }
        int dev = 0, cus = 0, per_cu = 1;
        (void)hipGetDevice(&dev); (void)hipDeviceGetAttribute(&cus, hipDeviceAttributeMultiprocessorCount, dev);
#if !MK_MULTI
        (void)hipFuncSetAttribute((const void*)mk_fwd, hipFuncAttributeMaxDynamicSharedMemorySize, LDS_BYTES);
        (void)hipOccupancyMaxActiveBlocksPerMultiprocessor(&per_cu, (const void*)mk_fwd, 512, LDS_BYTES);
        if (per_cu < 1) { fprintf(stderr, "kernel_launch: occupancy query says %d blocks per CU\n", per_cu); per_cu = 1; }
#endif
        (void)hipGetLastError();
        grid = cus * per_cu;
    }
    if (grid < 0) return;
    (void)hipMemsetAsync((char*)d_ws + WS_CTL, 0, CTL_BYTES, stream);
    Params p{};
    const float** pp = (const float**)&p;
    for (int i = 0; i < 22; ++i) pp[i] = (const float*)d_in[i];
    p.out = (float*)d_out; p.ws = (unsigned char*)d_ws;
#if MK_MULTI
    launch_one<0>(grid, stream, p, 0);
    for (int l = 0; l < DEPTH; ++l) {
        launch_one<1>(grid, stream, p, l); launch_one<2>(grid, stream, p, l); launch_one<3>(grid, stream, p, l); launch_one<4>(grid, stream, p, l); launch_one<5>(grid, stream, p, l);
        launch_one<6>(grid, stream, p, l); launch_one<7>(grid, stream, p, l); launch_one<9>(grid, stream, p, l);
    }
#else
    p.ph_lo = 0; p.ph_hi = NPHASE;
    void* args[] = {&p};
    hipError_t e = hipLaunchCooperativeKernel((const void*)mk_fwd, dim3(grid), dim3(512), args, LDS_BYTES, stream);
    if (e != hipSuccess) fprintf(stderr, "cooperative launch failed: %s (grid %d)\n", hipGetErrorString(e), grid);
#endif
}
```

```cpp
#include <hip/hip_runtime.h>
#include <hip/hip_cooperative_groups.h>
#include <cstdio>
#include <cstdint>
namespace cg = cooperative_groups;

#ifndef MK_MULTI
#define MK_MULTI 0
#endif

#define LAS __attribute__((address_space(3)))
typedef unsigned short bf16_t;
typedef short bf16x8 __attribute__((ext_vector_type(8)));
typedef short s16x4 __attribute__((ext_vector_type(4)));
typedef float f32x2 __attribute__((ext_vector_type(2)));
typedef float f32x4 __attribute__((ext_vector_type(4)));
typedef float f32x16 __attribute__((ext_vector_type(16)));
typedef unsigned u32x2 __attribute__((ext_vector_type(2)));
typedef unsigned u32x4 __attribute__((ext_vector_type(4)));
typedef __bf16 bf16x2_t __attribute__((ext_vector_type(2)));

constexpr int NTOK = 32768, DM = 1024, TSEQ = 2048, NBATCH = 16, DEPTH = 2;
constexpr int INCOLS = 4888, NPAD = 5120;
constexpr float LOG2E = 1.4426950408889634f;
constexpr float QSCALE = 0.125f * LOG2E;
constexpr int NPHASE = 1 + 9 * DEPTH;

constexpr size_t MiB = 1u << 20;
constexpr size_t WS_CTL = 0, CTL_BYTES = 65536;
constexpr size_t WS_WIN = 1 * MiB;
constexpr size_t WS_WA = 21 * MiB;
constexpr size_t WS_WB = 23 * MiB;
constexpr size_t WS_WO = 25 * MiB;
constexpr size_t WS_WC1 = 29 * MiB;
constexpr size_t WS_WGU = 31 * MiB;
constexpr size_t WS_WD = 47 * MiB;
constexpr size_t WS_MISC = 55 * MiB;
constexpr size_t WS_LIST = 58 * MiB;
constexpr size_t WS_WL = 60 * MiB;
constexpr size_t WS_XN = 64 * MiB;
constexpr size_t WS_NQ = 128 * MiB;
constexpr size_t WS_KV6 = 160 * MiB;
constexpr size_t WS_NG = 208 * MiB;
constexpr size_t WS_DQ = 210 * MiB;
constexpr size_t WS_DK = 242 * MiB;
constexpr size_t WS_DV = 274 * MiB;
constexpr size_t WS_GA = 306 * MiB;
constexpr size_t WS_GB = 370 * MiB;
constexpr size_t WS_HB = 434 * MiB;
constexpr size_t WS_END = 498 * MiB;
constexpr size_t WS_RSTD = WS_MISC + 2 * MiB;
constexpr size_t WS_RSTD1 = WS_MISC + 2 * MiB + 131072;
constexpr size_t WS_H = WS_DK;
constexpr int CW_QCTR = 64;
constexpr int CW_ECNT = 1024;
constexpr int CW_BAR = 4096;

constexpr int LDS_BYTES = 151552;
constexpr int LDS_MISC = 147456;

struct Params {
    const float* x; const float* norm1_g; const float* w_in; const float* cmp_pe; const float* cmp_w1; const float* cmp_b1; const float* cmp_w2; const float* cmp_b2;
    const float* diff_lambda; const float* diff_subln_g; const float* w_branch_a; const float* w_branch_b; const float* w_out; const float* norm2_g;
    const float* router_grp_w; const float* router_grp_b; const float* router_exp_w; const float* router_exp_b; const float* exp_w_gate; const float* exp_w_up; const float* exp_w_down; const float* final_norm_g;
    float* out; unsigned char* ws; int ph_lo, ph_hi;
};

typedef const __attribute__((address_space(4))) Params& PRef;

constexpr int LDS_WTAB = LDS_MISC + 512;
__device__ __forceinline__ int hw_wave_key() { return (int)(__builtin_amdgcn_s_getreg((5 << 11) | 4) & 63u); }
__device__ __forceinline__ int TIDX() {
    int lane, key;
    asm volatile("v_mbcnt_lo_u32_b32 %0, -1, 0\n\tv_mbcnt_hi_u32_b32 %0, -1, %0\n\ts_getreg_b32 %1, hwreg(HW_REG_HW_ID, 0, 6)" : "=&v"(lane), "=s"(key));
    const int wv = __builtin_amdgcn_readfirstlane(((LAS const int*)(size_t)LDS_WTAB)[key]);
    return wv * 64 + lane;
}
__device__ __forceinline__ int BID() { int b = (int)blockIdx.x; asm volatile("" : "+s"(b)); return b; }
__device__ __forceinline__ int GSZ() { int g = (int)gridDim.x; asm volatile("" : "+s"(g)); return g; }
__device__ __forceinline__ unsigned cvtpk(float lo, float hi) { f32x2 v = {lo, hi}; bf16x2_t b = __builtin_convertvector(v, bf16x2_t); return __builtin_bit_cast(unsigned, b); }
__device__ __forceinline__ float bflo(unsigned u) { return __uint_as_float(u << 16); }
__device__ __forceinline__ float bfhi(unsigned u) { return __uint_as_float(u & 0xffff0000u); }
__device__ __forceinline__ float bf1(bf16_t b) { return __uint_as_float(((unsigned)b) << 16); }
__device__ __forceinline__ bf16_t f2bf(float f) { return (bf16_t)(cvtpk(f, 0.f) & 0xffffu); }
__device__ __forceinline__ int crow(int r, int hi) { return (r & 3) + 8 * (r >> 2) + 4 * hi; }
__device__ __forceinline__ float shx(float v, int m, int lane) { return __int_as_float(__builtin_amdgcn_ds_bpermute((lane ^ m) << 2, __float_as_int(v))); }
__device__ __forceinline__ unsigned shxu(unsigned v, int m, int lane) { return (unsigned)__builtin_amdgcn_ds_bpermute((lane ^ m) << 2, (int)v); }
__device__ __forceinline__ float shl_(float v, int src) { return __int_as_float(__builtin_amdgcn_ds_bpermute(src << 2, __float_as_int(v))); }
__device__ __forceinline__ float wave_sum(float v, int lane) {
#pragma unroll
    for (int o = 1; o < 64; o <<= 1) v += shx(v, o, lane);
    return v;
}
__device__ __forceinline__ float s32(float x) { auto rr = __builtin_amdgcn_permlane32_swap(__float_as_uint(x), __float_as_uint(x), false, false); return __uint_as_float(rr[0]) + __uint_as_float(rr[1]); }
__device__ __forceinline__ float m32(float x) { auto rr = __builtin_amdgcn_permlane32_swap(__float_as_uint(x), __float_as_uint(x), false, false); return fmaxf(__uint_as_float(rr[0]), __uint_as_float(rr[1])); }
__device__ __forceinline__ float o32(float x, int hi) { auto rr = __builtin_amdgcn_permlane32_swap(__float_as_uint(x), __float_as_uint(x), false, false); return hi ? __uint_as_float(rr[0]) : __uint_as_float(rr[1]); }
__device__ __forceinline__ float sigm(float x) { return __builtin_amdgcn_rcpf(1.f + __builtin_amdgcn_exp2f(-1.4426950408889634f * x)); }
__device__ __forceinline__ float ex2(float x) { return __builtin_amdgcn_exp2f(x); }
__device__ __forceinline__ float alibi_slope(int i  ) { return exp2f(-8.0f * (float)i / 12.0f); }
__device__ __forceinline__ s16x4 vtr(LAS const unsigned char* p) { return __builtin_bit_cast(s16x4, __builtin_amdgcn_ds_read_tr16_b64_v4i16((LAS s16x4*)p)); }
#define MFMA32(a, b, c) __builtin_amdgcn_mfma_f32_32x32x16_bf16(a, b, c, 0, 0, 0)
#define MFMA16(a, b, c) __builtin_amdgcn_mfma_f32_16x16x32_bf16(a, b, c, 0, 0, 0)

struct ARowLin { const char* base; size_t stride; __device__ __forceinline__ const char* operator()(int r) const { return base + (size_t)r * stride; } };

template <class ARow>
__device__ __forceinline__ void sg_kloop(f32x4 (&acc)[2][4], const ARow& arow, int kstepA, const bf16_t* Bt, int ldb, int nt, LAS unsigned char* lds) {
    int tid_ = TIDX(); asm volatile("" : "+v"(tid_));
    const int tid = tid_, lane = tid & 63, wid = tid >> 6, wr = wid >> 1, wc = wid & 1, fr = lane & 15, fq = lane >> 4;
    const int lrow = tid >> 3, lch = tid & 7;
    const char* pa0 = arow(lrow) + lch * 16; const char* pa1 = arow(lrow + 64) + lch * 16;
    const char* pb0 = (const char*)(Bt + (size_t)lrow * ldb) + lch * 16; const char* pb1 = (const char*)(Bt + (size_t)(lrow + 64) * ldb) + lch * 16;
    const int wofs0 = lrow * 128 + ((lch ^ ((lrow >> 1) & 7)) << 4), wofs1 = wofs0 + 64 * 128;
    u32x4 ra0 = *(const u32x4*)pa0, ra1 = *(const u32x4*)pa1, rb0 = *(const u32x4*)pb0, rb1 = *(const u32x4*)pb1;
    for (int t = 0; t < nt; ++t) {
        __syncthreads();
        *(LAS u32x4*)(lds + wofs0) = ra0; *(LAS u32x4*)(lds + wofs1) = ra1; *(LAS u32x4*)(lds + 16384 + wofs0) = rb0; *(LAS u32x4*)(lds + 16384 + wofs1) = rb1;
        __syncthreads();
        if (t + 1 < nt) { pa0 += kstepA; pa1 += kstepA; pb0 += 128; pb1 += 128; ra0 = *(const u32x4*)pa0; ra1 = *(const u32x4*)pa1; rb0 = *(const u32x4*)pb0; rb1 = *(const u32x4*)pb1; }
#pragma unroll
        for (int ks = 0; ks < 2; ++ks) {
            bf16x8 af[2], bfr[4];
            const int ch = ks * 4 + fq;
#pragma unroll
            for (int m = 0; m < 2; ++m) { const int row = wr * 32 + m * 16 + fr; af[m] = *(LAS const bf16x8*)(lds + row * 128 + ((ch ^ ((row >> 1) & 7)) << 4)); }
#pragma unroll
            for (int n = 0; n < 4; ++n) { const int row = wc * 64 + n * 16 + fr; bfr[n] = *(LAS const bf16x8*)(lds + 16384 + row * 128 + ((ch ^ ((row >> 1) & 7)) << 4)); }
#pragma unroll
            for (int m = 0; m < 2; ++m)
#pragma unroll
                for (int n = 0; n < 4; ++n) acc[m][n] = MFMA16(bfr[n], af[m], acc[m][n]);
        }
    }
}
#define SG_ZERO(acc) do { _Pragma("unroll") for (int m_ = 0; m_ < 2; ++m_) _Pragma("unroll") for (int n_ = 0; n_ < 4; ++n_) acc[m_][n_] = (f32x4){0.f, 0.f, 0.f, 0.f}; } while (0)
#define SG_IDS int tid_ = TIDX(); asm volatile("" : "+v"(tid_)); const int tid = tid_, lane = tid & 63, wid = tid >> 6, wr = wid >> 1, wc = wid & 1, fr = lane & 15, fq = lane >> 4; (void)tid; (void)lane; (void)wid;
#define SG_ROW(m) (wr * 32 + (m) * 16 + fr)
#define SG_COL(n) (wc * 64 + (n) * 16 + 4 * fq)
__device__ __forceinline__ void st4bf(bf16_t* dst, f32x4 v) { u32x2 w; w.x = cvtpk(v[0], v[1]); w.y = cvtpk(v[2], v[3]); *(u32x2*)dst = w; }

__device__ __forceinline__ void transpose_item(const float* W, int ldw, int src_col, int valid, bf16_t* WT, int K, int dst_row, int k0, LAS float* scr, int lane, const float* gk = nullptr  ) {
    const int kq = lane >> 3, c4 = (lane & 7) * 4;
    if ((valid == 32) && ((src_col & 3) == 0) && ((ldw & 3) == 0)) {
        f32x4 v[8];
#pragma unroll
        for (int i = 0; i < 8; ++i) v[i] = *(const f32x4*)(W + (size_t)(k0 + 8 * i + kq) * ldw + src_col + c4);
        if (gk) {
#pragma unroll
            for (int i = 0; i < 8; ++i) v[i] = v[i] * gk[k0 + 8 * i + kq]; }
#pragma unroll
        for (int i = 0; i < 8; ++i) { LAS float* d = scr + (8 * i + kq) * 33 + c4; d[0] = v[i][0]; d[1] = v[i][1]; d[2] = v[i][2]; d[3] = v[i][3]; }
    } else {
        float v[32];
#pragma unroll
        for (int i = 0; i < 32; ++i) { const int kk = 2 * i + (lane >> 5), c = lane & 31; v[i] = (c < valid) ? W[(size_t)(k0 + kk) * ldw + src_col + c] * (gk ? gk[k0 + kk] : 1.f) : 0.f; }
#pragma unroll
        for (int i = 0; i < 32; ++i) { const int kk = 2 * i + (lane >> 5), c = lane & 31; scr[kk * 33 + c] = v[i]; }
    }
    asm volatile("s_waitcnt lgkmcnt(0)" ::: "memory");
    const int c = lane & 7;
#pragma unroll
    for (int j = 0; j < 4; ++j) { const int n = (lane >> 3) + 8 * j; LAS const float* s = scr + (8 * c) * 33 + n;
        u32x4 o; o.x = cvtpk(s[0 * 33], s[1 * 33]); o.y = cvtpk(s[2 * 33], s[3 * 33]); o.z = cvtpk(s[4 * 33], s[5 * 33]); o.w = cvtpk(s[6 * 33], s[7 * 33]);
        *(u32x4*)(WT + (size_t)(dst_row + n) * K + k0 + 8 * c) = o; }
    asm volatile("s_waitcnt lgkmcnt(0)" ::: "memory");
}
__device__ __forceinline__ void weight_prep(PRef p, int l, LAS unsigned char* lds) {
    int tid_ = TIDX(); asm volatile("" : "+v"(tid_));
    const int tid = tid_, lane = tid & 63, wid = tid >> 6;
    const int gw = BID() * 8 + wid, NGW = GSZ() * 8;
    LAS float* scr = (LAS float*)(lds + wid * 8448);
    unsigned char* ws = p.ws;
    constexpr int I_IN = 16 * 160, I_A = 8 * 32, I_O = 16 * 32, I_C1 = 2 * 32 * 4, I_G = 16 * 16 * 4, I_D = 16 * 2 * 32;
    constexpr int I_LAYER = I_IN + 2 * I_A + I_O + I_C1 + 2 * I_G + I_D;
    for (int it = gw; it < I_LAYER; it += NGW) {
        int r = it;
        if (r < I_IN) { const int kb = r / 160, nb = r % 160, n0 = nb * 32; int src, valid = 32;
            if (n0 < 1280) src = n0; else if (n0 < 4864) src = n0 + 24; else { src = 1280 + (n0 - 4864); valid = (n0 == 4864) ? 24 : 0; if (valid == 0) src = 0; }
            transpose_item(p.w_in + (size_t)l * DM * INCOLS, INCOLS, src, valid, (bf16_t*)(ws + WS_WIN) + (size_t)l * NPAD * DM, DM, n0, kb * 64, scr, lane, p.norm1_g + (size_t)l * DM); continue; }
        r -= I_IN;
        if (r < I_A) { const int kb = r / 32, nb = r % 32; transpose_item(p.w_branch_a + (size_t)l * 512 * DM, DM, nb * 32, 32, (bf16_t*)(ws + WS_WA) + (size_t)l * DM * 512, 512, nb * 32, kb * 64, scr, lane); continue; }
        r -= I_A;
        if (r < I_A) { const int kb = r / 32, nb = r % 32; transpose_item(p.w_branch_b + (size_t)l * 512 * DM, DM, nb * 32, 32, (bf16_t*)(ws + WS_WB) + (size_t)l * DM * 512, 512, nb * 32, kb * 64, scr, lane); continue; }
        r -= I_A;
        if (r < I_O) { const int kb = r / 32, nb = r % 32; transpose_item(p.w_out + (size_t)l * DM * DM, DM, nb * 32, 32, (bf16_t*)(ws + WS_WO) + (size_t)l * DM * DM, DM, nb * 32, kb * 64, scr, lane); continue; }
        r -= I_O;
        if (r < I_C1) { const int kv = r / 128, r2 = r % 128, kb = r2 / 4, nb = r2 % 4;
            transpose_item(p.cmp_w1 + (size_t)(l * 2 + kv) * 2048 * 128, 128, nb * 32, 32, (bf16_t*)(ws + WS_WC1) + (size_t)(l * 2 + kv) * 128 * 2048, 2048, nb * 32, kb * 64, scr, lane); continue; }
        r -= I_C1;
        if (r < 2 * I_G) { const int which = r / I_G, r2 = r % I_G, e = r2 / 64, r3 = r2 % 64, kb = r3 / 4, nb = r3 % 4;
            const float* W = (which ? p.exp_w_up : p.exp_w_gate) + (size_t)(l * 16 + e) * DM * 128;
            transpose_item(W, 128, nb * 32, 32, (bf16_t*)(ws + WS_WGU) + (size_t)(l * 16 + e) * 256 * DM, DM, which * 128 + nb * 32, kb * 64, scr, lane, p.norm2_g + (size_t)l * DM); continue; }
        r -= 2 * I_G;
        { const int e = r / 64, r3 = r % 64, kb = r3 / 32, nb = r3 % 32;
            transpose_item(p.exp_w_down + (size_t)(l * 16 + e) * 128 * DM, DM, nb * 32, 32, (bf16_t*)(ws + WS_WD) + (size_t)(l * 16 + e) * DM * 128, 128, nb * 32, kb * 64, scr, lane); }
    }
}
__device__ __forceinline__ void phase_prologue(PRef p, LAS unsigned char* lds) {
    int tid_ = TIDX(); asm volatile("" : "+v"(tid_));
    const int tid = tid_, lane = tid & 63, wid = tid >> 6;
    const int gw = BID() * 8 + wid, NGW = GSZ() * 8;
    LAS float* scr = (LAS float*)(lds + wid * 8448);
    unsigned char* ws = p.ws;
    weight_prep(p, 0, lds);
    for (int m0 = gw * 4; m0 < NTOK; m0 += NGW * 4) {
        f32x4 v[4][4];
#pragma unroll
        for (int rr = 0; rr < 4; ++rr)
#pragma unroll
            for (int j = 0; j < 4; ++j) v[rr][j] = *(const f32x4*)(p.x + (size_t)(m0 + rr) * DM + (64 * j + lane) * 4);
#pragma unroll
        for (int rr = 0; rr < 4; ++rr) { float ss = 0.f;
#pragma unroll
            for (int j = 0; j < 4; ++j) ss += (v[rr][j][0] * v[rr][j][0] + v[rr][j][1] * v[rr][j][1]) + (v[rr][j][2] * v[rr][j][2] + v[rr][j][3] * v[rr][j][3]);
            const float rstd = rsqrtf(wave_sum(ss, lane) * (1.f / 1024.f) + 1e-6f);
            if (lane == 0) ((float*)(ws + WS_RSTD1))[m0 + rr] = rstd;
#pragma unroll
            for (int j = 0; j < 4; ++j) st4bf((bf16_t*)(ws + WS_HB) + (size_t)(m0 + rr) * DM + (64 * j + lane) * 4, v[rr][j]); }
    }
    __syncthreads();
    if (BID() < 8) {
        const int l = BID() >> 2, kv = (BID() >> 1) & 1, jh = BID() & 1, j = jh * 64 + lane;
        const float* pe = p.cmp_pe + (size_t)(l * 2 + kv) * 2048; const float* w1 = p.cmp_w1 + (size_t)(l * 2 + kv) * 2048 * 128;
        float s = 0.f;
        for (int f = wid * 256; f < wid * 256 + 256; ++f) s += pe[f] * w1[(size_t)f * 128 + j];
        LAS float* part = (LAS float*)(lds + 70000);
        part[wid * 64 + lane] = s;
        __syncthreads();
        if (wid == 0) { float t = p.cmp_b1[(l * 2 + kv) * 128 + j];
#pragma unroll
            for (int w = 0; w < 8; ++w) t += part[w * 64 + lane];
            ((float*)(ws + WS_MISC))[(l * 2 + kv) * 128 + j] = t; }
    }
    if (BID() == 8 && wid < DEPTH) {
        const int l = wid; const float* lp = p.diff_lambda + l * 256;
        const float a = wave_sum(lp[lane] * lp[64 + lane], lane), b = wave_sum(lp[128 + lane] * lp[192 + lane], lane);
        const float lam_init = (l == 0) ? 0.2f : 0.35550906f;
        if (lane == 0) ((float*)(ws + WS_MISC + 4096))[l] = expf(a) - expf(b) + lam_init;
    }
}

namespace pg8 {
#define PG8_LAS __attribute__((address_space(3)))
constexpr int BM = 256, BK = 64, HALF = 128, HTB = HALF * BK * 2  , STAGE_BYTES = 8 * HTB, NXCD = 8, WGM = 8;

__host__ __device__ __forceinline__ int lds_byte(int r, int c) { const int st = (r >> 4) * 2 + (c >> 5), rr = r & 15, cc = c & 31, ob = rr * 64 + cc * 2; return st * 1024 + (ob ^ (((ob >> 9) & 1) << 5)); }
__host__ __device__ __forceinline__ void stage_rc(int b, int& R, int& C) { const int st = b / 1024, sb = b % 1024, swz = sb ^ (((sb >> 9) & 1) << 5); R = (st >> 1) * 16 + swz / 64; C = (st & 1) * 32 + (swz % 64) / 2; }
__host__ __device__ __forceinline__ int perm32(int rho) { const int n = rho >> 4, i = rho & 15; return 8 * (i >> 2) + 4 * n + (i & 3); }

struct Unit { int pm, pn, z; };
struct Gemm { const bf16_t* A; const bf16_t* Bt; const bf16_t* A2; const bf16_t* Bt2; int M, N, K; };

struct StaticOrder {
    int nM, nN, nwg, G, c;
    __host__ __device__ void init(int M, int N, int G_, int c_) { nM = M / BM; nN = N / BM; nwg = nM * nN; G = G_; c = c_; }
    __host__ __device__ bool next(int i, Unit& u) const {
        const long L = (long)i * G + c; if (L >= nwg) return false;
        int wgid = (int)L; { const int q = nwg / NXCD, r = nwg % NXCD, xcd = wgid % NXCD, off = wgid / NXCD; wgid = (xcd < r ? xcd * (q + 1) : r * (q + 1) + (xcd - r) * q) + off; }
        const int nig = WGM * nN, gid = wgid / nig, fm = gid * WGM, gsz = (nM - fm) < WGM ? (nM - fm) : WGM;
        u.pm = fm + ((wgid % nig) % gsz); u.pn = (wgid % nig) / gsz; u.z = 0; return true;
    }
    __device__ __forceinline__ void a_ready(const Unit&) const {}
    __device__ __forceinline__ void done(const Unit&) const {}
};

template <class Epi, class Sched, bool ALIGN_EPI = false, bool SP2 = false>
__device__ __forceinline__ void gemm_phase(PG8_LAS unsigned char* lds, const Gemm g, const Sched& S, const Epi& E) {
    int tid_ = TIDX(); asm volatile("" : "+v"(tid_));
    const int tid = tid_, wid = __builtin_amdgcn_readfirstlane(tid >> 6), lane = tid & 63, wr = wid >> 2, wc = wid & 3, fr = lane & 15, fq = lane >> 4;
    const int K = g.K, nt = K / BK;
    unsigned voffA[2], voffB[2];
#pragma unroll
    for (int i = 0; i < 2; ++i) { int R, C; stage_rc(tid * 16 + i * 8192, R, C); const int Rb = Epi::PERM ? (64 * (R >> 5) + perm32(R & 31)) : R;
        voffA[i] = (unsigned)(R * K + C) * 2u; voffB[i] = (unsigned)(Rb * K + C) * 2u; }
    const size_t kstep = (size_t)(BK * 2);
    const size_t hstep = (size_t)HALF * K * 2;
    const size_t tstep = 2 * hstep;
    const size_t hstepB = Epi::PERM ? (size_t)32 * K * 2 : hstep;
    const unsigned ldsw = (unsigned)wid * 1024u;
    const int aoff = lds_byte(wr * 64 + fr, fq * 8), boff = lds_byte(wc * 32 + fr, fq * 8);
#define PG8_SA(b, h) (((b) * 2 + (h)) * HTB)
#define PG8_SB(b, h) ((4 + (b) * 2 + (h)) * HTB)
#define PG8_STAGE(bufoff, gbase, voff) do { _Pragma("unroll") for (int _i = 0; _i < 2; ++_i) \
        __builtin_amdgcn_global_load_lds((const unsigned*)((const char*)(gbase) + (voff)[_i]), (PG8_LAS unsigned*)(lds + (bufoff) + ldsw + _i * 8192), 16, 0, 0); } while (0)
#define PG8_LDA(dst, b, h) do { _Pragma("unroll") for (int m = 0; m < 4; ++m) _Pragma("unroll") for (int k = 0; k < 2; ++k) dst[m][k] = *(const PG8_LAS bf16x8*)(lds + PG8_SA(b, h) + aoff + m * 2048 + k * 1024); } while (0)
#define PG8_LDB(dst, b, h) do { _Pragma("unroll") for (int n = 0; n < 2; ++n) _Pragma("unroll") for (int k = 0; k < 2; ++k) dst[n][k] = *(const PG8_LAS bf16x8*)(lds + PG8_SB(b, h) + boff + n * 2048 + k * 1024); } while (0)
#define PG8_MMA(ai, bj, At, Bt) do { __builtin_amdgcn_s_setprio(1); _Pragma("unroll") for (int m = 0; m < 4; ++m) _Pragma("unroll") for (int n = 0; n < 2; ++n) _Pragma("unroll") for (int k = 0; k < 2; ++k) \
        acc[ai][bj][m][n] = __builtin_amdgcn_mfma_f32_16x16x32_bf16(Bt[n][k], At[m][k], acc[ai][bj][m][n], 0, 0, 0); __builtin_amdgcn_s_setprio(0); } while (0)
#define PG8_WAIT_V(n) asm volatile("s_waitcnt vmcnt(" #n ")" ::: "memory")
#define PG8_WAIT_L(n) asm volatile("s_waitcnt lgkmcnt(" #n ")" ::: "memory")
#define PG8_BAR __builtin_amdgcn_s_barrier()
#define PG8_SCHED __builtin_amdgcn_sched_barrier(0)
    Unit cur, nxt; int ui = 0;
    if (!S.next(0, cur)) return;
    f32x4 acc[2][2][4][2];
#pragma unroll
    for (int a = 0; a < 2; ++a)
#pragma unroll
        for (int b = 0; b < 2; ++b)
#pragma unroll
            for (int m = 0; m < 4; ++m)
#pragma unroll
                for (int n = 0; n < 2; ++n) acc[a][b][m][n] = (f32x4){0.f, 0.f, 0.f, 0.f};
    bf16x8 At[4][2], B0[2][2], B1[2][2];
    const char* cA = (const char*)(cur.z ? g.A2 : g.A) + (size_t)cur.pm * tstep; const char* cB = (const char*)(cur.z ? g.Bt2 : g.Bt) + (size_t)cur.pn * tstep;
    S.a_ready(cur);
    if constexpr (SP2) {
        PG8_STAGE(PG8_SB(0, 0), cB, voffB); PG8_STAGE(PG8_SB(0, 1), cB + hstepB, voffB); PG8_STAGE(PG8_SA(0, 0), cA, voffA); PG8_STAGE(PG8_SA(0, 1), cA + hstep, voffA);
        if (wr == 1) PG8_BAR;
        PG8_WAIT_V(2); PG8_BAR;
        PG8_STAGE(PG8_SB(1, 0), cB + kstep, voffB); PG8_STAGE(PG8_SA(1, 0), cA + kstep, voffA); PG8_STAGE(PG8_SB(1, 1), cB + hstepB + kstep, voffB);
        PG8_WAIT_V(6); PG8_BAR;
    } else {
        PG8_STAGE(PG8_SB(0, 0), cB, voffB); PG8_STAGE(PG8_SA(0, 0), cA, voffA); PG8_STAGE(PG8_SB(0, 1), cB + hstepB, voffB); PG8_STAGE(PG8_SA(0, 1), cA + hstep, voffA);
        if (wr == 1) PG8_BAR;
        PG8_WAIT_V(4); PG8_BAR;
        PG8_STAGE(PG8_SB(1, 0), cB + kstep, voffB); PG8_STAGE(PG8_SA(1, 0), cA + kstep, voffA); PG8_STAGE(PG8_SB(1, 1), cB + hstepB + kstep, voffB);
        PG8_WAIT_V(6); PG8_BAR;
    }
    for (;;) {
        const bool has_next = S.next(ui + 1, nxt);
        const char* nA = has_next ? (const char*)(nxt.z ? g.A2 : g.A) + (size_t)nxt.pm * tstep : cA; const char* nB = has_next ? (const char*)(nxt.z ? g.Bt2 : g.Bt) + (size_t)nxt.pn * tstep : cB;
        for (int t = 0; t < nt; t += 2) {
            const bool last = (t == nt - 2);
            const char* a1 = cA + (size_t)(t + 1) * kstep;
            const char* a2 = last ? nA : cA + (size_t)(t + 2) * kstep; const char* b2 = last ? nB : cB + (size_t)(t + 2) * kstep;
            const char* a3 = a2 + kstep; const char* b3 = b2 + kstep;
            if (last && has_next) S.a_ready(nxt);
            if constexpr (SP2) {
            PG8_LDB(B0, 0, 0); PG8_LDB(B1, 0, 1); PG8_SCHED; PG8_LDA(At, 0, 0); PG8_STAGE(PG8_SA(1, 1), a1 + hstep, voffA);
            PG8_WAIT_V(8); PG8_WAIT_L(0); PG8_BAR; PG8_MMA(0, 0, At, B0); PG8_MMA(0, 1, At, B1); PG8_BAR; PG8_SCHED;
            PG8_LDA(At, 0, 1); PG8_STAGE(PG8_SB(0, 0), b2, voffB); PG8_STAGE(PG8_SB(0, 1), b2 + hstepB, voffB); PG8_STAGE(PG8_SA(0, 0), a2, voffA);
            PG8_WAIT_V(8); PG8_WAIT_L(0); PG8_BAR; PG8_MMA(1, 0, At, B0); PG8_MMA(1, 1, At, B1); PG8_BAR; PG8_SCHED;
            PG8_LDB(B0, 1, 0); PG8_LDB(B1, 1, 1); PG8_SCHED; PG8_LDA(At, 1, 0); PG8_STAGE(PG8_SA(0, 1), a2 + hstep, voffA);
            PG8_WAIT_V(8); PG8_WAIT_L(0); PG8_BAR; PG8_MMA(0, 0, At, B0); PG8_MMA(0, 1, At, B1); PG8_BAR; PG8_SCHED;
            PG8_LDA(At, 1, 1); PG8_STAGE(PG8_SB(1, 0), b3, voffB); PG8_STAGE(PG8_SB(1, 1), b3 + hstepB, voffB); PG8_STAGE(PG8_SA(1, 0), a3, voffA);
            PG8_WAIT_V(8); PG8_WAIT_L(0); PG8_BAR; PG8_MMA(1, 0, At, B0); PG8_MMA(1, 1, At, B1); PG8_BAR; PG8_SCHED;
            } else {
            PG8_LDB(B0, 0, 0); PG8_SCHED; PG8_LDA(At, 0, 0); PG8_STAGE(PG8_SA(1, 1), a1 + hstep, voffA);
            PG8_WAIT_L(8); PG8_BAR; PG8_WAIT_L(0); PG8_MMA(0, 0, At, B0); PG8_BAR; PG8_SCHED;
            PG8_LDB(B1, 0, 1); PG8_STAGE(PG8_SB(0, 0), b2, voffB);
            PG8_BAR; PG8_WAIT_L(0); PG8_MMA(0, 1, At, B1); PG8_BAR;
            PG8_LDA(At, 0, 1); PG8_STAGE(PG8_SA(0, 0), a2, voffA);
            PG8_BAR; PG8_WAIT_L(0); PG8_MMA(1, 0, At, B0); PG8_BAR; PG8_SCHED;
            PG8_STAGE(PG8_SB(0, 1), b2 + hstepB, voffB);
            PG8_WAIT_V(6); PG8_BAR; PG8_MMA(1, 1, At, B1); PG8_BAR;
            PG8_LDB(B0, 1, 0); PG8_SCHED; PG8_LDA(At, 1, 0); PG8_STAGE(PG8_SA(0, 1), a2 + hstep, voffA);
            PG8_WAIT_L(8); PG8_BAR; PG8_WAIT_L(0); PG8_MMA(0, 0, At, B0); PG8_BAR; PG8_SCHED;
            PG8_LDB(B1, 1, 1); PG8_STAGE(PG8_SB(1, 0), b3, voffB);
            PG8_BAR; PG8_WAIT_L(0); PG8_MMA(0, 1, At, B1); PG8_BAR;
            PG8_LDA(At, 1, 1); PG8_STAGE(PG8_SA(1, 0), a3, voffA);
            PG8_BAR; PG8_WAIT_L(0); PG8_MMA(1, 0, At, B0); PG8_BAR; PG8_SCHED;
            PG8_STAGE(PG8_SB(1, 1), b3 + hstepB, voffB);
            PG8_WAIT_V(6); PG8_BAR; PG8_MMA(1, 1, At, B1); PG8_BAR;
            }
        }
        if constexpr (ALIGN_EPI) { if (wr == 0) PG8_BAR; }
        if constexpr (!Epi::AFTER_DRAIN) { E(acc, cur, wr, wc, fr, fq); S.done(cur); }
        if (!has_next) break;
        if (!Epi::keep(cur)) {
#pragma unroll
        for (int a = 0; a < 2; ++a)
#pragma unroll
            for (int b = 0; b < 2; ++b)
#pragma unroll
                for (int m = 0; m < 4; ++m)
#pragma unroll
                    for (int n = 0; n < 2; ++n) acc[a][b][m][n] = (f32x4){0.f, 0.f, 0.f, 0.f}; }
        cur = nxt; cA = nA; cB = nB; ++ui;
        if constexpr (ALIGN_EPI) { if (wr == 1) PG8_BAR; }
    }
    PG8_WAIT_V(0);
    if constexpr (!ALIGN_EPI) { if (wr == 0) PG8_BAR; }
    PG8_BAR;
    if constexpr (Epi::AFTER_DRAIN) { E.fused(acc, cur, wr, wc, fr, fq, lds, wid, lane); S.done(cur); }
#undef PG8_SA
#undef PG8_SB
#undef PG8_STAGE
#undef PG8_LDA
#undef PG8_LDB
#undef PG8_MMA
#undef PG8_WAIT_V
#undef PG8_WAIT_L
#undef PG8_BAR
#undef PG8_SCHED
}
}

typedef pg8::Unit PUnit;
__device__ __forceinline__ unsigned ror8(unsigned v) { return (unsigned)__builtin_amdgcn_mov_dpp((int)v, 0x128, 0xf, 0xf, true); }
__device__ __forceinline__ void st_lines(bf16_t* px  , size_t pitch8  , const u32x4 w0, const u32x4 w1, bool lo) {
    u32x4 snd, rcv, x, y;
    snd.x = lo ? w1.x : w0.x; snd.y = lo ? w1.y : w0.y; snd.z = lo ? w1.z : w0.z; snd.w = lo ? w1.w : w0.w;
    rcv.x = ror8(snd.x); rcv.y = ror8(snd.y); rcv.z = ror8(snd.z); rcv.w = ror8(snd.w);
    x.x = lo ? w0.x : rcv.x; x.y = lo ? w0.y : rcv.y; x.z = lo ? w0.z : rcv.z; x.w = lo ? w0.w : rcv.w;
    y.x = lo ? rcv.x : w1.x; y.y = lo ? rcv.y : w1.y; y.z = lo ? rcv.z : w1.z; y.w = lo ? rcv.w : w1.w;
    *(u32x4*)px = x; *(u32x4*)(px + pitch8) = y;
}
template <int AB> struct EpiInprojT {
    static constexpr bool PERM = true, AFTER_DRAIN = false;
    unsigned char* ws;
    static __device__ __forceinline__ bool keep(const PUnit&) { return false; }
    __device__ __forceinline__ void operator()(f32x4 (&acc)[2][2][4][2], const PUnit& u, int wr, int wc, int fr, int fq) const {
        const int n0 = u.pn * 256;
        bf16_t* dst; int pitch, c0, mode = 0;
        if (n0 < 512) { dst = (bf16_t*)(ws + WS_NQ); pitch = 512; c0 = n0; mode = 1; }
        else if (n0 < 1280) { dst = (bf16_t*)(ws + WS_KV6); pitch = 768; c0 = n0 - 512; }
        else if (n0 < 1792) { dst = (bf16_t*)(ws + WS_DQ); pitch = 512; c0 = n0 - 1280; mode = 1; }
        else if (n0 < 2304) { dst = (bf16_t*)(ws + WS_DK); pitch = 512; c0 = n0 - 1792; }
        else if (n0 < 2816) { dst = (bf16_t*)(ws + WS_DV); pitch = 512; c0 = n0 - 2304; }
        else if (n0 < 3840) { dst = (bf16_t*)(ws + WS_GA); pitch = 1024; c0 = n0 - 2816; mode = 2; }
        else if (n0 < 4864) { dst = (bf16_t*)(ws + WS_GB); pitch = 1024; c0 = n0 - 3840; mode = 2; }
        else { dst = (bf16_t*)(ws + WS_NG); pitch = 32; c0 = 0; mode = 3; }
        int rsub = 0;
        if (AB == 3 && mode != 3) { dst = (bf16_t*)(ws + WS_XN) + (size_t)BID() * 65536; pitch = 256; c0 = 0; rsub = u.pm * 256; }
        asm volatile("" : "+v"(fr), "+v"(fq));
        const int row0 = u.pm * 256 + wr * 64 + fr;
        const bool lo = (fr & 8) == 0;
        const int rowx = u.pm * 256 + wr * 64 + (fr & 7), colx = wc * 64 + (lo ? 0 : 32) + 8 * fq;
        float rsv[2][4];
#pragma unroll
        for (int ai = 0; ai < 2; ++ai)
#pragma unroll
            for (int m = 0; m < 4; ++m) rsv[ai][m] = ((const float*)(ws + WS_RSTD1))[row0 + ai * 128 + m * 16];
#pragma unroll
        for (int ai = 0; ai < 2; ++ai)
#pragma unroll
            for (int m = 0; m < 4; ++m) {
                const float rs = rsv[ai][m];
                u32x4 w[2]; u32x2 g8[2];
#pragma unroll
                for (int bj = 0; bj < 2; ++bj) { f32x4 v0 = acc[ai][bj][m][0] * rs, v1 = acc[ai][bj][m][1] * rs;
                    if (AB == 2) { asm volatile("" :: "v"(v0), "v"(v1)); continue; }
                    if (AB == 1) {} else if (mode == 1) { v0 = v0 * QSCALE; v1 = v1 * QSCALE; }
                    else if (mode == 2) { unsigned d0 = 0u, d1 = 0u;
#pragma unroll
                        for (int i = 0; i < 4; ++i) { d0 = __builtin_amdgcn_cvt_pk_u8_f32(fmaf(sigm(v0[i]), 256.f, -0.5f), i, d0); d1 = __builtin_amdgcn_cvt_pk_u8_f32(fmaf(sigm(v1[i]), 256.f, -0.5f), i, d1); }
                        g8[bj].x = d0; g8[bj].y = d1; continue; }
                    else if (mode == 3) {
#pragma unroll
                        for (int i = 0; i < 4; ++i) { v0[i] = sigm(v0[i]); v1[i] = sigm(v1[i]); } }
                    w[bj].x = cvtpk(v0[0], v0[1]); w[bj].y = cvtpk(v0[2], v0[3]); w[bj].z = cvtpk(v1[0], v1[1]); w[bj].w = cvtpk(v1[2], v1[3]); }
                if (AB == 2) continue;
                if (mode == 3) { if (wc == 0) *(u32x4*)(dst + (size_t)(row0 + ai * 128 + m * 16) * pitch + 8 * fq) = w[0]; }
                else if (mode == 2) *(u32x4*)((unsigned char*)dst + (size_t)(row0 - rsub + ai * 128 + m * 16) * (AB == 3 ? 256 : 1024) + c0 + wc * 64 + fq * 16) = (u32x4){g8[0].x, g8[0].y, g8[1].x, g8[1].y};
                else st_lines(dst + (size_t)(rowx - rsub + ai * 128 + m * 16) * pitch + c0 + colx, (size_t)8 * pitch, w[0], w[1], lo); }
    }
};
struct EpiMerge {
    static constexpr bool PERM = true, AFTER_DRAIN = false;
    const bf16_t* GA; const bf16_t* GB; bf16_t* MG;
    static __device__ __forceinline__ bool keep(const PUnit& u) { return u.z == 0; }
    __device__ __forceinline__ void operator()(f32x4 (&acc)[2][2][4][2], const PUnit& u, int wr, int wc, int fr, int fq) const {
        asm volatile("" : "+v"(fr), "+v"(fq));
        const int row0 = u.pm * 256 + wr * 64 + fr, col0 = u.pn * 256 + wc * 64 + 8 * fq;
        const bool lo = (fr & 8) == 0;
        const int rowx = u.pm * 256 + wr * 64 + (fr & 7), colx = u.pn * 256 + wc * 64 + (lo ? 0 : 32) + 8 * fq;
#pragma unroll
        for (int ai = 0; ai < 2; ++ai)
#pragma unroll
            for (int m = 0; m < 4; ++m) { const size_t ro = (size_t)(row0 + ai * 128 + m * 16) * DM + col0;
                u32x4 wq[2];
                const size_t go = (size_t)(row0 + ai * 128 + m * 16) * 1024 + u.pn * 256 + wc * 64 + fq * 16;
                const u32x4 gb = *(const u32x4*)((const unsigned char*)GB + go);
                u32x4 ga = gb; if (u.z == 0) ga = *(const u32x4*)((const unsigned char*)GA + go);
#pragma unroll
                for (int bj = 0; bj < 2; ++bj) {
                    const unsigned gb0 = bj ? gb.z : gb.x, gb1 = bj ? gb.w : gb.y, ga0 = bj ? ga.z : ga.x, ga1 = bj ? ga.w : ga.y;
                    f32x4 b0, b1;
#pragma unroll
                    for (int i = 0; i < 4; ++i) { b0[i] = (float)((gb0 >> (8 * i)) & 0xffu) + 0.5f; b1[i] = (float)((gb1 >> (8 * i)) & 0xffu) + 0.5f; }
                    if (u.z == 0) {
#pragma unroll
                        for (int i = 0; i < 4; ++i) { const float a0 = (float)((ga0 >> (8 * i)) & 0xffu) + 0.5f, a1 = (float)((ga1 >> (8 * i)) & 0xffu) + 0.5f;
                            acc[ai][bj][m][0][i] *= a0 * __builtin_amdgcn_rcpf(b0[i]); acc[ai][bj][m][1][i] *= a1 * __builtin_amdgcn_rcpf(b1[i]); } }
                    else { const f32x4 v0 = acc[ai][bj][m][0] * b0 * (1.f / 256.f), v1 = acc[ai][bj][m][1] * b1 * (1.f / 256.f);
                        wq[bj].x = cvtpk(v0[0], v0[1]); wq[bj].y = cvtpk(v0[2], v0[3]); wq[bj].z = cvtpk(v1[0], v1[1]); wq[bj].w = cvtpk(v1[2], v1[3]); } }
                if (u.z != 0) st_lines(MG + (size_t)(rowx + ai * 128 + m * 16) * DM + colx, (size_t)8 * DM, wq[0], wq[1], lo); }
    }
};
struct MergeOrder {
    int G, c;
    __device__ __forceinline__ bool next(int i, PUnit& u) const { const int t = (i >> 1) * G + c; if (t >= 512) return false;
        int wgid = t; { const int q = 512 / 8, xcd = wgid % 8, off = wgid / 8; wgid = xcd * q + off; }
        u.pm = (wgid >> 5) * 8 + (wgid & 7); u.pn = (wgid >> 3) & 3; u.z = i & 1; return true; }
    __device__ __forceinline__ void a_ready(const PUnit&) const {}
    __device__ __forceinline__ void done(const PUnit&) const {}
};
struct EpiOut {
    static constexpr bool PERM = true, AFTER_DRAIN = false;
    const float* xin; const bf16_t* hin; bf16_t* hout;
    static __device__ __forceinline__ bool keep(const PUnit&) { return false; }
    __device__ __forceinline__ void operator()(f32x4 (&acc)[2][2][4][2], const PUnit& u, int wr, int wc, int fr, int fq) const {
        asm volatile("" : "+v"(fr), "+v"(fq));
        const int row0 = u.pm * 256 + wr * 64 + fr, col0 = u.pn * 256 + wc * 64 + 8 * fq;
        const bool lo = (fr & 8) == 0;
        const int rowx = u.pm * 256 + wr * 64 + (fr & 7), colx = u.pn * 256 + wc * 64 + (lo ? 0 : 32) + 8 * fq;
#pragma unroll
        for (int ai = 0; ai < 2; ++ai)
#pragma unroll
            for (int m = 0; m < 4; ++m) { const size_t ro = (size_t)(row0 + ai * 128 + m * 16) * DM + col0;
                u32x4 wq[2];
#pragma unroll
                for (int bj = 0; bj < 2; ++bj) { const size_t off = ro + bj * 32; f32x4 b0, b1;
                    if (xin) { b0 = *(const f32x4*)(xin + off); b1 = *(const f32x4*)(xin + off + 4); }
                    else { const u32x4 hb = *(const u32x4*)(hin + off); b0 = (f32x4){bflo(hb.x), bfhi(hb.x), bflo(hb.y), bfhi(hb.y)}; b1 = (f32x4){bflo(hb.z), bfhi(hb.z), bflo(hb.w), bfhi(hb.w)}; }
                    const f32x4 v0 = b0 + acc[ai][bj][m][0], v1 = b1 + acc[ai][bj][m][1];
                    wq[bj].x = cvtpk(v0[0], v0[1]); wq[bj].y = cvtpk(v0[2], v0[3]); wq[bj].z = cvtpk(v1[0], v1[1]); wq[bj].w = cvtpk(v1[2], v1[3]); }
                st_lines(hout + (size_t)(rowx + ai * 128 + m * 16) * DM + colx, (size_t)8 * DM, wq[0], wq[1], lo); }
    }
};
typedef EpiInprojT<0> EpiInproj;
template <int AB> __device__ __forceinline__ void phase_inproj_pg8(PRef p, int l, LAS unsigned char* lds) {
    unsigned char* ws = p.ws;
    const bf16_t* W = (const bf16_t*)(ws + WS_WIN) + (size_t)l * NPAD * DM;
    pg8::Gemm g{(const bf16_t*)(ws + WS_HB), W, (const bf16_t*)(ws + WS_HB), W, NTOK, NPAD, DM};
    pg8::StaticOrder S; S.init(NTOK, NPAD, GSZ(), BID());
    EpiInprojT<AB> E{ws};
    pg8::gemm_phase<EpiInprojT<AB>, pg8::StaticOrder, true, true>(lds, g, S, E);
}
__device__ __forceinline__ void phase_merge_pg8(PRef p, int l, LAS unsigned char* lds) {
    unsigned char* ws = p.ws;
    pg8::Gemm g{(const bf16_t*)(ws + WS_NQ), (const bf16_t*)(ws + WS_WA) + (size_t)l * DM * 512, (const bf16_t*)(ws + WS_DQ), (const bf16_t*)(ws + WS_WB) + (size_t)l * DM * 512, NTOK, DM, 512};
    MergeOrder S{GSZ(), BID()};
    EpiMerge E{(const bf16_t*)(ws + WS_GA), (const bf16_t*)(ws + WS_GB), (bf16_t*)(ws + WS_XN)};
    pg8::gemm_phase<EpiMerge, MergeOrder, true, true>(lds, g, S, E);
}
__device__ __forceinline__ void phase_outproj_pg8(PRef p, int l, LAS unsigned char* lds, bool dry = false) {
    unsigned char* ws = p.ws;
    const bf16_t* WO = (const bf16_t*)(ws + WS_WO) + (size_t)l * DM * DM;
    pg8::Gemm g{(const bf16_t*)(ws + WS_XN), WO, (const bf16_t*)(ws + WS_XN), WO, NTOK, DM, DM};
    pg8::StaticOrder S; S.init(NTOK, DM, GSZ(), BID());
    EpiOut E{(const float*)nullptr, (const bf16_t*)(ws + WS_HB), dry ? (bf16_t*)(ws + WS_GA) : (bf16_t*)(ws + WS_HB)};
    pg8::gemm_phase<EpiOut, pg8::StaticOrder, true, true>(lds, g, S, E);
}

__device__ __forceinline__ int kswz(int row, int ch) { return row * 128 + ((ch ^ ((row >> 1) & 7)) << 4); }
__device__ __forceinline__ void stage_k(LAS unsigned char* kdst, const bf16_t* src  , int pitch, int tid) {
    const int row = tid >> 3, ch = tid & 7;
    *(LAS u32x4*)(kdst + kswz(row, ch)) = *(const u32x4*)(src + (size_t)row * pitch + ch * 8);
}
template <int NDB> __device__ __forceinline__ void stage_v(LAS unsigned char* vdst, const bf16_t* src, int pitch, int tid) {
#pragma unroll
    for (int i = 0; i < NDB / 2; ++i) { const int pc = tid + 512 * i, pw = pc >> 6, ln = pc & 63, db = pw >> 2, rg = pw & 3;
        *(LAS u32x4*)(vdst + pw * 1024 + ln * 16) = *(const u32x4*)(src + (size_t)(16 * rg + (ln >> 2)) * pitch + db * 32 + (ln & 3) * 8); }
}
__device__ __forceinline__ void qkt(f32x16& p0, f32x16& p1, LAS const unsigned char* K, const bf16x8 (&qr)[4], int r32, int hi) {
    p0 = (f32x16){0.f}; p1 = (f32x16){0.f};
#pragma unroll
    for (int d0 = 0; d0 < 4; ++d0) {
        LAS const unsigned char* kb = K + kswz(r32, 2 * d0 + hi);
        const bf16x8 b0 = *(LAS const bf16x8*)(kb), b1 = *(LAS const bf16x8*)(kb + 4096);
        p0 = MFMA32(b0, qr[d0], p0); p1 = MFMA32(b1, qr[d0], p1);
    }
    __builtin_amdgcn_sched_barrier(0);
}
template <int NDB> __device__ __forceinline__ void pv(f32x16 (&o)[NDB], const f32x16& p0, const f32x16& p1, LAS const unsigned char* V, int lane, int hi) {
    u32x4 pw[4];
    pw[0] = (u32x4){cvtpk(p0[0], p0[1]), cvtpk(p0[2], p0[3]), cvtpk(p0[4], p0[5]), cvtpk(p0[6], p0[7])};
    pw[1] = (u32x4){cvtpk(p0[8], p0[9]), cvtpk(p0[10], p0[11]), cvtpk(p0[12], p0[13]), cvtpk(p0[14], p0[15])};
    pw[2] = (u32x4){cvtpk(p1[0], p1[1]), cvtpk(p1[2], p1[3]), cvtpk(p1[4], p1[5]), cvtpk(p1[6], p1[7])};
    pw[3] = (u32x4){cvtpk(p1[8], p1[9]), cvtpk(p1[10], p1[11]), cvtpk(p1[12], p1[13]), cvtpk(p1[14], p1[15])};
    LAS const unsigned char* vb = V + ((lane >> 4) & 1) * 32 + (lane & 3) * 8 + (4 * hi + ((lane & 15) >> 2)) * 64;
#pragma unroll
    for (int d0 = 0; d0 < NDB; ++d0)
#pragma unroll
        for (int ks = 0; ks < 4; ++ks) {
            const s16x4 lo = vtr(vb + d0 * 4096 + ks * 1024), hh = vtr(vb + d0 * 4096 + ks * 1024 + 512);
            const bf16x8 vf = (bf16x8){lo[0], lo[1], lo[2], lo[3], hh[0], hh[1], hh[2], hh[3]};
            o[d0] = MFMA32(__builtin_bit_cast(bf16x8, pw[ks]), vf, o[d0]);
            if (ks == 3) __builtin_amdgcn_sched_barrier(0);
        }
}
__device__ __forceinline__ void glds16(const void* gsrc, unsigned lds_dst) {
    unsigned keep;
    asm volatile("s_mov_b32 %0, m0\n\ts_mov_b32 m0, %2\n\ts_nop 0\n\tglobal_load_lds_dwordx4 %1, off\n\ts_mov_b32 m0, %0" : "=&s"(keep) : "v"(gsrc), "s"(lds_dst) : "memory");
}
__device__ __forceinline__ void glds16s(const void* sbase  , unsigned voff  , unsigned lds_dst) {
    unsigned keep;
    asm volatile("s_mov_b32 %0, m0\n\ts_mov_b32 m0, %3\n\ts_nop 0\n\tglobal_load_lds_dwordx4 %1, %2\n\ts_mov_b32 m0, %0" : "=&s"(keep) : "v"(voff), "s"(sbase), "s"(lds_dst) : "memory");
}
__device__ __forceinline__ void qkt_nb(f32x16& p0, f32x16& p1, LAS const unsigned char* K, const bf16x8 (&qr)[4], int r32, int hi) {
#pragma unroll
    for (int d0 = 0; d0 < 4; ++d0) {
        LAS const unsigned char* kb = K + kswz(r32, 2 * d0 + hi);
        const bf16x8 b0 = *(LAS const bf16x8*)(kb), b1 = *(LAS const bf16x8*)(kb + 4096);
        p0 = MFMA32(b0, qr[d0], p0); p1 = MFMA32(b1, qr[d0], p1);
    }
}
#define PACKP(pw, P0, P1) do { pw[0] = (u32x4){cvtpk(P0[0], P0[1]), cvtpk(P0[2], P0[3]), cvtpk(P0[4], P0[5]), cvtpk(P0[6], P0[7])}; \
    pw[1] = (u32x4){cvtpk(P0[8], P0[9]), cvtpk(P0[10], P0[11]), cvtpk(P0[12], P0[13]), cvtpk(P0[14], P0[15])}; \
    pw[2] = (u32x4){cvtpk(P1[0], P1[1]), cvtpk(P1[2], P1[3]), cvtpk(P1[4], P1[5]), cvtpk(P1[6], P1[7])}; \
    pw[3] = (u32x4){cvtpk(P1[8], P1[9]), cvtpk(P1[10], P1[11]), cvtpk(P1[12], P1[13]), cvtpk(P1[14], P1[15])}; } while (0)
template <int NDB> __device__ __forceinline__ void pv_nb(f32x16 (&o)[NDB], const u32x4 (&pw)[4], LAS const unsigned char* V, int lane, int hi) {
    LAS const unsigned char* vb = V + ((lane >> 4) & 1) * 32 + (lane & 3) * 8 + (4 * hi + ((lane & 15) >> 2)) * 64;
#pragma unroll
    for (int d0 = 0; d0 < NDB; ++d0)
#pragma unroll
        for (int ks = 0; ks < 4; ++ks) {
            const s16x4 lo = vtr(vb + d0 * 4096 + ks * 1024), hh = vtr(vb + d0 * 4096 + ks * 1024 + 512);
            const bf16x8 vf = (bf16x8){lo[0], lo[1], lo[2], lo[3], hh[0], hh[1], hh[2], hh[3]};
            o[d0] = MFMA32(__builtin_bit_cast(bf16x8, pw[ks]), vf, o[d0]);
        }
}
__device__ __forceinline__ float rowmax32(const f32x16& a, const f32x16& b) {
    float x = fmaxf(fmaxf(a[0], a[1]), b[0]), y = fmaxf(fmaxf(a[2], a[3]), b[1]);
    x = fmaxf(fmaxf(x, b[2]), b[3]);
#pragma unroll
    for (int r = 4; r < 16; r += 4) { x = fmaxf(fmaxf(x, a[r]), a[r + 1]); y = fmaxf(fmaxf(y, a[r + 2]), a[r + 3]); x = fmaxf(fmaxf(x, b[r]), b[r + 1]); y = fmaxf(fmaxf(y, b[r + 2]), b[r + 3]); }
    const float mm = fmaxf(x, y);
    auto rr = __builtin_amdgcn_permlane32_swap(__float_as_uint(mm), __float_as_uint(mm), false, false);
    return fmaxf(__uint_as_float(rr[0]), __uint_as_float(rr[1]));
}
constexpr float SM_THR = 6.0f;
constexpr float NEG = -1e30f;
template <int NDB> __device__ __forceinline__ void softmax_pv(f32x16& s0, f32x16& s1, float& m, float& l, f32x16 (&o)[NDB], LAS float* wsf, LAS const unsigned char* V, int lane, int r32, int hi) {
    float rm = fmaxf(s0[0], s1[0]);
#pragma unroll
    for (int r = 1; r < 16; ++r) rm = fmaxf(rm, fmaxf(s0[r], s1[r]));
    rm = m32(rm);
    if (__any(rm > m + SM_THR)) {
        const float mn = fmaxf(m, rm), f = ex2(m - mn); l *= f; m = mn;
        if (hi == 0) wsf[r32] = f;
#pragma unroll
        for (int r = 0; r < 16; ++r) { const float fr_ = wsf[crow(r, hi)];
#pragma unroll
            for (int d = 0; d < NDB; ++d) o[d][r] *= fr_; }
    }
    float sum = 0.f;
#pragma unroll
    for (int r = 0; r < 16; ++r) { s0[r] = ex2(s0[r] - m); s1[r] = ex2(s1[r] - m); sum += s0[r] + s1[r]; }
    l += sum;
    pv<NDB>(o, s0, s1, V, lane, hi);
}

#define QFETCH() int qnx_ = 0; if (tid == 0) qnx_ = (int)__hip_atomic_fetch_add(qctr, 1u, __ATOMIC_RELAXED, __HIP_MEMORY_SCOPE_AGENT)
#define QPARK() do { if (tid == 0) ((LAS int*)(lds + LDS_MISC))[1] = qnx_; } while (0)
__device__ __forceinline__ float gelu_tanh(float x) { const float u = 0.7978845608f * (x + 0.044715f * x * x * x); const float e = __expf(2.f * u); return 0.5f * x * (2.f - 2.f / (1.f + e)); }

__device__ __forceinline__ void compress_unit(PRef p, int l, int u, LAS unsigned char* lds, unsigned* qctr) {
    SG_IDS
    unsigned char* ws = p.ws;
    const int kv = u >> 5, m0 = (u & 31) * 128;
    const bf16_t* KV6 = (const bf16_t*)(ws + WS_KV6);
    struct ARowC { const bf16_t* KV6; int m0, kv; __device__ __forceinline__ const char* operator()(int r) const { const int mm = m0 + r, g = mm >> 11, tok = (mm & 2047) * 16; return (const char*)(KV6 + (size_t)tok * 768 + kv * 128 + g * 64); } };
    f32x4 acc[2][4]; SG_ZERO(acc);
    sg_kloop(acc, ARowC{KV6, m0, kv}, 768 * 2, (const bf16_t*)(ws + WS_WC1) + (size_t)(l * 2 + kv) * 128 * 2048, 2048, 32, lds);
    QFETCH();
    LAS bf16_t* Ht = (LAS bf16_t*)(lds + 32768);
    LAS float* W2 = (LAS float*)(lds + 32768 + 34816);
    const float* cb1 = (const float*)(ws + WS_MISC) + (l * 2 + kv) * 128;
#pragma unroll
    for (int m = 0; m < 2; ++m)
#pragma unroll
        for (int n = 0; n < 4; ++n) { const int row = SG_ROW(m), col = SG_COL(n); const f32x4 b = *(const f32x4*)(cb1 + col); f32x4 v = acc[m][n] + b;
            u32x2 w; w.x = cvtpk(gelu_tanh(v[0]), gelu_tanh(v[1])); w.y = cvtpk(gelu_tanh(v[2]), gelu_tanh(v[3])); *(LAS u32x2*)(Ht + row * 136 + col) = w; }
    const float* w2g = p.cmp_w2 + (size_t)(l * 2 + kv) * 128 * 64;
    for (int i = tid; i < 128 * 64 / 4; i += 512) *(LAS f32x4*)(W2 + i * 4) = *(const f32x4*)(w2g + i * 4);
    __syncthreads();
    const int d = tid & 63; const float b2 = p.cmp_b2[(l * 2 + kv) * 64 + d];
    bf16_t* dstb = (bf16_t*)(ws + WS_MISC + 65536 + (size_t)kv * 524288);
    for (int i = 0; i < 16; ++i) { const int row = (tid >> 6) + 8 * i; float s = b2;
#pragma unroll 8
        for (int f = 0; f < 128; ++f) s += bf1(Ht[row * 136 + f]) * W2[f * 64 + d];
        const int mm = m0 + row, g = mm >> 11, bi = mm & 2047;
        dstb[((size_t)bi * 2 + g) * 64 + d] = f2bf(s); }
    QPARK();
    __syncthreads();
}

#ifndef ABL
#define ABL 0
#endif
template <int AB> __device__ __forceinline__ void diff_unit(PRef p, int l, int u, LAS unsigned char* lds, bool dry, unsigned* qctr) {
    int tid_ = TIDX(); asm volatile("" : "+v"(tid_));
    const int tid = tid_, lane = tid & 63, r32 = lane & 31, hi = lane >> 5, wid = __builtin_amdgcn_readfirstlane(tid >> 6);
    unsigned char* ws = p.ws;
    const int c = 15 - (u >> 6), b = (u & 63) >> 2, hd = u & 3;
    const int cm = wid >> 2, qq = wid & 3, t0 = 128 * c + 32 * qq, tq = t0 + r32;
    const size_t tokb = (size_t)b * TSEQ;
    bf16_t* DQ = (bf16_t*)(ws + WS_DQ); const bf16_t* DK = (const bf16_t*)(ws + WS_DK); const bf16_t* DV = (const bf16_t*)(ws + WS_DV);
    const float sl2 = alibi_slope(9 + hd) * LOG2E;
    const float cbh = sl2 * (float)(4 * hi);
#define CB(r) fmaf(sl2, (float)(((r) & 3) + 8 * ((r) >> 2)), cbh)
    f32x16 o[4];
#pragma unroll
    for (int d = 0; d < 4; ++d) o[d] = (f32x16){0.f};
    float m = 0.f, lsum = 0.f; bool seen = false;
    LAS float* wsf = (LAS float*)(lds + LDS_MISC + 1024 + wid * 128);
    const unsigned lds0 = (unsigned)(uintptr_t)lds;
    const int srow = tid >> 3, spos = tid & 7, sch = spos ^ ((srow >> 1) & 7);
    const int vln = lane;
    const bf16_t* kub = DK + tokb * 512 + hd * 128; const bf16_t* vub = DV + tokb * 512 + hd * 128 + (size_t)(16 * (wid & 3)) * 512 + (wid >> 2) * 32;
    const unsigned kvo = (unsigned)(srow * 512 + sch * 8) * 2u, vvo = (unsigned)((vln >> 2) * 512 + (vln & 3) * 8) * 2u;
    const unsigned dk0 = lds0 + wid * 1024, dk1 = dk0 + 8192, dv0 = lds0 + 16384 + wid * 1024, dv1 = dv0 + 8192;
#define DDMA(j, off) do { const size_t to_ = (size_t)(64 * (j)) * 512; const unsigned o_ = (unsigned)(off); \
        glds16s(kub + to_, kvo, (unsigned)__builtin_amdgcn_readfirstlane(dk0 + o_)); glds16s(kub + to_ + 64, kvo, (unsigned)__builtin_amdgcn_readfirstlane(dk1 + o_)); \
        glds16s(vub + to_, vvo, (unsigned)__builtin_amdgcn_readfirstlane(dv0 + o_)); glds16s(vub + to_ + 64, vvo, (unsigned)__builtin_amdgcn_readfirstlane(dv1 + o_)); } while (0)
#define DCIN(A0, A1, j) do { float slv_ = sl2; asm volatile("" : "+v"(slv_)); \
        const float tc_ = slv_ * (float)(64 * (j) - 128 * c) + slv_ * (float)(4 * hi) - m, tc1_ = tc_ + 32.f * slv_; \
        _Pragma("unroll") for (int r = 0; r < 16; ++r) { const float kc_ = (float)((r & 3) + 8 * (r >> 2)); A0[r] = fmaf(slv_, kc_, tc_); A1[r] = fmaf(slv_, kc_, tc1_); } } while (0)
#define DMASK(A0, A1, j, RM, MASKED) do { \
        if (MASKED) { if (64 * (j) + 63 > t0) { const int lim_ = tq - 64 * (j); _Pragma("unroll") for (int r = 0; r < 16; ++r) { if (crow(r, hi) > lim_) A0[r] = NEG; if (crow(r, hi) + 32 > lim_) A1[r] = NEG; } } } \
        RM = rowmax32(A0, A1); } while (0)
#define DRESC(C0, C1, RM) do { const bool real_ = RM > -1e29f; const bool need_ = (RM > SM_THR) || (!seen && real_); seen = seen || real_;     \
        if (__any(need_)) { const float d_ = need_ ? RM : 0.f, f_ = ex2(-d_); m += d_; lsum *= f_; if (hi == 0) wsf[r32] = f_; \
        _Pragma("unroll") for (int r = 0; r < 16; ++r) { C0[r] -= d_; C1[r] -= d_; const float fr_ = wsf[crow(r, hi)]; _Pragma("unroll") for (int d = 0; d < 4; ++d) o[d][r] *= fr_; } } } while (0)
#define DEXP(C0, C1, PW) do { float sum_ = 0.f; \
        if (AB == 1) { _Pragma("unroll") for (int r = 0; r < 16; ++r) { sum_ += C0[r] + C1[r]; } } \
        else if (AB != 5) { _Pragma("unroll") for (int r = 0; r < 16; ++r) { C0[r] = ex2(C0[r]); C1[r] = ex2(C1[r]); sum_ += C0[r] + C1[r]; } } \
        lsum += sum_; PACKP(PW, C0, C1); } while (0)
#define DEND(t) do { if (AB == 6) asm volatile("s_waitcnt vmcnt(0) lgkmcnt(0)" ::: "memory"); else if ((t) + 3 <= J0) asm volatile("s_waitcnt vmcnt(4) lgkmcnt(0)\n\ts_barrier" ::: "memory"); else asm volatile("s_waitcnt vmcnt(0) lgkmcnt(0)\n\ts_barrier" ::: "memory"); \
        { const int tmp_ = oc_; oc_ = on_; on_ = o2_; o2_ = ow_; ow_ = tmp_; } } while (0)
#define SBAR() __builtin_amdgcn_sched_barrier(0)
#define KLD(KF, Kp) do { _Pragma("unroll") for (int d0 = 0; d0 < 4; ++d0) { LAS const unsigned char* kb_ = (Kp) + kswz(r32, 2 * d0 + hi); KF[2 * d0] = *(LAS const bf16x8*)(kb_); KF[2 * d0 + 1] = *(LAS const bf16x8*)(kb_ + 4096); } } while (0)
#define QK8(P0, P1, KF) do { _Pragma("unroll") for (int d0 = 0; d0 < 4; ++d0) { P0 = MFMA32(KF[2 * d0], qr[d0], P0); P1 = MFMA32(KF[2 * d0 + 1], qr[d0], P1); } } while (0)
#define VLDK(VF, Vp, ks) do { _Pragma("unroll") for (int d0 = 0; d0 < 4; ++d0) { const s16x4 lo_ = vtr((Vp) + d0 * 4096 + (ks) * 1024), hh_ = vtr((Vp) + d0 * 4096 + (ks) * 1024 + 512); \
        VF[d0] = (bf16x8){lo_[0], lo_[1], lo_[2], lo_[3], hh_[0], hh_[1], hh_[2], hh_[3]}; } } while (0)
#define MMA4(VF, PWk) do { _Pragma("unroll") for (int d0 = 0; d0 < 4; ++d0) o[d0] = MFMA32(__builtin_bit_cast(bf16x8, PWk), VF[d0], o[d0]); } while (0)
#define DSTEP_N(C0, C1, RMC, N0, N1, RMN, t, MASKED) do { \
        if (AB != 4 && (t) + 3 <= J0) DDMA(J0 - (t) - 3, ow_); \
        bf16x8 kf_[8]; KLD(kf_, lds + on_ + cm * 8192); \
        SBAR(); \
        if (AB != 5) DRESC(C0, C1, RMC); \
        u32x4 pw_[4]; \
        DEXP(C0, C1, pw_); \
        DCIN(N0, N1, J0 - (t) - 1); \
        SBAR(); \
        if (AB != 3) QK8(N0, N1, kf_); \
        int ln_ = lane; asm volatile("" : "+v"(ln_)); LAS const unsigned char* vp_ = lds + oc_ + 16384 + ((ln_ >> 4) & 1) * 32 + (ln_ & 3) * 8 + ((ln_ >> 5) * 4 + ((ln_ & 15) >> 2)) * 64; \
        bf16x8 va_[4], vc_[4]; \
        VLDK(va_, vp_, 0); VLDK(vc_, vp_, 1); SBAR(); \
        if (AB != 2) MMA4(va_, pw_[0]); VLDK(va_, vp_, 2); SBAR(); \
        if (AB != 2) MMA4(vc_, pw_[1]); VLDK(vc_, vp_, 3); SBAR(); \
        if (AB != 5) DMASK(N0, N1, J0 - (t) - 1, RMN, MASKED); else RMN = RMC; \
        if (AB != 2) { MMA4(va_, pw_[2]); MMA4(vc_, pw_[3]); } \
        SBAR(); \
        DEND(t); } while (0)
#define DSTEP_L(C0, C1, RMC, t) do { DRESC(C0, C1, RMC); u32x4 pw_[4]; DEXP(C0, C1, pw_); int ln_ = lane; asm volatile("" : "+v"(ln_)); LAS const unsigned char* vp_ = lds + oc_ + 16384 + ((ln_ >> 4) & 1) * 32 + (ln_ & 3) * 8 + ((ln_ >> 5) * 4 + ((ln_ & 15) >> 2)) * 64; bf16x8 va_[4], vc_[4]; \
        VLDK(va_, vp_, 0); VLDK(vc_, vp_, 1); SBAR(); MMA4(va_, pw_[0]); VLDK(va_, vp_, 2); SBAR(); MMA4(vc_, pw_[1]); VLDK(vc_, vp_, 3); SBAR(); MMA4(va_, pw_[2]); MMA4(vc_, pw_[3]); DEND(t); } while (0)
    const int J0 = 2 * c + 1;
    int oc_ = 0, on_ = 32768, o2_ = 65536, ow_ = 98304;
    __syncthreads();
    DDMA(J0, 0); DDMA(J0 - 1, 32768);
    if (J0 >= 2) DDMA(J0 - 2, 65536);
    bf16x8 qr[4];
    { const bf16_t* qp = DQ + (tokb + tq) * 512 + hd * 128 + cm * 64 + hi * 8;
#pragma unroll
      for (int d0 = 0; d0 < 4; ++d0) qr[d0] = *(const bf16x8*)(qp + d0 * 16); }
    asm volatile("" : "+v"(qr[0]), "+v"(qr[1]), "+v"(qr[2]), "+v"(qr[3]));
    asm volatile("s_waitcnt vmcnt(0)\n\ts_barrier" ::: "memory");
    f32x16 sA0, sA1, sB0, sB1; float rmA, rmB;
    DCIN(sA0, sA1, J0);
    qkt_nb(sA0, sA1, lds + cm * 8192, qr, r32, hi);
    DMASK(sA0, sA1, J0, rmA, true);
    DSTEP_N(sA0, sA1, rmA, sB0, sB1, rmB, 0, true);
    for (int t = 1; t + 1 <= J0 - 1; t += 2) {
        DSTEP_N(sB0, sB1, rmB, sA0, sA1, rmA, t, false); DSTEP_N(sA0, sA1, rmA, sB0, sB1, rmB, t + 1, false);
    }
    DSTEP_L(sB0, sB1, rmB, J0);
#undef DDMA
#undef DCIN
#undef DMASK
#undef DRESC
#undef DEXP
#undef DEND
#undef DSTEP_N
#undef DSTEP_L
#undef KLD
#undef QK8
#undef VLDK
#undef MMA4
#undef SBAR
    QFETCH();
    const float lam = ((const float*)(ws + WS_MISC + 4096))[l];
    const float lam_init = (l == 0) ? 0.2f : 0.35550906f;
    const float ltot = s32(lsum);
    if (hi == 0) wsf[r32] = (cm == 0 ? 1.f : lam) / ltot;
    LAS float* X = (LAS float*)(lds + cm * 65536);
#pragma unroll
    for (int r = 0; r < 16; ++r) { const float f = wsf[crow(r, hi)]; const int q = 32 * qq + crow(r, hi);
#pragma unroll
        for (int d = 0; d < 4; ++d) X[q * 128 + d * 32 + r32] = o[d][r] * f; }
    __syncthreads();
    { const int q = tid >> 2, qt = tid & 3; LAS const float* x0 = (LAS const float*)lds + q * 128 + qt * 32; LAS const float* x1 = x0 + 16384;
      float v[32]; float ss = 0.f;
#pragma unroll
      for (int i = 0; i < 32; ++i) { v[i] = x0[i] - x1[i]; ss += v[i] * v[i]; }
      ss += shx(ss, 1, lane); ss += shx(ss, 2, lane);
      unsigned omlb = (l == 0) ? 0x3f4ccccdu : 0x3f24fd5cu; asm volatile("" : "+s"(omlb)); const float oml = __uint_as_float(omlb);
      const float rstd = rsqrtf(ss * (1.f / 128.f) + 1e-5f) * oml;
      const float* sg = p.diff_subln_g + l * 128 + qt * 32;
      bf16_t* dst = (dry ? (bf16_t*)(ws + WS_XN) + (size_t)NTOK * 512 : DQ) + (tokb + 128 * c + q) * 512 + hd * 128 + qt * 32;
#pragma unroll
      for (int i = 0; i < 32; i += 8) { u32x4 w; w.x = cvtpk(v[i] * rstd * sg[i], v[i + 1] * rstd * sg[i + 1]); w.y = cvtpk(v[i + 2] * rstd * sg[i + 2], v[i + 3] * rstd * sg[i + 3]);
          w.z = cvtpk(v[i + 4] * rstd * sg[i + 4], v[i + 5] * rstd * sg[i + 5]); w.w = cvtpk(v[i + 6] * rstd * sg[i + 6], v[i + 7] * rstd * sg[i + 7]); *(u32x4*)(dst + i) = w; } }
    QPARK();
    __syncthreads();
}

template <int AB> __device__ __forceinline__ void nsa_unit(PRef p, int l, int u, LAS unsigned char* lds, bool dry, unsigned* qctr) {
    int tid_ = TIDX(); asm volatile("" : "+v"(tid_));
    const int tid = tid_, lane = tid & 63, r32 = lane & 31, hi = lane >> 5, wid = __builtin_amdgcn_readfirstlane(tid >> 6);
    unsigned char* ws = p.ws;
    const int c = 31 - (u >> 5), b = (u & 31) >> 1, g = u & 1;
    const int hl = wid >> 1, qh = wid & 1, h = g * 4 + hl, t0 = 64 * c + 32 * qh, tq = t0 + r32, ql = 32 * qh + r32;
    const size_t tokb = (size_t)b * TSEQ;
    bf16_t* NQ = (bf16_t*)(ws + WS_NQ); const bf16_t* KV6 = (const bf16_t*)(ws + WS_KV6); const bf16_t* NG = (const bf16_t*)(ws + WS_NG);
    const bf16_t* KC = (const bf16_t*)(ws + WS_MISC + 65536); const bf16_t* VC = (const bf16_t*)(ws + WS_MISC + 65536 + 524288);
    constexpr int RING_W = 0, RING_S = 65536, CK = 65536, CV = 81920, IMPH_OFF = 98304;
    const unsigned lds0 = (unsigned)(uintptr_t)lds;
    const int jlo = c - 8 < 0 ? 0 : c - 8;
    const unsigned wmask = ((c >= 31) ? 0xffffffffu : ((2u << c) - 1u)) & ~((1u << jlo) - 1u);
    const int srow = tid >> 3, spos = tid & 7, sch = spos ^ ((srow >> 1) & 7);
    const unsigned kvo768 = (unsigned)(srow * 768 + sch * 8) * 2u, vvo768 = (unsigned)((lane >> 2) * 768 + (lane & 3) * 8) * 2u;
    const bf16_t* kub = KV6 + tokb * 768 + g * 64; const bf16_t* vub = KV6 + tokb * 768 + g * 64 + 128 + (size_t)(16 * (wid & 3)) * 768 + (wid >> 2) * 32;
    const unsigned dk = lds0 + wid * 1024, dv = dk + 8192;
#define NDMA(j, kind, off) do { const size_t to_ = (size_t)(64 * (j)) * 768 + ((kind) == 1 ? 256 : 512); const unsigned o_ = (unsigned)(off); \
        glds16s(kub + to_, kvo768, (unsigned)__builtin_amdgcn_readfirstlane(dk + o_)); glds16s(vub + to_, vvo768, (unsigned)__builtin_amdgcn_readfirstlane(dv + o_)); } while (0)
    __syncthreads();
    { const unsigned kvo128 = (unsigned)(srow * 128 + sch * 8) * 2u, vvo128 = (unsigned)((lane >> 2) * 128 + (lane & 3) * 8) * 2u;
      const bf16_t* kcb = KC + ((size_t)b * 128 * 2 + g) * 64; const bf16_t* vcb = VC + ((size_t)b * 128 * 2 + g) * 64 + (size_t)(16 * (wid & 3)) * 128 + (wid >> 2) * 32;
      glds16s(kcb, kvo128, (unsigned)__builtin_amdgcn_readfirstlane(dk + CK)); glds16s(kcb + 64 * 128, kvo128, (unsigned)__builtin_amdgcn_readfirstlane(dk + CK + 8192));
      glds16s(vcb, vvo128, (unsigned)__builtin_amdgcn_readfirstlane(dk + CV)); glds16s(vcb + 64 * 128, vvo128, (unsigned)__builtin_amdgcn_readfirstlane(dk + CV + 8192)); }
    unsigned wd = wmask; int nwd = 0;
#pragma unroll
    for (int i = 0; i < 3; ++i) if (wd) { const int j = 31 - __builtin_clz(wd); wd &= ~(1u << j); NDMA(j, 2, RING_W + i * 16384); ++nwd; }
    bf16x8 qr[4];
    { const bf16_t* qp = NQ + (tokb + tq) * 512 + h * 64 + hi * 8;
#pragma unroll
      for (int d0 = 0; d0 < 4; ++d0) qr[d0] = *(const bf16x8*)(qp + d0 * 16); }
    float g0 = bf1(NG[(tokb + tq) * 32 + h * 3 + 0]), g1 = bf1(NG[(tokb + tq) * 32 + h * 3 + 1]), g2 = bf1(NG[(tokb + tq) * 32 + h * 3 + 2]);
    asm volatile("" : "+v"(qr[0]), "+v"(qr[1]), "+v"(qr[2]), "+v"(qr[3]), "+v"(g0), "+v"(g1), "+v"(g2));
    const float sl2 = alibi_slope(h + 1) * LOG2E;
    const float cbh = sl2 * (float)(4 * hi);
    LAS float* wsf = (LAS float*)(lds + LDS_MISC + 1024 + wid * 128);
    LAS unsigned char* Kt = lds + CK; LAS unsigned char* Vt = lds + CV;
    LAS float* IMPH = (LAS float*)(lds + IMPH_OFF);
    LAS float* VAL = (LAS float*)(lds + CK);
    LAS unsigned* MASK = (LAS unsigned*)(lds + LDS_MISC + 2048);
    f32x16 oacc[2];
    if (tid < 64) MASK[tid] = 0u;
    asm volatile("s_waitcnt vmcnt(0) lgkmcnt(0)\n\ts_barrier" ::: "memory");
    {
        f32x16 s[4];
        qkt(s[0], s[1], Kt, qr, r32, hi); qkt(s[2], s[3], Kt + 8192, qr, r32, hi);
        int nmax = (tq - 31) >> 4; if (nmax > 126) nmax = 126;
        float rm = NEG;
#pragma unroll
        for (int k = 0; k < 4; ++k)
#pragma unroll
            for (int r = 0; r < 16; ++r) { const int n = 32 * k + crow(r, hi); float v = s[k][r] + 16.f * CB(r) + sl2 * (float)(512 * k);
                v = (n <= nmax) ? v : NEG; s[k][r] = v; rm = fmaxf(rm, v); }
        rm = m32(rm);
        float sum = 0.f;
#pragma unroll
        for (int k = 0; k < 4; ++k)
#pragma unroll
            for (int r = 0; r < 16; ++r) { const float e = ex2(s[k][r] - rm); s[k][r] = e; sum += e; }
        sum = s32(sum);
        const float inv = (nmax >= 0) ? 1.f / sum : 0.f;
#pragma unroll
        for (int k = 0; k < 4; ++k)
#pragma unroll
            for (int r = 0; r < 16; ++r) s[k][r] *= inv;
        float prev = 0.f;
#pragma unroll
        for (int k = 0; k < 4; ++k)
#pragma unroll
            for (int a = 0; a < 4; ++a) { const int i = 4 * k + a; const float Bi = 0.5f * s[k][4 * a + 3]; const float Ai = (s[k][4 * a] + s[k][4 * a + 1]) + (s[k][4 * a + 2] + Bi);
                const float rc = o32(Bi, hi); const float add = hi ? rc : prev; prev = rc;
                IMPH[(hl * 64 + ql) * 32 + 2 * i + hi] = Ai + add; }
        f32x16 o[2]; o[0] = (f32x16){0.f}; o[1] = (f32x16){0.f};
        pv<2>(o, s[0], s[1], Vt, lane, hi); pv<2>(o, s[2], s[3], Vt + 8192, lane, hi);
        if (hi == 0) wsf[r32] = g0;
#pragma unroll
        for (int r = 0; r < 16; ++r) { const float f = wsf[crow(r, hi)]; oacc[0][r] = o[0][r] * f; oacc[1][r] = o[1][r] * f; }
        asm volatile("" : "+v"(oacc[0]), "+v"(oacc[1]));
    }
    __syncthreads();
    { const int q = tid >> 3, mg = tid & 7;
#pragma unroll
      for (int i = 0; i < 4; ++i) { const int mb = 4 * mg + i; float v = ((IMPH[(0 * 64 + q) * 32 + mb] + IMPH[(1 * 64 + q) * 32 + mb]) + IMPH[(2 * 64 + q) * 32 + mb]) + IMPH[(3 * 64 + q) * 32 + mb];
          if (mb == 0 || mb == c || mb == c - 1) v = 1e9f; if (mb > c) v = -1.f; VAL[q * 32 + mb] = v; }
      asm volatile("s_waitcnt lgkmcnt(0)" ::: "memory");
      float mine[4];
#pragma unroll
      for (int i = 0; i < 4; ++i) mine[i] = VAL[q * 32 + 4 * mg + i];
      int cnt0 = 0, cnt1 = 0, cnt2 = 0, cnt3 = 0;
#pragma unroll 4
      for (int m2 = 0; m2 < 32; ++m2) { const float v2 = VAL[q * 32 + m2]; const int rel = m2 - 4 * mg;
          cnt0 += (int)(v2 > mine[0]) | ((int)(v2 == mine[0]) & (int)(rel < 0));
          cnt1 += (int)(v2 > mine[1]) | ((int)(v2 == mine[1]) & (int)(rel < 1));
          cnt2 += (int)(v2 > mine[2]) | ((int)(v2 == mine[2]) & (int)(rel < 2));
          cnt3 += (int)(v2 > mine[3]) | ((int)(v2 == mine[3]) & (int)(rel < 3)); }
      unsigned bits = ((cnt0 < 8) ? 1u : 0u) | ((cnt1 < 8) ? 2u : 0u) | ((cnt2 < 8) ? 4u : 0u) | ((cnt3 < 8) ? 8u : 0u);
      bits <<= 4 * mg;
      bits |= shxu(bits, 1, lane); bits |= shxu(bits, 2, lane); bits |= shxu(bits, 4, lane);
      if (mg == 0) MASK[q] = bits; }
    __syncthreads();
    const unsigned vmask = (c >= 31) ? 0xffffffffu : ((2u << c) - 1u);
    const unsigned mymask = MASK[ql] & vmask;
    unsigned uni;
    { unsigned mk = MASK[lane] & vmask;
#pragma unroll
      for (int o_ = 1; o_ < 64; o_ <<= 1) mk |= shxu(mk, o_, lane);
      uni = __builtin_amdgcn_readfirstlane(mk); }
    unsigned sd = uni; int nsd = 0;
#pragma unroll
    for (int i = 0; i < 3; ++i) if (sd) { const int j = 31 - __builtin_clz(sd); sd &= ~(1u << j); NDMA(j, 1, RING_S + i * 16384); ++nsd; }
#define NCIN(A0, A1, j, kind) do { float slv_ = sl2; asm volatile("" : "+v"(slv_)); \
        const float tc_ = slv_ * (float)(64 * ((j) - c)) + slv_ * (float)(4 * hi) - m, tc1_ = tc_ + 32.f * slv_; \
        _Pragma("unroll") for (int r = 0; r < 16; ++r) { const float kc_ = (float)((r & 3) + 8 * (r >> 2)); A0[r] = fmaf(slv_, kc_, tc_); A1[r] = fmaf(slv_, kc_, tc1_); } } while (0)
#define NMASK(A0, A1, j, kind, RM) do { \
        const bool sel_ = ((kind) == 2) || ((mymask >> (j)) & 1u); \
        if ((j) == c || ((kind) == 2 && (j) == c - 8) || !__all(sel_)) { const int lim_ = ((j) == c) ? ql : 64, low_ = ((kind) == 2 && (j) == c - 8) ? ql : -1; \
            _Pragma("unroll") for (int r = 0; r < 16; ++r) { const int k0_ = crow(r, hi), k1_ = k0_ + 32; if (!sel_ || k0_ > lim_ || k0_ <= low_) A0[r] = NEG; if (!sel_ || k1_ > lim_ || k1_ <= low_) A1[r] = NEG; } } \
        RM = rowmax32(A0, A1); } while (0)
#define NRESC(C0, C1, RM) do { const bool real_ = RM > -1e29f; const bool need_ = (RM > SM_THR) || (!seen && real_); seen = seen || real_; \
        if (__any(need_)) { const float d_ = need_ ? RM : 0.f, f_ = ex2(-d_); m += d_; lsum *= f_; if (hi == 0) wsf[r32] = f_; \
        _Pragma("unroll") for (int r = 0; r < 16; ++r) { C0[r] -= d_; C1[r] -= d_; const float fr_ = wsf[crow(r, hi)]; o[0][r] *= fr_; o[1][r] *= fr_; } } } while (0)
#define NEXP(C0, C1, PW) do { float sum_ = 0.f; \
        _Pragma("unroll") for (int r = 0; r < 16; ++r) { C0[r] = ex2(C0[r]); C1[r] = ex2(C1[r]); sum_ += C0[r] + C1[r]; } lsum += sum_; PACKP(PW, C0, C1); } while (0)
#define NSTEP(C0, C1, RMC, N0, N1, RMN, kind) do { \
        if (dcur_) { const int jd_ = 31 - __builtin_clz(dcur_); dcur_ &= ~(1u << jd_); NDMA(jd_, kind, ring_ + ow_); dissued_ = true; } else dissued_ = false; \
        NRESC(C0, C1, RMC); \
        u32x4 pw_[4]; \
        NEXP(C0, C1, pw_); \
        const bool has_ = (ccur_ != 0u); int jn_ = 0; if (has_) { jn_ = 31 - __builtin_clz(ccur_); ccur_ &= ~(1u << jn_); } \
        if (has_) { NCIN(N0, N1, jn_, kind); qkt_nb(N0, N1, lds + ring_ + on_, qr, r32, hi); } \
        __builtin_amdgcn_sched_barrier(0); \
        pv_nb<2>(o, pw_, lds + ring_ + oc_ + 8192, lane, hi); \
        if (has_) NMASK(N0, N1, jn_, kind, RMN); \
        if (dissued_) asm volatile("s_waitcnt vmcnt(2) lgkmcnt(0)\n\ts_barrier" ::: "memory"); else asm volatile("s_waitcnt vmcnt(0) lgkmcnt(0)\n\ts_barrier" ::: "memory"); \
        { const int tmp_ = oc_; oc_ = on_; on_ = o2_; o2_ = ow_; ow_ = tmp_; } \
        more_ = has_; } while (0)
#define NSTREAM(tmask, dmask, kind, ringbase, gate) do { \
        f32x16 o[2]; o[0] = (f32x16){0.f}; o[1] = (f32x16){0.f}; float m = 0.f, lsum = 0.f; bool seen = false; \
        const int ring_ = (ringbase); int oc_ = 0, on_ = 16384, o2_ = 32768, ow_ = 49152; \
        unsigned ccur_ = (tmask), dcur_ = (dmask); bool dissued_ = false, more_ = true; \
        f32x16 sA0, sA1, sB0, sB1; float rmA, rmB = NEG; \
        { const int j0_ = 31 - __builtin_clz(ccur_); ccur_ &= ~(1u << j0_); NCIN(sA0, sA1, j0_, kind); qkt_nb(sA0, sA1, lds + ring_, qr, r32, hi); NMASK(sA0, sA1, j0_, kind, rmA); } \
        for (;;) { NSTEP(sA0, sA1, rmA, sB0, sB1, rmB, kind); if (!more_) break; NSTEP(sB0, sB1, rmB, sA0, sA1, rmA, kind); if (!more_) break; } \
        const float ltot_ = s32(lsum); \
        if (hi == 0) wsf[r32] = (gate) / ltot_; \
        _Pragma("unroll") for (int r = 0; r < 16; ++r) { const float f = wsf[crow(r, hi)]; oacc[0][r] += o[0][r] * f; oacc[1][r] += o[1][r] * f; } \
        asm volatile("" : "+v"(oacc[0]), "+v"(oacc[1])); } while (0)
    if (nsd == 3) asm volatile("s_waitcnt vmcnt(6) lgkmcnt(0)\n\ts_barrier" ::: "memory"); else if (nsd == 2) asm volatile("s_waitcnt vmcnt(4) lgkmcnt(0)\n\ts_barrier" ::: "memory"); else asm volatile("s_waitcnt vmcnt(2) lgkmcnt(0)\n\ts_barrier" ::: "memory");
    if (AB != 1) {
        NSTREAM(wmask, wd, 2, RING_W, g2);
        NSTREAM(uni, sd, 1, RING_S, g1);
    }
#undef NDMA
#undef NCIN
#undef NMASK
#undef NRESC
#undef NEXP
#undef NSTEP
#undef NSTREAM
    QFETCH();
    { LAS bf16_t* stg = (LAS bf16_t*)(lds + wid * 4096);
#pragma unroll
      for (int r = 0; r < 16; ++r) { const int orow = crow(r, hi); stg[orow * 64 + r32] = f2bf(oacc[0][r]); stg[orow * 64 + 32 + r32] = f2bf(oacc[1][r]); }
      asm volatile("s_waitcnt lgkmcnt(0)" ::: "memory");
      bf16_t* ob = (dry ? (bf16_t*)(ws + WS_XN) : NQ) + (tokb + t0) * 512 + h * 64;
      int lane2 = lane; asm volatile("" : "+v"(lane2));
#pragma unroll
      for (int i = 0; i < 4; ++i) { const int row = i * 8 + (lane2 >> 3), ch = lane2 & 7; *(u32x4*)(ob + (size_t)row * 512 + ch * 8) = *(LAS const u32x4*)(stg + row * 64 + ch * 8); } }
    (void)nwd;
    QPARK();
}

__device__ __forceinline__ int next_unit(unsigned* ctr, LAS unsigned char* lds) {
    LAS int* bc = (LAS int*)(lds + LDS_MISC);
    __syncthreads();
    if (TIDX() == 0) bc[0] = (int)__hip_atomic_fetch_add(ctr, 1u, __ATOMIC_RELAXED, __HIP_MEMORY_SCOPE_AGENT);
    __syncthreads();
    return __builtin_amdgcn_readfirstlane(bc[0]);
}


__device__ __forceinline__ void phase_router(PRef p, int l, LAS unsigned char* lds, bool dry = false) {
    int tid_ = TIDX(); asm volatile("" : "+v"(tid_));
    const int tid = tid_, lane = tid & 63, wid = tid >> 6;
    unsigned char* ws = p.ws;
    constexpr int WP = 1028;
    LAS float* WT = (LAS float*)lds;
    LAS unsigned* cntl = (LAS unsigned*)(lds + 82432);
    LAS unsigned* lbase = (LAS unsigned*)(lds + 82432 + 64);
    LAS unsigned* loc = (LAS unsigned*)(lds + 82560);
    LAS float* wloc = (LAS float*)(lds + 82560 + 16384);
    LAS float* GL = (LAS float*)(lds + 115328);
    const float* gwp = p.router_grp_w + (size_t)l * DM * 4; const float* ewp = p.router_exp_w + (size_t)l * DM * 16;
    const float* g2 = p.norm2_g + (size_t)l * DM;
    __syncthreads();
    for (int k = tid; k < DM; k += 512) {
        const float gk = g2[k]; GL[k] = gk;
        const f32x4 a = *(const f32x4*)(gwp + k * 4);
#pragma unroll
        for (int i = 0; i < 4; ++i) WT[i * WP + k] = a[i] * gk;
#pragma unroll
        for (int q4 = 0; q4 < 4; ++q4) { const f32x4 e = *(const f32x4*)(ewp + k * 16 + q4 * 4);
#pragma unroll
            for (int i = 0; i < 4; ++i) WT[(4 + q4 * 4 + i) * WP + k] = e[i] * gk; }
    }
    const float* gb = p.router_grp_b + l * 4; const float* eb = p.router_exp_b + l * 16;
    unsigned* ecnt = (unsigned*)(ws + WS_CTL) + CW_ECNT + 64 * l + (dry ? 32 : 0);
    unsigned* LIST = (unsigned*)(ws + (dry ? WS_NQ : WS_LIST)); float* WL = (float*)(ws + (dry ? WS_NQ + 4 * MiB : WS_WL));
    float* RSTD = (float*)(ws + WS_RSTD);
    const int n = lane & 15, kq = lane >> 4;
    for (int ch = BID(); ch < NTOK / 128; ch += GSZ()) {
        __syncthreads();
        if (tid < 16) cntl[tid] = 0u;
        __syncthreads();
        const int tok = ch * 128 + wid * 16 + n;
        const bf16_t* xr = (const bf16_t*)(ws + WS_HB) + (size_t)tok * DM + kq * 256;
        LAS const float* w0 = WT + n * WP + kq * 256;
        LAS const float* w1 = WT + (16 + (n & 3)) * WP + kq * 256;
        f32x4 acc0 = {0.f, 0.f, 0.f, 0.f}, acc1 = {0.f, 0.f, 0.f, 0.f}; float ss = 0.f;
        u32x4 xa[8], xb[8];
#pragma unroll
        for (int u = 0; u < 8; ++u) xa[u] = *(const u32x4*)(xr + 8 * u);
#define ROUTER_BATCH(XC, XN_, jb) do { \
        if ((jb) + 8 < 32) { _Pragma("unroll") for (int u = 0; u < 8; ++u) XN_[u] = *(const u32x4*)(xr + 8 * ((jb) + 8 + u)); } \
        _Pragma("unroll") for (int u = 0; u < 8; ++u) { const int jj = (jb) + u; const u32x4 xw = XC[u]; \
            const f32x4 x0 = {bflo(xw.x), bfhi(xw.x), bflo(xw.y), bfhi(xw.y)}, x1 = {bflo(xw.z), bfhi(xw.z), bflo(xw.w), bfhi(xw.w)}; \
            const f32x4 a0 = *(LAS const f32x4*)(w0 + 8 * jj), a1 = *(LAS const f32x4*)(w1 + 8 * jj), a2 = *(LAS const f32x4*)(w0 + 8 * jj + 4), a3 = *(LAS const f32x4*)(w1 + 8 * jj + 4); \
            ss += ((x0[0] * x0[0] + x0[1] * x0[1]) + (x0[2] * x0[2] + x0[3] * x0[3])) + ((x1[0] * x1[0] + x1[1] * x1[1]) + (x1[2] * x1[2] + x1[3] * x1[3])); \
            _Pragma("unroll") for (int i = 0; i < 4; ++i) { acc0 = __builtin_amdgcn_mfma_f32_16x16x4f32(a0[i], x0[i], acc0, 0, 0, 0); acc1 = __builtin_amdgcn_mfma_f32_16x16x4f32(a1[i], x0[i], acc1, 0, 0, 0); } \
            _Pragma("unroll") for (int i = 0; i < 4; ++i) { acc0 = __builtin_amdgcn_mfma_f32_16x16x4f32(a2[i], x1[i], acc0, 0, 0, 0); acc1 = __builtin_amdgcn_mfma_f32_16x16x4f32(a3[i], x1[i], acc1, 0, 0, 0); } \
            __builtin_amdgcn_sched_barrier(0); } } while (0)
#pragma unroll 1
        for (int jb = 0; jb < 32; jb += 16) { ROUTER_BATCH(xa, xb, jb); ROUTER_BATCH(xb, xa, jb + 8); }
#undef ROUTER_BATCH
        ss += shx(ss, 16, lane); ss += shx(ss, 32, lane);
        const float rstd = rsqrtf(ss * (1.f / 1024.f) + 1e-6f);
        if (kq == 0) RSTD[tok] = rstd;
        int gi = 0; float gwt = 0.f;
        { float gl[4];
#pragma unroll
          for (int r = 0; r < 4; ++r) gl[r] = acc0[r] * rstd + gb[r];
          float gm = gl[0];
#pragma unroll
          for (int r = 1; r < 4; ++r) if (gl[r] > gm) { gm = gl[r]; gi = r; }
          float gs = 0.f;
#pragma unroll
          for (int r = 0; r < 4; ++r) gs += __expf(gl[r] - gm);
          gwt = 1.f / gs; }
        gi = __builtin_amdgcn_ds_bpermute(n << 2, gi); gwt = shl_(gwt, n);
        const int mygrp = (kq == 0) ? 3 : kq - 1;
        if (mygrp == gi) {
            float el[4];
#pragma unroll
            for (int r = 0; r < 4; ++r) el[r] = ((kq == 0) ? acc1[r] : acc0[r]) * rstd + eb[mygrp * 4 + r];
            int i1 = 0; float v1 = el[0];
#pragma unroll
            for (int e = 1; e < 4; ++e) if (el[e] > v1) { v1 = el[e]; i1 = e; }
            int i2 = -1; float v2 = -3.0e38f;
#pragma unroll
            for (int e = 0; e < 4; ++e) if (e != i1 && el[e] > v2) { v2 = el[e]; i2 = e; }
            const float ex = __expf(v2 - v1), w1_ = gwt / (1.f + ex), w2_ = gwt * ex / (1.f + ex);
            const int e1 = gi * 4 + i1, e2 = gi * 4 + i2;
            const unsigned s1 = __hip_atomic_fetch_add(&cntl[e1], 1u, __ATOMIC_RELAXED, __HIP_MEMORY_SCOPE_WORKGROUP); loc[e1 * 256 + s1] = (unsigned)tok * 2u; wloc[e1 * 256 + s1] = w1_;
            const unsigned s2 = __hip_atomic_fetch_add(&cntl[e2], 1u, __ATOMIC_RELAXED, __HIP_MEMORY_SCOPE_WORKGROUP); loc[e2 * 256 + s2] = (unsigned)tok * 2u + 1u; wloc[e2 * 256 + s2] = w2_;
        }
        __syncthreads();
        if (tid < 16) lbase[tid] = __hip_atomic_fetch_add(&ecnt[tid], cntl[tid], __ATOMIC_RELAXED, __HIP_MEMORY_SCOPE_AGENT);
        __syncthreads();
        for (int e = 0; e < 16; ++e) { const unsigned nn = cntl[e], bs = lbase[e];
            for (unsigned i = tid; i < nn; i += 512) { LIST[(size_t)e * NTOK + bs + i] = loc[e * 256 + i]; WL[(size_t)e * NTOK + bs + i] = wloc[e * 256 + i]; } }
    }
}

struct MoeUnit { int e, tile, n, hoff; };
__device__ __forceinline__ bool moe_find(LAS const int* cnts, int ut, MoeUnit& mu) {
    int pre = 0;
    for (int e = 0; e < 16; ++e) { const int cn = cnts[e], nt = (cn + 127) >> 7; if (ut < pre + nt) { mu.e = e; mu.tile = ut - pre; mu.n = cn - mu.tile * 128; if (mu.n > 128) mu.n = 128; mu.hoff = (pre + mu.tile) * 128; return true; } pre += nt; }
    return false;
}

__device__ __forceinline__ bool moe_item(LAS const int* cnts, int c, int r, int G, MoeUnit& mu, int& nt0, int& nbt) {
    int total = 0;
    for (int e = 0; e < 16; ++e) total += (cnts[e] + 127) >> 7;
    const int extra = total - 2 * G;
    nt0 = 0; nbt = 8;
    if (extra <= 0 || extra * 8 > G) return moe_find(cnts, c + r * G, mu);
    if (r < 2) return moe_find(cnts, c + r * G, mu);
    if (r > 2 || (c >> 3) >= extra) return false;
    nt0 = c & 7; nbt = 1;
    return moe_find(cnts, 2 * G + (c >> 3), mu);
}

template <int AB> __device__ __forceinline__ void phase_moe_fused(PRef p, int l, LAS unsigned char* lds) {
    SG_IDS
    unsigned char* ws = p.ws;
    LAS int* cnts = (LAS int*)(lds + LDS_MISC + 64);
    const unsigned* ecnt = (const unsigned*)(ws + WS_CTL) + CW_ECNT + 64 * l;
    __syncthreads();
    if (tid < 16) cnts[tid] = (int)__hip_atomic_load(&ecnt[tid], __ATOMIC_RELAXED, __HIP_MEMORY_SCOPE_AGENT);
    __syncthreads();
    const unsigned* LIST = (const unsigned*)(ws + WS_LIST); const float* WL = (const float*)(ws + WS_WL);
    const char* XN = (const char*)(ws + WS_HB); const float* RSTD = (const float*)(ws + WS_RSTD);
    bf16_t* Y0 = (bf16_t*)(ws + WS_GA); bf16_t* Y1 = (bf16_t*)(ws + WS_GB);
    constexpr int SLOT = 49152;
    const unsigned lds0 = (unsigned)(uintptr_t)lds;
    const int lrow = tid >> 3, lpos = tid & 7, lchk = lpos ^ ((lrow >> 1) & 7);
    const unsigned dw = lds0 + wid * 1024;
    const unsigned wvo = (unsigned)(lrow * DM + lchk * 8) * 2u;
    const unsigned dvo = (unsigned)(((lrow & ~31) + pg8::perm32(lrow & 31)) * 128 + lchk * 8) * 2u;
    MoeUnit mu, mun; int rnd = 0, nt0 = 0, nbt = 8, nt0n = 0, nbtn = 8;
    if (!moe_item(cnts, BID(), 0, GSZ(), mu, nt0, nbt)) return;
    const char* pa0; const char* pa1; unsigned en0, en1; float wg0, wg1, rs0, rs1;
    const char* pa0n = nullptr; const char* pa1n = nullptr; unsigned en0n = 0, en1n = 0; float wg0n = 0.f, wg1n = 0.f, rs0n = 0.f, rs1n = 0.f;
#define RFL(x) ((unsigned)__builtin_amdgcn_readfirstlane(x))
#define MLOAD1(MU, PA0, PA1, E0_, E1_) do { const unsigned* lst_ = LIST + (size_t)(MU).e * NTOK + (MU).tile * 128; \
        const unsigned g0_ = lst_[lrow < (MU).n ? lrow : (MU).n - 1], g1_ = lst_[lrow + 64 < (MU).n ? lrow + 64 : (MU).n - 1]; \
        PA0 = XN + (size_t)(g0_ >> 1) * 2048 + lchk * 16; PA1 = XN + (size_t)(g1_ >> 1) * 2048 + lchk * 16; \
        const int r0_ = SG_ROW(0), r1_ = SG_ROW(1); E0_ = lst_[r0_ < (MU).n ? r0_ : (MU).n - 1]; E1_ = lst_[r1_ < (MU).n ? r1_ : (MU).n - 1]; } while (0)
#define MLOAD2(MU, E0_, E1_, W0_, W1_, R0_, R1_) do { const float* wl_ = WL + (size_t)(MU).e * NTOK + (MU).tile * 128; const int r0_ = SG_ROW(0), r1_ = SG_ROW(1); \
        const float a0_ = wl_[r0_], a1_ = wl_[r1_]; W0_ = (r0_ < (MU).n) ? a0_ : 0.f; W1_ = (r1_ < (MU).n) ? a1_ : 0.f; R0_ = RSTD[E0_ >> 1]; R1_ = RSTD[E1_ >> 1]; } while (0)
#define ADMA(PA0, PA1, Wp, t, so) do { const int ko_ = (t) * 128; const unsigned o_ = (unsigned)(so); \
        glds16(PA0 + ko_, RFL(dw + o_)); glds16(PA1 + ko_, RFL(dw + o_ + 8192)); \
        glds16s((const char*)(Wp) + ko_, wvo, RFL(dw + o_ + 16384)); glds16s((const char*)((Wp) + (size_t)64 * DM) + ko_, wvo, RFL(dw + o_ + 24576)); \
        glds16s((const char*)((Wp) + (size_t)128 * DM) + ko_, wvo, RFL(dw + o_ + 32768)); glds16s((const char*)((Wp) + (size_t)192 * DM) + ko_, wvo, RFL(dw + o_ + 40960)); } while (0)
#define BDMA(WDp, nt, so) do { const char* b_ = (const char*)((WDp) + (size_t)(nt) * 128 * 128); const unsigned o_ = (unsigned)(so); \
        glds16s(b_, dvo, RFL(dw + o_)); glds16s(b_ + 64 * 128 * 2, dvo, RFL(dw + o_ + 8192)); \
        glds16s(b_ + 128, dvo, RFL(dw + o_ + 16384)); glds16s(b_ + 64 * 128 * 2 + 128, dvo, RFL(dw + o_ + 24576)); } while (0)
#define MWAIT(N) asm volatile("s_waitcnt vmcnt(" #N ") lgkmcnt(0)\n\ts_barrier" ::: "memory")
#define MWAITV(n) do { const int n_ = (n); if (n_ >= 10) MWAIT(10); else if (n_ >= 8) MWAIT(8); else if (n_ >= 6) MWAIT(6); else if (n_ >= 4) MWAIT(4); else MWAIT(0); } while (0)
#define ACOMPUTE(so) do { LAS unsigned char* As = lds + (so); LAS unsigned char* Bg = As + 16384; LAS unsigned char* Bu = As + 32768; \
        _Pragma("unroll") for (int ks = 0; ks < 2; ++ks) { bf16x8 af[2], bg[4], bu[4]; const int ch = ks * 4 + fq; \
            _Pragma("unroll") for (int m = 0; m < 2; ++m) { const int row = wr * 32 + m * 16 + fr; af[m] = *(LAS const bf16x8*)(As + row * 128 + ((ch ^ ((row >> 1) & 7)) << 4)); } \
            _Pragma("unroll") for (int n = 0; n < 4; ++n) { const int row = wc * 64 + n * 16 + fr; const int o_ = row * 128 + ((ch ^ ((row >> 1) & 7)) << 4); bg[n] = *(LAS const bf16x8*)(Bg + o_); bu[n] = *(LAS const bf16x8*)(Bu + o_); } \
            _Pragma("unroll") for (int m = 0; m < 2; ++m) _Pragma("unroll") for (int n = 0; n < 4; ++n) { ag[m][n] = MFMA16(bg[n], af[m], ag[m][n]); au[m][n] = MFMA16(bu[n], af[m], au[m][n]); } } } while (0)
    MLOAD1(mu, pa0, pa1, en0, en1);
    MLOAD2(mu, en0, en1, wg0, wg1, rs0, rs1);
    {
        const bf16_t* W = (const bf16_t*)(ws + WS_WGU) + (size_t)(l * 16 + mu.e) * 256 * DM;
        ADMA(pa0, pa1, W, 0, 0); ADMA(pa0, pa1, W, 1, SLOT);
        MWAIT(6);
    }
    for (;;) {
        const bool has_next = moe_item(cnts, BID(), rnd + 1, GSZ(), mun, nt0n, nbtn);
        const bool full = (mu.n == 128);
        const bf16_t* W = (const bf16_t*)(ws + WS_WGU) + (size_t)(l * 16 + mu.e) * 256 * DM;
        const bf16_t* WD = (const bf16_t*)(ws + WS_WD) + (size_t)(l * 16 + mu.e) * DM * 128;
        f32x4 ag[2][4], au[2][4]; SG_ZERO(ag); SG_ZERO(au);
        int so = 0, so2 = 2 * SLOT;
        for (int t = 0; t < 14; ++t) {
            ADMA(pa0, pa1, W, t + 2, so2);
            ACOMPUTE(so);
            MWAIT(6);
            so += SLOT; if (so == 3 * SLOT) so = 0; so2 += SLOT; if (so2 == 3 * SLOT) so2 = 0;
        }
        BDMA(WD, nt0, SLOT);     ACOMPUTE(2 * SLOT); MWAIT(4);
        BDMA(WD, nbt > 1 ? nt0 + 1 : nt0, 2 * SLOT); ACOMPUTE(0);        MWAIT(4);
        LAS unsigned char* Hs = lds;
#pragma unroll
        for (int m = 0; m < 2; ++m) { const int rl = SG_ROW(m); const float wgt = m ? wg1 : wg0, rs = m ? rs1 : rs0;
#pragma unroll
            for (int n = 0; n < 4; ++n) { f32x4 gv = ag[m][n] * rs, uv = au[m][n] * rs, hv;
#pragma unroll
                for (int i = 0; i < 4; ++i) hv[i] = gv[i] * sigm(gv[i]) * uv[i] * wgt;
                const int chk = 2 * n + (fq >> 1);
                u32x2 w; w.x = cvtpk(hv[0], hv[1]); w.y = cvtpk(hv[2], hv[3]);
                *(LAS u32x2*)(Hs + wc * 16384 + rl * 128 + ((chk ^ ((rl >> 1) & 7)) << 4) + (fq & 1) * 8) = w; } }
        asm volatile("s_waitcnt lgkmcnt(0)\n\ts_barrier" ::: "memory");
        bf16x8 hf[2][4];
#pragma unroll
        for (int m = 0; m < 2; ++m)
#pragma unroll
            for (int kk = 0; kk < 4; ++kk) { const int row = wr * 32 + m * 16 + fr, ch = (kk & 1) * 4 + fq; hf[m][kk] = *(LAS const bf16x8*)(Hs + (kk >> 1) * 16384 + row * 128 + ((ch ^ ((row >> 1) & 7)) << 4)); }
        asm volatile("s_waitcnt lgkmcnt(0)\n\ts_barrier" ::: "memory");
        const bf16_t* Wn = (const bf16_t*)(ws + WS_WGU) + (size_t)(l * 16 + (has_next ? mun.e : mu.e)) * 256 * DM;
#pragma unroll
        for (int jt = 0; jt < 8; ++jt) {
            if (jt >= nbt) break;
            const int nt = nt0 + jt;
            const int sb = ((16 + jt) % 3) * SLOT, sb2 = ((18 + jt) % 3) * SLOT;
            int cnew = 0;
            if (jt + 2 < nbt) { BDMA(WD, nt + 2, sb2); cnew = 4; }
            else if (jt >= 6 && has_next) { ADMA(pa0n, pa1n, Wn, jt - 6, sb2); cnew = 6; }
            if (jt == 0 && has_next) MLOAD1(mun, pa0n, pa1n, en0n, en1n);
            if (jt == 4 && has_next) MLOAD2(mun, en0n, en1n, wg0n, wg1n, rs0n, rs1n);
            f32x4 acc[2][4]; SG_ZERO(acc);
#pragma unroll
            for (int kk = 0; kk < 4; ++kk) {
                bf16x8 bfr[4];
                const int ch = (kk & 1) * 4 + fq;
#pragma unroll
                for (int n = 0; n < 4; ++n) { const int row = wc * 64 + n * 16 + fr; bfr[n] = *(LAS const bf16x8*)(lds + sb + (kk >> 1) * 16384 + row * 128 + ((ch ^ ((row >> 1) & 7)) << 4)); }
#pragma unroll
                for (int m = 0; m < 2; ++m)
#pragma unroll
                    for (int n = 0; n < 4; ++n) acc[m][n] = MFMA16(bfr[n], hf[m][kk], acc[m][n]);
            }
            MWAITV(cnew + ((jt > 0 && full && AB != 5) ? 4 : 0));
#pragma unroll
            for (int m = 0; m < 2; ++m) if (SG_ROW(m) < mu.n) { const unsigned en = m ? en1 : en0; bf16_t* dst = ((en & 1u) ? Y1 : Y0) + (size_t)(en >> 1) * DM + nt * 128 + wc * 64 + 8 * fq;
#pragma unroll
                for (int np = 0; np < 2; ++np) { const f32x4 v0 = acc[m][2 * np], v1 = acc[m][2 * np + 1];
                    if (AB == 5) { asm volatile("" :: "v"(v0), "v"(v1)); continue; }
                    u32x4 w; w.x = cvtpk(v0[0], v0[1]); w.y = cvtpk(v0[2], v0[3]); w.z = cvtpk(v1[0], v1[1]); w.w = cvtpk(v1[2], v1[3]); *(u32x4*)(dst + 32 * np) = w; } }
        }
        if (!has_next) break;
        mu = mun; ++rnd; nt0 = nt0n; nbt = nbtn; pa0 = pa0n; pa1 = pa1n; en0 = en0n; en1 = en1n; wg0 = wg0n; wg1 = wg1n; rs0 = rs0n; rs1 = rs1n;
    }
#undef RFL
#undef MLOAD1
#undef MLOAD2
#undef ADMA
#undef BDMA
#undef MWAIT
#undef MWAITV
#undef ACOMPUTE
}

__device__ __forceinline__ void phase_combine(PRef p, int l, bool dry = false) {
    int tid_ = TIDX(); asm volatile("" : "+v"(tid_));
    const int tid = tid_, lane = tid & 63, wid = tid >> 6;
    unsigned char* ws = p.ws;
    const int gw = BID() * 8 + wid, NGW = GSZ() * 8;
    const bf16_t* Y0 = (const bf16_t*)(ws + WS_GA); const bf16_t* Y1 = (const bf16_t*)(ws + WS_GB);
    bf16_t* HB = (bf16_t*)(ws + WS_HB); bf16_t* HO = dry ? (bf16_t*)(ws + WS_NQ) : HB; float* OUT = dry ? (float*)(ws + WS_NQ) : p.out;
    const bool last = (l == DEPTH - 1);
    for (int m0 = gw * 4; m0 < NTOK; m0 += NGW * 4) {
        u32x2 hv[4][4], ya[4][4], yb[4][4];
#pragma unroll
        for (int rr = 0; rr < 4; ++rr)
#pragma unroll
            for (int j = 0; j < 4; ++j) { const size_t off = (size_t)(m0 + rr) * DM + (64 * j + lane) * 4; hv[rr][j] = *(const u32x2*)(HB + off); ya[rr][j] = *(const u32x2*)(Y0 + off); yb[rr][j] = *(const u32x2*)(Y1 + off); }
#pragma unroll
        for (int rr = 0; rr < 4; ++rr) {
            f32x4 v[4]; float s = 0.f;
#pragma unroll
            for (int j = 0; j < 4; ++j) { const u32x2 h2 = hv[rr][j], a = ya[rr][j], b2 = yb[rr][j];
                v[j] = (f32x4){bflo(h2.x), bfhi(h2.x), bflo(h2.y), bfhi(h2.y)} + (f32x4){bflo(a.x), bfhi(a.x), bflo(a.y), bfhi(a.y)} + (f32x4){bflo(b2.x), bfhi(b2.x), bflo(b2.y), bfhi(b2.y)};
                s += (v[j][0] * v[j][0] + v[j][1] * v[j][1]) + (v[j][2] * v[j][2] + v[j][3] * v[j][3]); }
            const float rstd = rsqrtf(wave_sum(s, lane) * (1.f / 1024.f) + 1e-6f);
            if (last) {
#pragma unroll
                for (int j = 0; j < 4; ++j) { const int cidx = (64 * j + lane) * 4; const f32x4 gg = *(const f32x4*)(p.final_norm_g + cidx); *(f32x4*)(OUT + (size_t)(m0 + rr) * DM + cidx) = v[j] * rstd * gg; }
            } else {
                if (lane == 0 && !dry) ((float*)(ws + WS_RSTD1))[m0 + rr] = rstd;
#pragma unroll
                for (int j = 0; j < 4; ++j) st4bf(HO + (size_t)(m0 + rr) * DM + (64 * j + lane) * 4, v[j]);
            }
        }
    }
}

#define XB_TMO      128
#define XB_XCNT(j)  (256  + 64 * (j))
#define XB_XSUB(j)  (1280 + 64 * (j))
#define XB_XGEN(j)  (2304 + 64 * (j))
#define XB_TOP      3328
#define XB_TOPGEN   3392
#define XCD_BAR_WORDS 3456
#define XB_SPIN_CAP (1u << 18)
__device__ __forceinline__ unsigned xb_ld(unsigned* p)              { return __hip_atomic_load(p, __ATOMIC_RELAXED, __HIP_MEMORY_SCOPE_AGENT); }
__device__ __forceinline__ unsigned xb_add(unsigned* p, unsigned v) { return __hip_atomic_fetch_add(p, v, __ATOMIC_RELAXED, __HIP_MEMORY_SCOPE_AGENT); }
__device__ __forceinline__ unsigned xb_xcc_id() { return (unsigned)__builtin_amdgcn_s_getreg((3 << 11) | 20) & 0xFu; }
#define XB_SPIN(cond, bar) do { unsigned _sp = 0; while (cond) { __builtin_amdgcn_s_sleep(1); \
    if ((++_sp & 255u) == 0u) { if (xb_ld(&(bar)[XB_TMO])) break; if (_sp > XB_SPIN_CAP) { atomicAdd(&(bar)[XB_TMO], 1u); break; } } } } while (0)
struct XcdBarrier { unsigned* bar; unsigned x; volatile LAS unsigned* st; };
__device__ __forceinline__ XcdBarrier xcd_barrier_post(unsigned* bar, volatile LAS unsigned* st) {
    XcdBarrier b; b.bar = bar; b.x = xb_xcc_id(); b.st = st;
    if (TIDX() == 0) (void)xb_add(&bar[XB_XCNT(b.x)], 1u);
    return b;
}
__device__ __forceinline__ void xcd_barrier_complete(unsigned* bar, unsigned x, unsigned& nloc, unsigned& nx) {
    const unsigned G = gridDim.x * gridDim.y * gridDim.z;
    unsigned sum, cnt, mine, sp = 0u;
    for (;;) {
        sum = 0u; cnt = 0u; mine = 0u;
#pragma unroll
        for (unsigned j = 0; j < 16; ++j) { const unsigned c = xb_ld(&bar[XB_XCNT(j)]); sum += c; cnt += (c > 0u) ? 1u : 0u; mine = (j == x) ? c : mine; }
        if (sum == G) break;
        __builtin_amdgcn_s_sleep(1);
        if ((++sp & 255u) == 0u) { if (xb_ld(&bar[XB_TMO])) break; if (sp > XB_SPIN_CAP) { atomicAdd(&bar[XB_TMO], 1u); break; } }
    }
    nloc = mine > 0u ? mine : 1u; nx = cnt > 0u ? cnt : 1u;
}
__device__ __forceinline__ void xcd_barrier(const XcdBarrier& b_) {
    asm volatile("s_waitcnt vmcnt(0)" ::: "memory");
    __syncthreads();
    if (TIDX() == 0) {
        unsigned* bar = b_.bar; asm volatile("" : "+s"(bar));
        XcdBarrier b; b.bar = bar; b.st = b_.st; b.x = xb_xcc_id();
        __builtin_amdgcn_s_waitcnt(0);
        unsigned nloc = b.st[0], nx = b.st[1];
        if (nloc == 0u) { xcd_barrier_complete(bar, b.x, nloc, nx); b.st[0] = nloc; b.st[1] = nx; }
        const unsigned old = xb_add(&bar[XB_XSUB(b.x)], 1u);
        const unsigned gen = old / nloc;
        if (old + 1u == (gen + 1u) * nloc) {
            __builtin_amdgcn_fence(__ATOMIC_RELEASE, "agent");
            asm volatile("s_waitcnt vmcnt(0)" ::: "memory");
            const unsigned og = xb_add(&bar[XB_TOP], 1u);
            const unsigned tg = og / nx;
            if (og + 1u == (tg + 1u) * nx) xb_add(&bar[XB_TOPGEN], 1u);
            else XB_SPIN(xb_ld(&bar[XB_TOPGEN]) == tg, bar);
            __builtin_amdgcn_fence(__ATOMIC_ACQUIRE, "agent");
            xb_add(&bar[XB_XGEN(b.x)], 1u);
            asm volatile("s_waitcnt vmcnt(0)" ::: "memory");
        } else {
            XB_SPIN(xb_ld(&bar[XB_XGEN(b.x)]) == gen, bar);
            __builtin_amdgcn_fence(__ATOMIC_ACQUIRE, "agent");
            asm volatile("s_waitcnt vmcnt(0)" ::: "memory");
        }
    }
    __syncthreads();
}

template <int K> __device__ __forceinline__ void run_phase(PRef p, int l, LAS unsigned char* lds, bool dry = false) {
    unsigned* ctl = (unsigned*)(p.ws + WS_CTL);
    if (K == 0) phase_prologue(p, lds);
    if (K == 1) { if (dry) phase_inproj_pg8<ABL>(p, l, lds); else { phase_inproj_pg8<0>(p, l, lds); if (l + 1 < DEPTH) { __syncthreads(); weight_prep(p, l + 1, lds); } } }
    if (K == 2) { unsigned* ctr = ctl + CW_QCTR + 64 * (l * 2 + 0) + (dry ? 16 : 0);
        int u = next_unit(ctr, lds);
        while (u < 64 + 1024) { if (u < 64) compress_unit(p, l, u, lds, ctr); else { if (dry) diff_unit<ABL>(p, l, u - 64, lds, true, ctr); else diff_unit<0>(p, l, u - 64, lds, false, ctr); }
            __syncthreads(); u = __builtin_amdgcn_readfirstlane(((LAS int*)(lds + LDS_MISC))[1]); } }
    if (K == 3) { unsigned* ctr = ctl + CW_QCTR + 64 * (l * 2 + 1) + (dry ? 16 : 0);
        int u = next_unit(ctr, lds);
        while (u < 1024) { if (dry) nsa_unit<ABL>(p, l, u, lds, true, ctr); else nsa_unit<0>(p, l, u, lds, false, ctr);
            __syncthreads(); u = __builtin_amdgcn_readfirstlane(((LAS int*)(lds + LDS_MISC))[1]); } }
    if (K == 4) phase_merge_pg8(p, l, lds);
    if (K == 5) phase_outproj_pg8(p, l, lds, dry);
    if (K == 6) phase_router(p, l, lds, dry);
    if (K == 7) { if (dry) phase_moe_fused<ABL>(p, l, lds); else phase_moe_fused<0>(p, l, lds); }
    if (K == 9) phase_combine(p, l, dry);
}
#if MK_MULTI
template <int K> __global__ void __launch_bounds__(512, 2) mk_one(Params p) {
    extern __shared__ __attribute__((aligned(16))) unsigned char lds_raw[];
    const __attribute__((address_space(4))) Params* pp_ = (const __attribute__((address_space(4))) Params*)__builtin_amdgcn_kernarg_segment_ptr();
    if ((threadIdx.x & 63) == 0) ((LAS int*)(size_t)LDS_WTAB)[hw_wave_key()] = (int)(threadIdx.x >> 6);
    __syncthreads();
    run_phase<K>(*pp_, p.ph_lo, (LAS unsigned char*)lds_raw);
}
template <int K> static void launch_one(int grid, hipStream_t stream, Params p, int l) {
    static bool attr = false;
    if (!attr) { (void)hipFuncSetAttribute((const void*)mk_one<K>, hipFuncAttributeMaxDynamicSharedMemorySize, LDS_BYTES); attr = true; }
    p.ph_lo = l; p.ph_hi = l + 1;
    hipLaunchKernelGGL(mk_one<K>, dim3(grid), dim3(512), LDS_BYTES, stream, p);
}
#else
__global__ void __launch_bounds__(512, 2) mk_fwd(Params p) {
    extern __shared__ __attribute__((aligned(16))) unsigned char lds_raw[];
    LAS unsigned char* lds = (LAS unsigned char*)lds_raw;
    volatile LAS unsigned* bst = (volatile LAS unsigned*)(lds + LDS_MISC + 256);
    if ((threadIdx.x & 63) == 0) ((LAS int*)(size_t)LDS_WTAB)[hw_wave_key()] = (int)(threadIdx.x >> 6);
    if (threadIdx.x < 2) bst[threadIdx.x] = 0u;
    __syncthreads();
    const XcdBarrier bar = xcd_barrier_post((unsigned*)(p.ws + WS_CTL) + CW_BAR, bst);
#define SEAM() xcd_barrier(bar)
#ifndef PROBE_DUP
#define PROBE_DUP -1
#endif
#ifndef PROBE_DUP2
#define PROBE_DUP2 -1
#endif
#define RUN(K, l) do { const __attribute__((address_space(4))) Params* pp_ = (const __attribute__((address_space(4))) Params*)__builtin_amdgcn_kernarg_segment_ptr(); asm volatile("" : "+s"(pp_)); \
    if (K == PROBE_DUP || K == PROBE_DUP2) { run_phase<K>(*pp_, l, lds, true); SEAM(); } run_phase<K>(*pp_, l, lds); } while (0)
    RUN(0, 0); SEAM();
    for (int l = 0; l < DEPTH; ++l) {
        RUN(1, l); SEAM();
        RUN(2, l); SEAM();
        RUN(3, l); SEAM();
        RUN(4, l); SEAM();
        RUN(5, l); SEAM();
        RUN(6, l); SEAM();
        RUN(7, l); SEAM();
        RUN(9, l); if (l + 1 < DEPTH) SEAM();
    }
}
#endif

extern "C" void kernel_launch(void* const* d_in, const int* in_sizes, int n_in, void* d_out, int out_size, void* d_ws, size_t ws_size, hipStream_t stream) {
    static int grid = 0;
    if (grid == 0) {
        if (n_in != 22 || in_sizes[0] != NTOK * DM || out_size != NTOK * DM || ws_size < WS_END) { fprintf(stderr, "kernel_launch: unexpected shapes (n_in %d, in0 %d, out %d, ws %zu)\n", n_in, n_in > 0 ? in_sizes[0] : -1, out_size, ws_size); grid = -1; return; }
        int dev = 0, cus = 0, per_cu = 1;
        (void)hipGetDevice(&dev); (void)hipDeviceGetAttribute(&cus, hipDeviceAttributeMultiprocessorCount, dev);
#if !MK_MULTI
        (void)hipFuncSetAttribute((const void*)mk_fwd, hipFuncAttributeMaxDynamicSharedMemorySize, LDS_BYTES);
        (void)hipOccupancyMaxActiveBlocksPerMultiprocessor(&per_cu, (const void*)mk_fwd, 512, LDS_BYTES);
        if (per_cu < 1) { fprintf(stderr, "kernel_launch: occupancy query says %d blocks per CU\n", per_cu); per_cu = 1; }
#endif
        (void)hipGetLastError();
        grid = cus * per_cu;
    }
    if (grid < 0) return;
    (void)hipMemsetAsync((char*)d_ws + WS_CTL, 0, CTL_BYTES, stream);
    Params p{};
    const float** pp = (const float**)&p;
    for (int i = 0; i < 22; ++i) pp[i] = (const float*)d_in[i];
    p.out = (float*)d_out; p.ws = (unsigned char*)d_ws;
#if MK_MULTI
    launch_one<0>(grid, stream, p, 0);
    for (int l = 0; l < DEPTH; ++l) {
        launch_one<1>(grid, stream, p, l); launch_one<2>(grid, stream, p, l); launch_one<3>(grid, stream, p, l); launch_one<4>(grid, stream, p, l); launch_one<5>(grid, stream, p, l);
        launch_one<6>(grid, stream, p, l); launch_one<7>(grid, stream, p, l); launch_one<9>(grid, stream, p, l);
    }
#else
    p.ph_lo = 0; p.ph_hi = NPHASE;
    void* args[] = {&p};
    hipError_t e = hipLaunchCooperativeKernel((const void*)mk_fwd, dim3(grid), dim3(512), args, LDS_BYTES, stream);
    if (e != hipSuccess) fprintf(stderr, "cooperative launch failed: %s (grid %d)\n", hipGetErrorString(e), grid);
#endif
}
```

```cpp
#include <hip/hip_runtime.h>
#include <hip/hip_cooperative_groups.h>
#include <cstdio>
#include <cstdint>
namespace cg = cooperative_groups;

#ifndef MK_MULTI
#define MK_MULTI 0
#endif

#define LAS __attribute__((address_space(3)))
typedef unsigned short bf16_t;
typedef short bf16x8 __attribute__((ext_vector_type(8)));
typedef short s16x4 __attribute__((ext_vector_type(4)));
typedef float f32x2 __attribute__((ext_vector_type(2)));
typedef float f32x4 __attribute__((ext_vector_type(4)));
typedef float f32x16 __attribute__((ext_vector_type(16)));
typedef unsigned u32x2 __attribute__((ext_vector_type(2)));
typedef unsigned u32x4 __attribute__((ext_vector_type(4)));
typedef __bf16 bf16x2_t __attribute__((ext_vector_type(2)));

constexpr int NTOK = 32768, DM = 1024, TSEQ = 2048, NBATCH = 16, DEPTH = 2;
constexpr int INCOLS = 4888, NPAD = 5120;
constexpr float LOG2E = 1.4426950408889634f;
constexpr float QSCALE = 0.125f * LOG2E;
constexpr int NPHASE = 1 + 9 * DEPTH;

constexpr size_t MiB = 1u << 20;
constexpr size_t WS_CTL = 0, CTL_BYTES = 65536;
constexpr size_t WS_WIN = 1 * MiB;
constexpr size_t WS_WA = 21 * MiB;
constexpr size_t WS_WB = 23 * MiB;
constexpr size_t WS_WO = 25 * MiB;
constexpr size_t WS_WC1 = 29 * MiB;
constexpr size_t WS_WGU = 31 * MiB;
constexpr size_t WS_WD = 47 * MiB;
constexpr size_t WS_MISC = 55 * MiB;
constexpr size_t WS_LIST = 58 * MiB;
constexpr size_t WS_WL = 60 * MiB;
constexpr size_t WS_XN = 64 * MiB;
constexpr size_t WS_NQ = 128 * MiB;
constexpr size_t WS_KV6 = 160 * MiB;
constexpr size_t WS_NG = 208 * MiB;
constexpr size_t WS_DQ = 210 * MiB;
constexpr size_t WS_DK = 242 * MiB;
constexpr size_t WS_DV = 274 * MiB;
constexpr size_t WS_GA = 306 * MiB;
constexpr size_t WS_GB = 370 * MiB;
constexpr size_t WS_HB = 434 * MiB;
constexpr size_t WS_END = 498 * MiB;
constexpr size_t WS_RSTD = WS_MISC + 2 * MiB;
constexpr size_t WS_RSTD1 = WS_MISC + 2 * MiB + 131072;
constexpr size_t WS_H = WS_DK;
constexpr int CW_QCTR = 64;
constexpr int CW_ECNT = 1024;
constexpr int CW_BAR = 4096;

constexpr int LDS_BYTES = 151552;
constexpr int LDS_MISC = 147456;

struct Params {
    const float* x; const float* norm1_g; const float* w_in; const float* cmp_pe; const float* cmp_w1; const float* cmp_b1; const float* cmp_w2; const float* cmp_b2;
    const float* diff_lambda; const float* diff_subln_g; const float* w_branch_a; const float* w_branch_b; const float* w_out; const float* norm2_g;
    const float* router_grp_w; const float* router_grp_b; const float* router_exp_w; const float* router_exp_b; const float* exp_w_gate; const float* exp_w_up; const float* exp_w_down; const float* final_norm_g;
    float* out; unsigned char* ws; int ph_lo, ph_hi;
};

typedef const __attribute__((address_space(4))) Params& PRef;

constexpr int LDS_WTAB = LDS_MISC + 512;
__device__ __forceinline__ int hw_wave_key() { return (int)(__builtin_amdgcn_s_getreg((5 << 11) | 4) & 63u); }
__device__ __forceinline__ int TIDX() {
    int lane, key;
    asm volatile("v_mbcnt_lo_u32_b32 %0, -1, 0\n\tv_mbcnt_hi_u32_b32 %0, -1, %0\n\ts_getreg_b32 %1, hwreg(HW_REG_HW_ID, 0, 6)" : "=&v"(lane), "=s"(key));
    const int wv = __builtin_amdgcn_readfirstlane(((LAS const int*)(size_t)LDS_WTAB)[key]);
    return wv * 64 + lane;
}
__device__ __forceinline__ int BID() { int b = (int)blockIdx.x; asm volatile("" : "+s"(b)); return b; }
__device__ __forceinline__ int GSZ() { int g = (int)gridDim.x; asm volatile("" : "+s"(g)); return g; }
__device__ __forceinline__ unsigned cvtpk(float lo, float hi) { f32x2 v = {lo, hi}; bf16x2_t b = __builtin_convertvector(v, bf16x2_t); return __builtin_bit_cast(unsigned, b); }
__device__ __forceinline__ float bflo(unsigned u) { return __uint_as_float(u << 16); }
__device__ __forceinline__ float bfhi(unsigned u) { return __uint_as_float(u & 0xffff0000u); }
__device__ __forceinline__ float bf1(bf16_t b) { return __uint_as_float(((unsigned)b) << 16); }
__device__ __forceinline__ bf16_t f2bf(float f) { return (bf16_t)(cvtpk(f, 0.f) & 0xffffu); }
__device__ __forceinline__ int crow(int r, int hi) { return (r & 3) + 8 * (r >> 2) + 4 * hi; }
__device__ __forceinline__ float shx(float v, int m, int lane) { return __int_as_float(__builtin_amdgcn_ds_bpermute((lane ^ m) << 2, __float_as_int(v))); }
__device__ __forceinline__ unsigned shxu(unsigned v, int m, int lane) { return (unsigned)__builtin_amdgcn_ds_bpermute((lane ^ m) << 2, (int)v); }
__device__ __forceinline__ float shl_(float v, int src) { return __int_as_float(__builtin_amdgcn_ds_bpermute(src << 2, __float_as_int(v))); }
__device__ __forceinline__ float wave_sum(float v, int lane) {
#pragma unroll
    for (int o = 1; o < 64; o <<= 1) v += shx(v, o, lane);
    return v;
}
__device__ __forceinline__ float s32(float x) { auto rr = __builtin_amdgcn_permlane32_swap(__float_as_uint(x), __float_as_uint(x), false, false); return __uint_as_float(rr[0]) + __uint_as_float(rr[1]); }
__device__ __forceinline__ float m32(float x) { auto rr = __builtin_amdgcn_permlane32_swap(__float_as_uint(x), __float_as_uint(x), false, false); return fmaxf(__uint_as_float(rr[0]), __uint_as_float(rr[1])); }
__device__ __forceinline__ float o32(float x, int hi) { auto rr = __builtin_amdgcn_permlane32_swap(__float_as_uint(x), __float_as_uint(x), false, false); return hi ? __uint_as_float(rr[0]) : __uint_as_float(rr[1]); }
__device__ __forceinline__ float sigm(float x) { return __builtin_amdgcn_rcpf(1.f + __builtin_amdgcn_exp2f(-1.4426950408889634f * x)); }
__device__ __forceinline__ float ex2(float x) { return __builtin_amdgcn_exp2f(x); }
__device__ __forceinline__ float alibi_slope(int i  ) { return exp2f(-8.0f * (float)i / 12.0f); }
__device__ __forceinline__ s16x4 vtr(LAS const unsigned char* p) { return __builtin_bit_cast(s16x4, __builtin_amdgcn_ds_read_tr16_b64_v4i16((LAS s16x4*)p)); }
#define MFMA32(a, b, c) __builtin_amdgcn_mfma_f32_32x32x16_bf16(a, b, c, 0, 0, 0)
#define MFMA16(a, b, c) __builtin_amdgcn_mfma_f32_16x16x32_bf16(a, b, c, 0, 0, 0)

struct ARowLin { const char* base; size_t stride; __device__ __forceinline__ const char* operator()(int r) const { return base + (size_t)r * stride; } };

template <class ARow>
__device__ __forceinline__ void sg_kloop(f32x4 (&acc)[2][4], const ARow& arow, int kstepA, const bf16_t* Bt, int ldb, int nt, LAS unsigned char* lds) {
    int tid_ = TIDX(); asm volatile("" : "+v"(tid_));
    const int tid = tid_, lane = tid & 63, wid = tid >> 6, wr = wid >> 1, wc = wid & 1, fr = lane & 15, fq = lane >> 4;
    const int lrow = tid >> 3, lch = tid & 7;
    const char* pa0 = arow(lrow) + lch * 16; const char* pa1 = arow(lrow + 64) + lch * 16;
    const char* pb0 = (const char*)(Bt + (size_t)lrow * ldb) + lch * 16; const char* pb1 = (const char*)(Bt + (size_t)(lrow + 64) * ldb) + lch * 16;
    const int wofs0 = lrow * 128 + ((lch ^ ((lrow >> 1) & 7)) << 4), wofs1 = wofs0 + 64 * 128;
    u32x4 ra0 = *(const u32x4*)pa0, ra1 = *(const u32x4*)pa1, rb0 = *(const u32x4*)pb0, rb1 = *(const u32x4*)pb1;
    for (int t = 0; t < nt; ++t) {
        __syncthreads();
        *(LAS u32x4*)(lds + wofs0) = ra0; *(LAS u32x4*)(lds + wofs1) = ra1; *(LAS u32x4*)(lds + 16384 + wofs0) = rb0; *(LAS u32x4*)(lds + 16384 + wofs1) = rb1;
        __syncthreads();
        if (t + 1 < nt) { pa0 += kstepA; pa1 += kstepA; pb0 += 128; pb1 += 128; ra0 = *(const u32x4*)pa0; ra1 = *(const u32x4*)pa1; rb0 = *(const u32x4*)pb0; rb1 = *(const u32x4*)pb1; }
#pragma unroll
        for (int ks = 0; ks < 2; ++ks) {
            bf16x8 af[2], bfr[4];
            const int ch = ks * 4 + fq;
#pragma unroll
            for (int m = 0; m < 2; ++m) { const int row = wr * 32 + m * 16 + fr; af[m] = *(LAS const bf16x8*)(lds + row * 128 + ((ch ^ ((row >> 1) & 7)) << 4)); }
#pragma unroll
            for (int n = 0; n < 4; ++n) { const int row = wc * 64 + n * 16 + fr; bfr[n] = *(LAS const bf16x8*)(lds + 16384 + row * 128 + ((ch ^ ((row >> 1) & 7)) << 4)); }
#pragma unroll
            for (int m = 0; m < 2; ++m)
#pragma unroll
                for (int n = 0; n < 4; ++n) acc[m][n] = MFMA16(bfr[n], af[m], acc[m][n]);
        }
    }
}
#define SG_ZERO(acc) do { _Pragma("unroll") for (int m_ = 0; m_ < 2; ++m_) _Pragma("unroll") for (int n_ = 0; n_ < 4; ++n_) acc[m_][n_] = (f32x4){0.f, 0.f, 0.f, 0.f}; } while (0)
#define SG_IDS int tid_ = TIDX(); asm volatile("" : "+v"(tid_)); const int tid = tid_, lane = tid & 63, wid = tid >> 6, wr = wid >> 1, wc = wid & 1, fr = lane & 15, fq = lane >> 4; (void)tid; (void)lane; (void)wid;
#define SG_ROW(m) (wr * 32 + (m) * 16 + fr)
#define SG_COL(n) (wc * 64 + (n) * 16 + 4 * fq)
__device__ __forceinline__ void st4bf(bf16_t* dst, f32x4 v) { u32x2 w; w.x = cvtpk(v[0], v[1]); w.y = cvtpk(v[2], v[3]); *(u32x2*)dst = w; }

__device__ __forceinline__ void transpose_item(const float* W, int ldw, int src_col, int valid, bf16_t* WT, int K, int dst_row, int k0, LAS float* scr, int lane, const float* gk = nullptr  ) {
    const int kq = lane >> 3, c4 = (lane & 7) * 4;
    if ((valid == 32) && ((src_col & 3) == 0) && ((ldw & 3) == 0)) {
        f32x4 v[8];
#pragma unroll
        for (int i = 0; i < 8; ++i) v[i] = *(const f32x4*)(W + (size_t)(k0 + 8 * i + kq) * ldw + src_col + c4);
        if (gk) {
#pragma unroll
            for (int i = 0; i < 8; ++i) v[i] = v[i] * gk[k0 + 8 * i + kq]; }
#pragma unroll
        for (int i = 0; i < 8; ++i) { LAS float* d = scr + (8 * i + kq) * 33 + c4; d[0] = v[i][0]; d[1] = v[i][1]; d[2] = v[i][2]; d[3] = v[i][3]; }
    } else {
        float v[32];
#pragma unroll
        for (int i = 0; i < 32; ++i) { const int kk = 2 * i + (lane >> 5), c = lane & 31; v[i] = (c < valid) ? W[(size_t)(k0 + kk) * ldw + src_col + c] * (gk ? gk[k0 + kk] : 1.f) : 0.f; }
#pragma unroll
        for (int i = 0; i < 32; ++i) { const int kk = 2 * i + (lane >> 5), c = lane & 31; scr[kk * 33 + c] = v[i]; }
    }
    asm volatile("s_waitcnt lgkmcnt(0)" ::: "memory");
    const int c = lane & 7;
#pragma unroll
    for (int j = 0; j < 4; ++j) { const int n = (lane >> 3) + 8 * j; LAS const float* s = scr + (8 * c) * 33 + n;
        u32x4 o; o.x = cvtpk(s[0 * 33], s[1 * 33]); o.y = cvtpk(s[2 * 33], s[3 * 33]); o.z = cvtpk(s[4 * 33], s[5 * 33]); o.w = cvtpk(s[6 * 33], s[7 * 33]);
        *(u32x4*)(WT + (size_t)(dst_row + n) * K + k0 + 8 * c) = o; }
    asm volatile("s_waitcnt lgkmcnt(0)" ::: "memory");
}
__device__ __forceinline__ void weight_prep(PRef p, int l, LAS unsigned char* lds) {
    int tid_ = TIDX(); asm volatile("" : "+v"(tid_));
    const int tid = tid_, lane = tid & 63, wid = tid >> 6;
    const int gw = BID() * 8 + wid, NGW = GSZ() * 8;
    LAS float* scr = (LAS float*)(lds + wid * 8448);
    unsigned char* ws = p.ws;
    constexpr int I_IN = 16 * 160, I_A = 8 * 32, I_O = 16 * 32, I_C1 = 2 * 32 * 4, I_G = 16 * 16 * 4, I_D = 16 * 2 * 32;
    constexpr int I_LAYER = I_IN + 2 * I_A + I_O + I_C1 + 2 * I_G + I_D;
    for (int it = gw; it < I_LAYER; it += NGW) {
        int r = it;
        if (r < I_IN) { const int kb = r / 160, nb = r % 160, n0 = nb * 32; int src, valid = 32;
            if (n0 < 1280) src = n0; else if (n0 < 4864) src = n0 + 24; else { src = 1280 + (n0 - 4864); valid = (n0 == 4864) ? 24 : 0; if (valid == 0) src = 0; }
            transpose_item(p.w_in + (size_t)l * DM * INCOLS, INCOLS, src, valid, (bf16_t*)(ws + WS_WIN) + (size_t)l * NPAD * DM, DM, n0, kb * 64, scr, lane, p.norm1_g + (size_t)l * DM); continue; }
        r -= I_IN;
        if (r < I_A) { const int kb = r / 32, nb = r % 32; transpose_item(p.w_branch_a + (size_t)l * 512 * DM, DM, nb * 32, 32, (bf16_t*)(ws + WS_WA) + (size_t)l * DM * 512, 512, nb * 32, kb * 64, scr, lane); continue; }
        r -= I_A;
        if (r < I_A) { const int kb = r / 32, nb = r % 32; transpose_item(p.w_branch_b + (size_t)l * 512 * DM, DM, nb * 32, 32, (bf16_t*)(ws + WS_WB) + (size_t)l * DM * 512, 512, nb * 32, kb * 64, scr, lane); continue; }
        r -= I_A;
        if (r < I_O) { const int kb = r / 32, nb = r % 32; transpose_item(p.w_out + (size_t)l * DM * DM, DM, nb * 32, 32, (bf16_t*)(ws + WS_WO) + (size_t)l * DM * DM, DM, nb * 32, kb * 64, scr, lane); continue; }
        r -= I_O;
        if (r < I_C1) { const int kv = r / 128, r2 = r % 128, kb = r2 / 4, nb = r2 % 4;
            transpose_item(p.cmp_w1 + (size_t)(l * 2 + kv) * 2048 * 128, 128, nb * 32, 32, (bf16_t*)(ws + WS_WC1) + (size_t)(l * 2 + kv) * 128 * 2048, 2048, nb * 32, kb * 64, scr, lane); continue; }
        r -= I_C1;
        if (r < 2 * I_G) { const int which = r / I_G, r2 = r % I_G, e = r2 / 64, r3 = r2 % 64, kb = r3 / 4, nb = r3 % 4;
            const float* W = (which ? p.exp_w_up : p.exp_w_gate) + (size_t)(l * 16 + e) * DM * 128;
            transpose_item(W, 128, nb * 32, 32, (bf16_t*)(ws + WS_WGU) + (size_t)(l * 16 + e) * 256 * DM, DM, which * 128 + nb * 32, kb * 64, scr, lane, p.norm2_g + (size_t)l * DM); continue; }
        r -= 2 * I_G;
        { const int e = r / 64, r3 = r % 64, kb = r3 / 32, nb = r3 % 32;
            transpose_item(p.exp_w_down + (size_t)(l * 16 + e) * 128 * DM, DM, nb * 32, 32, (bf16_t*)(ws + WS_WD) + (size_t)(l * 16 + e) * DM * 128, 128, nb * 32, kb * 64, scr, lane); }
    }
}
__device__ __forceinline__ void phase_prologue(PRef p, LAS unsigned char* lds) {
    int tid_ = TIDX(); asm volatile("" : "+v"(tid_));
    const int tid = tid_, lane = tid & 63, wid = tid >> 6;
    const int gw = BID() * 8 + wid, NGW = GSZ() * 8;
    LAS float* scr = (LAS float*)(lds + wid * 8448);
    unsigned char* ws = p.ws;
    weight_prep(p, 0, lds);
    for (int m0 = gw * 4; m0 < NTOK; m0 += NGW * 4) {
        f32x4 v[4][4];
#pragma unroll
        for (int rr = 0; rr < 4; ++rr)
#pragma unroll
            for (int j = 0; j < 4; ++j) v[rr][j] = *(const f32x4*)(p.x + (size_t)(m0 + rr) * DM + (64 * j + lane) * 4);
#pragma unroll
        for (int rr = 0; rr < 4; ++rr) { float ss = 0.f;
#pragma unroll
            for (int j = 0; j < 4; ++j) ss += (v[rr][j][0] * v[rr][j][0] + v[rr][j][1] * v[rr][j][1]) + (v[rr][j][2] * v[rr][j][2] + v[rr][j][3] * v[rr][j][3]);
            const float rstd = rsqrtf(wave_sum(ss, lane) * (1.f / 1024.f) + 1e-6f);
            if (lane == 0) ((float*)(ws + WS_RSTD1))[m0 + rr] = rstd;
#pragma unroll
            for (int j = 0; j < 4; ++j) st4bf((bf16_t*)(ws + WS_HB) + (size_t)(m0 + rr) * DM + (64 * j + lane) * 4, v[rr][j]); }
    }
    __syncthreads();
    if (BID() < 8) {
        const int l = BID() >> 2, kv = (BID() >> 1) & 1, jh = BID() & 1, j = jh * 64 + lane;
        const float* pe = p.cmp_pe + (size_t)(l * 2 + kv) * 2048; const float* w1 = p.cmp_w1 + (size_t)(l * 2 + kv) * 2048 * 128;
        float s = 0.f;
        for (int f = wid * 256; f < wid * 256 + 256; ++f) s += pe[f] * w1[(size_t)f * 128 + j];
        LAS float* part = (LAS float*)(lds + 70000);
        part[wid * 64 + lane] = s;
        __syncthreads();
        if (wid == 0) { float t = p.cmp_b1[(l * 2 + kv) * 128 + j];
#pragma unroll
            for (int w = 0; w < 8; ++w) t += part[w * 64 + lane];
            ((float*)(ws + WS_MISC))[(l * 2 + kv) * 128 + j] = t; }
    }
    if (BID() == 8 && wid < DEPTH) {
        const int l = wid; const float* lp = p.diff_lambda + l * 256;
        const float a = wave_sum(lp[lane] * lp[64 + lane], lane), b = wave_sum(lp[128 + lane] * lp[192 + lane], lane);
        const float lam_init = (l == 0) ? 0.2f : 0.35550906f;
        if (lane == 0) ((float*)(ws + WS_MISC + 4096))[l] = expf(a) - expf(b) + lam_init;
    }
}

namespace pg8 {
#define PG8_LAS __attribute__((address_space(3)))
constexpr int BM = 256, BK = 64, HALF = 128, HTB = HALF * BK * 2  , STAGE_BYTES = 8 * HTB, NXCD = 8, WGM = 8;

__host__ __device__ __forceinline__ int lds_byte(int r, int c) { const int st = (r >> 4) * 2 + (c >> 5), rr = r & 15, cc = c & 31, ob = rr * 64 + cc * 2; return st * 1024 + (ob ^ (((ob >> 9) & 1) << 5)); }
__host__ __device__ __forceinline__ void stage_rc(int b, int& R, int& C) { const int st = b / 1024, sb = b % 1024, swz = sb ^ (((sb >> 9) & 1) << 5); R = (st >> 1) * 16 + swz / 64; C = (st & 1) * 32 + (swz % 64) / 2; }
__host__ __device__ __forceinline__ int perm32(int rho) { const int n = rho >> 4, i = rho & 15; return 8 * (i >> 2) + 4 * n + (i & 3); }

struct Unit { int pm, pn, z; };
struct Gemm { const bf16_t* A; const bf16_t* Bt; const bf16_t* A2; const bf16_t* Bt2; int M, N, K; };

struct StaticOrder {
    int nM, nN, nwg, G, c;
    __host__ __device__ void init(int M, int N, int G_, int c_) { nM = M / BM; nN = N / BM; nwg = nM * nN; G = G_; c = c_; }
    __host__ __device__ bool next(int i, Unit& u) const {
        const long L = (long)i * G + c; if (L >= nwg) return false;
        int wgid = (int)L; { const int q = nwg / NXCD, r = nwg % NXCD, xcd = wgid % NXCD, off = wgid / NXCD; wgid = (xcd < r ? xcd * (q + 1) : r * (q + 1) + (xcd - r) * q) + off; }
        const int nig = WGM * nN, gid = wgid / nig, fm = gid * WGM, gsz = (nM - fm) < WGM ? (nM - fm) : WGM;
        u.pm = fm + ((wgid % nig) % gsz); u.pn = (wgid % nig) / gsz; u.z = 0; return true;
    }
    __device__ __forceinline__ void a_ready(const Unit&) const {}
    __device__ __forceinline__ void done(const Unit&) const {}
};

template <class Epi, class Sched, bool ALIGN_EPI = false, bool SP2 = false>
__device__ __forceinline__ void gemm_phase(PG8_LAS unsigned char* lds, const Gemm g, const Sched& S, const Epi& E) {
    int tid_ = TIDX(); asm volatile("" : "+v"(tid_));
    const int tid = tid_, wid = __builtin_amdgcn_readfirstlane(tid >> 6), lane = tid & 63, wr = wid >> 2, wc = wid & 3, fr = lane & 15, fq = lane >> 4;
    const int K = g.K, nt = K / BK;
    unsigned voffA[2], voffB[2];
#pragma unroll
    for (int i = 0; i < 2; ++i) { int R, C; stage_rc(tid * 16 + i * 8192, R, C); const int Rb = Epi::PERM ? (64 * (R >> 5) + perm32(R & 31)) : R;
        voffA[i] = (unsigned)(R * K + C) * 2u; voffB[i] = (unsigned)(Rb * K + C) * 2u; }
    const size_t kstep = (size_t)(BK * 2);
    const size_t hstep = (size_t)HALF * K * 2;
    const size_t tstep = 2 * hstep;
    const size_t hstepB = Epi::PERM ? (size_t)32 * K * 2 : hstep;
    const unsigned ldsw = (unsigned)wid * 1024u;
    const int aoff = lds_byte(wr * 64 + fr, fq * 8), boff = lds_byte(wc * 32 + fr, fq * 8);
#define PG8_SA(b, h) (((b) * 2 + (h)) * HTB)
#define PG8_SB(b, h) ((4 + (b) * 2 + (h)) * HTB)
#define PG8_STAGE(bufoff, gbase, voff) do { _Pragma("unroll") for (int _i = 0; _i < 2; ++_i) \
        __builtin_amdgcn_global_load_lds((const unsigned*)((const char*)(gbase) + (voff)[_i]), (PG8_LAS unsigned*)(lds + (bufoff) + ldsw + _i * 8192), 16, 0, 0); } while (0)
#define PG8_LDA(dst, b, h) do { _Pragma("unroll") for (int m = 0; m < 4; ++m) _Pragma("unroll") for (int k = 0; k < 2; ++k) dst[m][k] = *(const PG8_LAS bf16x8*)(lds + PG8_SA(b, h) + aoff + m * 2048 + k * 1024); } while (0)
#define PG8_LDB(dst, b, h) do { _Pragma("unroll") for (int n = 0; n < 2; ++n) _Pragma("unroll") for (int k = 0; k < 2; ++k) dst[n][k] = *(const PG8_LAS bf16x8*)(lds + PG8_SB(b, h) + boff + n * 2048 + k * 1024); } while (0)
#define PG8_MMA(ai, bj, At, Bt) do { __builtin_amdgcn_s_setprio(1); _Pragma("unroll") for (int m = 0; m < 4; ++m) _Pragma("unroll") for (int n = 0; n < 2; ++n) _Pragma("unroll") for (int k = 0; k < 2; ++k) \
        acc[ai][bj][m][n] = __builtin_amdgcn_mfma_f32_16x16x32_bf16(Bt[n][k], At[m][k], acc[ai][bj][m][n], 0, 0, 0); __builtin_amdgcn_s_setprio(0); } while (0)
#define PG8_WAIT_V(n) asm volatile("s_waitcnt vmcnt(" #n ")" ::: "memory")
#define PG8_WAIT_L(n) asm volatile("s_waitcnt lgkmcnt(" #n ")" ::: "memory")
#define PG8_BAR __builtin_amdgcn_s_barrier()
#define PG8_SCHED __builtin_amdgcn_sched_barrier(0)
    Unit cur, nxt; int ui = 0;
    if (!S.next(0, cur)) return;
    f32x4 acc[2][2][4][2];
#pragma unroll
    for (int a = 0; a < 2; ++a)
#pragma unroll
        for (int b = 0; b < 2; ++b)
#pragma unroll
            for (int m = 0; m < 4; ++m)
#pragma unroll
                for (int n = 0; n < 2; ++n) acc[a][b][m][n] = (f32x4){0.f, 0.f, 0.f, 0.f};
    bf16x8 At[4][2], B0[2][2], B1[2][2];
    const char* cA = (const char*)(cur.z ? g.A2 : g.A) + (size_t)cur.pm * tstep; const char* cB = (const char*)(cur.z ? g.Bt2 : g.Bt) + (size_t)cur.pn * tstep;
    S.a_ready(cur);
    if constexpr (SP2) {
        PG8_STAGE(PG8_SB(0, 0), cB, voffB); PG8_STAGE(PG8_SB(0, 1), cB + hstepB, voffB); PG8_STAGE(PG8_SA(0, 0), cA, voffA); PG8_STAGE(PG8_SA(0, 1), cA + hstep, voffA);
        if (wr == 1) PG8_BAR;
        PG8_WAIT_V(2); PG8_BAR;
        PG8_STAGE(PG8_SB(1, 0), cB + kstep, voffB); PG8_STAGE(PG8_SA(1, 0), cA + kstep, voffA); PG8_STAGE(PG8_SB(1, 1), cB + hstepB + kstep, voffB);
        PG8_WAIT_V(6); PG8_BAR;
    } else {
        PG8_STAGE(PG8_SB(0, 0), cB, voffB); PG8_STAGE(PG8_SA(0, 0), cA, voffA); PG8_STAGE(PG8_SB(0, 1), cB + hstepB, voffB); PG8_STAGE(PG8_SA(0, 1), cA + hstep, voffA);
        if (wr == 1) PG8_BAR;
        PG8_WAIT_V(4); PG8_BAR;
        PG8_STAGE(PG8_SB(1, 0), cB + kstep, voffB); PG8_STAGE(PG8_SA(1, 0), cA + kstep, voffA); PG8_STAGE(PG8_SB(1, 1), cB + hstepB + kstep, voffB);
        PG8_WAIT_V(6); PG8_BAR;
    }
    for (;;) {
        const bool has_next = S.next(ui + 1, nxt);
        const char* nA = has_next ? (const char*)(nxt.z ? g.A2 : g.A) + (size_t)nxt.pm * tstep : cA; const char* nB = has_next ? (const char*)(nxt.z ? g.Bt2 : g.Bt) + (size_t)nxt.pn * tstep : cB;
        for (int t = 0; t < nt; t += 2) {
            const bool last = (t == nt - 2);
            const char* a1 = cA + (size_t)(t + 1) * kstep;
            const char* a2 = last ? nA : cA + (size_t)(t + 2) * kstep; const char* b2 = last ? nB : cB + (size_t)(t + 2) * kstep;
            const char* a3 = a2 + kstep; const char* b3 = b2 + kstep;
            if (last && has_next) S.a_ready(nxt);
            if constexpr (SP2) {
            PG8_LDB(B0, 0, 0); PG8_LDB(B1, 0, 1); PG8_SCHED; PG8_LDA(At, 0, 0); PG8_STAGE(PG8_SA(1, 1), a1 + hstep, voffA);
            PG8_WAIT_V(8); PG8_WAIT_L(0); PG8_BAR; PG8_MMA(0, 0, At, B0); PG8_MMA(0, 1, At, B1); PG8_BAR; PG8_SCHED;
            PG8_LDA(At, 0, 1); PG8_STAGE(PG8_SB(0, 0), b2, voffB); PG8_STAGE(PG8_SB(0, 1), b2 + hstepB, voffB); PG8_STAGE(PG8_SA(0, 0), a2, voffA);
            PG8_WAIT_V(8); PG8_WAIT_L(0); PG8_BAR; PG8_MMA(1, 0, At, B0); PG8_MMA(1, 1, At, B1); PG8_BAR; PG8_SCHED;
            PG8_LDB(B0, 1, 0); PG8_LDB(B1, 1, 1); PG8_SCHED; PG8_LDA(At, 1, 0); PG8_STAGE(PG8_SA(0, 1), a2 + hstep, voffA);
            PG8_WAIT_V(8); PG8_WAIT_L(0); PG8_BAR; PG8_MMA(0, 0, At, B0); PG8_MMA(0, 1, At, B1); PG8_BAR; PG8_SCHED;
            PG8_LDA(At, 1, 1); PG8_STAGE(PG8_SB(1, 0), b3, voffB); PG8_STAGE(PG8_SB(1, 1), b3 + hstepB, voffB); PG8_STAGE(PG8_SA(1, 0), a3, voffA);
            PG8_WAIT_V(8); PG8_WAIT_L(0); PG8_BAR; PG8_MMA(1, 0, At, B0); PG8_MMA(1, 1, At, B1); PG8_BAR; PG8_SCHED;
            } else {
            PG8_LDB(B0, 0, 0); PG8_SCHED; PG8_LDA(At, 0, 0); PG8_STAGE(PG8_SA(1, 1), a1 + hstep, voffA);
            PG8_WAIT_L(8); PG8_BAR; PG8_WAIT_L(0); PG8_MMA(0, 0, At, B0); PG8_BAR; PG8_SCHED;
            PG8_LDB(B1, 0, 1); PG8_STAGE(PG8_SB(0, 0), b2, voffB);
            PG8_BAR; PG8_WAIT_L(0); PG8_MMA(0, 1, At, B1); PG8_BAR;
            PG8_LDA(At, 0, 1); PG8_STAGE(PG8_SA(0, 0), a2, voffA);
            PG8_BAR; PG8_WAIT_L(0); PG8_MMA(1, 0, At, B0); PG8_BAR; PG8_SCHED;
            PG8_STAGE(PG8_SB(0, 1), b2 + hstepB, voffB);
            PG8_WAIT_V(6); PG8_BAR; PG8_MMA(1, 1, At, B1); PG8_BAR;
            PG8_LDB(B0, 1, 0); PG8_SCHED; PG8_LDA(At, 1, 0); PG8_STAGE(PG8_SA(0, 1), a2 + hstep, voffA);
            PG8_WAIT_L(8); PG8_BAR; PG8_WAIT_L(0); PG8_MMA(0, 0, At, B0); PG8_BAR; PG8_SCHED;
            PG8_LDB(B1, 1, 1); PG8_STAGE(PG8_SB(1, 0), b3, voffB);
            PG8_BAR; PG8_WAIT_L(0); PG8_MMA(0, 1, At, B1); PG8_BAR;
            PG8_LDA(At, 1, 1); PG8_STAGE(PG8_SA(1, 0), a3, voffA);
            PG8_BAR; PG8_WAIT_L(0); PG8_MMA(1, 0, At, B0); PG8_BAR; PG8_SCHED;
            PG8_STAGE(PG8_SB(1, 1), b3 + hstepB, voffB);
            PG8_WAIT_V(6); PG8_BAR; PG8_MMA(1, 1, At, B1); PG8_BAR;
            }
        }
        if constexpr (ALIGN_EPI) { if (wr == 0) PG8_BAR; }
        if constexpr (!Epi::AFTER_DRAIN) { E(acc, cur, wr, wc, fr, fq); S.done(cur); }
        if (!has_next) break;
        if (!Epi::keep(cur)) {
#pragma unroll
        for (int a = 0; a < 2; ++a)
#pragma unroll
            for (int b = 0; b < 2; ++b)
#pragma unroll
                for (int m = 0; m < 4; ++m)
#pragma unroll
                    for (int n = 0; n < 2; ++n) acc[a][b][m][n] = (f32x4){0.f, 0.f, 0.f, 0.f}; }
        cur = nxt; cA = nA; cB = nB; ++ui;
        if constexpr (ALIGN_EPI) { if (wr == 1) PG8_BAR; }
    }
    PG8_WAIT_V(0);
    if constexpr (!ALIGN_EPI) { if (wr == 0) PG8_BAR; }
    PG8_BAR;
    if constexpr (Epi::AFTER_DRAIN) { E.fused(acc, cur, wr, wc, fr, fq, lds, wid, lane); S.done(cur); }
#undef PG8_SA
#undef PG8_SB
#undef PG8_STAGE
#undef PG8_LDA
#undef PG8_LDB
#undef PG8_MMA
#undef PG8_WAIT_V
#undef PG8_WAIT_L
#undef PG8_BAR
#undef PG8_SCHED
}
}

typedef pg8::Unit PUnit;
__device__ __forceinline__ unsigned ror8(unsigned v) { return (unsigned)__builtin_amdgcn_mov_dpp((int)v, 0x128, 0xf, 0xf, true); }
__device__ __forceinline__ void st_lines(bf16_t* px  , size_t pitch8  , const u32x4 w0, const u32x4 w1, bool lo) {
    u32x4 snd, rcv, x, y;
    snd.x = lo ? w1.x : w0.x; snd.y = lo ? w1.y : w0.y; snd.z = lo ? w1.z : w0.z; snd.w = lo ? w1.w : w0.w;
    rcv.x = ror8(snd.x); rcv.y = ror8(snd.y); rcv.z = ror8(snd.z); rcv.w = ror8(snd.w);
    x.x = lo ? w0.x : rcv.x; x.y = lo ? w0.y : rcv.y; x.z = lo ? w0.z : rcv.z; x.w = lo ? w0.w : rcv.w;
    y.x = lo ? rcv.x : w1.x; y.y = lo ? rcv.y : w1.y; y.z = lo ? rcv.z : w1.z; y.w = lo ? rcv.w : w1.w;
    *(u32x4*)px = x; *(u32x4*)(px + pitch8) = y;
}
template <int AB> struct EpiInprojT {
    static constexpr bool PERM = true, AFTER_DRAIN = false;
    unsigned char* ws;
    static __device__ __forceinline__ bool keep(const PUnit&) { return false; }
    __device__ __forceinline__ void operator()(f32x4 (&acc)[2][2][4][2], const PUnit& u, int wr, int wc, int fr, int fq) const {
        const int n0 = u.pn * 256;
        bf16_t* dst; int pitch, c0, mode = 0;
        if (n0 < 512) { dst = (bf16_t*)(ws + WS_NQ); pitch = 512; c0 = n0; mode = 1; }
        else if (n0 < 1280) { dst = (bf16_t*)(ws + WS_KV6); pitch = 768; c0 = n0 - 512; }
        else if (n0 < 1792) { dst = (bf16_t*)(ws + WS_DQ); pitch = 512; c0 = n0 - 1280; mode = 1; }
        else if (n0 < 2304) { dst = (bf16_t*)(ws + WS_DK); pitch = 512; c0 = n0 - 1792; }
        else if (n0 < 2816) { dst = (bf16_t*)(ws + WS_DV); pitch = 512; c0 = n0 - 2304; }
        else if (n0 < 3840) { dst = (bf16_t*)(ws + WS_GA); pitch = 1024; c0 = n0 - 2816; mode = 2; }
        else if (n0 < 4864) { dst = (bf16_t*)(ws + WS_GB); pitch = 1024; c0 = n0 - 3840; mode = 2; }
        else { dst = (bf16_t*)(ws + WS_NG); pitch = 32; c0 = 0; mode = 3; }
        int rsub = 0;
        if (AB == 3 && mode != 3) { dst = (bf16_t*)(ws + WS_XN) + (size_t)BID() * 65536; pitch = 256; c0 = 0; rsub = u.pm * 256; }
        asm volatile("" : "+v"(fr), "+v"(fq));
        const int row0 = u.pm * 256 + wr * 64 + fr;
        const bool lo = (fr & 8) == 0;
        const int rowx = u.pm * 256 + wr * 64 + (fr & 7), colx = wc * 64 + (lo ? 0 : 32) + 8 * fq;
        float rsv[2][4];
#pragma unroll
        for (int ai = 0; ai < 2; ++ai)
#pragma unroll
            for (int m = 0; m < 4; ++m) rsv[ai][m] = ((const float*)(ws + WS_RSTD1))[row0 + ai * 128 + m * 16];
#pragma unroll
        for (int ai = 0; ai < 2; ++ai)
#pragma unroll
            for (int m = 0; m < 4; ++m) {
                const float rs = rsv[ai][m];
                u32x4 w[2]; u32x2 g8[2];
#pragma unroll
                for (int bj = 0; bj < 2; ++bj) { f32x4 v0 = acc[ai][bj][m][0] * rs, v1 = acc[ai][bj][m][1] * rs;
                    if (AB == 2) { asm volatile("" :: "v"(v0), "v"(v1)); continue; }
                    if (AB == 1) {} else if (mode == 1) { v0 = v0 * QSCALE; v1 = v1 * QSCALE; }
                    else if (mode == 2) { unsigned d0 = 0u, d1 = 0u;
#pragma unroll
                        for (int i = 0; i < 4; ++i) { d0 = __builtin_amdgcn_cvt_pk_u8_f32(fmaf(sigm(v0[i]), 256.f, -0.5f), i, d0); d1 = __builtin_amdgcn_cvt_pk_u8_f32(fmaf(sigm(v1[i]), 256.f, -0.5f), i, d1); }
                        g8[bj].x = d0; g8[bj].y = d1; continue; }
                    else if (mode == 3) {
#pragma unroll
                        for (int i = 0; i < 4; ++i) { v0[i] = sigm(v0[i]); v1[i] = sigm(v1[i]); } }
                    w[bj].x = cvtpk(v0[0], v0[1]); w[bj].y = cvtpk(v0[2], v0[3]); w[bj].z = cvtpk(v1[0], v1[1]); w[bj].w = cvtpk(v1[2], v1[3]); }
                if (AB == 2) continue;
                if (mode == 3) { if (wc == 0) *(u32x4*)(dst + (size_t)(row0 + ai * 128 + m * 16) * pitch + 8 * fq) = w[0]; }
                else if (mode == 2) *(u32x4*)((unsigned char*)dst + (size_t)(row0 - rsub + ai * 128 + m * 16) * (AB == 3 ? 256 : 1024) + c0 + wc * 64 + fq * 16) = (u32x4){g8[0].x, g8[0].y, g8[1].x, g8[1].y};
                else st_lines(dst + (size_t)(rowx - rsub + ai * 128 + m * 16) * pitch + c0 + colx, (size_t)8 * pitch, w[0], w[1], lo); }
    }
};
struct EpiMerge {
    static constexpr bool PERM = true, AFTER_DRAIN = false;
    const bf16_t* GA; const bf16_t* GB; bf16_t* MG;
    static __device__ __forceinline__ bool keep(const PUnit& u) { return u.z == 0; }
    __device__ __forceinline__ void operator()(f32x4 (&acc)[2][2][4][2], const PUnit& u, int wr, int wc, int fr, int fq) const {
        asm volatile("" : "+v"(fr), "+v"(fq));
        const int row0 = u.pm * 256 + wr * 64 + fr, col0 = u.pn * 256 + wc * 64 + 8 * fq;
        const bool lo = (fr & 8) == 0;
        const int rowx = u.pm * 256 + wr * 64 + (fr & 7), colx = u.pn * 256 + wc * 64 + (lo ? 0 : 32) + 8 * fq;
#pragma unroll
        for (int ai = 0; ai < 2; ++ai)
#pragma unroll
            for (int m = 0; m < 4; ++m) { const size_t ro = (size_t)(row0 + ai * 128 + m * 16) * DM + col0;
                u32x4 wq[2];
                const size_t go = (size_t)(row0 + ai * 128 + m * 16) * 1024 + u.pn * 256 + wc * 64 + fq * 16;
                const u32x4 gb = *(const u32x4*)((const unsigned char*)GB + go);
                u32x4 ga = gb; if (u.z == 0) ga = *(const u32x4*)((const unsigned char*)GA + go);
#pragma unroll
                for (int bj = 0; bj < 2; ++bj) {
                    const unsigned gb0 = bj ? gb.z : gb.x, gb1 = bj ? gb.w : gb.y, ga0 = bj ? ga.z : ga.x, ga1 = bj ? ga.w : ga.y;
                    f32x4 b0, b1;
#pragma unroll
                    for (int i = 0; i < 4; ++i) { b0[i] = (float)((gb0 >> (8 * i)) & 0xffu) + 0.5f; b1[i] = (float)((gb1 >> (8 * i)) & 0xffu) + 0.5f; }
                    if (u.z == 0) {
#pragma unroll
                        for (int i = 0; i < 4; ++i) { const float a0 = (float)((ga0 >> (8 * i)) & 0xffu) + 0.5f, a1 = (float)((ga1 >> (8 * i)) & 0xffu) + 0.5f;
                            acc[ai][bj][m][0][i] *= a0 * __builtin_amdgcn_rcpf(b0[i]); acc[ai][bj][m][1][i] *= a1 * __builtin_amdgcn_rcpf(b1[i]); } }
                    else { const f32x4 v0 = acc[ai][bj][m][0] * b0 * (1.f / 256.f), v1 = acc[ai][bj][m][1] * b1 * (1.f / 256.f);
                        wq[bj].x = cvtpk(v0[0], v0[1]); wq[bj].y = cvtpk(v0[2], v0[3]); wq[bj].z = cvtpk(v1[0], v1[1]); wq[bj].w = cvtpk(v1[2], v1[3]); } }
                if (u.z != 0) st_lines(MG + (size_t)(rowx + ai * 128 + m * 16) * DM + colx, (size_t)8 * DM, wq[0], wq[1], lo); }
    }
};
struct MergeOrder {
    int G, c;
    __device__ __forceinline__ bool next(int i, PUnit& u) const { const int t = (i >> 1) * G + c; if (t >= 512) return false;
        int wgid = t; { const int q = 512 / 8, xcd = wgid % 8, off = wgid / 8; wgid = xcd * q + off; }
        u.pm = (wgid >> 5) * 8 + (wgid & 7); u.pn = (wgid >> 3) & 3; u.z = i & 1; return true; }
    __device__ __forceinline__ void a_ready(const PUnit&) const {}
    __device__ __forceinline__ void done(const PUnit&) const {}
};
struct EpiOut {
    static constexpr bool PERM = true, AFTER_DRAIN = false;
    const float* xin; const bf16_t* hin; bf16_t* hout;
    static __device__ __forceinline__ bool keep(const PUnit&) { return false; }
    __device__ __forceinline__ void operator()(f32x4 (&acc)[2][2][4][2], const PUnit& u, int wr, int wc, int fr, int fq) const {
        asm volatile("" : "+v"(fr), "+v"(fq));
        const int row0 = u.pm * 256 + wr * 64 + fr, col0 = u.pn * 256 + wc * 64 + 8 * fq;
        const bool lo = (fr & 8) == 0;
        const int rowx = u.pm * 256 + wr * 64 + (fr & 7), colx = u.pn * 256 + wc * 64 + (lo ? 0 : 32) + 8 * fq;
#pragma unroll
        for (int ai = 0; ai < 2; ++ai)
#pragma unroll
            for (int m = 0; m < 4; ++m) { const size_t ro = (size_t)(row0 + ai * 128 + m * 16) * DM + col0;
                u32x4 wq[2];
#pragma unroll
                for (int bj = 0; bj < 2; ++bj) { const size_t off = ro + bj * 32; f32x4 b0, b1;
                    if (xin) { b0 = *(const f32x4*)(xin + off); b1 = *(const f32x4*)(xin + off + 4); }
                    else { const u32x4 hb = *(const u32x4*)(hin + off); b0 = (f32x4){bflo(hb.x), bfhi(hb.x), bflo(hb.y), bfhi(hb.y)}; b1 = (f32x4){bflo(hb.z), bfhi(hb.z), bflo(hb.w), bfhi(hb.w)}; }
                    const f32x4 v0 = b0 + acc[ai][bj][m][0], v1 = b1 + acc[ai][bj][m][1];
                    wq[bj].x = cvtpk(v0[0], v0[1]); wq[bj].y = cvtpk(v0[2], v0[3]); wq[bj].z = cvtpk(v1[0], v1[1]); wq[bj].w = cvtpk(v1[2], v1[3]); }
                st_lines(hout + (size_t)(rowx + ai * 128 + m * 16) * DM + colx, (size_t)8 * DM, wq[0], wq[1], lo); }
    }
};
typedef EpiInprojT<0> EpiInproj;
template <int AB> __device__ __forceinline__ void phase_inproj_pg8(PRef p, int l, LAS unsigned char* lds) {
    unsigned char* ws = p.ws;
    const bf16_t* W = (const bf16_t*)(ws + WS_WIN) + (size_t)l * NPAD * DM;
    pg8::Gemm g{(const bf16_t*)(ws + WS_HB), W, (const bf16_t*)(ws + WS_HB), W, NTOK, NPAD, DM};
    pg8::StaticOrder S; S.init(NTOK, NPAD, GSZ(), BID());
    EpiInprojT<AB> E{ws};
    pg8::gemm_phase<EpiInprojT<AB>, pg8::StaticOrder, true, true>(lds, g, S, E);
}
__device__ __forceinline__ void phase_merge_pg8(PRef p, int l, LAS unsigned char* lds) {
    unsigned char* ws = p.ws;
    pg8::Gemm g{(const bf16_t*)(ws + WS_NQ), (const bf16_t*)(ws + WS_WA) + (size_t)l * DM * 512, (const bf16_t*)(ws + WS_DQ), (const bf16_t*)(ws + WS_WB) + (size_t)l * DM * 512, NTOK, DM, 512};
    MergeOrder S{GSZ(), BID()};
    EpiMerge E{(const bf16_t*)(ws + WS_GA), (const bf16_t*)(ws + WS_GB), (bf16_t*)(ws + WS_XN)};
    pg8::gemm_phase<EpiMerge, MergeOrder, true, true>(lds, g, S, E);
}
__device__ __forceinline__ void phase_outproj_pg8(PRef p, int l, LAS unsigned char* lds, bool dry = false) {
    unsigned char* ws = p.ws;
    const bf16_t* WO = (const bf16_t*)(ws + WS_WO) + (size_t)l * DM * DM;
    pg8::Gemm g{(const bf16_t*)(ws + WS_XN), WO, (const bf16_t*)(ws + WS_XN), WO, NTOK, DM, DM};
    pg8::StaticOrder S; S.init(NTOK, DM, GSZ(), BID());
    EpiOut E{(const float*)nullptr, (const bf16_t*)(ws + WS_HB), dry ? (bf16_t*)(ws + WS_GA) : (bf16_t*)(ws + WS_HB)};
    pg8::gemm_phase<EpiOut, pg8::StaticOrder, true, true>(lds, g, S, E);
}

__device__ __forceinline__ int kswz(int row, int ch) { return row * 128 + ((ch ^ ((row >> 1) & 7)) << 4); }
__device__ __forceinline__ void stage_k(LAS unsigned char* kdst, const bf16_t* src  , int pitch, int tid) {
    const int row = tid >> 3, ch = tid & 7;
    *(LAS u32x4*)(kdst + kswz(row, ch)) = *(const u32x4*)(src + (size_t)row * pitch + ch * 8);
}
template <int NDB> __device__ __forceinline__ void stage_v(LAS unsigned char* vdst, const bf16_t* src, int pitch, int tid) {
#pragma unroll
    for (int i = 0; i < NDB / 2; ++i) { const int pc = tid + 512 * i, pw = pc >> 6, ln = pc & 63, db = pw >> 2, rg = pw & 3;
        *(LAS u32x4*)(vdst + pw * 1024 + ln * 16) = *(const u32x4*)(src + (size_t)(16 * rg + (ln >> 2)) * pitch + db * 32 + (ln & 3) * 8); }
}
__device__ __forceinline__ void qkt(f32x16& p0, f32x16& p1, LAS const unsigned char* K, const bf16x8 (&qr)[4], int r32, int hi) {
    p0 = (f32x16){0.f}; p1 = (f32x16){0.f};
#pragma unroll
    for (int d0 = 0; d0 < 4; ++d0) {
        LAS const unsigned char* kb = K + kswz(r32, 2 * d0 + hi);
        const bf16x8 b0 = *(LAS const bf16x8*)(kb), b1 = *(LAS const bf16x8*)(kb + 4096);
        p0 = MFMA32(b0, qr[d0], p0); p1 = MFMA32(b1, qr[d0], p1);
    }
    __builtin_amdgcn_sched_barrier(0);
}
template <int NDB> __device__ __forceinline__ void pv(f32x16 (&o)[NDB], const f32x16& p0, const f32x16& p1, LAS const unsigned char* V, int lane, int hi) {
    u32x4 pw[4];
    pw[0] = (u32x4){cvtpk(p0[0], p0[1]), cvtpk(p0[2], p0[3]), cvtpk(p0[4], p0[5]), cvtpk(p0[6], p0[7])};
    pw[1] = (u32x4){cvtpk(p0[8], p0[9]), cvtpk(p0[10], p0[11]), cvtpk(p0[12], p0[13]), cvtpk(p0[14], p0[15])};
    pw[2] = (u32x4){cvtpk(p1[0], p1[1]), cvtpk(p1[2], p1[3]), cvtpk(p1[4], p1[5]), cvtpk(p1[6], p1[7])};
    pw[3] = (u32x4){cvtpk(p1[8], p1[9]), cvtpk(p1[10], p1[11]), cvtpk(p1[12], p1[13]), cvtpk(p1[14], p1[15])};
    LAS const unsigned char* vb = V + ((lane >> 4) & 1) * 32 + (lane & 3) * 8 + (4 * hi + ((lane & 15) >> 2)) * 64;
#pragma unroll
    for (int d0 = 0; d0 < NDB; ++d0)
#pragma unroll
        for (int ks = 0; ks < 4; ++ks) {
            const s16x4 lo = vtr(vb + d0 * 4096 + ks * 1024), hh = vtr(vb + d0 * 4096 + ks * 1024 + 512);
            const bf16x8 vf = (bf16x8){lo[0], lo[1], lo[2], lo[3], hh[0], hh[1], hh[2], hh[3]};
            o[d0] = MFMA32(__builtin_bit_cast(bf16x8, pw[ks]), vf, o[d0]);
            if (ks == 3) __builtin_amdgcn_sched_barrier(0);
        }
}
__device__ __forceinline__ void glds16(const void* gsrc, unsigned lds_dst) {
    unsigned keep;
    asm volatile("s_mov_b32 %0, m0\n\ts_mov_b32 m0, %2\n\ts_nop 0\n\tglobal_load_lds_dwordx4 %1, off\n\ts_mov_b32 m0, %0" : "=&s"(keep) : "v"(gsrc), "s"(lds_dst) : "memory");
}
__device__ __forceinline__ void glds16s(const void* sbase  , unsigned voff  , unsigned lds_dst) {
    unsigned keep;
    asm volatile("s_mov_b32 %0, m0\n\ts_mov_b32 m0, %3\n\ts_nop 0\n\tglobal_load_lds_dwordx4 %1, %2\n\ts_mov_b32 m0, %0" : "=&s"(keep) : "v"(voff), "s"(sbase), "s"(lds_dst) : "memory");
}
__device__ __forceinline__ void qkt_nb(f32x16& p0, f32x16& p1, LAS const unsigned char* K, const bf16x8 (&qr)[4], int r32, int hi) {
#pragma unroll
    for (int d0 = 0; d0 < 4; ++d0) {
        LAS const unsigned char* kb = K + kswz(r32, 2 * d0 + hi);
        const bf16x8 b0 = *(LAS const bf16x8*)(kb), b1 = *(LAS const bf16x8*)(kb + 4096);
        p0 = MFMA32(b0, qr[d0], p0); p1 = MFMA32(b1, qr[d0], p1);
    }
}
#define PACKP(pw, P0, P1) do { pw[0] = (u32x4){cvtpk(P0[0], P0[1]), cvtpk(P0[2], P0[3]), cvtpk(P0[4], P0[5]), cvtpk(P0[6], P0[7])}; \
    pw[1] = (u32x4){cvtpk(P0[8], P0[9]), cvtpk(P0[10], P0[11]), cvtpk(P0[12], P0[13]), cvtpk(P0[14], P0[15])}; \
    pw[2] = (u32x4){cvtpk(P1[0], P1[1]), cvtpk(P1[2], P1[3]), cvtpk(P1[4], P1[5]), cvtpk(P1[6], P1[7])}; \
    pw[3] = (u32x4){cvtpk(P1[8], P1[9]), cvtpk(P1[10], P1[11]), cvtpk(P1[12], P1[13]), cvtpk(P1[14], P1[15])}; } while (0)
template <int NDB> __device__ __forceinline__ void pv_nb(f32x16 (&o)[NDB], const u32x4 (&pw)[4], LAS const unsigned char* V, int lane, int hi) {
    LAS const unsigned char* vb = V + ((lane >> 4) & 1) * 32 + (lane & 3) * 8 + (4 * hi + ((lane & 15) >> 2)) * 64;
#pragma unroll
    for (int d0 = 0; d0 < NDB; ++d0)
#pragma unroll
        for (int ks = 0; ks < 4; ++ks) {
            const s16x4 lo = vtr(vb + d0 * 4096 + ks * 1024), hh = vtr(vb + d0 * 4096 + ks * 1024 + 512);
            const bf16x8 vf = (bf16x8){lo[0], lo[1], lo[2], lo[3], hh[0], hh[1], hh[2], hh[3]};
            o[d0] = MFMA32(__builtin_bit_cast(bf16x8, pw[ks]), vf, o[d0]);
        }
}
__device__ __forceinline__ float rowmax32(const f32x16& a, const f32x16& b) {
    float x = fmaxf(fmaxf(a[0], a[1]), b[0]), y = fmaxf(fmaxf(a[2], a[3]), b[1]);
    x = fmaxf(fmaxf(x, b[2]), b[3]);
#pragma unroll
    for (int r = 4; r < 16; r += 4) { x = fmaxf(fmaxf(x, a[r]), a[r + 1]); y = fmaxf(fmaxf(y, a[r + 2]), a[r + 3]); x = fmaxf(fmaxf(x, b[r]), b[r + 1]); y = fmaxf(fmaxf(y, b[r + 2]), b[r + 3]); }
    const float mm = fmaxf(x, y);
    auto rr = __builtin_amdgcn_permlane32_swap(__float_as_uint(mm), __float_as_uint(mm), false, false);
    return fmaxf(__uint_as_float(rr[0]), __uint_as_float(rr[1]));
}
constexpr float SM_THR = 6.0f;
constexpr float NEG = -1e30f;
template <int NDB> __device__ __forceinline__ void softmax_pv(f32x16& s0, f32x16& s1, float& m, float& l, f32x16 (&o)[NDB], LAS float* wsf, LAS const unsigned char* V, int lane, int r32, int hi) {
    float rm = fmaxf(s0[0], s1[0]);
#pragma unroll
    for (int r = 1; r < 16; ++r) rm = fmaxf(rm, fmaxf(s0[r], s1[r]));
    rm = m32(rm);
    if (__any(rm > m + SM_THR)) {
        const float mn = fmaxf(m, rm), f = ex2(m - mn); l *= f; m = mn;
        if (hi == 0) wsf[r32] = f;
#pragma unroll
        for (int r = 0; r < 16; ++r) { const float fr_ = wsf[crow(r, hi)];
#pragma unroll
            for (int d = 0; d < NDB; ++d) o[d][r] *= fr_; }
    }
    float sum = 0.f;
#pragma unroll
    for (int r = 0; r < 16; ++r) { s0[r] = ex2(s0[r] - m); s1[r] = ex2(s1[r] - m); sum += s0[r] + s1[r]; }
    l += sum;
    pv<NDB>(o, s0, s1, V, lane, hi);
}

#define QFETCH() int qnx_ = 0; if (tid == 0) qnx_ = (int)__hip_atomic_fetch_add(qctr, 1u, __ATOMIC_RELAXED, __HIP_MEMORY_SCOPE_AGENT)
#define QPARK() do { if (tid == 0) ((LAS int*)(lds + LDS_MISC))[1] = qnx_; } while (0)
__device__ __forceinline__ float gelu_tanh(float x) { const float u = 0.7978845608f * (x + 0.044715f * x * x * x); const float e = __expf(2.f * u); return 0.5f * x * (2.f - 2.f / (1.f + e)); }

__device__ __forceinline__ void compress_unit(PRef p, int l, int u, LAS unsigned char* lds, unsigned* qctr) {
    SG_IDS
    unsigned char* ws = p.ws;
    const int kv = u >> 5, m0 = (u & 31) * 128;
    const bf16_t* KV6 = (const bf16_t*)(ws + WS_KV6);
    struct ARowC { const bf16_t* KV6; int m0, kv; __device__ __forceinline__ const char* operator()(int r) const { const int mm = m0 + r, g = mm >> 11, tok = (mm & 2047) * 16; return (const char*)(KV6 + (size_t)tok * 768 + kv * 128 + g * 64); } };
    f32x4 acc[2][4]; SG_ZERO(acc);
    sg_kloop(acc, ARowC{KV6, m0, kv}, 768 * 2, (const bf16_t*)(ws + WS_WC1) + (size_t)(l * 2 + kv) * 128 * 2048, 2048, 32, lds);
    QFETCH();
    LAS bf16_t* Ht = (LAS bf16_t*)(lds + 32768);
    LAS float* W2 = (LAS float*)(lds + 32768 + 34816);
    const float* cb1 = (const float*)(ws + WS_MISC) + (l * 2 + kv) * 128;
#pragma unroll
    for (int m = 0; m < 2; ++m)
#pragma unroll
        for (int n = 0; n < 4; ++n) { const int row = SG_ROW(m), col = SG_COL(n); const f32x4 b = *(const f32x4*)(cb1 + col); f32x4 v = acc[m][n] + b;
            u32x2 w; w.x = cvtpk(gelu_tanh(v[0]), gelu_tanh(v[1])); w.y = cvtpk(gelu_tanh(v[2]), gelu_tanh(v[3])); *(LAS u32x2*)(Ht + row * 136 + col) = w; }
    const float* w2g = p.cmp_w2 + (size_t)(l * 2 + kv) * 128 * 64;
    for (int i = tid; i < 128 * 64 / 4; i += 512) *(LAS f32x4*)(W2 + i * 4) = *(const f32x4*)(w2g + i * 4);
    __syncthreads();
    const int d = tid & 63; const float b2 = p.cmp_b2[(l * 2 + kv) * 64 + d];
    bf16_t* dstb = (bf16_t*)(ws + WS_MISC + 65536 + (size_t)kv * 524288);
    for (int i = 0; i < 16; ++i) { const int row = (tid >> 6) + 8 * i; float s = b2;
#pragma unroll 8
        for (int f = 0; f < 128; ++f) s += bf1(Ht[row * 136 + f]) * W2[f * 64 + d];
        const int mm = m0 + row, g = mm >> 11, bi = mm & 2047;
        dstb[((size_t)bi * 2 + g) * 64 + d] = f2bf(s); }
    QPARK();
    __syncthreads();
}

#ifndef ABL
#define ABL 0
#endif
template <int AB> __device__ __forceinline__ void diff_unit(PRef p, int l, int u, LAS unsigned char* lds, bool dry, unsigned* qctr) {
    int tid_ = TIDX(); asm volatile("" : "+v"(tid_));
    const int tid = tid_, lane = tid & 63, r32 = lane & 31, hi = lane >> 5, wid = __builtin_amdgcn_readfirstlane(tid >> 6);
    unsigned char* ws = p.ws;
    const int c = 15 - (u >> 6), b = (u & 63) >> 2, hd = u & 3;
    const int cm = wid >> 2, qq = wid & 3, t0 = 128 * c + 32 * qq, tq = t0 + r32;
    const size_t tokb = (size_t)b * TSEQ;
    bf16_t* DQ = (bf16_t*)(ws + WS_DQ); const bf16_t* DK = (const bf16_t*)(ws + WS_DK); const bf16_t* DV = (const bf16_t*)(ws + WS_DV);
    const float sl2 = alibi_slope(9 + hd) * LOG2E;
    const float cbh = sl2 * (float)(4 * hi);
#define CB(r) fmaf(sl2, (float)(((r) & 3) + 8 * ((r) >> 2)), cbh)
    f32x16 o[4];
#pragma unroll
    for (int d = 0; d < 4; ++d) o[d] = (f32x16){0.f};
    float m = 0.f, lsum = 0.f; bool seen = false;
    LAS float* wsf = (LAS float*)(lds + LDS_MISC + 1024 + wid * 128);
    const unsigned lds0 = (unsigned)(uintptr_t)lds;
    const int srow = tid >> 3, spos = tid & 7, sch = spos ^ ((srow >> 1) & 7);
    const int vln = lane;
    const bf16_t* kub = DK + tokb * 512 + hd * 128; const bf16_t* vub = DV + tokb * 512 + hd * 128 + (size_t)(16 * (wid & 3)) * 512 + (wid >> 2) * 32;
    const unsigned kvo = (unsigned)(srow * 512 + sch * 8) * 2u, vvo = (unsigned)((vln >> 2) * 512 + (vln & 3) * 8) * 2u;
    const unsigned dk0 = lds0 + wid * 1024, dk1 = dk0 + 8192, dv0 = lds0 + 16384 + wid * 1024, dv1 = dv0 + 8192;
#define DDMA(j, off) do { const size_t to_ = (size_t)(64 * (j)) * 512; const unsigned o_ = (unsigned)(off); \
        glds16s(kub + to_, kvo, (unsigned)__builtin_amdgcn_readfirstlane(dk0 + o_)); glds16s(kub + to_ + 64, kvo, (unsigned)__builtin_amdgcn_readfirstlane(dk1 + o_)); \
        glds16s(vub + to_, vvo, (unsigned)__builtin_amdgcn_readfirstlane(dv0 + o_)); glds16s(vub + to_ + 64, vvo, (unsigned)__builtin_amdgcn_readfirstlane(dv1 + o_)); } while (0)
#define DCIN(A0, A1, j) do { float slv_ = sl2; asm volatile("" : "+v"(slv_)); \
        const float tc_ = slv_ * (float)(64 * (j) - 128 * c) + slv_ * (float)(4 * hi) - m, tc1_ = tc_ + 32.f * slv_; \
        _Pragma("unroll") for (int r = 0; r < 16; ++r) { const float kc_ = (float)((r & 3) + 8 * (r >> 2)); A0[r] = fmaf(slv_, kc_, tc_); A1[r] = fmaf(slv_, kc_, tc1_); } } while (0)
#define DMASK(A0, A1, j, RM, MASKED) do { \
        if (MASKED) { if (64 * (j) + 63 > t0) { const int lim_ = tq - 64 * (j); _Pragma("unroll") for (int r = 0; r < 16; ++r) { if (crow(r, hi) > lim_) A0[r] = NEG; if (crow(r, hi) + 32 > lim_) A1[r] = NEG; } } } \
        RM = rowmax32(A0, A1); } while (0)
#define DRESC(C0, C1, RM) do { const bool real_ = RM > -1e29f; const bool need_ = (RM > SM_THR) || (!seen && real_); seen = seen || real_;     \
        if (__any(need_)) { const float d_ = need_ ? RM : 0.f, f_ = ex2(-d_); m += d_; lsum *= f_; if (hi == 0) wsf[r32] = f_; \
        _Pragma("unroll") for (int r = 0; r < 16; ++r) { C0[r] -= d_; C1[r] -= d_; const float fr_ = wsf[crow(r, hi)]; _Pragma("unroll") for (int d = 0; d < 4; ++d) o[d][r] *= fr_; } } } while (0)
#define DEXP(C0, C1, PW) do { float sum_ = 0.f; \
        if (AB == 1) { _Pragma("unroll") for (int r = 0; r < 16; ++r) { sum_ += C0[r] + C1[r]; } } \
        else if (AB != 5) { _Pragma("unroll") for (int r = 0; r < 16; ++r) { C0[r] = ex2(C0[r]); C1[r] = ex2(C1[r]); sum_ += C0[r] + C1[r]; } } \
        lsum += sum_; PACKP(PW, C0, C1); } while (0)
#define DEND(t) do { if (AB == 6) asm volatile("s_waitcnt vmcnt(0) lgkmcnt(0)" ::: "memory"); else if ((t) + 3 <= J0) asm volatile("s_waitcnt vmcnt(4) lgkmcnt(0)\n\ts_barrier" ::: "memory"); else asm volatile("s_waitcnt vmcnt(0) lgkmcnt(0)\n\ts_barrier" ::: "memory"); \
        { const int tmp_ = oc_; oc_ = on_; on_ = o2_; o2_ = ow_; ow_ = tmp_; } } while (0)
#define SBAR() __builtin_amdgcn_sched_barrier(0)
#define KLD(KF, Kp) do { _Pragma("unroll") for (int d0 = 0; d0 < 4; ++d0) { LAS const unsigned char* kb_ = (Kp) + kswz(r32, 2 * d0 + hi); KF[2 * d0] = *(LAS const bf16x8*)(kb_); KF[2 * d0 + 1] = *(LAS const bf16x8*)(kb_ + 4096); } } while (0)
#define QK8(P0, P1, KF) do { _Pragma("unroll") for (int d0 = 0; d0 < 4; ++d0) { P0 = MFMA32(KF[2 * d0], qr[d0], P0); P1 = MFMA32(KF[2 * d0 + 1], qr[d0], P1); } } while (0)
#define VLDK(VF, Vp, ks) do { _Pragma("unroll") for (int d0 = 0; d0 < 4; ++d0) { const s16x4 lo_ = vtr((Vp) + d0 * 4096 + (ks) * 1024), hh_ = vtr((Vp) + d0 * 4096 + (ks) * 1024 + 512); \
        VF[d0] = (bf16x8){lo_[0], lo_[1], lo_[2], lo_[3], hh_[0], hh_[1], hh_[2], hh_[3]}; } } while (0)
#define MMA4(VF, PWk) do { _Pragma("unroll") for (int d0 = 0; d0 < 4; ++d0) o[d0] = MFMA32(__builtin_bit_cast(bf16x8, PWk), VF[d0], o[d0]); } while (0)
#define DSTEP_N(C0, C1, RMC, N0, N1, RMN, t, MASKED) do { \
        if (AB != 4 && (t) + 3 <= J0) DDMA(J0 - (t) - 3, ow_); \
        bf16x8 kf_[8]; KLD(kf_, lds + on_ + cm * 8192); \
        SBAR(); \
        if (AB != 5) DRESC(C0, C1, RMC); \
        u32x4 pw_[4]; \
        DEXP(C0, C1, pw_); \
        DCIN(N0, N1, J0 - (t) - 1); \
        SBAR(); \
        if (AB != 3) QK8(N0, N1, kf_); \
        int ln_ = lane; asm volatile("" : "+v"(ln_)); LAS const unsigned char* vp_ = lds + oc_ + 16384 + ((ln_ >> 4) & 1) * 32 + (ln_ & 3) * 8 + ((ln_ >> 5) * 4 + ((ln_ & 15) >> 2)) * 64; \
        bf16x8 va_[4], vc_[4]; \
        VLDK(va_, vp_, 0); VLDK(vc_, vp_, 1); SBAR(); \
        if (AB != 2) MMA4(va_, pw_[0]); VLDK(va_, vp_, 2); SBAR(); \
        if (AB != 2) MMA4(vc_, pw_[1]); VLDK(vc_, vp_, 3); SBAR(); \
        if (AB != 5) DMASK(N0, N1, J0 - (t) - 1, RMN, MASKED); else RMN = RMC; \
        if (AB != 2) { MMA4(va_, pw_[2]); MMA4(vc_, pw_[3]); } \
        SBAR(); \
        DEND(t); } while (0)
#define DSTEP_L(C0, C1, RMC, t) do { DRESC(C0, C1, RMC); u32x4 pw_[4]; DEXP(C0, C1, pw_); int ln_ = lane; asm volatile("" : "+v"(ln_)); LAS const unsigned char* vp_ = lds + oc_ + 16384 + ((ln_ >> 4) & 1) * 32 + (ln_ & 3) * 8 + ((ln_ >> 5) * 4 + ((ln_ & 15) >> 2)) * 64; bf16x8 va_[4], vc_[4]; \
        VLDK(va_, vp_, 0); VLDK(vc_, vp_, 1); SBAR(); MMA4(va_, pw_[0]); VLDK(va_, vp_, 2); SBAR(); MMA4(vc_, pw_[1]); VLDK(vc_, vp_, 3); SBAR(); MMA4(va_, pw_[2]); MMA4(vc_, pw_[3]); DEND(t); } while (0)
    const int J0 = 2 * c + 1;
    int oc_ = 0, on_ = 32768, o2_ = 65536, ow_ = 98304;
    __syncthreads();
    DDMA(J0, 0); DDMA(J0 - 1, 32768);
    if (J0 >= 2) DDMA(J0 - 2, 65536);
    bf16x8 qr[4];
    { const bf16_t* qp = DQ + (tokb + tq) * 512 + hd * 128 + cm * 64 + hi * 8;
#pragma unroll
      for (int d0 = 0; d0 < 4; ++d0) qr[d0] = *(const bf16x8*)(qp + d0 * 16); }
    asm volatile("" : "+v"(qr[0]), "+v"(qr[1]), "+v"(qr[2]), "+v"(qr[3]));
    asm volatile("s_waitcnt vmcnt(0)\n\ts_barrier" ::: "memory");
    f32x16 sA0, sA1, sB0, sB1; float rmA, rmB;
    DCIN(sA0, sA1, J0);
    qkt_nb(sA0, sA1, lds + cm * 8192, qr, r32, hi);
    DMASK(sA0, sA1, J0, rmA, true);
    DSTEP_N(sA0, sA1, rmA, sB0, sB1, rmB, 0, true);
    for (int t = 1; t + 1 <= J0 - 1; t += 2) {
        DSTEP_N(sB0, sB1, rmB, sA0, sA1, rmA, t, false); DSTEP_N(sA0, sA1, rmA, sB0, sB1, rmB, t + 1, false);
    }
    DSTEP_L(sB0, sB1, rmB, J0);
#undef DDMA
#undef DCIN
#undef DMASK
#undef DRESC
#undef DEXP
#undef DEND
#undef DSTEP_N
#undef DSTEP_L
#undef KLD
#undef QK8
#undef VLDK
#undef MMA4
#undef SBAR
    QFETCH();
    const float lam = ((const float*)(ws + WS_MISC + 4096))[l];
    const float lam_init = (l == 0) ? 0.2f : 0.35550906f;
    const float ltot = s32(lsum);
    if (hi == 0) wsf[r32] = (cm == 0 ? 1.f : lam) / ltot;
    LAS float* X = (LAS float*)(lds + cm * 65536);
#pragma unroll
    for (int r = 0; r < 16; ++r) { const float f = wsf[crow(r, hi)]; const int q = 32 * qq + crow(r, hi);
#pragma unroll
        for (int d = 0; d < 4; ++d) X[q * 128 + d * 32 + r32] = o[d][r] * f; }
    __syncthreads();
    { const int q = tid >> 2, qt = tid & 3; LAS const float* x0 = (LAS const float*)lds + q * 128 + qt * 32; LAS const float* x1 = x0 + 16384;
      float v[32]; float ss = 0.f;
#pragma unroll
      for (int i = 0; i < 32; ++i) { v[i] = x0[i] - x1[i]; ss += v[i] * v[i]; }
      ss += shx(ss, 1, lane); ss += shx(ss, 2, lane);
      unsigned omlb = (l == 0) ? 0x3f4ccccdu : 0x3f24fd5cu; asm volatile("" : "+s"(omlb)); const float oml = __uint_as_float(omlb);
      const float rstd = rsqrtf(ss * (1.f / 128.f) + 1e-5f) * oml;
      const float* sg = p.diff_subln_g + l * 128 + qt * 32;
      bf16_t* dst = (dry ? (bf16_t*)(ws + WS_XN) + (size_t)NTOK * 512 : DQ) + (tokb + 128 * c + q) * 512 + hd * 128 + qt * 32;
#pragma unroll
      for (int i = 0; i < 32; i += 8) { u32x4 w; w.x = cvtpk(v[i] * rstd * sg[i], v[i + 1] * rstd * sg[i + 1]); w.y = cvtpk(v[i + 2] * rstd * sg[i + 2], v[i + 3] * rstd * sg[i + 3]);
          w.z = cvtpk(v[i + 4] * rstd * sg[i + 4], v[i + 5] * rstd * sg[i + 5]); w.w = cvtpk(v[i + 6] * rstd * sg[i + 6], v[i + 7] * rstd * sg[i + 7]); *(u32x4*)(dst + i) = w; } }
    QPARK();
    __syncthreads();
}

template <int AB> __device__ __forceinline__ void nsa_unit(PRef p, int l, int u, LAS unsigned char* lds, bool dry, unsigned* qctr) {
    int tid_ = TIDX(); asm volatile("" : "+v"(tid_));
    const int tid = tid_, lane = tid & 63, r32 = lane & 31, hi = lane >> 5, wid = __builtin_amdgcn_readfirstlane(tid >> 6);
    unsigned char* ws = p.ws;
    const int c = 31 - (u >> 5), b = (u & 31) >> 1, g = u & 1;
    const int hl = wid >> 1, qh = wid & 1, h = g * 4 + hl, t0 = 64 * c + 32 * qh, tq = t0 + r32, ql = 32 * qh + r32;
    const size_t tokb = (size_t)b * TSEQ;
    bf16_t* NQ = (bf16_t*)(ws + WS_NQ); const bf16_t* KV6 = (const bf16_t*)(ws + WS_KV6); const bf16_t* NG = (const bf16_t*)(ws + WS_NG);
    const bf16_t* KC = (const bf16_t*)(ws + WS_MISC + 65536); const bf16_t* VC = (const bf16_t*)(ws + WS_MISC + 65536 + 524288);
    constexpr int RING_W = 0, RING_S = 65536, CK = 65536, CV = 81920, IMPH_OFF = 98304;
    const unsigned lds0 = (unsigned)(uintptr_t)lds;
    const int jlo = c - 8 < 0 ? 0 : c - 8;
    const unsigned wmask = ((c >= 31) ? 0xffffffffu : ((2u << c) - 1u)) & ~((1u << jlo) - 1u);
    const int srow = tid >> 3, spos = tid & 7, sch = spos ^ ((srow >> 1) & 7);
    const unsigned kvo768 = (unsigned)(srow * 768 + sch * 8) * 2u, vvo768 = (unsigned)((lane >> 2) * 768 + (lane & 3) * 8) * 2u;
    const bf16_t* kub = KV6 + tokb * 768 + g * 64; const bf16_t* vub = KV6 + tokb * 768 + g * 64 + 128 + (size_t)(16 * (wid & 3)) * 768 + (wid >> 2) * 32;
    const unsigned dk = lds0 + wid * 1024, dv = dk + 8192;
#define NDMA(j, kind, off) do { const size_t to_ = (size_t)(64 * (j)) * 768 + ((kind) == 1 ? 256 : 512); const unsigned o_ = (unsigned)(off); \
        glds16s(kub + to_, kvo768, (unsigned)__builtin_amdgcn_readfirstlane(dk + o_)); glds16s(vub + to_, vvo768, (unsigned)__builtin_amdgcn_readfirstlane(dv + o_)); } while (0)
    __syncthreads();
    { const unsigned kvo128 = (unsigned)(srow * 128 + sch * 8) * 2u, vvo128 = (unsigned)((lane >> 2) * 128 + (lane & 3) * 8) * 2u;
      const bf16_t* kcb = KC + ((size_t)b * 128 * 2 + g) * 64; const bf16_t* vcb = VC + ((size_t)b * 128 * 2 + g) * 64 + (size_t)(16 * (wid & 3)) * 128 + (wid >> 2) * 32;
      glds16s(kcb, kvo128, (unsigned)__builtin_amdgcn_readfirstlane(dk + CK)); glds16s(kcb + 64 * 128, kvo128, (unsigned)__builtin_amdgcn_readfirstlane(dk + CK + 8192));
      glds16s(vcb, vvo128, (unsigned)__builtin_amdgcn_readfirstlane(dk + CV)); glds16s(vcb + 64 * 128, vvo128, (unsigned)__builtin_amdgcn_readfirstlane(dk + CV + 8192)); }
    unsigned wd = wmask; int nwd = 0;
#pragma unroll
    for (int i = 0; i < 3; ++i) if (wd) { const int j = 31 - __builtin_clz(wd); wd &= ~(1u << j); NDMA(j, 2, RING_W + i * 16384); ++nwd; }
    bf16x8 qr[4];
    { const bf16_t* qp = NQ + (tokb + tq) * 512 + h * 64 + hi * 8;
#pragma unroll
      for (int d0 = 0; d0 < 4; ++d0) qr[d0] = *(const bf16x8*)(qp + d0 * 16); }
    float g0 = bf1(NG[(tokb + tq) * 32 + h * 3 + 0]), g1 = bf1(NG[(tokb + tq) * 32 + h * 3 + 1]), g2 = bf1(NG[(tokb + tq) * 32 + h * 3 + 2]);
    asm volatile("" : "+v"(qr[0]), "+v"(qr[1]), "+v"(qr[2]), "+v"(qr[3]), "+v"(g0), "+v"(g1), "+v"(g2));
    const float sl2 = alibi_slope(h + 1) * LOG2E;
    const float cbh = sl2 * (float)(4 * hi);
    LAS float* wsf = (LAS float*)(lds + LDS_MISC + 1024 + wid * 128);
    LAS unsigned char* Kt = lds + CK; LAS unsigned char* Vt = lds + CV;
    LAS float* IMPH = (LAS float*)(lds + IMPH_OFF);
    LAS float* VAL = (LAS float*)(lds + CK);
    LAS unsigned* MASK = (LAS unsigned*)(lds + LDS_MISC + 2048);
    f32x16 oacc[2];
    if (tid < 64) MASK[tid] = 0u;
    asm volatile("s_waitcnt vmcnt(0) lgkmcnt(0)\n\ts_barrier" ::: "memory");
    {
        f32x16 s[4];
        const bool need2 = (c >= 16);
        qkt(s[0], s[1], Kt, qr, r32, hi);
        if (need2) qkt(s[2], s[3], Kt + 8192, qr, r32, hi); else { s[2] = (f32x16){0.f}; s[3] = (f32x16){0.f}; }
        int nmax = (tq - 31) >> 4; if (nmax > 126) nmax = 126;
        float rm = NEG;
#pragma unroll
        for (int k = 0; k < 4; ++k)
#pragma unroll
            for (int r = 0; r < 16; ++r) { const int n = 32 * k + crow(r, hi); float v = s[k][r] + 16.f * CB(r) + sl2 * (float)(512 * k);
                v = (n <= nmax) ? v : NEG; s[k][r] = v; rm = fmaxf(rm, v); }
        rm = m32(rm);
        float sum = 0.f;
#pragma unroll
        for (int k = 0; k < 2; ++k)
#pragma unroll
            for (int r = 0; r < 16; ++r) { const float e = ex2(s[k][r] - rm); s[k][r] = e; sum += e; }
        if (need2) {
#pragma unroll
            for (int k = 2; k < 4; ++k)
#pragma unroll
                for (int r = 0; r < 16; ++r) { const float e = ex2(s[k][r] - rm); s[k][r] = e; sum += e; } }
        else { s[2] = (f32x16){0.f}; s[3] = (f32x16){0.f}; }
        sum = s32(sum);
        const float inv = (nmax >= 0) ? 1.f / sum : 0.f;
#pragma unroll
        for (int k = 0; k < 4; ++k)
#pragma unroll
            for (int r = 0; r < 16; ++r) s[k][r] *= inv;
        float prev = 0.f;
#pragma unroll
        for (int k = 0; k < 4; ++k)
#pragma unroll
            for (int a = 0; a < 4; ++a) { const int i = 4 * k + a; const float Bi = 0.5f * s[k][4 * a + 3]; const float Ai = (s[k][4 * a] + s[k][4 * a + 1]) + (s[k][4 * a + 2] + Bi);
                const float rc = o32(Bi, hi); const float add = hi ? rc : prev; prev = rc;
                IMPH[(hl * 64 + ql) * 32 + 2 * i + hi] = Ai + add; }
        f32x16 o[2]; o[0] = (f32x16){0.f}; o[1] = (f32x16){0.f};
        pv<2>(o, s[0], s[1], Vt, lane, hi); if (need2) pv<2>(o, s[2], s[3], Vt + 8192, lane, hi);
        if (hi == 0) wsf[r32] = g0;
#pragma unroll
        for (int r = 0; r < 16; ++r) { const float f = wsf[crow(r, hi)]; oacc[0][r] = o[0][r] * f; oacc[1][r] = o[1][r] * f; }
        asm volatile("" : "+v"(oacc[0]), "+v"(oacc[1]));
    }
    __syncthreads();
    { const int q = tid >> 3, mg = tid & 7;
#pragma unroll
      for (int i = 0; i < 4; ++i) { const int mb = 4 * mg + i; float v = ((IMPH[(0 * 64 + q) * 32 + mb] + IMPH[(1 * 64 + q) * 32 + mb]) + IMPH[(2 * 64 + q) * 32 + mb]) + IMPH[(3 * 64 + q) * 32 + mb];
          if (mb == 0 || mb == c || mb == c - 1) v = 1e9f; if (mb > c) v = -1.f; VAL[q * 32 + mb] = v; }
      asm volatile("s_waitcnt lgkmcnt(0)" ::: "memory");
      float mine[4];
#pragma unroll
      for (int i = 0; i < 4; ++i) mine[i] = VAL[q * 32 + 4 * mg + i];
      int cnt0 = 0, cnt1 = 0, cnt2 = 0, cnt3 = 0;
#pragma unroll 4
      for (int m2 = 0; m2 < 32; ++m2) { const float v2 = VAL[q * 32 + m2]; const int rel = m2 - 4 * mg;
          cnt0 += (int)(v2 > mine[0]) | ((int)(v2 == mine[0]) & (int)(rel < 0));
          cnt1 += (int)(v2 > mine[1]) | ((int)(v2 == mine[1]) & (int)(rel < 1));
          cnt2 += (int)(v2 > mine[2]) | ((int)(v2 == mine[2]) & (int)(rel < 2));
          cnt3 += (int)(v2 > mine[3]) | ((int)(v2 == mine[3]) & (int)(rel < 3)); }
      unsigned bits = ((cnt0 < 8) ? 1u : 0u) | ((cnt1 < 8) ? 2u : 0u) | ((cnt2 < 8) ? 4u : 0u) | ((cnt3 < 8) ? 8u : 0u);
      bits <<= 4 * mg;
      bits |= shxu(bits, 1, lane); bits |= shxu(bits, 2, lane); bits |= shxu(bits, 4, lane);
      if (mg == 0) MASK[q] = bits; }
    __syncthreads();
    const unsigned vmask = (c >= 31) ? 0xffffffffu : ((2u << c) - 1u);
    const unsigned mymask = MASK[ql] & vmask;
    unsigned uni;
    { unsigned mk = MASK[lane] & vmask;
#pragma unroll
      for (int o_ = 1; o_ < 64; o_ <<= 1) mk |= shxu(mk, o_, lane);
      uni = __builtin_amdgcn_readfirstlane(mk); }
    unsigned sd = uni; int nsd = 0;
#pragma unroll
    for (int i = 0; i < 3; ++i) if (sd) { const int j = 31 - __builtin_clz(sd); sd &= ~(1u << j); NDMA(j, 1, RING_S + i * 16384); ++nsd; }
#define NCIN(A0, A1, j, kind) do { float slv_ = sl2; asm volatile("" : "+v"(slv_)); \
        const float tc_ = slv_ * (float)(64 * ((j) - c)) + slv_ * (float)(4 * hi) - m, tc1_ = tc_ + 32.f * slv_; \
        _Pragma("unroll") for (int r = 0; r < 16; ++r) { const float kc_ = (float)((r & 3) + 8 * (r >> 2)); A0[r] = fmaf(slv_, kc_, tc_); A1[r] = fmaf(slv_, kc_, tc1_); } } while (0)
#define NMASK(A0, A1, j, kind, RM) do { \
        const bool sel_ = ((kind) == 2) || ((mymask >> (j)) & 1u); \
        if ((j) == c || ((kind) == 2 && (j) == c - 8) || !__all(sel_)) { const int lim_ = ((j) == c) ? ql : 64, low_ = ((kind) == 2 && (j) == c - 8) ? ql : -1; \
            _Pragma("unroll") for (int r = 0; r < 16; ++r) { const int k0_ = crow(r, hi), k1_ = k0_ + 32; if (!sel_ || k0_ > lim_ || k0_ <= low_) A0[r] = NEG; if (!sel_ || k1_ > lim_ || k1_ <= low_) A1[r] = NEG; } } \
        RM = rowmax32(A0, A1); } while (0)
#define NRESC(C0, C1, RM) do { const bool real_ = RM > -1e29f; const bool need_ = (RM > SM_THR) || (!seen && real_); seen = seen || real_; \
        if (__any(need_)) { const float d_ = need_ ? RM : 0.f, f_ = ex2(-d_); m += d_; lsum *= f_; if (hi == 0) wsf[r32] = f_; \
        _Pragma("unroll") for (int r = 0; r < 16; ++r) { C0[r] -= d_; C1[r] -= d_; const float fr_ = wsf[crow(r, hi)]; o[0][r] *= fr_; o[1][r] *= fr_; } } } while (0)
#define NEXP(C0, C1, PW) do { float sum_ = 0.f; \
        _Pragma("unroll") for (int r = 0; r < 16; ++r) { C0[r] = ex2(C0[r]); C1[r] = ex2(C1[r]); sum_ += C0[r] + C1[r]; } lsum += sum_; PACKP(PW, C0, C1); } while (0)
#define NSTEP(C0, C1, RMC, N0, N1, RMN, kind) do { \
        if (dcur_) { const int jd_ = 31 - __builtin_clz(dcur_); dcur_ &= ~(1u << jd_); NDMA(jd_, kind, ring_ + ow_); dissued_ = true; } else dissued_ = false; \
        NRESC(C0, C1, RMC); \
        u32x4 pw_[4]; \
        NEXP(C0, C1, pw_); \
        const bool has_ = (ccur_ != 0u); int jn_ = 0; if (has_) { jn_ = 31 - __builtin_clz(ccur_); ccur_ &= ~(1u << jn_); } \
        if (has_) { NCIN(N0, N1, jn_, kind); qkt_nb(N0, N1, lds + ring_ + on_, qr, r32, hi); } \
        __builtin_amdgcn_sched_barrier(0); \
        pv_nb<2>(o, pw_, lds + ring_ + oc_ + 8192, lane, hi); \
        if (has_) NMASK(N0, N1, jn_, kind, RMN); \
        if (dissued_) asm volatile("s_waitcnt vmcnt(2) lgkmcnt(0)\n\ts_barrier" ::: "memory"); else asm volatile("s_waitcnt vmcnt(0) lgkmcnt(0)\n\ts_barrier" ::: "memory"); \
        { const int tmp_ = oc_; oc_ = on_; on_ = o2_; o2_ = ow_; ow_ = tmp_; } \
        more_ = has_; } while (0)
#define NSTREAM(tmask, dmask, kind, ringbase, gate) do { \
        f32x16 o[2]; o[0] = (f32x16){0.f}; o[1] = (f32x16){0.f}; float m = 0.f, lsum = 0.f; bool seen = false; \
        const int ring_ = (ringbase); int oc_ = 0, on_ = 16384, o2_ = 32768, ow_ = 49152; \
        unsigned ccur_ = (tmask), dcur_ = (dmask); bool dissued_ = false, more_ = true; \
        f32x16 sA0, sA1, sB0, sB1; float rmA, rmB = NEG; \
        { const int j0_ = 31 - __builtin_clz(ccur_); ccur_ &= ~(1u << j0_); NCIN(sA0, sA1, j0_, kind); qkt_nb(sA0, sA1, lds + ring_, qr, r32, hi); NMASK(sA0, sA1, j0_, kind, rmA); } \
        for (;;) { NSTEP(sA0, sA1, rmA, sB0, sB1, rmB, kind); if (!more_) break; NSTEP(sB0, sB1, rmB, sA0, sA1, rmA, kind); if (!more_) break; } \
        const float ltot_ = s32(lsum); \
        if (hi == 0) wsf[r32] = (gate) / ltot_; \
        _Pragma("unroll") for (int r = 0; r < 16; ++r) { const float f = wsf[crow(r, hi)]; oacc[0][r] += o[0][r] * f; oacc[1][r] += o[1][r] * f; } \
        asm volatile("" : "+v"(oacc[0]), "+v"(oacc[1])); } while (0)
    if (nsd == 3) asm volatile("s_waitcnt vmcnt(6) lgkmcnt(0)\n\ts_barrier" ::: "memory"); else if (nsd == 2) asm volatile("s_waitcnt vmcnt(4) lgkmcnt(0)\n\ts_barrier" ::: "memory"); else asm volatile("s_waitcnt vmcnt(2) lgkmcnt(0)\n\ts_barrier" ::: "memory");
    if (AB != 1) {
        NSTREAM(wmask, wd, 2, RING_W, g2);
        NSTREAM(uni, sd, 1, RING_S, g1);
    }
#undef NDMA
#undef NCIN
#undef NMASK
#undef NRESC
#undef NEXP
#undef NSTEP
#undef NSTREAM
    QFETCH();
    { LAS bf16_t* stg = (LAS bf16_t*)(lds + wid * 4096);
#pragma unroll
      for (int r = 0; r < 16; ++r) { const int orow = crow(r, hi); stg[orow * 64 + r32] = f2bf(oacc[0][r]); stg[orow * 64 + 32 + r32] = f2bf(oacc[1][r]); }
      asm volatile("s_waitcnt lgkmcnt(0)" ::: "memory");
      bf16_t* ob = (dry ? (bf16_t*)(ws + WS_XN) : NQ) + (tokb + t0) * 512 + h * 64;
      int lane2 = lane; asm volatile("" : "+v"(lane2));
#pragma unroll
      for (int i = 0; i < 4; ++i) { const int row = i * 8 + (lane2 >> 3), ch = lane2 & 7; *(u32x4*)(ob + (size_t)row * 512 + ch * 8) = *(LAS const u32x4*)(stg + row * 64 + ch * 8); } }
    (void)nwd;
    QPARK();
}

__device__ __forceinline__ int next_unit(unsigned* ctr, LAS unsigned char* lds) {
    LAS int* bc = (LAS int*)(lds + LDS_MISC);
    __syncthreads();
    if (TIDX() == 0) bc[0] = (int)__hip_atomic_fetch_add(ctr, 1u, __ATOMIC_RELAXED, __HIP_MEMORY_SCOPE_AGENT);
    __syncthreads();
    return __builtin_amdgcn_readfirstlane(bc[0]);
}


__device__ __forceinline__ void phase_router(PRef p, int l, LAS unsigned char* lds, bool dry = false) {
    int tid_ = TIDX(); asm volatile("" : "+v"(tid_));
    const int tid = tid_, lane = tid & 63, wid = tid >> 6;
    unsigned char* ws = p.ws;
    constexpr int WP = 1028;
    LAS float* WT = (LAS float*)lds;
    LAS unsigned* cntl = (LAS unsigned*)(lds + 82432);
    LAS unsigned* lbase = (LAS unsigned*)(lds + 82432 + 64);
    LAS unsigned* loc = (LAS unsigned*)(lds + 82560);
    LAS float* wloc = (LAS float*)(lds + 82560 + 16384);
    LAS float* GL = (LAS float*)(lds + 115328);
    const float* gwp = p.router_grp_w + (size_t)l * DM * 4; const float* ewp = p.router_exp_w + (size_t)l * DM * 16;
    const float* g2 = p.norm2_g + (size_t)l * DM;
    __syncthreads();
    for (int k = tid; k < DM; k += 512) {
        const float gk = g2[k]; GL[k] = gk;
        const f32x4 a = *(const f32x4*)(gwp + k * 4);
#pragma unroll
        for (int i = 0; i < 4; ++i) WT[i * WP + k] = a[i] * gk;
#pragma unroll
        for (int q4 = 0; q4 < 4; ++q4) { const f32x4 e = *(const f32x4*)(ewp + k * 16 + q4 * 4);
#pragma unroll
            for (int i = 0; i < 4; ++i) WT[(4 + q4 * 4 + i) * WP + k] = e[i] * gk; }
    }
    const float* gb = p.router_grp_b + l * 4; const float* eb = p.router_exp_b + l * 16;
    unsigned* ecnt = (unsigned*)(ws + WS_CTL) + CW_ECNT + 64 * l + (dry ? 32 : 0);
    unsigned* LIST = (unsigned*)(ws + (dry ? WS_NQ : WS_LIST)); float* WL = (float*)(ws + (dry ? WS_NQ + 4 * MiB : WS_WL));
    float* RSTD = (float*)(ws + WS_RSTD);
    const int n = lane & 15, kq = lane >> 4;
    for (int ch = BID(); ch < NTOK / 128; ch += GSZ()) {
        __syncthreads();
        if (tid < 16) cntl[tid] = 0u;
        __syncthreads();
        const int tok = ch * 128 + wid * 16 + n;
        const bf16_t* xr = (const bf16_t*)(ws + WS_HB) + (size_t)tok * DM + kq * 256;
        LAS const float* w0 = WT + n * WP + kq * 256;
        LAS const float* w1 = WT + (16 + (n & 3)) * WP + kq * 256;
        f32x4 acc0 = {0.f, 0.f, 0.f, 0.f}, acc1 = {0.f, 0.f, 0.f, 0.f}; float ss = 0.f;
        u32x4 xa[8], xb[8];
#pragma unroll
        for (int u = 0; u < 8; ++u) xa[u] = *(const u32x4*)(xr + 8 * u);
#define ROUTER_BATCH(XC, XN_, jb) do { \
        if ((jb) + 8 < 32) { _Pragma("unroll") for (int u = 0; u < 8; ++u) XN_[u] = *(const u32x4*)(xr + 8 * ((jb) + 8 + u)); } \
        _Pragma("unroll") for (int u = 0; u < 8; ++u) { const int jj = (jb) + u; const u32x4 xw = XC[u]; \
            const f32x4 x0 = {bflo(xw.x), bfhi(xw.x), bflo(xw.y), bfhi(xw.y)}, x1 = {bflo(xw.z), bfhi(xw.z), bflo(xw.w), bfhi(xw.w)}; \
            const f32x4 a0 = *(LAS const f32x4*)(w0 + 8 * jj), a1 = *(LAS const f32x4*)(w1 + 8 * jj), a2 = *(LAS const f32x4*)(w0 + 8 * jj + 4), a3 = *(LAS const f32x4*)(w1 + 8 * jj + 4); \
            ss += ((x0[0] * x0[0] + x0[1] * x0[1]) + (x0[2] * x0[2] + x0[3] * x0[3])) + ((x1[0] * x1[0] + x1[1] * x1[1]) + (x1[2] * x1[2] + x1[3] * x1[3])); \
            _Pragma("unroll") for (int i = 0; i < 4; ++i) { acc0 = __builtin_amdgcn_mfma_f32_16x16x4f32(a0[i], x0[i], acc0, 0, 0, 0); acc1 = __builtin_amdgcn_mfma_f32_16x16x4f32(a1[i], x0[i], acc1, 0, 0, 0); } \
            _Pragma("unroll") for (int i = 0; i < 4; ++i) { acc0 = __builtin_amdgcn_mfma_f32_16x16x4f32(a2[i], x1[i], acc0, 0, 0, 0); acc1 = __builtin_amdgcn_mfma_f32_16x16x4f32(a3[i], x1[i], acc1, 0, 0, 0); } \
            __builtin_amdgcn_sched_barrier(0); } } while (0)
#pragma unroll 1
        for (int jb = 0; jb < 32; jb += 16) { ROUTER_BATCH(xa, xb, jb); ROUTER_BATCH(xb, xa, jb + 8); }
#undef ROUTER_BATCH
        ss += shx(ss, 16, lane); ss += shx(ss, 32, lane);
        const float rstd = rsqrtf(ss * (1.f / 1024.f) + 1e-6f);
        if (kq == 0) RSTD[tok] = rstd;
        int gi = 0; float gwt = 0.f;
        { float gl[4];
#pragma unroll
          for (int r = 0; r < 4; ++r) gl[r] = acc0[r] * rstd + gb[r];
          float gm = gl[0];
#pragma unroll
          for (int r = 1; r < 4; ++r) if (gl[r] > gm) { gm = gl[r]; gi = r; }
          float gs = 0.f;
#pragma unroll
          for (int r = 0; r < 4; ++r) gs += __expf(gl[r] - gm);
          gwt = 1.f / gs; }
        gi = __builtin_amdgcn_ds_bpermute(n << 2, gi); gwt = shl_(gwt, n);
        const int mygrp = (kq == 0) ? 3 : kq - 1;
        if (mygrp == gi) {
            float el[4];
#pragma unroll
            for (int r = 0; r < 4; ++r) el[r] = ((kq == 0) ? acc1[r] : acc0[r]) * rstd + eb[mygrp * 4 + r];
            int i1 = 0; float v1 = el[0];
#pragma unroll
            for (int e = 1; e < 4; ++e) if (el[e] > v1) { v1 = el[e]; i1 = e; }
            int i2 = -1; float v2 = -3.0e38f;
#pragma unroll
            for (int e = 0; e < 4; ++e) if (e != i1 && el[e] > v2) { v2 = el[e]; i2 = e; }
            const float ex = __expf(v2 - v1), w1_ = gwt / (1.f + ex), w2_ = gwt * ex / (1.f + ex);
            const int e1 = gi * 4 + i1, e2 = gi * 4 + i2;
            const unsigned s1 = __hip_atomic_fetch_add(&cntl[e1], 1u, __ATOMIC_RELAXED, __HIP_MEMORY_SCOPE_WORKGROUP); loc[e1 * 256 + s1] = (unsigned)tok * 2u; wloc[e1 * 256 + s1] = w1_;
            const unsigned s2 = __hip_atomic_fetch_add(&cntl[e2], 1u, __ATOMIC_RELAXED, __HIP_MEMORY_SCOPE_WORKGROUP); loc[e2 * 256 + s2] = (unsigned)tok * 2u + 1u; wloc[e2 * 256 + s2] = w2_;
        }
        __syncthreads();
        if (tid < 16) lbase[tid] = __hip_atomic_fetch_add(&ecnt[tid], cntl[tid], __ATOMIC_RELAXED, __HIP_MEMORY_SCOPE_AGENT);
        __syncthreads();
        for (int e = 0; e < 16; ++e) { const unsigned nn = cntl[e], bs = lbase[e];
            for (unsigned i = tid; i < nn; i += 512) { LIST[(size_t)e * NTOK + bs + i] = loc[e * 256 + i]; WL[(size_t)e * NTOK + bs + i] = wloc[e * 256 + i]; } }
    }
}

struct MoeUnit { int e, tile, n, hoff; };
__device__ __forceinline__ bool moe_find(LAS const int* cnts, int ut, MoeUnit& mu) {
    int pre = 0;
    for (int e = 0; e < 16; ++e) { const int cn = cnts[e], nt = (cn + 127) >> 7; if (ut < pre + nt) { mu.e = e; mu.tile = ut - pre; mu.n = cn - mu.tile * 128; if (mu.n > 128) mu.n = 128; mu.hoff = (pre + mu.tile) * 128; return true; } pre += nt; }
    return false;
}

__device__ __forceinline__ bool moe_item(LAS const int* cnts, int c, int r, int G, MoeUnit& mu, int& nt0, int& nbt) {
    int total = 0;
    for (int e = 0; e < 16; ++e) total += (cnts[e] + 127) >> 7;
    const int extra = total - 2 * G;
    nt0 = 0; nbt = 8;
    if (extra <= 0 || extra * 8 > G) return moe_find(cnts, c + r * G, mu);
    if (r < 2) return moe_find(cnts, c + r * G, mu);
    if (r > 2 || (c >> 3) >= extra) return false;
    nt0 = c & 7; nbt = 1;
    return moe_find(cnts, 2 * G + (c >> 3), mu);
}

template <int AB> __device__ __forceinline__ void phase_moe_fused(PRef p, int l, LAS unsigned char* lds) {
    SG_IDS
    unsigned char* ws = p.ws;
    LAS int* cnts = (LAS int*)(lds + LDS_MISC + 64);
    const unsigned* ecnt = (const unsigned*)(ws + WS_CTL) + CW_ECNT + 64 * l;
    __syncthreads();
    if (tid < 16) cnts[tid] = (int)__hip_atomic_load(&ecnt[tid], __ATOMIC_RELAXED, __HIP_MEMORY_SCOPE_AGENT);
    __syncthreads();
    const unsigned* LIST = (const unsigned*)(ws + WS_LIST); const float* WL = (const float*)(ws + WS_WL);
    const char* XN = (const char*)(ws + WS_HB); const float* RSTD = (const float*)(ws + WS_RSTD);
    bf16_t* Y0 = (bf16_t*)(ws + WS_GA); bf16_t* Y1 = (bf16_t*)(ws + WS_GB);
    constexpr int SLOT = 49152;
    const unsigned lds0 = (unsigned)(uintptr_t)lds;
    const int lrow = tid >> 3, lpos = tid & 7, lchk = lpos ^ ((lrow >> 1) & 7);
    const unsigned dw = lds0 + wid * 1024;
    const unsigned wvo = (unsigned)(lrow * DM + lchk * 8) * 2u;
    const unsigned dvo = (unsigned)(((lrow & ~31) + pg8::perm32(lrow & 31)) * 128 + lchk * 8) * 2u;
    MoeUnit mu, mun; int rnd = 0, nt0 = 0, nbt = 8, nt0n = 0, nbtn = 8;
    if (!moe_item(cnts, BID(), 0, GSZ(), mu, nt0, nbt)) return;
    const char* pa0; const char* pa1; unsigned en0, en1; float wg0, wg1, rs0, rs1;
    const char* pa0n = nullptr; const char* pa1n = nullptr; unsigned en0n = 0, en1n = 0; float wg0n = 0.f, wg1n = 0.f, rs0n = 0.f, rs1n = 0.f;
#define RFL(x) ((unsigned)__builtin_amdgcn_readfirstlane(x))
#define MLOAD1(MU, PA0, PA1, E0_, E1_) do { const unsigned* lst_ = LIST + (size_t)(MU).e * NTOK + (MU).tile * 128; \
        const unsigned g0_ = lst_[lrow < (MU).n ? lrow : (MU).n - 1], g1_ = lst_[lrow + 64 < (MU).n ? lrow + 64 : (MU).n - 1]; \
        PA0 = XN + (size_t)(g0_ >> 1) * 2048 + lchk * 16; PA1 = XN + (size_t)(g1_ >> 1) * 2048 + lchk * 16; \
        const int r0_ = SG_ROW(0), r1_ = SG_ROW(1); E0_ = lst_[r0_ < (MU).n ? r0_ : (MU).n - 1]; E1_ = lst_[r1_ < (MU).n ? r1_ : (MU).n - 1]; } while (0)
#define MLOAD2(MU, E0_, E1_, W0_, W1_, R0_, R1_) do { const float* wl_ = WL + (size_t)(MU).e * NTOK + (MU).tile * 128; const int r0_ = SG_ROW(0), r1_ = SG_ROW(1); \
        const float a0_ = wl_[r0_], a1_ = wl_[r1_]; W0_ = (r0_ < (MU).n) ? a0_ : 0.f; W1_ = (r1_ < (MU).n) ? a1_ : 0.f; R0_ = RSTD[E0_ >> 1]; R1_ = RSTD[E1_ >> 1]; } while (0)
#define ADMA(PA0, PA1, Wp, t, so) do { const int ko_ = (t) * 128; const unsigned o_ = (unsigned)(so); \
        glds16(PA0 + ko_, RFL(dw + o_)); glds16(PA1 + ko_, RFL(dw + o_ + 8192)); \
        glds16s((const char*)(Wp) + ko_, wvo, RFL(dw + o_ + 16384)); glds16s((const char*)((Wp) + (size_t)64 * DM) + ko_, wvo, RFL(dw + o_ + 24576)); \
        glds16s((const char*)((Wp) + (size_t)128 * DM) + ko_, wvo, RFL(dw + o_ + 32768)); glds16s((const char*)((Wp) + (size_t)192 * DM) + ko_, wvo, RFL(dw + o_ + 40960)); } while (0)
#define BDMA(WDp, nt, so) do { const char* b_ = (const char*)((WDp) + (size_t)(nt) * 128 * 128); const unsigned o_ = (unsigned)(so); \
        glds16s(b_, dvo, RFL(dw + o_)); glds16s(b_ + 64 * 128 * 2, dvo, RFL(dw + o_ + 8192)); \
        glds16s(b_ + 128, dvo, RFL(dw + o_ + 16384)); glds16s(b_ + 64 * 128 * 2 + 128, dvo, RFL(dw + o_ + 24576)); } while (0)
#define MWAIT(N) asm volatile("s_waitcnt vmcnt(" #N ") lgkmcnt(0)\n\ts_barrier" ::: "memory")
#define MWAITV(n) do { const int n_ = (n); if (n_ >= 10) MWAIT(10); else if (n_ >= 8) MWAIT(8); else if (n_ >= 6) MWAIT(6); else if (n_ >= 4) MWAIT(4); else MWAIT(0); } while (0)
#define ACOMPUTE(so) do { LAS unsigned char* As = lds + (so); LAS unsigned char* Bg = As + 16384; LAS unsigned char* Bu = As + 32768; \
        _Pragma("unroll") for (int ks = 0; ks < 2; ++ks) { bf16x8 af[2], bg[4], bu[4]; const int ch = ks * 4 + fq; \
            _Pragma("unroll") for (int m = 0; m < 2; ++m) { const int row = wr * 32 + m * 16 + fr; af[m] = *(LAS const bf16x8*)(As + row * 128 + ((ch ^ ((row >> 1) & 7)) << 4)); } \
            _Pragma("unroll") for (int n = 0; n < 4; ++n) { const int row = wc * 64 + n * 16 + fr; const int o_ = row * 128 + ((ch ^ ((row >> 1) & 7)) << 4); bg[n] = *(LAS const bf16x8*)(Bg + o_); bu[n] = *(LAS const bf16x8*)(Bu + o_); } \
            _Pragma("unroll") for (int m = 0; m < 2; ++m) _Pragma("unroll") for (int n = 0; n < 4; ++n) { ag[m][n] = MFMA16(bg[n], af[m], ag[m][n]); au[m][n] = MFMA16(bu[n], af[m], au[m][n]); } } } while (0)
    MLOAD1(mu, pa0, pa1, en0, en1);
    MLOAD2(mu, en0, en1, wg0, wg1, rs0, rs1);
    {
        const bf16_t* W = (const bf16_t*)(ws + WS_WGU) + (size_t)(l * 16 + mu.e) * 256 * DM;
        ADMA(pa0, pa1, W, 0, 0); ADMA(pa0, pa1, W, 1, SLOT);
        MWAIT(6);
    }
    for (;;) {
        const bool has_next = moe_item(cnts, BID(), rnd + 1, GSZ(), mun, nt0n, nbtn);
        const bool full = (mu.n == 128);
        const bf16_t* W = (const bf16_t*)(ws + WS_WGU) + (size_t)(l * 16 + mu.e) * 256 * DM;
        const bf16_t* WD = (const bf16_t*)(ws + WS_WD) + (size_t)(l * 16 + mu.e) * DM * 128;
        f32x4 ag[2][4], au[2][4]; SG_ZERO(ag); SG_ZERO(au);
        int so = 0, so2 = 2 * SLOT;
        for (int t = 0; t < 14; ++t) {
            ADMA(pa0, pa1, W, t + 2, so2);
            ACOMPUTE(so);
            MWAIT(6);
            so += SLOT; if (so == 3 * SLOT) so = 0; so2 += SLOT; if (so2 == 3 * SLOT) so2 = 0;
        }
        BDMA(WD, nt0, SLOT);     ACOMPUTE(2 * SLOT); MWAIT(4);
        BDMA(WD, nbt > 1 ? nt0 + 1 : nt0, 2 * SLOT); ACOMPUTE(0);        MWAIT(4);
        LAS unsigned char* Hs = lds;
#pragma unroll
        for (int m = 0; m < 2; ++m) { const int rl = SG_ROW(m); const float wgt = m ? wg1 : wg0, rs = m ? rs1 : rs0;
#pragma unroll
            for (int n = 0; n < 4; ++n) { f32x4 gv = ag[m][n] * rs, uv = au[m][n] * rs, hv;
#pragma unroll
                for (int i = 0; i < 4; ++i) hv[i] = gv[i] * sigm(gv[i]) * uv[i] * wgt;
                const int chk = 2 * n + (fq >> 1);
                u32x2 w; w.x = cvtpk(hv[0], hv[1]); w.y = cvtpk(hv[2], hv[3]);
                *(LAS u32x2*)(Hs + wc * 16384 + rl * 128 + ((chk ^ ((rl >> 1) & 7)) << 4) + (fq & 1) * 8) = w; } }
        asm volatile("s_waitcnt lgkmcnt(0)\n\ts_barrier" ::: "memory");
        bf16x8 hf[2][4];
#pragma unroll
        for (int m = 0; m < 2; ++m)
#pragma unroll
            for (int kk = 0; kk < 4; ++kk) { const int row = wr * 32 + m * 16 + fr, ch = (kk & 1) * 4 + fq; hf[m][kk] = *(LAS const bf16x8*)(Hs + (kk >> 1) * 16384 + row * 128 + ((ch ^ ((row >> 1) & 7)) << 4)); }
        asm volatile("s_waitcnt lgkmcnt(0)\n\ts_barrier" ::: "memory");
        const bf16_t* Wn = (const bf16_t*)(ws + WS_WGU) + (size_t)(l * 16 + (has_next ? mun.e : mu.e)) * 256 * DM;
#pragma unroll
        for (int jt = 0; jt < 8; ++jt) {
            if (jt >= nbt) break;
            const int nt = nt0 + jt;
            const int sb = ((16 + jt) % 3) * SLOT, sb2 = ((18 + jt) % 3) * SLOT;
            int cnew = 0;
            if (jt + 2 < nbt) { BDMA(WD, nt + 2, sb2); cnew = 4; }
            else if (jt >= 6 && has_next) { ADMA(pa0n, pa1n, Wn, jt - 6, sb2); cnew = 6; }
            if (jt == 0 && has_next) MLOAD1(mun, pa0n, pa1n, en0n, en1n);
            if (jt == 4 && has_next) MLOAD2(mun, en0n, en1n, wg0n, wg1n, rs0n, rs1n);
            f32x4 acc[2][4]; SG_ZERO(acc);
#pragma unroll
            for (int kk = 0; kk < 4; ++kk) {
                bf16x8 bfr[4];
                const int ch = (kk & 1) * 4 + fq;
#pragma unroll
                for (int n = 0; n < 4; ++n) { const int row = wc * 64 + n * 16 + fr; bfr[n] = *(LAS const bf16x8*)(lds + sb + (kk >> 1) * 16384 + row * 128 + ((ch ^ ((row >> 1) & 7)) << 4)); }
#pragma unroll
                for (int m = 0; m < 2; ++m)
#pragma unroll
                    for (int n = 0; n < 4; ++n) acc[m][n] = MFMA16(bfr[n], hf[m][kk], acc[m][n]);
            }
            MWAITV(cnew + ((jt > 0 && full && AB != 5) ? 4 : 0));
#pragma unroll
            for (int m = 0; m < 2; ++m) if (SG_ROW(m) < mu.n) { const unsigned en = m ? en1 : en0; bf16_t* dst = ((en & 1u) ? Y1 : Y0) + (size_t)(en >> 1) * DM + nt * 128 + wc * 64 + 8 * fq;
#pragma unroll
                for (int np = 0; np < 2; ++np) { const f32x4 v0 = acc[m][2 * np], v1 = acc[m][2 * np + 1];
                    if (AB == 5) { asm volatile("" :: "v"(v0), "v"(v1)); continue; }
                    u32x4 w; w.x = cvtpk(v0[0], v0[1]); w.y = cvtpk(v0[2], v0[3]); w.z = cvtpk(v1[0], v1[1]); w.w = cvtpk(v1[2], v1[3]); *(u32x4*)(dst + 32 * np) = w; } }
        }
        if (!has_next) break;
        mu = mun; ++rnd; nt0 = nt0n; nbt = nbtn; pa0 = pa0n; pa1 = pa1n; en0 = en0n; en1 = en1n; wg0 = wg0n; wg1 = wg1n; rs0 = rs0n; rs1 = rs1n;
    }
#undef RFL
#undef MLOAD1
#undef MLOAD2
#undef ADMA
#undef BDMA
#undef MWAIT
#undef MWAITV
#undef ACOMPUTE
}

__device__ __forceinline__ void phase_combine(PRef p, int l, bool dry = false) {
    int tid_ = TIDX(); asm volatile("" : "+v"(tid_));
    const int tid = tid_, lane = tid & 63, wid = tid >> 6;
    unsigned char* ws = p.ws;
    const int gw = BID() * 8 + wid, NGW = GSZ() * 8;
    const bf16_t* Y0 = (const bf16_t*)(ws + WS_GA); const bf16_t* Y1 = (const bf16_t*)(ws + WS_GB);
    bf16_t* HB = (bf16_t*)(ws + WS_HB); bf16_t* HO = dry ? (bf16_t*)(ws + WS_NQ) : HB; float* OUT = dry ? (float*)(ws + WS_NQ) : p.out;
    const bool last = (l == DEPTH - 1);
    for (int m0 = gw * 4; m0 < NTOK; m0 += NGW * 4) {
        u32x2 hv[4][4], ya[4][4], yb[4][4];
#pragma unroll
        for (int rr = 0; rr < 4; ++rr)
#pragma unroll
            for (int j = 0; j < 4; ++j) { const size_t off = (size_t)(m0 + rr) * DM + (64 * j + lane) * 4; hv[rr][j] = *(const u32x2*)(HB + off); ya[rr][j] = *(const u32x2*)(Y0 + off); yb[rr][j] = *(const u32x2*)(Y1 + off); }
#pragma unroll
        for (int rr = 0; rr < 4; ++rr) {
            f32x4 v[4]; float s = 0.f;
#pragma unroll
            for (int j = 0; j < 4; ++j) { const u32x2 h2 = hv[rr][j], a = ya[rr][j], b2 = yb[rr][j];
                v[j] = (f32x4){bflo(h2.x), bfhi(h2.x), bflo(h2.y), bfhi(h2.y)} + (f32x4){bflo(a.x), bfhi(a.x), bflo(a.y), bfhi(a.y)} + (f32x4){bflo(b2.x), bfhi(b2.x), bflo(b2.y), bfhi(b2.y)};
                s += (v[j][0] * v[j][0] + v[j][1] * v[j][1]) + (v[j][2] * v[j][2] + v[j][3] * v[j][3]); }
            const float rstd = rsqrtf(wave_sum(s, lane) * (1.f / 1024.f) + 1e-6f);
            if (last) {
#pragma unroll
                for (int j = 0; j < 4; ++j) { const int cidx = (64 * j + lane) * 4; const f32x4 gg = *(const f32x4*)(p.final_norm_g + cidx); *(f32x4*)(OUT + (size_t)(m0 + rr) * DM + cidx) = v[j] * rstd * gg; }
            } else {
                if (lane == 0 && !dry) ((float*)(ws + WS_RSTD1))[m0 + rr] = rstd;
#pragma unroll
                for (int j = 0; j < 4; ++j) st4bf(HO + (size_t)(m0 + rr) * DM + (64 * j + lane) * 4, v[j]);
            }
        }
    }
}

#define XB_TMO      128
#define XB_XCNT(j)  (256  + 64 * (j))
#define XB_XSUB(j)  (1280 + 64 * (j))
#define XB_XGEN(j)  (2304 + 64 * (j))
#define XB_TOP      3328
#define XB_TOPGEN   3392
#define XCD_BAR_WORDS 3456
#define XB_SPIN_CAP (1u << 18)
__device__ __forceinline__ unsigned xb_ld(unsigned* p)              { return __hip_atomic_load(p, __ATOMIC_RELAXED, __HIP_MEMORY_SCOPE_AGENT); }
__device__ __forceinline__ unsigned xb_add(unsigned* p, unsigned v) { return __hip_atomic_fetch_add(p, v, __ATOMIC_RELAXED, __HIP_MEMORY_SCOPE_AGENT); }
__device__ __forceinline__ unsigned xb_xcc_id() { return (unsigned)__builtin_amdgcn_s_getreg((3 << 11) | 20) & 0xFu; }
#define XB_SPIN(cond, bar) do { unsigned _sp = 0; while (cond) { __builtin_amdgcn_s_sleep(1); \
    if ((++_sp & 255u) == 0u) { if (xb_ld(&(bar)[XB_TMO])) break; if (_sp > XB_SPIN_CAP) { atomicAdd(&(bar)[XB_TMO], 1u); break; } } } } while (0)
struct XcdBarrier { unsigned* bar; unsigned x; volatile LAS unsigned* st; };
__device__ __forceinline__ XcdBarrier xcd_barrier_post(unsigned* bar, volatile LAS unsigned* st) {
    XcdBarrier b; b.bar = bar; b.x = xb_xcc_id(); b.st = st;
    if (TIDX() == 0) (void)xb_add(&bar[XB_XCNT(b.x)], 1u);
    return b;
}
__device__ __forceinline__ void xcd_barrier_complete(unsigned* bar, unsigned x, unsigned& nloc, unsigned& nx) {
    const unsigned G = gridDim.x * gridDim.y * gridDim.z;
    unsigned sum, cnt, mine, sp = 0u;
    for (;;) {
        sum = 0u; cnt = 0u; mine = 0u;
#pragma unroll
        for (unsigned j = 0; j < 16; ++j) { const unsigned c = xb_ld(&bar[XB_XCNT(j)]); sum += c; cnt += (c > 0u) ? 1u : 0u; mine = (j == x) ? c : mine; }
        if (sum == G) break;
        __builtin_amdgcn_s_sleep(1);
        if ((++sp & 255u) == 0u) { if (xb_ld(&bar[XB_TMO])) break; if (sp > XB_SPIN_CAP) { atomicAdd(&bar[XB_TMO], 1u); break; } }
    }
    nloc = mine > 0u ? mine : 1u; nx = cnt > 0u ? cnt : 1u;
}
__device__ __forceinline__ void xcd_barrier(const XcdBarrier& b_) {
    asm volatile("s_waitcnt vmcnt(0)" ::: "memory");
    __syncthreads();
    if (TIDX() == 0) {
        unsigned* bar = b_.bar; asm volatile("" : "+s"(bar));
        XcdBarrier b; b.bar = bar; b.st = b_.st; b.x = xb_xcc_id();
        __builtin_amdgcn_s_waitcnt(0);
        unsigned nloc = b.st[0], nx = b.st[1];
        if (nloc == 0u) { xcd_barrier_complete(bar, b.x, nloc, nx); b.st[0] = nloc; b.st[1] = nx; }
        const unsigned old = xb_add(&bar[XB_XSUB(b.x)], 1u);
        const unsigned gen = old / nloc;
        if (old + 1u == (gen + 1u) * nloc) {
            __builtin_amdgcn_fence(__ATOMIC_RELEASE, "agent");
            asm volatile("s_waitcnt vmcnt(0)" ::: "memory");
            const unsigned og = xb_add(&bar[XB_TOP], 1u);
            const unsigned tg = og / nx;
            if (og + 1u == (tg + 1u) * nx) xb_add(&bar[XB_TOPGEN], 1u);
            else XB_SPIN(xb_ld(&bar[XB_TOPGEN]) == tg, bar);
            __builtin_amdgcn_fence(__ATOMIC_ACQUIRE, "agent");
            xb_add(&bar[XB_XGEN(b.x)], 1u);
            asm volatile("s_waitcnt vmcnt(0)" ::: "memory");
        } else {
            XB_SPIN(xb_ld(&bar[XB_XGEN(b.x)]) == gen, bar);
            __builtin_amdgcn_fence(__ATOMIC_ACQUIRE, "agent");
            asm volatile("s_waitcnt vmcnt(0)" ::: "memory");
        }
    }
    __syncthreads();
}

template <int K> __device__ __forceinline__ void run_phase(PRef p, int l, LAS unsigned char* lds, bool dry = false) {
    unsigned* ctl = (unsigned*)(p.ws + WS_CTL);
    if (K == 0) phase_prologue(p, lds);
    if (K == 1) { if (dry) phase_inproj_pg8<ABL>(p, l, lds); else { phase_inproj_pg8<0>(p, l, lds); if (l + 1 < DEPTH) { __syncthreads(); weight_prep(p, l + 1, lds); } } }
    if (K == 2) { unsigned* ctr = ctl + CW_QCTR + 64 * (l * 2 + 0) + (dry ? 16 : 0);
        int u = next_unit(ctr, lds);
        while (u < 64 + 1024) { if (u < 64) compress_unit(p, l, u, lds, ctr); else { if (dry) diff_unit<ABL>(p, l, u - 64, lds, true, ctr); else diff_unit<0>(p, l, u - 64, lds, false, ctr); }
            __syncthreads(); u = __builtin_amdgcn_readfirstlane(((LAS int*)(lds + LDS_MISC))[1]); } }
    if (K == 3) { unsigned* ctr = ctl + CW_QCTR + 64 * (l * 2 + 1) + (dry ? 16 : 0);
        int u = next_unit(ctr, lds);
        while (u < 1024) { if (dry) nsa_unit<ABL>(p, l, u, lds, true, ctr); else nsa_unit<0>(p, l, u, lds, false, ctr);
            __syncthreads(); u = __builtin_amdgcn_readfirstlane(((LAS int*)(lds + LDS_MISC))[1]); } }
    if (K == 4) phase_merge_pg8(p, l, lds);
    if (K == 5) phase_outproj_pg8(p, l, lds, dry);
    if (K == 6) phase_router(p, l, lds, dry);
    if (K == 7) { if (dry) phase_moe_fused<ABL>(p, l, lds); else phase_moe_fused<0>(p, l, lds); }
    if (K == 9) phase_combine(p, l, dry);
}
#if MK_MULTI
template <int K> __global__ void __launch_bounds__(512, 2) mk_one(Params p) {
    extern __shared__ __attribute__((aligned(16))) unsigned char lds_raw[];
    const __attribute__((address_space(4))) Params* pp_ = (const __attribute__((address_space(4))) Params*)__builtin_amdgcn_kernarg_segment_ptr();
    if ((threadIdx.x & 63) == 0) ((LAS int*)(size_t)LDS_WTAB)[hw_wave_key()] = (int)(threadIdx.x >> 6);
    __syncthreads();
    run_phase<K>(*pp_, p.ph_lo, (LAS unsigned char*)lds_raw);
}
template <int K> static void launch_one(int grid, hipStream_t stream, Params p, int l) {
    static bool attr = false;
    if (!attr) { (void)hipFuncSetAttribute((const void*)mk_one<K>, hipFuncAttributeMaxDynamicSharedMemorySize, LDS_BYTES); attr = true; }
    p.ph_lo = l; p.ph_hi = l + 1;
    hipLaunchKernelGGL(mk_one<K>, dim3(grid), dim3(512), LDS_BYTES, stream, p);
}
#else
__global__ void __launch_bounds__(512, 2) mk_fwd(Params p) {
    extern __shared__ __attribute__((aligned(16))) unsigned char lds_raw[];
    LAS unsigned char* lds = (LAS unsigned char*)lds_raw;
    volatile LAS unsigned* bst = (volatile LAS unsigned*)(lds + LDS_MISC + 256);
    if ((threadIdx.x & 63) == 0) ((LAS int*)(size_t)LDS_WTAB)[hw_wave_key()] = (int)(threadIdx.x >> 6);
    if (threadIdx.x < 2) bst[threadIdx.x] = 0u;
    __syncthreads();
    const XcdBarrier bar = xcd_barrier_post((unsigned*)(p.ws + WS_CTL) + CW_BAR, bst);
#define SEAM() xcd_barrier(bar)
#ifndef PROBE_DUP
#define PROBE_DUP -1
#endif
#ifndef PROBE_DUP2
#define PROBE_DUP2 -1
#endif
#define RUN(K, l) do { const __attribute__((address_space(4))) Params* pp_ = (const __attribute__((address_space(4))) Params*)__builtin_amdgcn_kernarg_segment_ptr(); asm volatile("" : "+s"(pp_)); \
    if (K == PROBE_DUP || K == PROBE_DUP2) { run_phase<K>(*pp_, l, lds, true); SEAM(); } run_phase<K>(*pp_, l, lds); } while (0)
    RUN(0, 0); SEAM();
    for (int l = 0; l < DEPTH; ++l) {
        RUN(1, l); SEAM();
        RUN(2, l); SEAM();
        RUN(3, l); SEAM();
        RUN(4, l); SEAM();
        RUN(5, l); SEAM();
        RUN(6, l); SEAM();
        RUN(7, l); SEAM();
        RUN(9, l); if (l + 1 < DEPTH) SEAM();
    }
}
#endif

extern "C" void kernel_launch(void* const* d_in, const int* in_sizes, int n_in, void* d_out, int out_size, void* d_ws, size_t ws_size, hipStream_t stream) {
    static int grid = 0;
    if (grid == 0) {
        if (n_in != 22 || in_sizes[0] != NTOK * DM || out_size != NTOK * DM || ws_size < WS_END) { fprintf(stderr, "kernel_launch: unexpected shapes (n_in %d, in0 %d, out %d, ws %zu)\n", n_in, n_in > 0 ? in_sizes[0] : -1, out_size, ws_size); grid = -1; return; }
        int dev = 0, cus = 0, per_cu = 1;
        (void)hipGetDevice(&dev); (void)hipDeviceGetAttribute(&cus, hipDeviceAttributeMultiprocessorCount, dev);
#if !MK_MULTI
        (void)hipFuncSetAttribute((const void*)mk_fwd, hipFuncAttributeMaxDynamicSharedMemorySize, LDS_BYTES);
        (void)hipOccupancyMaxActiveBlocksPerMultiprocessor(&per_cu, (const void*)mk_fwd, 512, LDS_BYTES);
        if (per_cu < 1) { fprintf(stderr, "kernel_launch: occupancy query says %d blocks per CU\n", per_cu); per_cu = 1; }
#endif
        (void)hipGetLastError();
        grid = cus * per_cu;
    }
    if (grid < 0) return;
    (void)hipMemsetAsync((char*)d_ws + WS_CTL, 0, CTL_BYTES, stream);
    Params p{};
    const float** pp = (const float**)&p;
    for (int i = 0; i < 22; ++i) pp[i] = (const float*)d_in[i];
    p.out = (float*)d_out; p.ws = (unsigned char*)d_ws;
#if MK_MULTI
    launch_one<0>(grid, stream, p, 0);
    for (int l = 0; l < DEPTH; ++l) {
        launch_one<1>(grid, stream, p, l); launch_one<2>(grid, stream, p, l); launch_one<3>(grid, stream, p, l); launch_one<4>(grid, stream, p, l); launch_one<5>(grid, stream, p, l);
        launch_one<6>(grid, stream, p, l); launch_one<7>(grid, stream, p, l); launch_one<9>(grid, stream, p, l);
    }
#else
    p.ph_lo = 0; p.ph_hi = NPHASE;
    void* args[] = {&p};
    hipError_t e = hipLaunchCooperativeKernel((const void*)mk_fwd, dim3(grid), dim3(512), args, LDS_BYTES, stream);
    if (e != hipSuccess) fprintf(stderr, "cooperative launch failed: %s (grid %d)\n", hipGetErrorString(e), grid);
#endif
}
```
